# Optimizing an MI355X kernel written in HIP

```python
import math
import jax, jax.numpy as jnp
from jax import lax
import numpy as np

D_MODEL = 1024
BATCH = 4
SEQ = 8192
DEPTH = 2
DEC_BATCH = 4
DEC_SEQ = 4096
PAST_LEN = 128

EPS = 1e-6
RG_WIDTH = D_MODEL // 2
RG_BLOCKS = 8
RG_BLOCK_DIM = RG_WIDTH // RG_BLOCKS
RG_CONV_W = 4
RG_C = 8.0
DA_HEADS = 8
DA_HEAD_DIM = 64
DA_WIDTH = DA_HEADS * DA_HEAD_DIM
DILATED_PATTERNS = ((128, 1), (512, 4), (2048, 16))
DA_HALF_STEPS = 64
DA_BLOCK = 64
AB_IN_COLS = 2 * RG_WIDTH + 3 * DA_WIDTH
MLA_HEADS = 16
MLA_Q_RANK = 384
MLA_KV_RANK = 256
MLA_NOPE = 64
MLA_ROPE = 32
MLA_V = 64
MLA_QK = MLA_NOPE + MLA_ROPE
MLA_IN_COLS = MLA_Q_RANK + MLA_KV_RANK + MLA_ROPE
MLA_Q_BLOCK = 128
ROPE_THETA = 10000.0
FFN_HIDDEN = int(math.ceil(8 * D_MODEL / 3 / 256) * 256)
NEG_BIG = -1e30
N_AB = (DEPTH + 1) // 2
N_C = DEPTH // 2

kernel_name = "hybrid_rglru_dilated_mla_encoder"


def _rmsnorm(x, g):
    xf = x.astype(jnp.float32)
    y = xf * lax.rsqrt(jnp.mean(xf * xf, axis=-1, keepdims=True) + EPS)
    return (y * g.astype(jnp.float32)).astype(x.dtype)


def _swiglu(h, w_gate, w_up, w_down):
    return (jax.nn.silu(h @ w_gate) * (h @ w_up)) @ w_down


def _depthwise_conv(x, w):
    C = x.shape[-1]
    return lax.conv_general_dilated(
        x, w[:, None, :], window_strides=(1,), padding=[(2, 1)],
        dimension_numbers=("NWC", "WIO", "NWC"), feature_group_count=C)


def _lin_combine(c1, c2):
    a1, b1 = c1
    a2, b2 = c2
    return a1 * a2, a2 * b1 + b2


def _rglru_direction(x, w_a, b_a, w_i, b_i, lam, reverse):
    B, S, C = x.shape
    xb = x.reshape(B, S, RG_BLOCKS, RG_BLOCK_DIM)
    r = jax.nn.sigmoid(jnp.einsum("bshi,hij->bshj", xb, w_a).reshape(B, S, C) + b_a)
    gi = jax.nn.sigmoid(jnp.einsum("bshi,hij->bshj", xb, w_i).reshape(B, S, C) + b_i)
    log_a = -RG_C * r * jax.nn.softplus(-lam.astype(jnp.float32))
    a = jnp.exp(log_a)
    u = jnp.sqrt(-jnp.expm1(2.0 * log_a)) * (gi * x)
    _, h = lax.associative_scan(_lin_combine, (a, u), reverse=reverse, axis=1)
    return h


def _dilated_branch(q, k, v, dil, slopes):
    B, S, H, Dh = q.shape
    L = S // dil
    nb = -(-L // DA_BLOCK)
    Lp = nb * DA_BLOCK

    def to_res(t):
        return t.reshape(B, L, dil, H, Dh).transpose(0, 2, 1, 3, 4)

    qr = jnp.pad(to_res(q), ((0, 0), (0, 0), (0, Lp - L), (0, 0), (0, 0)))
    qr = qr.reshape(B, dil, nb, DA_BLOCK, H, Dh)

    def windows(t):
        tp = jnp.pad(to_res(t), ((0, 0), (0, 0), (DA_BLOCK, Lp - L + DA_BLOCK), (0, 0), (0, 0)))
        tp = tp.reshape(B, dil, nb + 2, DA_BLOCK, H, Dh)
        return jnp.concatenate([tp[:, :, :-2], tp[:, :, 1:-1], tp[:, :, 2:]], axis=3)

    kw = windows(k)
    vw = windows(v)
    s = jnp.einsum("bdnqhc,bdnkhc->bdnhqk", qr, kw,
                   preferred_element_type=jnp.float32) * (1.0 / math.sqrt(Dh))
    qi = jnp.arange(nb)[:, None] * DA_BLOCK + jnp.arange(DA_BLOCK)[None, :]
    kj = jnp.arange(nb)[:, None] * DA_BLOCK - DA_BLOCK + jnp.arange(3 * DA_BLOCK)[None, :]
    rel = kj[:, None, :] - qi[:, :, None]
    valid = (jnp.abs(rel) <= DA_HALF_STEPS) & (kj[:, None, :] >= 0) & (kj[:, None, :] < L)
    dist = (dil * jnp.abs(rel)).astype(jnp.float32)
    bias = -slopes[None, :, None, None] * dist[:, None, :, :]
    s = jnp.where(valid[:, None, :, :], s + bias, NEG_BIG)
    lse = jax.nn.logsumexp(s, axis=-1)
    p = jnp.exp(s - lse[..., None])
    o = jnp.einsum("bdnhqk,bdnkhc->bdnqhc", p, vw.astype(jnp.float32))
    o = o.reshape(B, dil, Lp, H, Dh)[:, :, :L].transpose(0, 2, 1, 3, 4).reshape(B, S, H, Dh)
    lse = lse.transpose(0, 1, 2, 4, 3).reshape(B, dil, Lp, H)[:, :, :L]
    lse = lse.transpose(0, 2, 1, 3).reshape(B, S, H)
    return o, lse


def _alibi_slopes(n):
    return jnp.asarray([2.0 ** (-8.0 * (h + 1) / n) for h in range(n)], dtype=jnp.float32)


def _mixer_ab(h, w_in, conv_w, conv_b, w_a, b_a, w_i, b_i, lam, w_out):
    B, S, _ = h.shape
    proj = h @ w_in
    xr, gate, q, k, v = jnp.split(proj, 5, axis=-1)
    xr = (_depthwise_conv(xr, conv_w) + conv_b).astype(jnp.float32)
    hr = (_rglru_direction(xr, w_a[0], b_a[0], w_i[0], b_i[0], lam[0], False)
          + _rglru_direction(xr, w_a[1], b_a[1], w_i[1], b_i[1], lam[1], True))
    y_rnn = jax.nn.gelu(gate.astype(jnp.float32)) * hr
    q = q.reshape(B, S, DA_HEADS, DA_HEAD_DIM)
    k = k.reshape(B, S, DA_HEADS, DA_HEAD_DIM)
    v = v.reshape(B, S, DA_HEADS, DA_HEAD_DIM)
    slopes = _alibi_slopes(DA_HEADS)
    outs, lses = [], []
    for _, dil in DILATED_PATTERNS:
        o_g, lse_g = _dilated_branch(q, k, v, dil, slopes)
        outs.append(o_g)
        lses.append(lse_g)
    wgt = jax.nn.softmax(jnp.stack(lses, axis=0), axis=0)
    o = jnp.sum(wgt[..., None] * jnp.stack(outs, axis=0), axis=0)
    y = jnp.concatenate([y_rnn, o.reshape(B, S, DA_WIDTH)], axis=-1).astype(h.dtype)
    return y @ w_out


def _rope_tables(S):
    inv_freq = 1.0 / (ROPE_THETA ** (jnp.arange(0, MLA_ROPE, 2, dtype=jnp.float32) / MLA_ROPE))
    ang = jnp.arange(S, dtype=jnp.float32)[:, None] * inv_freq[None, :]
    return jnp.cos(ang), jnp.sin(ang)


def _rope(t, cos, sin):
    t = t.astype(jnp.float32)
    t1, t2 = jnp.split(t, 2, axis=-1)
    c = cos[None, :, None, :]
    s = sin[None, :, None, :]
    return jnp.concatenate([t1 * c - t2 * s, t1 * s + t2 * c], axis=-1)


def _mixer_mla(h, w_in, q_norm, w_qb, kv_norm, w_kvb, w_out, cos, sin):
    B, S, _ = h.shape
    proj = h @ w_in
    cq = proj[..., :MLA_Q_RANK]
    ckv = proj[..., MLA_Q_RANK:MLA_Q_RANK + MLA_KV_RANK]
    k_rope = proj[..., MLA_Q_RANK + MLA_KV_RANK:]
    qh = (_rmsnorm(cq, q_norm) @ w_qb).reshape(B, S, MLA_HEADS, MLA_QK)
    kvh = (_rmsnorm(ckv, kv_norm) @ w_kvb).reshape(B, S, MLA_HEADS, MLA_NOPE + MLA_V)
    q = jnp.concatenate([qh[..., :MLA_NOPE].astype(jnp.float32),
                         _rope(qh[..., MLA_NOPE:], cos, sin)], axis=-1)
    kr = _rope(k_rope[:, :, None, :], cos, sin)
    k = jnp.concatenate([kvh[..., :MLA_NOPE].astype(jnp.float32),
                         jnp.broadcast_to(kr, (B, S, MLA_HEADS, MLA_ROPE))], axis=-1)
    v = kvh[..., MLA_NOPE:].astype(jnp.float32)
    scale = 1.0 / math.sqrt(MLA_QK)
    nq = S // MLA_Q_BLOCK
    qb = q.reshape(B, nq, MLA_Q_BLOCK, MLA_HEADS, MLA_QK).transpose(1, 0, 2, 3, 4)

    def attend(qblk):
        s = jnp.einsum("bqhc,bkhc->bhqk", qblk, k) * scale
        p = jax.nn.softmax(s, axis=-1)
        return jnp.einsum("bhqk,bkhc->bqhc", p, v)

    o = lax.map(attend, qb)
    o = o.transpose(1, 0, 2, 3, 4).reshape(B, S, MLA_HEADS * MLA_V).astype(h.dtype)
    return o @ w_out


def _trunk(x, norm_mix, norm_ffn, norm_final,
           ab_w_in, ab_conv_w, ab_conv_b, rg_w_a, rg_b_a, rg_w_i, rg_b_i, rg_lam, ab_w_out,
           mla_w_in, mla_q_norm, mla_w_qb, mla_kv_norm, mla_w_kvb, mla_w_out,
           ffn_w_gate, ffn_w_up, ffn_w_down):
    S = x.shape[1]
    cos, sin = _rope_tables(S)
    for layer in range(DEPTH):
        h = _rmsnorm(x, norm_mix[layer])
        j = layer // 2
        if layer % 2 == 0:
            y = _mixer_ab(h, ab_w_in[j], ab_conv_w[j], ab_conv_b[j], rg_w_a[j], rg_b_a[j],
                          rg_w_i[j], rg_b_i[j], rg_lam[j], ab_w_out[j])
        else:
            y = _mixer_mla(h, mla_w_in[j], mla_q_norm[j], mla_w_qb[j], mla_kv_norm[j],
                           mla_w_kvb[j], mla_w_out[j], cos, sin)
        x = x + y
        h = _rmsnorm(x, norm_ffn[layer])
        x = x + _swiglu(h, ffn_w_gate[layer], ffn_w_up[layer], ffn_w_down[layer])
    return _rmsnorm(x, norm_final)


def setup_inputs(seed: int = 0) -> dict:
    key = jax.random.key(seed)
    ks = jax.random.split(key, 32)
    f32 = jnp.float32

    def w(k, shape, fan_in, gain=1.0):
        return jax.random.normal(k, shape, f32) * (gain * fan_in ** -0.5)

    def gain(k, shape):
        return 1.0 + 0.02 * jax.random.normal(k, shape, f32)

    def bias(k, shape):
        return 0.02 * jax.random.normal(k, shape, f32)

    a0 = jax.random.uniform(ks[12], (N_AB, 2, RG_WIDTH), f32, 0.9, 0.999)
    return {
        "x_prompt": jax.random.normal(ks[0], (BATCH, SEQ, D_MODEL), f32),
        "x_sample": jax.random.normal(ks[1], (DEC_BATCH, DEC_SEQ, D_MODEL), f32),
        "norm_mix": gain(ks[2], (DEPTH, D_MODEL)),
        "norm_ffn": gain(ks[3], (DEPTH, D_MODEL)),
        "norm_final": gain(ks[4], (D_MODEL,)),
        "ab_w_in": w(ks[5], (N_AB, D_MODEL, AB_IN_COLS), D_MODEL),
        "ab_conv_w": w(ks[6], (N_AB, RG_CONV_W, RG_WIDTH), RG_CONV_W),
        "ab_conv_b": bias(ks[7], (N_AB, RG_WIDTH)),
        "rg_w_a": w(ks[8], (N_AB, 2, RG_BLOCKS, RG_BLOCK_DIM, RG_BLOCK_DIM), RG_BLOCK_DIM),
        "rg_b_a": bias(ks[9], (N_AB, 2, RG_WIDTH)),
        "rg_w_i": w(ks[10], (N_AB, 2, RG_BLOCKS, RG_BLOCK_DIM, RG_BLOCK_DIM), RG_BLOCK_DIM),
        "rg_b_i": bias(ks[11], (N_AB, 2, RG_WIDTH)),
        "rg_lam": jnp.log(a0) - jnp.log1p(-a0),
        "ab_w_out": w(ks[13], (N_AB, RG_WIDTH + DA_WIDTH, D_MODEL), RG_WIDTH + DA_WIDTH, 0.5),
        "mla_w_in": w(ks[14], (N_C, D_MODEL, MLA_IN_COLS), D_MODEL),
        "mla_q_norm": gain(ks[15], (N_C, MLA_Q_RANK)),
        "mla_w_qb": w(ks[16], (N_C, MLA_Q_RANK, MLA_HEADS * MLA_QK), MLA_Q_RANK),
        "mla_kv_norm": gain(ks[17], (N_C, MLA_KV_RANK)),
        "mla_w_kvb": w(ks[18], (N_C, MLA_KV_RANK, MLA_HEADS * (MLA_NOPE + MLA_V)), MLA_KV_RANK),
        "mla_w_out": w(ks[19], (N_C, MLA_HEADS * MLA_V, D_MODEL), MLA_HEADS * MLA_V, 0.5),
        "ffn_w_gate": w(ks[20], (DEPTH, D_MODEL, FFN_HIDDEN), D_MODEL),
        "ffn_w_up": w(ks[21], (DEPTH, D_MODEL, FFN_HIDDEN), D_MODEL),
        "ffn_w_down": w(ks[22], (DEPTH, FFN_HIDDEN, D_MODEL), FFN_HIDDEN, 0.5),
    }


def reference(x_prompt, x_sample, norm_mix, norm_ffn, norm_final,
              ab_w_in, ab_conv_w, ab_conv_b, rg_w_a, rg_b_a, rg_w_i, rg_b_i, rg_lam, ab_w_out,
              mla_w_in, mla_q_norm, mla_w_qb, mla_kv_norm, mla_w_kvb, mla_w_out,
              ffn_w_gate, ffn_w_up, ffn_w_down):
    params = (norm_mix, norm_ffn, norm_final,
              ab_w_in, ab_conv_w, ab_conv_b, rg_w_a, rg_b_a, rg_w_i, rg_b_i, rg_lam, ab_w_out,
              mla_w_in, mla_q_norm, mla_w_qb, mla_kv_norm, mla_w_kvb, mla_w_out,
              ffn_w_gate, ffn_w_up, ffn_w_down)
    y_prompt = _trunk(x_prompt, *params)
    y_sample = _trunk(x_sample, *params)
    return (y_prompt, y_sample)
```

```cpp
#include <hip/hip_runtime.h>
#include <hip/hip_cooperative_groups.h>
#include <cstdint>
#include <cstdio>
namespace cg = cooperative_groups;

#ifndef SINGLE_LAUNCH
#define SINGLE_LAUNCH 1
#endif

typedef unsigned short u16;
typedef short bf16x8 __attribute__((ext_vector_type(8)));
typedef short s16x4 __attribute__((ext_vector_type(4)));
typedef float f32x16 __attribute__((ext_vector_type(16)));
typedef float f32x4 __attribute__((ext_vector_type(4)));
typedef float f32x2 __attribute__((ext_vector_type(2)));
typedef unsigned u32x4 __attribute__((ext_vector_type(4)));
typedef unsigned u32x2 __attribute__((ext_vector_type(2)));
typedef __bf16 bf2_t __attribute__((ext_vector_type(2)));
#define DI __device__ __forceinline__
#define MFMA32(a, b, c) __builtin_amdgcn_mfma_f32_32x32x16_bf16((a), (b), (c), 0, 0, 0)

constexpr int M_TOT = 49152, M_P = 32768, DM = 1024, FH = 2816;
constexpr float LOG2E = 1.4426950408889634f;
constexpr size_t MiB = 1ull << 20;
constexpr size_t WT_ABIN = 0;
constexpr size_t WT_ABOUT = WT_ABIN + 2560ull * 1024 * 2;
constexpr size_t WT_GU0 = WT_ABOUT + 1024ull * 1024 * 2;
constexpr size_t WT_DOWN0 = WT_GU0 + 5632ull * 1024 * 2;
constexpr size_t WT_MLAIN = WT_DOWN0 + 1024ull * 2816 * 2;
constexpr size_t WT_QB = WT_MLAIN + 768ull * 1024 * 2;
constexpr size_t WT_KVB = WT_QB + 1536ull * 384 * 2;
constexpr size_t WT_MLAOUT = WT_KVB + 2048ull * 256 * 2;
constexpr size_t WT_GU1 = WT_MLAOUT + 1024ull * 1024 * 2;
constexpr size_t WT_DOWN1 = WT_GU1 + 5632ull * 1024 * 2;
constexpr size_t WT_GATES = WT_DOWN1 + 1024ull * 2816 * 2;
constexpr size_t WT_END = WT_GATES + 32ull * 4096 * 2;
static_assert(WT_END <= 46 * MiB, "weights region");
constexpr size_t OFF_SUM = 46 * MiB;
constexpr size_t OFF_KR = 46 * MiB;
constexpr size_t OFF_COS = 52 * MiB;
constexpr size_t OFF_SIN = 52 * MiB + 512 * 1024;
constexpr size_t OFF_H = 54 * MiB;
constexpr size_t OFF_CQN = 54 * MiB;
constexpr size_t OFF_CKVN = 90 * MiB;
constexpr size_t OFF_O = 54 * MiB;
constexpr size_t OFF_PROJ = 150 * MiB;
constexpr size_t OFF_ACT = 150 * MiB;
constexpr size_t OFF_P2 = 150 * MiB;
constexpr size_t OFF_Q = 150 * MiB;
constexpr size_t OFF_KV = 294 * MiB;
constexpr size_t OFF_Y = 390 * MiB;
constexpr size_t OFF_CARRY = 486 * MiB;
constexpr size_t WS_NEED = 490 * MiB;

struct Params {
  const float* xin0; const float* xin1;
  const float* norm_mix; const float* norm_ffn; const float* norm_final;
  const float* ab_w_in; const float* conv_w; const float* conv_b;
  const float* w_a; const float* b_a; const float* w_i; const float* b_i; const float* lam; const float* ab_w_out;
  const float* mla_w_in; const float* q_norm; const float* w_qb; const float* kv_norm; const float* w_kvb; const float* mla_w_out;
  const float* w_gate; const float* w_up; const float* w_down;
  float* out; char* ws;
};

DI float bf2f(u16 v) { return __uint_as_float(((unsigned)v) << 16); }
DI float bfs2f(short v) { return __uint_as_float(((unsigned)(u16)v) << 16); }
DI unsigned pk2(float lo, float hi) { f32x2 v = {lo, hi}; bf2_t r = __builtin_convertvector(v, bf2_t); return __builtin_bit_cast(unsigned, r); }
DI u16 f2bf(float a) { return (u16)(pk2(a, 0.f) & 0xffffu); }
DI int crow(int r, int hi) { return (r & 3) + 8 * (r >> 2) + 4 * hi; }
DI float sigmoidf_(float x) { return 1.f / (1.f + __expf(-x)); }
DI float pl32_max(float v) { auto rr = __builtin_amdgcn_permlane32_swap(__float_as_uint(v), __float_as_uint(v), false, false); return fmaxf(__uint_as_float(rr[0]), __uint_as_float(rr[1])); }
DI float pl32_sum(float v) { auto rr = __builtin_amdgcn_permlane32_swap(__float_as_uint(v), __float_as_uint(v), false, false); return __uint_as_float(rr[0]) + __uint_as_float(rr[1]); }
DI s16x4 tr_read(unsigned addr) { s16x4 r; asm volatile("ds_read_b64_tr_b16 %0, %1" : "=&v"(r) : "v"(addr) : "memory"); return r; }
#define LGKM0() do { asm volatile("s_waitcnt lgkmcnt(0)" ::: "memory"); __builtin_amdgcn_sched_barrier(0); } while (0)
DI bf16x8 cat4(s16x4 l, s16x4 h) { return (bf16x8){l[0], l[1], l[2], l[3], h[0], h[1], h[2], h[3]}; }
DI bf16x8 pack8(const f32x16& x, int s) {
  u32x4 w = {pk2(x[8 * s + 0], x[8 * s + 1]), pk2(x[8 * s + 2], x[8 * s + 3]), pk2(x[8 * s + 4], x[8 * s + 5]), pk2(x[8 * s + 6], x[8 * s + 7])};
  return __builtin_bit_cast(bf16x8, w);
}
DI void row_info(int m, int& seq_lo, int& S) { if (m < M_P) { seq_lo = m & ~8191; S = 8192; } else { seq_lo = M_P + ((m - M_P) & ~4095); S = 4096; } }

DI void tr_job(const float* __restrict__ src, int K, int N, u16* __restrict__ dst, int mode, float* tile, int bid, int nb, int& rot) {
  const int tk = K >> 6, tn = (N + 63) >> 6, nt = tk * tn;
  const int tx = threadIdx.x & 63, ty = threadIdx.x >> 6;
  for (int t = (bid + nb - rot) % nb; t < nt; t += nb) {
    const int k0 = (t / tn) << 6, n0 = (t % tn) << 6;
    __syncthreads();
#pragma unroll 4
    for (int r = 0; r < 16; ++r) { const int kk = ty + 4 * r, n = n0 + tx; tile[kk * 65 + tx] = n < N ? src[(size_t)(k0 + kk) * N + n] : 0.f; }
    __syncthreads();
#pragma unroll 4
    for (int r = 0; r < 16; ++r) {
      const int nn = ty + 4 * r, n = n0 + nn;
      if (n < N) { const int row = mode == 0 ? n : ((n >> 5) * 64 + (n & 31) + (mode == 2 ? 32 : 0)); dst[(size_t)row * K + k0 + tx] = f2bf(tile[tx * 65 + nn]); }
    }
  }
  rot = (rot + nt) % nb;
}

DI void rmsnorm_phase(const float* __restrict__ s0, const float* __restrict__ s1, const float* __restrict__ g, u16* outb, float* outf, int gw, int nw) {
  const int lane = threadIdx.x & 63;
  for (int m = gw; m < M_TOT; m += nw) {
    const float* src = m < M_P ? s0 + (size_t)m * DM : s1 + (size_t)(m - M_P) * DM;
    f32x4 v[4];
#pragma unroll
    for (int i = 0; i < 4; ++i) v[i] = *(const f32x4*)(src + i * 256 + lane * 4);
    float ss = 0.f;
#pragma unroll
    for (int i = 0; i < 4; ++i) ss += v[i][0] * v[i][0] + v[i][1] * v[i][1] + v[i][2] * v[i][2] + v[i][3] * v[i][3];
#pragma unroll
    for (int o = 32; o > 0; o >>= 1) ss += __shfl_xor(ss, o);
    const float rs = rsqrtf(ss * (1.f / 1024.f) + 1e-6f);
#pragma unroll
    for (int i = 0; i < 4; ++i) {
      const f32x4 gg = *(const f32x4*)(g + i * 256 + lane * 4);
      const f32x4 y = v[i] * rs * gg;
      if (outb) { u32x2 w = {pk2(y[0], y[1]), pk2(y[2], y[3])}; *(u32x2*)(outb + (size_t)m * DM + i * 256 + lane * 4) = w; }
      else *(f32x4*)(outf + (size_t)m * DM + i * 256 + lane * 4) = y;
    }
  }
}

DI void prep_phase(const Params& p, char* lds, int bid, int nb) {
  float* tile = (float*)lds;
  char* ws = p.ws;
  int rot = 0;
  tr_job(p.ab_w_in, 1024, 2560, (u16*)(ws + WT_ABIN), 0, tile, bid, nb, rot);
  tr_job(p.ab_w_out, 1024, 1024, (u16*)(ws + WT_ABOUT), 0, tile, bid, nb, rot);
  tr_job(p.w_gate, 1024, FH, (u16*)(ws + WT_GU0), 1, tile, bid, nb, rot);
  tr_job(p.w_up, 1024, FH, (u16*)(ws + WT_GU0), 2, tile, bid, nb, rot);
  tr_job(p.w_gate + (size_t)1024 * FH, 1024, FH, (u16*)(ws + WT_GU1), 1, tile, bid, nb, rot);
  tr_job(p.w_up + (size_t)1024 * FH, 1024, FH, (u16*)(ws + WT_GU1), 2, tile, bid, nb, rot);
  tr_job(p.w_down, FH, 1024, (u16*)(ws + WT_DOWN0), 0, tile, bid, nb, rot);
  tr_job(p.w_down + (size_t)FH * 1024, FH, 1024, (u16*)(ws + WT_DOWN1), 0, tile, bid, nb, rot);
  tr_job(p.mla_w_in, 1024, 672, (u16*)(ws + WT_MLAIN), 0, tile, bid, nb, rot);
  tr_job(p.w_qb, 384, 1536, (u16*)(ws + WT_QB), 0, tile, bid, nb, rot);
  tr_job(p.w_kvb, 256, 2048, (u16*)(ws + WT_KVB), 0, tile, bid, nb, rot);
  tr_job(p.mla_w_out, 1024, 1024, (u16*)(ws + WT_MLAOUT), 0, tile, bid, nb, rot);
  for (int dg = 0; dg < 32; ++dg) {
    const int cb = dg & 7, gate = (dg >> 3) & 1, dir = dg >> 4;
    const float* src = (gate == 0 ? p.w_a : p.w_i) + (size_t)(dir * 8 + cb) * 4096;
    tr_job(src, 64, 64, (u16*)(ws + WT_GATES) + (size_t)dg * 4096, 0, tile, bid, nb, rot);
  }
  const int gtid = bid * 256 + threadIdx.x, gn = nb * 256;
  { u16* d = (u16*)(ws + WT_MLAIN) + (size_t)672 * 1024; for (int i = gtid; i < 96 * 1024; i += gn) d[i] = 0; }
  { float* ct = (float*)(ws + OFF_COS); float* st = (float*)(ws + OFF_SIN);
    for (int i = gtid; i < 8192 * 16; i += gn) {
      const int pos = i >> 4, k = i & 15;
      const float inv_freq = 1.0f / powf(10000.0f, (float)(2 * k) / 32.0f);
      const float ang = (float)pos * inv_freq;
      double f = (double)ang * 0.15915494309189535; f -= rint(f);
      ct[i] = __builtin_amdgcn_cosf((float)f); st[i] = __builtin_amdgcn_sinf((float)f);
    } }
  rmsnorm_phase(p.xin0, p.xin1, p.norm_mix, (u16*)(ws + OFF_H), nullptr, bid * 4 + (threadIdx.x >> 6), nb * 4);
}

constexpr int GP = 72;
enum { EPI_BF16 = 0, EPI_RESID = 1, EPI_SWIGLU = 2 };
template <int EPI>
DI void gemm_phase(const u16* __restrict__ A, int lda, const u16* __restrict__ Bt, int K, int N, u16* outb, int ldo,
                   const float* r0, const float* r1, float* outf, char* lds, int bid, int nb) {
  const int tid = threadIdx.x, lane = tid & 63, wid = tid >> 6, wr = wid >> 1, wc = wid & 1, r32 = lane & 31, hi = lane >> 5;
  u16* As = (u16*)lds; u16* Bs = As + 2 * 128 * GP;
  const int nN = N >> 7, nT = (M_TOT >> 7) * nN, nk = K >> 6;
  const int lrow = tid >> 3, lch = tid & 7;
  for (int t = bid; t < nT; t += nb) {
    const int tm = t / nN, tn = t - tm * nN;
    const u16* Ag = A + (size_t)(tm * 128 + lrow) * lda + lch * 8;
    const u16* Bg = Bt + (size_t)(tn * 128 + lrow) * K + lch * 8;
    f32x16 acc00 = {}, acc01 = {}, acc10 = {}, acc11 = {};
    u32x4 ra[4], rb[4];
#pragma unroll
    for (int i = 0; i < 4; ++i) { ra[i] = *(const u32x4*)(Ag + (size_t)i * 32 * lda); rb[i] = *(const u32x4*)(Bg + (size_t)i * 32 * K); }
#pragma unroll
    for (int i = 0; i < 4; ++i) { *(u32x4*)(As + (lrow + 32 * i) * GP + lch * 8) = ra[i]; *(u32x4*)(Bs + (lrow + 32 * i) * GP + lch * 8) = rb[i]; }
    __syncthreads();
    for (int kt = 0; kt < nk; ++kt) {
      const int cur = kt & 1;
      if (kt + 1 < nk) {
#pragma unroll
        for (int i = 0; i < 4; ++i) { ra[i] = *(const u32x4*)(Ag + (size_t)i * 32 * lda + (kt + 1) * 64); rb[i] = *(const u32x4*)(Bg + (size_t)i * 32 * K + (kt + 1) * 64); }
      }
      const u16* as = As + cur * 128 * GP + (wr * 64 + r32) * GP + hi * 8;
      const u16* bs = Bs + cur * 128 * GP + (wc * 64 + r32) * GP + hi * 8;
#pragma unroll
      for (int ks = 0; ks < 4; ++ks) {
        const bf16x8 a0 = *(const bf16x8*)(as + ks * 16), a1 = *(const bf16x8*)(as + 32 * GP + ks * 16);
        const bf16x8 b0 = *(const bf16x8*)(bs + ks * 16), b1 = *(const bf16x8*)(bs + 32 * GP + ks * 16);
        acc00 = MFMA32(a0, b0, acc00); acc01 = MFMA32(a0, b1, acc01); acc10 = MFMA32(a1, b0, acc10); acc11 = MFMA32(a1, b1, acc11);
      }
      if (kt + 1 < nk) {
        u16* ad = As + (cur ^ 1) * 128 * GP; u16* bd = Bs + (cur ^ 1) * 128 * GP;
#pragma unroll
        for (int i = 0; i < 4; ++i) { *(u32x4*)(ad + (lrow + 32 * i) * GP + lch * 8) = ra[i]; *(u32x4*)(bd + (lrow + 32 * i) * GP + lch * 8) = rb[i]; }
      }
      __syncthreads();
    }
    const int mrow = tm * 128 + wr * 64;
    if constexpr (EPI == EPI_BF16) {
      const int col = tn * 128 + wc * 64 + r32;
#pragma unroll
      for (int reg = 0; reg < 16; ++reg) {
        const int rr = crow(reg, hi);
        u16* o0 = outb + (size_t)(mrow + rr) * ldo + col; u16* o1 = outb + (size_t)(mrow + 32 + rr) * ldo + col;
        o0[0] = f2bf(acc00[reg]); o0[32] = f2bf(acc01[reg]); o1[0] = f2bf(acc10[reg]); o1[32] = f2bf(acc11[reg]);
      }
    } else if constexpr (EPI == EPI_RESID) {
      const int col = tn * 128 + wc * 64 + r32;
      const float* rb_ = (tm * 128 < M_P) ? r0 : (r1 - (size_t)M_P * DM);
#pragma unroll
      for (int reg = 0; reg < 16; ++reg) {
        const int rr = crow(reg, hi);
        const size_t i0 = (size_t)(mrow + rr) * DM + col, i1 = (size_t)(mrow + 32 + rr) * DM + col;
        const float x00 = rb_[i0], x01 = rb_[i0 + 32], x10 = rb_[i1], x11 = rb_[i1 + 32];
        outf[i0] = x00 + acc00[reg]; outf[i0 + 32] = x01 + acc01[reg]; outf[i1] = x10 + acc10[reg]; outf[i1 + 32] = x11 + acc11[reg];
      }
    } else {
      const int col = (tn * 2 + wc) * 32 + r32;
#pragma unroll
      for (int reg = 0; reg < 16; ++reg) {
        const int rr = crow(reg, hi);
        const float g0 = acc00[reg], u0 = acc01[reg], g1 = acc10[reg], u1 = acc11[reg];
        outb[(size_t)(mrow + rr) * ldo + col] = f2bf(g0 * sigmoidf_(g0) * u0);
        outb[(size_t)(mrow + 32 + rr) * ldo + col] = f2bf(g1 * sigmoidf_(g1) * u1);
      }
    }
  }
}

template <bool FINAL>
DI void rg_phase(const Params& p, char* lds, int bid, int nb) {
  const int tid = threadIdx.x, lane = tid & 63, wid = tid >> 6, r32 = lane & 31, hi = lane >> 5;
  float* xcf = (float*)lds;
  u16* xcb = (u16*)(lds + 16384);
  float* Ab = (float*)(lds + 25600);
  float* U0 = (float*)(lds + 41984);
  float* U1 = (float*)(lds + 58368);
  const u16* PROJ = (const u16*)(p.ws + OFF_PROJ);
  const u16* WG = (const u16*)(p.ws + WT_GATES);
  float* SUM = (float*)(p.ws + OFF_SUM);
  const float* CARRY = (const float*)(p.ws + OFF_CARRY);
  u16* Y = (u16*)(p.ws + OFF_Y);
  for (int it = bid; it < 768 * 8; it += nb) {
    const int gc = it >> 3, cb = it & 7, m0 = gc * 64;
    int seq_lo, S; row_info(m0, seq_lo, S); const int seq_hi = seq_lo + S;
    __syncthreads();
    {
      const int ch = tid & 63, tq = tid >> 6, c = cb * 64 + ch;
      const float w0 = p.conv_w[c], w1 = p.conv_w[512 + c], w2 = p.conv_w[1024 + c], w3 = p.conv_w[1536 + c], cbias = p.conv_b[c];
      const int t0 = tq * 16;
      auto ld = [&](int t) -> float { const int m = m0 + t; return (m >= seq_lo && m < seq_hi) ? bf2f(PROJ[(size_t)m * 2560 + c]) : 0.f; };
      float xm2 = ld(t0 - 2), xm1 = ld(t0 - 1), x0 = ld(t0);
#pragma unroll 4
      for (int t = t0; t < t0 + 16; ++t) {
        const float xp1 = ld(t + 1);
        const float xc = w0 * xm2 + w1 * xm1 + w2 * x0 + w3 * xp1 + cbias;
        xcf[t * 64 + ch] = xc; xcb[t * 72 + ch] = f2bf(xc);
        xm2 = xm1; xm1 = x0; x0 = xp1;
      }
    }
    __syncthreads();
#pragma unroll 1
    for (int dir = 0; dir < 2; ++dir) {
      float* Ub = dir == 0 ? U0 : U1;
      {
        const int mt = wid >> 1, nt = wid & 1;
        f32x16 aa = {}, ai = {};
        const u16* wa = WG + (size_t)((dir * 2 + 0) * 8 + cb) * 4096 + (nt * 32 + r32) * 64 + 8 * hi;
        const u16* wi = WG + (size_t)((dir * 2 + 1) * 8 + cb) * 4096 + (nt * 32 + r32) * 64 + 8 * hi;
#pragma unroll
        for (int ks = 0; ks < 4; ++ks) {
          const bf16x8 af = *(const bf16x8*)(xcb + (mt * 32 + r32) * 72 + ks * 16 + 8 * hi);
          const bf16x8 ba = *(const bf16x8*)(wa + ks * 16), bi = *(const bf16x8*)(wi + ks * 16);
          aa = MFMA32(af, ba, aa); ai = MFMA32(af, bi, ai);
        }
        const int ch = nt * 32 + r32, c = cb * 64 + ch;
        const float bav = p.b_a[dir * 512 + c], biv = p.b_i[dir * 512 + c];
        const float sp = log1pf(__expf(-p.lam[dir * 512 + c]));
#pragma unroll
        for (int reg = 0; reg < 16; ++reg) {
          const int tok = mt * 32 + crow(reg, hi);
          const float r = sigmoidf_(aa[reg] + bav), gi = sigmoidf_(ai[reg] + biv);
          const float la = -8.f * r * sp, a = __expf(la);
          const float mult = sqrtf(fmaxf(0.f, 1.f - __expf(2.f * la)));
          Ab[tok * 64 + ch] = a; Ub[tok * 64 + ch] = mult * gi * xcf[tok * 64 + ch];
        }
      }
      __syncthreads();
      if (tid < 64) {
        const int ch = tid, c = cb * 64 + ch;
        if (!FINAL) {
          float h = 0.f, P = 1.f;
#pragma unroll 8
          for (int k = 0; k < 64; ++k) { const int t = dir == 0 ? k : 63 - k; const float a = Ab[t * 64 + ch], u = Ub[t * 64 + ch]; h = a * h + u; P *= a; }
          SUM[(size_t)((gc * 2 + dir) * 2 + 0) * 512 + c] = P; SUM[(size_t)((gc * 2 + dir) * 2 + 1) * 512 + c] = h;
        } else {
          float h = CARRY[(size_t)(gc * 2 + dir) * 512 + c];
          if (dir == 0) {
#pragma unroll 8
            for (int t = 0; t < 64; ++t) { const float a = Ab[t * 64 + ch], u = Ub[t * 64 + ch]; h = a * h + u; Ub[t * 64 + ch] = h; }
          } else {
#pragma unroll 8
            for (int k = 0; k < 64; ++k) {
              const int t = 63 - k; const float a = Ab[t * 64 + ch], u = Ub[t * 64 + ch]; h = a * h + u;
              const float gt = bf2f(PROJ[(size_t)(m0 + t) * 2560 + 512 + c]);
              const float ge = gt * sigmoidf_(1.5957691216057308f * (gt + 0.044715f * gt * gt * gt));
              Y[(size_t)(m0 + t) * 1024 + c] = f2bf(ge * (U0[t * 64 + ch] + h));
            }
          }
        }
      }
      __syncthreads();
    }
  }
}

DI void rg_carry_phase(const Params& p, int bid, int nb) {
  const float* __restrict__ SUM = (const float*)(p.ws + OFF_SUM);
  float* __restrict__ CARRY = (float*)(p.ws + OFF_CARRY);
  for (int idx = bid * 256 + threadIdx.x; idx < 8192; idx += nb * 256) {
    const int c = idx & 511, dir = (idx >> 9) & 1, seq = idx >> 10;
    const int gc0 = seq < 4 ? seq * 128 : 512 + (seq - 4) * 64, nch = seq < 4 ? 128 : 64;
    float carry = 0.f;
    for (int k0 = 0; k0 < nch; k0 += 8) {
      float P[8], Hh[8];
#pragma unroll
      for (int j = 0; j < 8; ++j) { const int k = k0 + j, gc = dir == 0 ? gc0 + k : gc0 + nch - 1 - k; P[j] = SUM[(size_t)((gc * 2 + dir) * 2 + 0) * 512 + c]; Hh[j] = SUM[(size_t)((gc * 2 + dir) * 2 + 1) * 512 + c]; }
#pragma unroll
      for (int j = 0; j < 8; ++j) { const int k = k0 + j, gc = dir == 0 ? gc0 + k : gc0 + nch - 1 - k; CARRY[(size_t)(gc * 2 + dir) * 512 + c] = carry; carry = P[j] * carry + Hh[j]; }
    }
  }
}

DI void dil_tile_info(int ti, int m0, int& d, int& u0) {
  if (ti < 5) { d = 16; u0 = m0 - 1024 + ti * 512; } else if (ti < 13) { d = 4; u0 = m0 - 256 + (ti - 5) * 128; } else { d = 1; u0 = m0 - 64 + (ti - 13) * 32; }
}
DI void dilated_phase(const Params& p, char* lds, int gw, int nw) {
  const int lane = threadIdx.x & 63, wid = threadIdx.x >> 6, r32 = lane & 31, hi = lane >> 5;
  u16* Vl = (u16*)(lds + wid * 6144);
  const unsigned vbase = (unsigned)(uintptr_t)Vl;
  const int li = lane & 15, tq = li >> 2, tp = li & 3, g1 = (lane >> 4) & 1;
  const unsigned trb = vbase + (4 * hi + tq) * 192 + (16 * g1 + 4 * tp) * 2;
  const u16* PROJ = (const u16*)(p.ws + OFF_PROJ);
  u16* Y = (u16*)(p.ws + OFF_Y);
  const int vrow = lane >> 3, vch = lane & 7;
  for (int id = gw; id < 12288; id += nw) {
    const int res = id & 15, h = (id >> 4) & 7, sp = id >> 7;
    const int m0 = sp * 512 + res;
    int seq_lo, S; row_info(sp * 512, seq_lo, S); const int seq_hi = seq_lo + S;
    const int mq = m0 + 16 * r32;
    bf16x8 qf[4];
#pragma unroll
    for (int ks = 0; ks < 4; ++ks) qf[ks] = *(const bf16x8*)(PROJ + (size_t)mq * 2560 + 1024 + h * 64 + ks * 16 + 8 * hi);
    const float slope2 = exp2f(-(float)(h + 1)) * LOG2E;
    const float c1 = 0.125f * LOG2E;
    float m_run = -1e30f, l_run = 0.f; f32x16 o0 = {}, o1 = {};
    const u16* kbase = PROJ + 1536 + h * 64 + 8 * hi;
    const u16* vbaseg = PROJ + 2048 + h * 64 + vch * 8;
    bf16x8 kf[4]; u32x4 vr[4];
    { int d, u0; dil_tile_info(0, m0, d, u0);
      const int ur = min(max(u0 + d * r32, seq_lo), seq_hi - 1);
#pragma unroll
      for (int ks = 0; ks < 4; ++ks) kf[ks] = *(const bf16x8*)(kbase + (size_t)ur * 2560 + ks * 16);
#pragma unroll
      for (int i = 0; i < 4; ++i) { const int uv = min(max(u0 + d * (vrow + 8 * i), seq_lo), seq_hi - 1); vr[i] = *(const u32x4*)(vbaseg + (size_t)uv * 2560); } }
#pragma unroll 1
    for (int ti = 0; ti < 33; ++ti) {
      int d, u0; dil_tile_info(ti, m0, d, u0);
#pragma unroll
      for (int i = 0; i < 4; ++i) *(u32x4*)(Vl + (vrow + 8 * i) * 96 + vch * 8) = vr[i];
      f32x16 pt = {};
#pragma unroll
      for (int ks = 0; ks < 4; ++ks) pt = MFMA32(kf[ks], qf[ks], pt);
      if (ti + 1 < 33) {
        int dn, un; dil_tile_info(ti + 1, m0, dn, un);
        const int ur = min(max(un + dn * r32, seq_lo), seq_hi - 1);
#pragma unroll
        for (int ks = 0; ks < 4; ++ks) kf[ks] = *(const bf16x8*)(kbase + (size_t)ur * 2560 + ks * 16);
#pragma unroll
        for (int i = 0; i < 4; ++i) { const int uv = min(max(un + dn * (vrow + 8 * i), seq_lo), seq_hi - 1); vr[i] = *(const u32x4*)(vbaseg + (size_t)uv * 2560); }
      }
      const int du0 = u0 - mq + d * 4 * hi, lim = 64 * d;
      float pmax = -INFINITY;
#pragma unroll
      for (int reg = 0; reg < 16; ++reg) {
        const int du = du0 + d * ((reg & 3) + 8 * (reg >> 2)), u = mq + du, ad = du < 0 ? -du : du;
        const bool valid = (ad <= lim) && (u >= seq_lo) && (u < seq_hi);
        const float tv = valid ? (pt[reg] * c1 - slope2 * (float)ad) : -INFINITY;
        pt[reg] = tv; pmax = fmaxf(pmax, tv);
      }
      pmax = pl32_max(pmax);
      const float mn = fmaxf(m_run, pmax), alpha = exp2f(m_run - mn);
      m_run = mn;
      float ps = 0.f;
#pragma unroll
      for (int reg = 0; reg < 16; ++reg) { pt[reg] = exp2f(pt[reg] - mn); ps += pt[reg]; }
      ps = pl32_sum(ps);
      l_run = l_run * alpha + ps;
#pragma unroll
      for (int reg = 0; reg < 16; ++reg) { o0[reg] *= alpha; o1[reg] *= alpha; }
      const bf16x8 pb0 = pack8(pt, 0), pb1 = pack8(pt, 1);
      const s16x4 l00 = tr_read(trb), h00 = tr_read(trb + 8 * 192), l01 = tr_read(trb + 64), h01 = tr_read(trb + 8 * 192 + 64);
      const s16x4 l10 = tr_read(trb + 16 * 192), h10 = tr_read(trb + 24 * 192), l11 = tr_read(trb + 16 * 192 + 64), h11 = tr_read(trb + 24 * 192 + 64);
      LGKM0();
      o0 = MFMA32(cat4(l00, h00), pb0, o0); o0 = MFMA32(cat4(l10, h10), pb1, o0);
      o1 = MFMA32(cat4(l01, h01), pb0, o1); o1 = MFMA32(cat4(l11, h11), pb1, o1);
    }
    const float inv = 1.f / l_run;
    u16* yo = Y + (size_t)mq * 1024 + 512 + h * 64 + 4 * hi;
#pragma unroll
    for (int g = 0; g < 4; ++g) {
      u32x2 w0 = {pk2(o0[4 * g] * inv, o0[4 * g + 1] * inv), pk2(o0[4 * g + 2] * inv, o0[4 * g + 3] * inv)};
      u32x2 w1 = {pk2(o1[4 * g] * inv, o1[4 * g + 1] * inv), pk2(o1[4 * g + 2] * inv, o1[4 * g + 3] * inv)};
      *(u32x2*)(yo + 8 * g) = w0; *(u32x2*)(yo + 32 + 8 * g) = w1;
    }
  }
}

DI void mla_norm_phase(const Params& p, int gw, int nw) {
  const int lane = threadIdx.x & 63;
  const u16* P2 = (const u16*)(p.ws + OFF_P2);
  u16* CQN = (u16*)(p.ws + OFF_CQN); u16* CKVN = (u16*)(p.ws + OFF_CKVN); u16* KR = (u16*)(p.ws + OFF_KR);
  const float* ct = (const float*)(p.ws + OFF_COS); const float* st = (const float*)(p.ws + OFF_SIN);
  for (int m = gw; m < M_TOT; m += nw) {
    const u16* src = P2 + (size_t)m * 768;
    float q[6], kv[4]; float sq = 0.f, skv = 0.f;
#pragma unroll
    for (int i = 0; i < 6; ++i) { q[i] = bf2f(src[i * 64 + lane]); sq += q[i] * q[i]; }
#pragma unroll
    for (int i = 0; i < 4; ++i) { kv[i] = bf2f(src[384 + i * 64 + lane]); skv += kv[i] * kv[i]; }
#pragma unroll
    for (int o = 32; o > 0; o >>= 1) { sq += __shfl_xor(sq, o); skv += __shfl_xor(skv, o); }
    const float rq = rsqrtf(sq * (1.f / 384.f) + 1e-6f), rkv = rsqrtf(skv * (1.f / 256.f) + 1e-6f);
#pragma unroll
    for (int i = 0; i < 6; ++i) CQN[(size_t)m * 384 + i * 64 + lane] = f2bf(q[i] * rq * p.q_norm[i * 64 + lane]);
#pragma unroll
    for (int i = 0; i < 4; ++i) CKVN[(size_t)m * 256 + i * 64 + lane] = f2bf(kv[i] * rkv * p.kv_norm[i * 64 + lane]);
    if (lane < 16) {
      const int pos = m < M_P ? (m & 8191) : ((m - M_P) & 4095);
      const float t1 = bf2f(src[640 + lane]), t2 = bf2f(src[656 + lane]);
      const float c = ct[pos * 16 + lane], s = st[pos * 16 + lane];
      KR[(size_t)m * 32 + lane] = f2bf(t1 * c - t2 * s); KR[(size_t)m * 32 + 16 + lane] = f2bf(t1 * s + t2 * c);
    }
  }
}

constexpr int KP = 104, VP = 96;
DI void mla_unit(const Params& p, char* lds, int seqbase, int S, int h, int qb) {
  const int tid = threadIdx.x, lane = tid & 63, wid = tid >> 6, r32 = lane & 31, hi = lane >> 5;
  u16* Kl = (u16*)lds;
  u16* Vl = (u16*)(lds + 2 * 64 * KP * 2);
  const unsigned vbase = (unsigned)(uintptr_t)Vl;
  const int li = lane & 15, tq = li >> 2, tp = li & 3, g1 = (lane >> 4) & 1;
  const unsigned trb = vbase + (4 * hi + tq) * (VP * 2) + (16 * g1 + 4 * tp) * 2;
  const u16* Q = (const u16*)(p.ws + OFF_Q); const u16* KV = (const u16*)(p.ws + OFF_KV); const u16* KR = (const u16*)(p.ws + OFF_KR);
  u16* O = (u16*)(p.ws + OFF_O);
  const float* ct = (const float*)(p.ws + OFF_COS); const float* st = (const float*)(p.ws + OFF_SIN);
  const int pos = qb * 128 + wid * 32 + r32, qrow = seqbase + pos;
  bf16x8 qf[6];
#pragma unroll
  for (int d0 = 0; d0 < 6; ++d0) qf[d0] = *(const bf16x8*)(Q + (size_t)qrow * 1536 + h * 96 + d0 * 16 + 8 * hi);
#pragma unroll
  for (int j = 0; j < 8; ++j) {
    const float c = ct[pos * 16 + 8 * hi + j], s = st[pos * 16 + 8 * hi + j];
    const float t1 = bfs2f(qf[4][j]), t2 = bfs2f(qf[5][j]);
    qf[4][j] = (short)f2bf(t1 * c - t2 * s); qf[5][j] = (short)f2bf(t1 * s + t2 * c);
  }
  const u16* ksrc[3]; int kdst[3];
#pragma unroll
  for (int i = 0; i < 3; ++i) {
    const int idx = tid + 256 * i, row = idx / 12, c = idx - row * 12;
    ksrc[i] = c < 8 ? KV + (size_t)(seqbase + row) * 2048 + h * 128 + c * 8 : KR + (size_t)(seqbase + row) * 32 + (c - 8) * 8;
    kdst[i] = row * KP + c * 8;
  }
  const int kstride[3] = {0, 0, 0}; (void)kstride;
  const int vrow = tid >> 3, vc = tid & 7;
  const u16* vsrc = KV + (size_t)(seqbase + vrow) * 2048 + h * 128 + 64 + vc * 8;
  const int vdst = vrow * VP + vc * 8;
  size_t kadv[3];
#pragma unroll
  for (int i = 0; i < 3; ++i) { const int idx = tid + 256 * i, row = idx / 12, c = idx - row * 12; (void)row; kadv[i] = c < 8 ? (size_t)64 * 2048 : (size_t)64 * 32; }
  const float C = 0.10206207261596577f * LOG2E;
  float m_run = -1e30f, l_run = 0.f; f32x16 o0 = {}, o1 = {};
  const int nkt = S >> 6;
  u32x4 rk[3], rv[2];
#pragma unroll
  for (int i = 0; i < 3; ++i) rk[i] = *(const u32x4*)(ksrc[i]);
  rv[0] = *(const u32x4*)(vsrc); rv[1] = *(const u32x4*)(vsrc + (size_t)32 * 2048);
#pragma unroll
  for (int i = 0; i < 3; ++i) *(u32x4*)(Kl + kdst[i]) = rk[i];
  *(u32x4*)(Vl + vdst) = rv[0]; *(u32x4*)(Vl + vdst + 32 * VP) = rv[1];
  __syncthreads();
#pragma unroll 1
  for (int kt = 0; kt < nkt; ++kt) {
    const int cur = kt & 1;
    if (kt + 1 < nkt) {
#pragma unroll
      for (int i = 0; i < 3; ++i) rk[i] = *(const u32x4*)(ksrc[i] + (size_t)(kt + 1) * kadv[i]);
      rv[0] = *(const u32x4*)(vsrc + (size_t)(kt + 1) * 64 * 2048); rv[1] = *(const u32x4*)(vsrc + (size_t)(kt + 1) * 64 * 2048 + (size_t)32 * 2048);
    }
    const u16* kl = Kl + cur * 64 * KP + r32 * KP + 8 * hi;
    f32x16 p0 = {}, p1 = {};
#pragma unroll
    for (int d0 = 0; d0 < 6; ++d0) {
      const bf16x8 k0 = *(const bf16x8*)(kl + d0 * 16), k1 = *(const bf16x8*)(kl + 32 * KP + d0 * 16);
      p0 = MFMA32(k0, qf[d0], p0); p1 = MFMA32(k1, qf[d0], p1);
    }
    float pmax = p0[0];
#pragma unroll
    for (int r = 1; r < 16; ++r) pmax = fmaxf(pmax, p0[r]);
#pragma unroll
    for (int r = 0; r < 16; ++r) pmax = fmaxf(pmax, p1[r]);
    pmax = pl32_max(pmax) * C;
    const float mn = fmaxf(m_run, pmax), alpha = exp2f(m_run - mn);
    m_run = mn;
    float ps = 0.f;
#pragma unroll
    for (int r = 0; r < 16; ++r) { p0[r] = exp2f(p0[r] * C - mn); ps += p0[r]; }
#pragma unroll
    for (int r = 0; r < 16; ++r) { p1[r] = exp2f(p1[r] * C - mn); ps += p1[r]; }
    ps = pl32_sum(ps);
    l_run = l_run * alpha + ps;
#pragma unroll
    for (int r = 0; r < 16; ++r) { o0[r] *= alpha; o1[r] *= alpha; }
    const bf16x8 pb0 = pack8(p0, 0), pb1 = pack8(p0, 1), pb2 = pack8(p1, 0), pb3 = pack8(p1, 1);
    const unsigned tb = trb + cur * (64 * VP * 2);
    {
      const s16x4 l0 = tr_read(tb), h0 = tr_read(tb + 8 * VP * 2), l1 = tr_read(tb + 16 * VP * 2), h1 = tr_read(tb + 24 * VP * 2);
      const s16x4 l2 = tr_read(tb + 32 * VP * 2), h2 = tr_read(tb + 40 * VP * 2), l3 = tr_read(tb + 48 * VP * 2), h3 = tr_read(tb + 56 * VP * 2);
      LGKM0();
      o0 = MFMA32(cat4(l0, h0), pb0, o0); o0 = MFMA32(cat4(l1, h1), pb1, o0); o0 = MFMA32(cat4(l2, h2), pb2, o0); o0 = MFMA32(cat4(l3, h3), pb3, o0);
    }
    {
      const unsigned tc = tb + 64;
      const s16x4 l0 = tr_read(tc), h0 = tr_read(tc + 8 * VP * 2), l1 = tr_read(tc + 16 * VP * 2), h1 = tr_read(tc + 24 * VP * 2);
      const s16x4 l2 = tr_read(tc + 32 * VP * 2), h2 = tr_read(tc + 40 * VP * 2), l3 = tr_read(tc + 48 * VP * 2), h3 = tr_read(tc + 56 * VP * 2);
      LGKM0();
      o1 = MFMA32(cat4(l0, h0), pb0, o1); o1 = MFMA32(cat4(l1, h1), pb1, o1); o1 = MFMA32(cat4(l2, h2), pb2, o1); o1 = MFMA32(cat4(l3, h3), pb3, o1);
    }
    if (kt + 1 < nkt) {
      u16* kd = Kl + (cur ^ 1) * 64 * KP; u16* vd = Vl + (cur ^ 1) * 64 * VP;
#pragma unroll
      for (int i = 0; i < 3; ++i) *(u32x4*)(kd + kdst[i]) = rk[i];
      *(u32x4*)(vd + vdst) = rv[0]; *(u32x4*)(vd + vdst + 32 * VP) = rv[1];
    }
    __syncthreads();
  }
  const float inv = 1.f / l_run;
  u16* oo = O + (size_t)qrow * 1024 + h * 64 + 4 * hi;
#pragma unroll
  for (int g = 0; g < 4; ++g) {
    u32x2 w0 = {pk2(o0[4 * g] * inv, o0[4 * g + 1] * inv), pk2(o0[4 * g + 2] * inv, o0[4 * g + 3] * inv)};
    u32x2 w1 = {pk2(o1[4 * g] * inv, o1[4 * g + 1] * inv), pk2(o1[4 * g + 2] * inv, o1[4 * g + 3] * inv)};
    *(u32x2*)(oo + 8 * g) = w0; *(u32x2*)(oo + 32 + 8 * g) = w1;
  }
}

DI void mla_attn_phase(const Params& p, char* lds, int bid, int nb) {
  if ((nb & 7) == 0) {
    const int xcd = bid & 7, j = bid >> 3, nper = nb >> 3;
    for (int lu = j; lu < 8 * 64; lu += nper) { const int bh = (lu >> 6) * 8 + xcd, qb = lu & 63; mla_unit(p, lds, (bh >> 4) * 8192, 8192, bh & 15, qb); }
    for (int lu = j; lu < 8 * 32; lu += nper) { const int bh = (lu >> 5) * 8 + xcd, qb = lu & 31; mla_unit(p, lds, M_P + (bh >> 4) * 4096, 4096, bh & 15, qb); }
  } else {
    for (int u = bid; u < 4096; u += nb) { const int bh = u >> 6, qb = u & 63; mla_unit(p, lds, (bh >> 4) * 8192, 8192, bh & 15, qb); }
    for (int u = bid; u < 2048; u += nb) { const int bh = u >> 5, qb = u & 31; mla_unit(p, lds, M_P + (bh >> 4) * 4096, 4096, bh & 15, qb); }
  }
}

constexpr int N_PHASES = 19;
constexpr int LDS_BYTES = 74752;
__global__ void __launch_bounds__(256, 2) mega(Params p, int ph_lo, int ph_hi) {
  __shared__ __attribute__((aligned(16))) char lds[LDS_BYTES];
  const int bid = blockIdx.x, nb = gridDim.x;
  const int gw = bid * 4 + (threadIdx.x >> 6), nw = nb * 4;
  char* ws = p.ws;
  float* out1 = p.out + (size_t)M_P * DM;
#define PHASE(k, ...) do { if (ph_lo <= (k) && (k) < ph_hi) { __VA_ARGS__ } if (ph_lo <= (k) && (k) + 1 < ph_hi) cg::this_grid().sync(); } while (0)
  PHASE(0, prep_phase(p, lds, bid, nb););
  PHASE(1, gemm_phase<EPI_BF16>((const u16*)(ws + OFF_H), 1024, (const u16*)(ws + WT_ABIN), 1024, 2560, (u16*)(ws + OFF_PROJ), 2560, nullptr, nullptr, nullptr, lds, bid, nb););
  PHASE(2, rg_phase<false>(p, lds, bid, nb); __syncthreads(); dilated_phase(p, lds, gw, nw););
  PHASE(3, rg_carry_phase(p, bid, nb););
  PHASE(4, rg_phase<true>(p, lds, bid, nb););
  PHASE(5, gemm_phase<EPI_RESID>((const u16*)(ws + OFF_Y), 1024, (const u16*)(ws + WT_ABOUT), 1024, 1024, nullptr, 0, p.xin0, p.xin1, p.out, lds, bid, nb););
  PHASE(6, rmsnorm_phase(p.out, out1, p.norm_ffn, (u16*)(ws + OFF_H), nullptr, gw, nw););
  PHASE(7, gemm_phase<EPI_SWIGLU>((const u16*)(ws + OFF_H), 1024, (const u16*)(ws + WT_GU0), 1024, 5632, (u16*)(ws + OFF_ACT), FH, nullptr, nullptr, nullptr, lds, bid, nb););
  PHASE(8, gemm_phase<EPI_RESID>((const u16*)(ws + OFF_ACT), FH, (const u16*)(ws + WT_DOWN0), FH, 1024, nullptr, 0, p.out, out1, p.out, lds, bid, nb););
  PHASE(9, rmsnorm_phase(p.out, out1, p.norm_mix + 1024, (u16*)(ws + OFF_H), nullptr, gw, nw););
  PHASE(10, gemm_phase<EPI_BF16>((const u16*)(ws + OFF_H), 1024, (const u16*)(ws + WT_MLAIN), 1024, 768, (u16*)(ws + OFF_P2), 768, nullptr, nullptr, nullptr, lds, bid, nb););
  PHASE(11, mla_norm_phase(p, gw, nw););
  PHASE(12, gemm_phase<EPI_BF16>((const u16*)(ws + OFF_CQN), 384, (const u16*)(ws + WT_QB), 384, 1536, (u16*)(ws + OFF_Q), 1536, nullptr, nullptr, nullptr, lds, bid, nb); gemm_phase<EPI_BF16>((const u16*)(ws + OFF_CKVN), 256, (const u16*)(ws + WT_KVB), 256, 2048, (u16*)(ws + OFF_KV), 2048, nullptr, nullptr, nullptr, lds, bid, nb););
  PHASE(13, mla_attn_phase(p, lds, bid, nb););
  PHASE(14, gemm_phase<EPI_RESID>((const u16*)(ws + OFF_O), 1024, (const u16*)(ws + WT_MLAOUT), 1024, 1024, nullptr, 0, p.out, out1, p.out, lds, bid, nb););
  PHASE(15, rmsnorm_phase(p.out, out1, p.norm_ffn + 1024, (u16*)(ws + OFF_H), nullptr, gw, nw););
  PHASE(16, gemm_phase<EPI_SWIGLU>((const u16*)(ws + OFF_H), 1024, (const u16*)(ws + WT_GU1), 1024, 5632, (u16*)(ws + OFF_ACT), FH, nullptr, nullptr, nullptr, lds, bid, nb););
  PHASE(17, gemm_phase<EPI_RESID>((const u16*)(ws + OFF_ACT), FH, (const u16*)(ws + WT_DOWN1), FH, 1024, nullptr, 0, p.out, out1, p.out, lds, bid, nb););
  PHASE(18, rmsnorm_phase(p.out, out1, p.norm_final, nullptr, p.out, gw, nw););
#undef PHASE
}

extern "C" void kernel_launch(void* const* d_in, const int* in_sizes, int n_in, void* d_out, int out_size, void* d_ws, size_t ws_size, hipStream_t stream) {
  static int grid_blocks = 0;
  if (!grid_blocks) {
    int dev = 0, cus = 0, per_cu = 0;
    hipGetDevice(&dev);
    hipDeviceGetAttribute(&cus, hipDeviceAttributeMultiprocessorCount, dev);
    hipOccupancyMaxActiveBlocksPerMultiprocessor(&per_cu, mega, 256, 0);
    if (per_cu > 2) per_cu = 2;
    if (per_cu < 1) per_cu = 1;
    grid_blocks = cus * per_cu;
  }
  if (n_in != 23 || ws_size < WS_NEED) { fprintf(stderr, "kernel_launch: bad inputs n_in=%d ws=%zu\n", n_in, ws_size); return; }
  Params p{};
  p.xin0 = (const float*)d_in[0]; p.xin1 = (const float*)d_in[1];
  p.norm_mix = (const float*)d_in[2]; p.norm_ffn = (const float*)d_in[3]; p.norm_final = (const float*)d_in[4];
  p.ab_w_in = (const float*)d_in[5]; p.conv_w = (const float*)d_in[6]; p.conv_b = (const float*)d_in[7];
  p.w_a = (const float*)d_in[8]; p.b_a = (const float*)d_in[9]; p.w_i = (const float*)d_in[10]; p.b_i = (const float*)d_in[11];
  p.lam = (const float*)d_in[12]; p.ab_w_out = (const float*)d_in[13];
  p.mla_w_in = (const float*)d_in[14]; p.q_norm = (const float*)d_in[15]; p.w_qb = (const float*)d_in[16]; p.kv_norm = (const float*)d_in[17];
  p.w_kvb = (const float*)d_in[18]; p.mla_w_out = (const float*)d_in[19];
  p.w_gate = (const float*)d_in[20]; p.w_up = (const float*)d_in[21]; p.w_down = (const float*)d_in[22];
  p.out = (float*)d_out; p.ws = (char*)d_ws;
#if SINGLE_LAUNCH
  int lo = 0, hi = N_PHASES;
  void* args[] = {&p, &lo, &hi};
  hipError_t e = hipLaunchCooperativeKernel((void*)mega, dim3(grid_blocks), dim3(256), args, 0, stream);
  if (e != hipSuccess) fprintf(stderr, "cooperative launch failed: %s (grid %d)\n", hipGetErrorString(e), grid_blocks);
#else
  for (int ph = 0; ph < N_PHASES; ++ph) hipLaunchKernelGGL(mega, dim3(grid_blocks), dim3(256), 0, stream, p, ph, ph + 1);
#endif
}
```

```cpp
#include <hip/hip_runtime.h>
#include <hip/hip_cooperative_groups.h>
#include <cstdint>
#include <cstdio>
namespace cg = cooperative_groups;

#ifndef SINGLE_LAUNCH
#define SINGLE_LAUNCH 1
#endif

typedef unsigned short u16;
typedef short bf16x8 __attribute__((ext_vector_type(8)));
typedef short s16x4 __attribute__((ext_vector_type(4)));
typedef float f32x16 __attribute__((ext_vector_type(16)));
typedef float f32x4 __attribute__((ext_vector_type(4)));
typedef float f32x2 __attribute__((ext_vector_type(2)));
typedef unsigned u32x4 __attribute__((ext_vector_type(4)));
typedef unsigned u32x2 __attribute__((ext_vector_type(2)));
typedef __bf16 bf2_t __attribute__((ext_vector_type(2)));
#define DI __device__ __forceinline__
#define MFMA32(a, b, c) __builtin_amdgcn_mfma_f32_32x32x16_bf16((a), (b), (c), 0, 0, 0)

constexpr int M_TOT = 49152, M_P = 32768, DM = 1024, FH = 2816;
constexpr float LOG2E = 1.4426950408889634f;
constexpr size_t MiB = 1ull << 20;
constexpr size_t WT_ABIN = 0;
constexpr size_t WT_ABOUT = WT_ABIN + 2560ull * 1024 * 2;
constexpr size_t WT_GU0 = WT_ABOUT + 1024ull * 1024 * 2;
constexpr size_t WT_DOWN0 = WT_GU0 + 5632ull * 1024 * 2;
constexpr size_t WT_MLAIN = WT_DOWN0 + 1024ull * 2816 * 2;
constexpr size_t WT_QB = WT_MLAIN + 768ull * 1024 * 2;
constexpr size_t WT_KVB = WT_QB + 1536ull * 384 * 2;
constexpr size_t WT_MLAOUT = WT_KVB + 2048ull * 256 * 2;
constexpr size_t WT_GU1 = WT_MLAOUT + 1024ull * 1024 * 2;
constexpr size_t WT_DOWN1 = WT_GU1 + 5632ull * 1024 * 2;
constexpr size_t WT_GATES = WT_DOWN1 + 1024ull * 2816 * 2;
constexpr size_t WT_END = WT_GATES + 32ull * 4096 * 2;
static_assert(WT_END <= 46 * MiB, "weights region");
constexpr size_t OFF_SUM = 46 * MiB;
constexpr size_t OFF_KR = 46 * MiB;
constexpr size_t OFF_COS = 52 * MiB;
constexpr size_t OFF_SIN = 52 * MiB + 512 * 1024;
constexpr size_t OFF_H = 54 * MiB;
constexpr size_t OFF_CQN = 54 * MiB;
constexpr size_t OFF_CKVN = 90 * MiB;
constexpr size_t OFF_O = 54 * MiB;
constexpr size_t OFF_PROJ = 150 * MiB;
constexpr size_t OFF_ACT = 150 * MiB;
constexpr size_t OFF_P2 = 150 * MiB;
constexpr size_t OFF_Q = 150 * MiB;
constexpr size_t OFF_KV = 294 * MiB;
constexpr size_t OFF_Y = 390 * MiB;
constexpr size_t OFF_CARRY = 486 * MiB;
constexpr size_t OFF_BAR = 489 * MiB;
constexpr size_t WS_NEED = 490 * MiB;

struct Params {
  const float* xin0; const float* xin1;
  const float* norm_mix; const float* norm_ffn; const float* norm_final;
  const float* ab_w_in; const float* conv_w; const float* conv_b;
  const float* w_a; const float* b_a; const float* w_i; const float* b_i; const float* lam; const float* ab_w_out;
  const float* mla_w_in; const float* q_norm; const float* w_qb; const float* kv_norm; const float* w_kvb; const float* mla_w_out;
  const float* w_gate; const float* w_up; const float* w_down;
  float* out; char* ws;
};

DI float bf2f(u16 v) { return __uint_as_float(((unsigned)v) << 16); }
DI float bfs2f(short v) { return __uint_as_float(((unsigned)(u16)v) << 16); }
DI unsigned pk2(float lo, float hi) { f32x2 v = {lo, hi}; bf2_t r = __builtin_convertvector(v, bf2_t); return __builtin_bit_cast(unsigned, r); }
DI u16 f2bf(float a) { return (u16)(pk2(a, 0.f) & 0xffffu); }
DI int crow(int r, int hi) { return (r & 3) + 8 * (r >> 2) + 4 * hi; }
DI float sigmoidf_(float x) { return 1.f / (1.f + __expf(-x)); }
DI float pl32_max(float v) { auto rr = __builtin_amdgcn_permlane32_swap(__float_as_uint(v), __float_as_uint(v), false, false); return fmaxf(__uint_as_float(rr[0]), __uint_as_float(rr[1])); }
DI float pl32_sum(float v) { auto rr = __builtin_amdgcn_permlane32_swap(__float_as_uint(v), __float_as_uint(v), false, false); return __uint_as_float(rr[0]) + __uint_as_float(rr[1]); }
DI s16x4 tr_read(unsigned addr) { s16x4 r; asm volatile("ds_read_b64_tr_b16 %0, %1" : "=&v"(r) : "v"(addr) : "memory"); return r; }
#define LGKM0() do { asm volatile("s_waitcnt lgkmcnt(0)" ::: "memory"); __builtin_amdgcn_sched_barrier(0); } while (0)
DI bf16x8 cat4(s16x4 l, s16x4 h) { return (bf16x8){l[0], l[1], l[2], l[3], h[0], h[1], h[2], h[3]}; }
DI bf16x8 pack8(const f32x16& x, int s) {
  u32x4 w = {pk2(x[8 * s + 0], x[8 * s + 1]), pk2(x[8 * s + 2], x[8 * s + 3]), pk2(x[8 * s + 4], x[8 * s + 5]), pk2(x[8 * s + 6], x[8 * s + 7])};
  return __builtin_bit_cast(bf16x8, w);
}
DI void row_info(int m, int& seq_lo, int& S) { if (m < M_P) { seq_lo = m & ~8191; S = 8192; } else { seq_lo = M_P + ((m - M_P) & ~4095); S = 4096; } }

DI void tr_job(const float* __restrict__ src, int K, int N, u16* __restrict__ dst, int mode, float* tile, int bid, int nb, int& rot) {
  const int tk = K >> 6, tn = (N + 63) >> 6, nt = tk * tn;
  const int tx = threadIdx.x & 63, ty = threadIdx.x >> 6;
  for (int t = (bid + nb - rot) % nb; t < nt; t += nb) {
    const int k0 = (t / tn) << 6, n0 = (t % tn) << 6;
    __syncthreads();
#pragma unroll 4
    for (int r = 0; r < 16; ++r) { const int kk = ty + 4 * r, n = n0 + tx; tile[kk * 65 + tx] = n < N ? src[(size_t)(k0 + kk) * N + n] : 0.f; }
    __syncthreads();
#pragma unroll 4
    for (int r = 0; r < 16; ++r) {
      const int nn = ty + 4 * r, n = n0 + nn;
      if (n < N) { const int row = mode == 0 ? n : ((n >> 5) * 64 + (n & 31) + (mode == 2 ? 32 : 0)); dst[(size_t)row * K + k0 + tx] = f2bf(tile[tx * 65 + nn]); }
    }
  }
  rot = (rot + nt) % nb;
}

DI void rmsnorm_phase(const float* __restrict__ s0, const float* __restrict__ s1, const float* __restrict__ g, u16* outb, float* outf, int gw, int nw) {
  const int lane = threadIdx.x & 63;
  for (int m = gw; m < M_TOT; m += nw) {
    const float* src = m < M_P ? s0 + (size_t)m * DM : s1 + (size_t)(m - M_P) * DM;
    f32x4 v[4];
#pragma unroll
    for (int i = 0; i < 4; ++i) v[i] = *(const f32x4*)(src + i * 256 + lane * 4);
    float ss = 0.f;
#pragma unroll
    for (int i = 0; i < 4; ++i) ss += v[i][0] * v[i][0] + v[i][1] * v[i][1] + v[i][2] * v[i][2] + v[i][3] * v[i][3];
#pragma unroll
    for (int o = 32; o > 0; o >>= 1) ss += __shfl_xor(ss, o);
    const float rs = rsqrtf(ss * (1.f / 1024.f) + 1e-6f);
#pragma unroll
    for (int i = 0; i < 4; ++i) {
      const f32x4 gg = *(const f32x4*)(g + i * 256 + lane * 4);
      const f32x4 y = v[i] * rs * gg;
      if (outb) { u32x2 w = {pk2(y[0], y[1]), pk2(y[2], y[3])}; *(u32x2*)(outb + (size_t)m * DM + i * 256 + lane * 4) = w; }
      else *(f32x4*)(outf + (size_t)m * DM + i * 256 + lane * 4) = y;
    }
  }
}

DI void prep_phase(const Params& p, char* lds, int bid, int nb) {
  float* tile = (float*)lds;
  char* ws = p.ws;
  int rot = 0;
  tr_job(p.ab_w_in, 1024, 2560, (u16*)(ws + WT_ABIN), 0, tile, bid, nb, rot);
  tr_job(p.ab_w_out, 1024, 1024, (u16*)(ws + WT_ABOUT), 0, tile, bid, nb, rot);
  tr_job(p.w_gate, 1024, FH, (u16*)(ws + WT_GU0), 1, tile, bid, nb, rot);
  tr_job(p.w_up, 1024, FH, (u16*)(ws + WT_GU0), 2, tile, bid, nb, rot);
  tr_job(p.w_gate + (size_t)1024 * FH, 1024, FH, (u16*)(ws + WT_GU1), 1, tile, bid, nb, rot);
  tr_job(p.w_up + (size_t)1024 * FH, 1024, FH, (u16*)(ws + WT_GU1), 2, tile, bid, nb, rot);
  tr_job(p.w_down, FH, 1024, (u16*)(ws + WT_DOWN0), 0, tile, bid, nb, rot);
  tr_job(p.w_down + (size_t)FH * 1024, FH, 1024, (u16*)(ws + WT_DOWN1), 0, tile, bid, nb, rot);
  tr_job(p.mla_w_in, 1024, 672, (u16*)(ws + WT_MLAIN), 0, tile, bid, nb, rot);
  tr_job(p.w_qb, 384, 1536, (u16*)(ws + WT_QB), 0, tile, bid, nb, rot);
  tr_job(p.w_kvb, 256, 2048, (u16*)(ws + WT_KVB), 0, tile, bid, nb, rot);
  tr_job(p.mla_w_out, 1024, 1024, (u16*)(ws + WT_MLAOUT), 0, tile, bid, nb, rot);
  for (int dg = 0; dg < 32; ++dg) {
    const int cb = dg & 7, gate = (dg >> 3) & 1, dir = dg >> 4;
    const float* src = (gate == 0 ? p.w_a : p.w_i) + (size_t)(dir * 8 + cb) * 4096;
    tr_job(src, 64, 64, (u16*)(ws + WT_GATES) + (size_t)dg * 4096, 0, tile, bid, nb, rot);
  }
  const int gtid = bid * 256 + threadIdx.x, gn = nb * 256;
  { u16* d = (u16*)(ws + WT_MLAIN) + (size_t)672 * 1024; for (int i = gtid; i < 96 * 1024; i += gn) d[i] = 0; }
  { float* ct = (float*)(ws + OFF_COS); float* st = (float*)(ws + OFF_SIN);
    for (int i = gtid; i < 8192 * 16; i += gn) {
      const int pos = i >> 4, k = i & 15;
      const float inv_freq = 1.0f / powf(10000.0f, (float)(2 * k) / 32.0f);
      const float ang = (float)pos * inv_freq;
      double f = (double)ang * 0.15915494309189535; f -= rint(f);
      ct[i] = __builtin_amdgcn_cosf((float)f); st[i] = __builtin_amdgcn_sinf((float)f);
    } }
  rmsnorm_phase(p.xin0, p.xin1, p.norm_mix, (u16*)(ws + OFF_H), nullptr, bid * 4 + (threadIdx.x >> 6), nb * 4);
}

constexpr int GP = 72;
enum { EPI_BF16 = 0, EPI_RESID = 1, EPI_SWIGLU = 2 };
template <int EPI>
DI void gemm_phase(const u16* __restrict__ A, int lda, const u16* __restrict__ Bt, int K, int N, u16* outb, int ldo,
                   const float* r0, const float* r1, float* outf, char* lds, int bid, int nb) {
  const int tid = threadIdx.x, lane = tid & 63, wid = tid >> 6, wr = wid >> 1, wc = wid & 1, r32 = lane & 31, hi = lane >> 5;
  u16* As = (u16*)lds; u16* Bs = As + 2 * 128 * GP;
  const int nN = N >> 7, nT = (M_TOT >> 7) * nN, nk = K >> 6;
  const int lrow = tid >> 3, lch = tid & 7;
  for (int t = bid; t < nT; t += nb) {
    const int tm = t / nN, tn = t - tm * nN;
    const u16* Ag = A + (size_t)(tm * 128 + lrow) * lda + lch * 8;
    const u16* Bg = Bt + (size_t)(tn * 128 + lrow) * K + lch * 8;
    f32x16 acc00 = {}, acc01 = {}, acc10 = {}, acc11 = {};
    u32x4 ra[4], rb[4];
#pragma unroll
    for (int i = 0; i < 4; ++i) { ra[i] = *(const u32x4*)(Ag + (size_t)i * 32 * lda); rb[i] = *(const u32x4*)(Bg + (size_t)i * 32 * K); }
#pragma unroll
    for (int i = 0; i < 4; ++i) { *(u32x4*)(As + (lrow + 32 * i) * GP + lch * 8) = ra[i]; *(u32x4*)(Bs + (lrow + 32 * i) * GP + lch * 8) = rb[i]; }
    __syncthreads();
    for (int kt = 0; kt < nk; ++kt) {
      const int cur = kt & 1;
      if (kt + 1 < nk) {
#pragma unroll
        for (int i = 0; i < 4; ++i) { ra[i] = *(const u32x4*)(Ag + (size_t)i * 32 * lda + (kt + 1) * 64); rb[i] = *(const u32x4*)(Bg + (size_t)i * 32 * K + (kt + 1) * 64); }
      }
      const u16* as = As + cur * 128 * GP + (wr * 64 + r32) * GP + hi * 8;
      const u16* bs = Bs + cur * 128 * GP + (wc * 64 + r32) * GP + hi * 8;
#pragma unroll
      for (int ks = 0; ks < 4; ++ks) {
        const bf16x8 a0 = *(const bf16x8*)(as + ks * 16), a1 = *(const bf16x8*)(as + 32 * GP + ks * 16);
        const bf16x8 b0 = *(const bf16x8*)(bs + ks * 16), b1 = *(const bf16x8*)(bs + 32 * GP + ks * 16);
        acc00 = MFMA32(a0, b0, acc00); acc01 = MFMA32(a0, b1, acc01); acc10 = MFMA32(a1, b0, acc10); acc11 = MFMA32(a1, b1, acc11);
      }
      if (kt + 1 < nk) {
        u16* ad = As + (cur ^ 1) * 128 * GP; u16* bd = Bs + (cur ^ 1) * 128 * GP;
#pragma unroll
        for (int i = 0; i < 4; ++i) { *(u32x4*)(ad + (lrow + 32 * i) * GP + lch * 8) = ra[i]; *(u32x4*)(bd + (lrow + 32 * i) * GP + lch * 8) = rb[i]; }
      }
      __syncthreads();
    }
    const int mrow = tm * 128 + wr * 64;
    if constexpr (EPI == EPI_BF16) {
      const int col = tn * 128 + wc * 64 + r32;
#pragma unroll
      for (int reg = 0; reg < 16; ++reg) {
        const int rr = crow(reg, hi);
        u16* o0 = outb + (size_t)(mrow + rr) * ldo + col; u16* o1 = outb + (size_t)(mrow + 32 + rr) * ldo + col;
        o0[0] = f2bf(acc00[reg]); o0[32] = f2bf(acc01[reg]); o1[0] = f2bf(acc10[reg]); o1[32] = f2bf(acc11[reg]);
      }
    } else if constexpr (EPI == EPI_RESID) {
      const int col = tn * 128 + wc * 64 + r32;
      const float* rb_ = (tm * 128 < M_P) ? r0 : (r1 - (size_t)M_P * DM);
#pragma unroll
      for (int reg = 0; reg < 16; ++reg) {
        const int rr = crow(reg, hi);
        const size_t i0 = (size_t)(mrow + rr) * DM + col, i1 = (size_t)(mrow + 32 + rr) * DM + col;
        const float x00 = rb_[i0], x01 = rb_[i0 + 32], x10 = rb_[i1], x11 = rb_[i1 + 32];
        outf[i0] = x00 + acc00[reg]; outf[i0 + 32] = x01 + acc01[reg]; outf[i1] = x10 + acc10[reg]; outf[i1 + 32] = x11 + acc11[reg];
      }
    } else {
      const int col = (tn * 2 + wc) * 32 + r32;
#pragma unroll
      for (int reg = 0; reg < 16; ++reg) {
        const int rr = crow(reg, hi);
        const float g0 = acc00[reg], u0 = acc01[reg], g1 = acc10[reg], u1 = acc11[reg];
        outb[(size_t)(mrow + rr) * ldo + col] = f2bf(g0 * sigmoidf_(g0) * u0);
        outb[(size_t)(mrow + 32 + rr) * ldo + col] = f2bf(g1 * sigmoidf_(g1) * u1);
      }
    }
  }
}

template <bool FINAL>
DI void rg_phase(const Params& p, char* lds, int bid, int nb) {
  const int tid = threadIdx.x, lane = tid & 63, wid = tid >> 6, r32 = lane & 31, hi = lane >> 5;
  float* xcf = (float*)lds;
  u16* xcb = (u16*)(lds + 16384);
  float* Ab = (float*)(lds + 25600);
  float* U0 = (float*)(lds + 41984);
  float* U1 = (float*)(lds + 58368);
  const u16* PROJ = (const u16*)(p.ws + OFF_PROJ);
  const u16* WG = (const u16*)(p.ws + WT_GATES);
  float* SUM = (float*)(p.ws + OFF_SUM);
  const float* CARRY = (const float*)(p.ws + OFF_CARRY);
  u16* Y = (u16*)(p.ws + OFF_Y);
  for (int it = bid; it < 768 * 8; it += nb) {
    const int gc = it >> 3, cb = it & 7, m0 = gc * 64;
    int seq_lo, S; row_info(m0, seq_lo, S); const int seq_hi = seq_lo + S;
    __syncthreads();
    {
      const int ch = tid & 63, tq = tid >> 6, c = cb * 64 + ch;
      const float w0 = p.conv_w[c], w1 = p.conv_w[512 + c], w2 = p.conv_w[1024 + c], w3 = p.conv_w[1536 + c], cbias = p.conv_b[c];
      const int t0 = tq * 16;
      auto ld = [&](int t) -> float { const int m = m0 + t; return (m >= seq_lo && m < seq_hi) ? bf2f(PROJ[(size_t)m * 2560 + c]) : 0.f; };
      float xm2 = ld(t0 - 2), xm1 = ld(t0 - 1), x0 = ld(t0);
#pragma unroll 4
      for (int t = t0; t < t0 + 16; ++t) {
        const float xp1 = ld(t + 1);
        const float xc = w0 * xm2 + w1 * xm1 + w2 * x0 + w3 * xp1 + cbias;
        xcf[t * 64 + ch] = xc; xcb[t * 72 + ch] = f2bf(xc);
        xm2 = xm1; xm1 = x0; x0 = xp1;
      }
    }
    __syncthreads();
#pragma unroll 1
    for (int dir = 0; dir < 2; ++dir) {
      float* Ub = dir == 0 ? U0 : U1;
      {
        const int mt = wid >> 1, nt = wid & 1;
        f32x16 aa = {}, ai = {};
        const u16* wa = WG + (size_t)((dir * 2 + 0) * 8 + cb) * 4096 + (nt * 32 + r32) * 64 + 8 * hi;
        const u16* wi = WG + (size_t)((dir * 2 + 1) * 8 + cb) * 4096 + (nt * 32 + r32) * 64 + 8 * hi;
#pragma unroll
        for (int ks = 0; ks < 4; ++ks) {
          const bf16x8 af = *(const bf16x8*)(xcb + (mt * 32 + r32) * 72 + ks * 16 + 8 * hi);
          const bf16x8 ba = *(const bf16x8*)(wa + ks * 16), bi = *(const bf16x8*)(wi + ks * 16);
          aa = MFMA32(af, ba, aa); ai = MFMA32(af, bi, ai);
        }
        const int ch = nt * 32 + r32, c = cb * 64 + ch;
        const float bav = p.b_a[dir * 512 + c], biv = p.b_i[dir * 512 + c];
        const float sp = log1pf(__expf(-p.lam[dir * 512 + c]));
#pragma unroll
        for (int reg = 0; reg < 16; ++reg) {
          const int tok = mt * 32 + crow(reg, hi);
          const float r = sigmoidf_(aa[reg] + bav), gi = sigmoidf_(ai[reg] + biv);
          const float la = -8.f * r * sp, a = __expf(la);
          const float mult = sqrtf(fmaxf(0.f, 1.f - __expf(2.f * la)));
          Ab[tok * 64 + ch] = a; Ub[tok * 64 + ch] = mult * gi * xcf[tok * 64 + ch];
        }
      }
      __syncthreads();
      if (tid < 64) {
        const int ch = tid, c = cb * 64 + ch;
        if (!FINAL) {
          float h = 0.f, P = 1.f;
#pragma unroll 8
          for (int k = 0; k < 64; ++k) { const int t = dir == 0 ? k : 63 - k; const float a = Ab[t * 64 + ch], u = Ub[t * 64 + ch]; h = a * h + u; P *= a; }
          SUM[(size_t)((gc * 2 + dir) * 2 + 0) * 512 + c] = P; SUM[(size_t)((gc * 2 + dir) * 2 + 1) * 512 + c] = h;
        } else {
          float h = CARRY[(size_t)(gc * 2 + dir) * 512 + c];
          if (dir == 0) {
#pragma unroll 8
            for (int t = 0; t < 64; ++t) { const float a = Ab[t * 64 + ch], u = Ub[t * 64 + ch]; h = a * h + u; Ub[t * 64 + ch] = h; }
          } else {
#pragma unroll 8
            for (int k = 0; k < 64; ++k) {
              const int t = 63 - k; const float a = Ab[t * 64 + ch], u = Ub[t * 64 + ch]; h = a * h + u;
              const float gt = bf2f(PROJ[(size_t)(m0 + t) * 2560 + 512 + c]);
              const float ge = gt * sigmoidf_(1.5957691216057308f * (gt + 0.044715f * gt * gt * gt));
              Y[(size_t)(m0 + t) * 1024 + c] = f2bf(ge * (U0[t * 64 + ch] + h));
            }
          }
        }
      }
      __syncthreads();
    }
  }
}

DI void rg_carry_phase(const Params& p, int bid, int nb) {
  const float* __restrict__ SUM = (const float*)(p.ws + OFF_SUM);
  float* __restrict__ CARRY = (float*)(p.ws + OFF_CARRY);
  for (int idx = bid * 256 + threadIdx.x; idx < 8192; idx += nb * 256) {
    const int c = idx & 511, dir = (idx >> 9) & 1, seq = idx >> 10;
    const int gc0 = seq < 4 ? seq * 128 : 512 + (seq - 4) * 64, nch = seq < 4 ? 128 : 64;
    float carry = 0.f;
    for (int k0 = 0; k0 < nch; k0 += 8) {
      float P[8], Hh[8];
#pragma unroll
      for (int j = 0; j < 8; ++j) { const int k = k0 + j, gc = dir == 0 ? gc0 + k : gc0 + nch - 1 - k; P[j] = SUM[(size_t)((gc * 2 + dir) * 2 + 0) * 512 + c]; Hh[j] = SUM[(size_t)((gc * 2 + dir) * 2 + 1) * 512 + c]; }
#pragma unroll
      for (int j = 0; j < 8; ++j) { const int k = k0 + j, gc = dir == 0 ? gc0 + k : gc0 + nch - 1 - k; CARRY[(size_t)(gc * 2 + dir) * 512 + c] = carry; carry = P[j] * carry + Hh[j]; }
    }
  }
}

DI void dil_tile_info(int ti, int m0, int& d, int& u0) {
  if (ti < 5) { d = 16; u0 = m0 - 1024 + ti * 512; } else if (ti < 13) { d = 4; u0 = m0 - 256 + (ti - 5) * 128; } else { d = 1; u0 = m0 - 64 + (ti - 13) * 32; }
}
DI void dilated_phase(const Params& p, char* lds, int gw, int nw) {
  const int lane = threadIdx.x & 63, wid = threadIdx.x >> 6, r32 = lane & 31, hi = lane >> 5;
  u16* Vl = (u16*)(lds + wid * 6144);
  const unsigned vbase = (unsigned)(uintptr_t)Vl;
  const int li = lane & 15, tq = li >> 2, tp = li & 3, g1 = (lane >> 4) & 1;
  const unsigned trb = vbase + (4 * hi + tq) * 192 + (16 * g1 + 4 * tp) * 2;
  const u16* PROJ = (const u16*)(p.ws + OFF_PROJ);
  u16* Y = (u16*)(p.ws + OFF_Y);
  const int vrow = lane >> 3, vch = lane & 7;
  for (int id = gw; id < 12288; id += nw) {
    const int res = id & 15, h = (id >> 4) & 7, sp = id >> 7;
    const int m0 = sp * 512 + res;
    int seq_lo, S; row_info(sp * 512, seq_lo, S); const int seq_hi = seq_lo + S;
    const int mq = m0 + 16 * r32;
    bf16x8 qf[4];
#pragma unroll
    for (int ks = 0; ks < 4; ++ks) qf[ks] = *(const bf16x8*)(PROJ + (size_t)mq * 2560 + 1024 + h * 64 + ks * 16 + 8 * hi);
    const float slope2 = exp2f(-(float)(h + 1)) * LOG2E;
    const float c1 = 0.125f * LOG2E;
    float m_run = -1e30f, l_run = 0.f; f32x16 o0 = {}, o1 = {};
    const u16* kbase = PROJ + 1536 + h * 64 + 8 * hi;
    const u16* vbaseg = PROJ + 2048 + h * 64 + vch * 8;
    bf16x8 kf[4]; u32x4 vr[4];
    { int d, u0; dil_tile_info(0, m0, d, u0);
      const int ur = min(max(u0 + d * r32, seq_lo), seq_hi - 1);
#pragma unroll
      for (int ks = 0; ks < 4; ++ks) kf[ks] = *(const bf16x8*)(kbase + (size_t)ur * 2560 + ks * 16);
#pragma unroll
      for (int i = 0; i < 4; ++i) { const int uv = min(max(u0 + d * (vrow + 8 * i), seq_lo), seq_hi - 1); vr[i] = *(const u32x4*)(vbaseg + (size_t)uv * 2560); } }
#pragma unroll 1
    for (int ti = 0; ti < 33; ++ti) {
      int d, u0; dil_tile_info(ti, m0, d, u0);
#pragma unroll
      for (int i = 0; i < 4; ++i) *(u32x4*)(Vl + (vrow + 8 * i) * 96 + vch * 8) = vr[i];
      f32x16 pt = {};
#pragma unroll
      for (int ks = 0; ks < 4; ++ks) pt = MFMA32(kf[ks], qf[ks], pt);
      if (ti + 1 < 33) {
        int dn, un; dil_tile_info(ti + 1, m0, dn, un);
        const int ur = min(max(un + dn * r32, seq_lo), seq_hi - 1);
#pragma unroll
        for (int ks = 0; ks < 4; ++ks) kf[ks] = *(const bf16x8*)(kbase + (size_t)ur * 2560 + ks * 16);
#pragma unroll
        for (int i = 0; i < 4; ++i) { const int uv = min(max(un + dn * (vrow + 8 * i), seq_lo), seq_hi - 1); vr[i] = *(const u32x4*)(vbaseg + (size_t)uv * 2560); }
      }
      const s16x4 l00 = tr_read(trb), h00 = tr_read(trb + 8 * 192), l01 = tr_read(trb + 64), h01 = tr_read(trb + 8 * 192 + 64);
      const s16x4 l10 = tr_read(trb + 16 * 192), h10 = tr_read(trb + 24 * 192), l11 = tr_read(trb + 16 * 192 + 64), h11 = tr_read(trb + 24 * 192 + 64);
      const int du0 = u0 - mq + d * 4 * hi, lim = 64 * d;
      float pmax = -INFINITY;
#pragma unroll
      for (int reg = 0; reg < 16; ++reg) {
        const int du = du0 + d * ((reg & 3) + 8 * (reg >> 2)), u = mq + du, ad = du < 0 ? -du : du;
        const bool valid = (ad <= lim) && (u >= seq_lo) && (u < seq_hi);
        const float tv = valid ? (pt[reg] * c1 - slope2 * (float)ad) : -INFINITY;
        pt[reg] = tv; pmax = fmaxf(pmax, tv);
      }
      pmax = pl32_max(pmax);
      if (__any(pmax > m_run)) {
        const float mn = fmaxf(m_run, pmax), alpha = __builtin_amdgcn_exp2f(m_run - mn);
        m_run = mn; l_run *= alpha;
#pragma unroll
        for (int reg = 0; reg < 16; ++reg) { o0[reg] *= alpha; o1[reg] *= alpha; }
      }
      float ps = 0.f;
#pragma unroll
      for (int reg = 0; reg < 16; ++reg) { pt[reg] = __builtin_amdgcn_exp2f(pt[reg] - m_run); ps += pt[reg]; }
      ps = pl32_sum(ps);
      l_run += ps;
      const bf16x8 pb0 = pack8(pt, 0), pb1 = pack8(pt, 1);
      LGKM0();
      o0 = MFMA32(cat4(l00, h00), pb0, o0); o0 = MFMA32(cat4(l10, h10), pb1, o0);
      o1 = MFMA32(cat4(l01, h01), pb0, o1); o1 = MFMA32(cat4(l11, h11), pb1, o1);
    }
    const float inv = 1.f / l_run;
    u16* yo = Y + (size_t)mq * 1024 + 512 + h * 64 + 4 * hi;
#pragma unroll
    for (int g = 0; g < 4; ++g) {
      u32x2 w0 = {pk2(o0[4 * g] * inv, o0[4 * g + 1] * inv), pk2(o0[4 * g + 2] * inv, o0[4 * g + 3] * inv)};
      u32x2 w1 = {pk2(o1[4 * g] * inv, o1[4 * g + 1] * inv), pk2(o1[4 * g + 2] * inv, o1[4 * g + 3] * inv)};
      *(u32x2*)(yo + 8 * g) = w0; *(u32x2*)(yo + 32 + 8 * g) = w1;
    }
  }
}

DI void mla_norm_phase(const Params& p, int gw, int nw) {
  const int lane = threadIdx.x & 63;
  const u16* P2 = (const u16*)(p.ws + OFF_P2);
  u16* CQN = (u16*)(p.ws + OFF_CQN); u16* CKVN = (u16*)(p.ws + OFF_CKVN); u16* KR = (u16*)(p.ws + OFF_KR);
  const float* ct = (const float*)(p.ws + OFF_COS); const float* st = (const float*)(p.ws + OFF_SIN);
  for (int m = gw; m < M_TOT; m += nw) {
    const u16* src = P2 + (size_t)m * 768;
    float q[6], kv[4]; float sq = 0.f, skv = 0.f;
#pragma unroll
    for (int i = 0; i < 6; ++i) { q[i] = bf2f(src[i * 64 + lane]); sq += q[i] * q[i]; }
#pragma unroll
    for (int i = 0; i < 4; ++i) { kv[i] = bf2f(src[384 + i * 64 + lane]); skv += kv[i] * kv[i]; }
#pragma unroll
    for (int o = 32; o > 0; o >>= 1) { sq += __shfl_xor(sq, o); skv += __shfl_xor(skv, o); }
    const float rq = rsqrtf(sq * (1.f / 384.f) + 1e-6f), rkv = rsqrtf(skv * (1.f / 256.f) + 1e-6f);
#pragma unroll
    for (int i = 0; i < 6; ++i) CQN[(size_t)m * 384 + i * 64 + lane] = f2bf(q[i] * rq * p.q_norm[i * 64 + lane]);
#pragma unroll
    for (int i = 0; i < 4; ++i) CKVN[(size_t)m * 256 + i * 64 + lane] = f2bf(kv[i] * rkv * p.kv_norm[i * 64 + lane]);
    if (lane < 16) {
      const int pos = m < M_P ? (m & 8191) : ((m - M_P) & 4095);
      const float t1 = bf2f(src[640 + lane]), t2 = bf2f(src[656 + lane]);
      const float c = ct[pos * 16 + lane], s = st[pos * 16 + lane];
      KR[(size_t)m * 32 + lane] = f2bf(t1 * c - t2 * s); KR[(size_t)m * 32 + 16 + lane] = f2bf(t1 * s + t2 * c);
    }
  }
}

constexpr int KP = 104, VP = 96;
DI void mla_unit(const Params& p, char* lds, int seqbase, int S, int h, int qb) {
  const int tid = threadIdx.x, lane = tid & 63, wid = tid >> 6, r32 = lane & 31, hi = lane >> 5;
  u16* Kl = (u16*)lds;
  u16* Vl = (u16*)(lds + 2 * 64 * KP * 2);
  const unsigned vbase = (unsigned)(uintptr_t)Vl;
  const int li = lane & 15, tq = li >> 2, tp = li & 3, g1 = (lane >> 4) & 1;
  const unsigned trb = vbase + (4 * hi + tq) * (VP * 2) + (16 * g1 + 4 * tp) * 2;
  const u16* Q = (const u16*)(p.ws + OFF_Q); const u16* KV = (const u16*)(p.ws + OFF_KV); const u16* KR = (const u16*)(p.ws + OFF_KR);
  u16* O = (u16*)(p.ws + OFF_O);
  const float* ct = (const float*)(p.ws + OFF_COS); const float* st = (const float*)(p.ws + OFF_SIN);
  const int pos = qb * 128 + wid * 32 + r32, qrow = seqbase + pos;
  bf16x8 qf[6];
#pragma unroll
  for (int d0 = 0; d0 < 6; ++d0) qf[d0] = *(const bf16x8*)(Q + (size_t)qrow * 1536 + h * 96 + d0 * 16 + 8 * hi);
  const float C = 0.10206207261596577f * LOG2E;
#pragma unroll
  for (int j = 0; j < 8; ++j) {
    const float c = ct[pos * 16 + 8 * hi + j], s = st[pos * 16 + 8 * hi + j];
    const float t1 = bfs2f(qf[4][j]), t2 = bfs2f(qf[5][j]);
    qf[4][j] = (short)f2bf((t1 * c - t2 * s) * C); qf[5][j] = (short)f2bf((t1 * s + t2 * c) * C);
  }
#pragma unroll
  for (int d0 = 0; d0 < 4; ++d0)
#pragma unroll
    for (int j = 0; j < 8; ++j) qf[d0][j] = (short)f2bf(bfs2f(qf[d0][j]) * C);
  const u16* ksrc[3]; int kdst[3];
#pragma unroll
  for (int i = 0; i < 3; ++i) {
    const int idx = tid + 256 * i, row = idx / 12, c = idx - row * 12;
    ksrc[i] = c < 8 ? KV + (size_t)(seqbase + row) * 2048 + h * 128 + c * 8 : KR + (size_t)(seqbase + row) * 32 + (c - 8) * 8;
    kdst[i] = row * KP + c * 8;
  }
  const int kstride[3] = {0, 0, 0}; (void)kstride;
  const int vrow = tid >> 3, vc = tid & 7;
  const u16* vsrc = KV + (size_t)(seqbase + vrow) * 2048 + h * 128 + 64 + vc * 8;
  const int vdst = vrow * VP + vc * 8;
  size_t kadv[3];
#pragma unroll
  for (int i = 0; i < 3; ++i) { const int idx = tid + 256 * i, row = idx / 12, c = idx - row * 12; (void)row; kadv[i] = c < 8 ? (size_t)64 * 2048 : (size_t)64 * 32; }
  float l_run = 0.f; f32x16 o0 = {}, o1 = {}, negm = {};
  const int nkt = S >> 6;
  u32x4 rk[3], rv[2];
#pragma unroll
  for (int i = 0; i < 3; ++i) rk[i] = *(const u32x4*)(ksrc[i]);
  rv[0] = *(const u32x4*)(vsrc); rv[1] = *(const u32x4*)(vsrc + (size_t)32 * 2048);
#pragma unroll
  for (int i = 0; i < 3; ++i) *(u32x4*)(Kl + kdst[i]) = rk[i];
  *(u32x4*)(Vl + vdst) = rv[0]; *(u32x4*)(Vl + vdst + 32 * VP) = rv[1];
  __syncthreads();
#pragma unroll 1
  for (int kt = 0; kt < nkt; ++kt) {
    const int cur = kt & 1;
    if (kt + 1 < nkt) {
#pragma unroll
      for (int i = 0; i < 3; ++i) rk[i] = *(const u32x4*)(ksrc[i] + (size_t)(kt + 1) * kadv[i]);
      rv[0] = *(const u32x4*)(vsrc + (size_t)(kt + 1) * 64 * 2048); rv[1] = *(const u32x4*)(vsrc + (size_t)(kt + 1) * 64 * 2048 + (size_t)32 * 2048);
    }
    const u16* kl = Kl + cur * 64 * KP + r32 * KP + 8 * hi;
    f32x16 p0, p1;
    { const bf16x8 k0 = *(const bf16x8*)(kl), k1 = *(const bf16x8*)(kl + 32 * KP);
      p0 = MFMA32(k0, qf[0], negm); p1 = MFMA32(k1, qf[0], negm); }
#pragma unroll
    for (int d0 = 1; d0 < 6; ++d0) {
      const bf16x8 k0 = *(const bf16x8*)(kl + d0 * 16), k1 = *(const bf16x8*)(kl + 32 * KP + d0 * 16);
      p0 = MFMA32(k0, qf[d0], p0); p1 = MFMA32(k1, qf[d0], p1);
    }
    const unsigned tb = trb + cur * (64 * VP * 2), tc = tb + 64;
    const s16x4 a0 = tr_read(tb), b0 = tr_read(tb + 8 * VP * 2), a1 = tr_read(tb + 16 * VP * 2), b1 = tr_read(tb + 24 * VP * 2);
    const s16x4 a2 = tr_read(tb + 32 * VP * 2), b2 = tr_read(tb + 40 * VP * 2), a3 = tr_read(tb + 48 * VP * 2), b3 = tr_read(tb + 56 * VP * 2);
    const s16x4 c0 = tr_read(tc), d0_ = tr_read(tc + 8 * VP * 2), c1 = tr_read(tc + 16 * VP * 2), d1 = tr_read(tc + 24 * VP * 2);
    const s16x4 c2 = tr_read(tc + 32 * VP * 2), d2 = tr_read(tc + 40 * VP * 2), c3 = tr_read(tc + 48 * VP * 2), d3 = tr_read(tc + 56 * VP * 2);
    float pmax = fmaxf(p0[0], p1[0]);
#pragma unroll
    for (int r = 1; r < 16; ++r) pmax = fmaxf(pmax, fmaxf(p0[r], p1[r]));
    pmax = pl32_max(pmax);
    if (kt == 0 || __any(pmax > 8.f)) {
      const float delta = kt == 0 ? pmax : fmaxf(pmax, 0.f);
      const float alpha = kt == 0 ? 1.f : __builtin_amdgcn_exp2f(-delta);
#pragma unroll
      for (int r = 0; r < 16; ++r) { negm[r] -= delta; p0[r] -= delta; p1[r] -= delta; o0[r] *= alpha; o1[r] *= alpha; }
      l_run *= alpha;
    }
    float ps = 0.f;
#pragma unroll
    for (int r = 0; r < 16; ++r) { p0[r] = __builtin_amdgcn_exp2f(p0[r]); p1[r] = __builtin_amdgcn_exp2f(p1[r]); ps += p0[r] + p1[r]; }
    ps = pl32_sum(ps);
    l_run += ps;
    const bf16x8 pb0 = pack8(p0, 0), pb1 = pack8(p0, 1), pb2 = pack8(p1, 0), pb3 = pack8(p1, 1);
    LGKM0();
    o0 = MFMA32(cat4(a0, b0), pb0, o0); o1 = MFMA32(cat4(c0, d0_), pb0, o1);
    o0 = MFMA32(cat4(a1, b1), pb1, o0); o1 = MFMA32(cat4(c1, d1), pb1, o1);
    o0 = MFMA32(cat4(a2, b2), pb2, o0); o1 = MFMA32(cat4(c2, d2), pb2, o1);
    o0 = MFMA32(cat4(a3, b3), pb3, o0); o1 = MFMA32(cat4(c3, d3), pb3, o1);
    if (kt + 1 < nkt) {
      u16* kd = Kl + (cur ^ 1) * 64 * KP; u16* vd = Vl + (cur ^ 1) * 64 * VP;
#pragma unroll
      for (int i = 0; i < 3; ++i) *(u32x4*)(kd + kdst[i]) = rk[i];
      *(u32x4*)(vd + vdst) = rv[0]; *(u32x4*)(vd + vdst + 32 * VP) = rv[1];
    }
    __syncthreads();
  }
  const float inv = 1.f / l_run;
  u16* oo = O + (size_t)qrow * 1024 + h * 64 + 4 * hi;
#pragma unroll
  for (int g = 0; g < 4; ++g) {
    u32x2 w0 = {pk2(o0[4 * g] * inv, o0[4 * g + 1] * inv), pk2(o0[4 * g + 2] * inv, o0[4 * g + 3] * inv)};
    u32x2 w1 = {pk2(o1[4 * g] * inv, o1[4 * g + 1] * inv), pk2(o1[4 * g + 2] * inv, o1[4 * g + 3] * inv)};
    *(u32x2*)(oo + 8 * g) = w0; *(u32x2*)(oo + 32 + 8 * g) = w1;
  }
}

DI void mla_attn_phase(const Params& p, char* lds, int bid, int nb) {
  if ((nb & 7) == 0) {
    const int xcd = bid & 7, j = bid >> 3, nper = nb >> 3;
    for (int lu = j; lu < 8 * 64; lu += nper) { const int bh = (lu >> 6) * 8 + xcd, qb = lu & 63; mla_unit(p, lds, (bh >> 4) * 8192, 8192, bh & 15, qb); }
    for (int lu = j; lu < 8 * 32; lu += nper) { const int bh = (lu >> 5) * 8 + xcd, qb = lu & 31; mla_unit(p, lds, M_P + (bh >> 4) * 4096, 4096, bh & 15, qb); }
  } else {
    for (int u = bid; u < 4096; u += nb) { const int bh = u >> 6, qb = u & 63; mla_unit(p, lds, (bh >> 4) * 8192, 8192, bh & 15, qb); }
    for (int u = bid; u < 2048; u += nb) { const int bh = u >> 5, qb = u & 31; mla_unit(p, lds, M_P + (bh >> 4) * 4096, 4096, bh & 15, qb); }
  }
}

#define XB_TMO      128
#define XB_XCNT(j)  (256  + 64 * (j))
#define XB_XSUB(j)  (1280 + 64 * (j))
#define XB_XGEN(j)  (2304 + 64 * (j))
#define XB_TOP      3328
#define XB_TOPGEN   3392
#define XCD_BAR_WORDS 3456
#define XB_SPIN_CAP (1u << 20)
#define LAS __attribute__((address_space(3)))
DI unsigned xb_ld(unsigned* p) { return __hip_atomic_load(p, __ATOMIC_RELAXED, __HIP_MEMORY_SCOPE_AGENT); }
DI unsigned xb_add(unsigned* p, unsigned v) { return __hip_atomic_fetch_add(p, v, __ATOMIC_RELAXED, __HIP_MEMORY_SCOPE_AGENT); }
DI unsigned xb_xcc_id() { return (unsigned)__builtin_amdgcn_s_getreg((3 << 11) | 20) & 0xFu; }
#define XB_SPIN(cond, bar) do { unsigned _sp = 0; while (cond) { __builtin_amdgcn_s_sleep(1); \
    if ((++_sp & 255u) == 0u) { if (xb_ld(&(bar)[XB_TMO])) break; if (_sp > XB_SPIN_CAP) { atomicAdd(&(bar)[XB_TMO], 1u); break; } } } } while (0)
struct XcdBarrier { unsigned* bar; unsigned x; volatile LAS unsigned* st; };
DI XcdBarrier xcd_barrier_post(unsigned* bar, volatile LAS unsigned* st) {
  XcdBarrier b; b.bar = bar; b.x = xb_xcc_id(); b.st = st;
  if (threadIdx.x == 0) (void)xb_add(&bar[XB_XCNT(b.x)], 1u);
  return b;
}
DI void xcd_barrier_complete(unsigned* bar, unsigned x, unsigned& nloc, unsigned& nx) {
  const unsigned G = gridDim.x * gridDim.y * gridDim.z;
  unsigned sum, cnt, mine, sp = 0u;
  for (;;) {
    sum = 0u; cnt = 0u; mine = 0u;
#pragma unroll
    for (unsigned j = 0; j < 16; ++j) { const unsigned c = xb_ld(&bar[XB_XCNT(j)]); sum += c; cnt += (c > 0u) ? 1u : 0u; mine = (j == x) ? c : mine; }
    if (sum == G) break;
    __builtin_amdgcn_s_sleep(1);
    if ((++sp & 255u) == 0u) { if (xb_ld(&bar[XB_TMO])) break; if (sp > XB_SPIN_CAP) { atomicAdd(&bar[XB_TMO], 1u); break; } }
  }
  nloc = mine > 0u ? mine : 1u; nx = cnt > 0u ? cnt : 1u;
}
DI void xcd_barrier(const XcdBarrier& b) {
  asm volatile("s_waitcnt vmcnt(0)" ::: "memory");
  __syncthreads();
  if (threadIdx.x == 0) {
    unsigned* bar = b.bar;
    __builtin_amdgcn_s_waitcnt(0);
    unsigned nloc = b.st[0], nx = b.st[1];
    if (nloc == 0u) { xcd_barrier_complete(bar, b.x, nloc, nx); b.st[0] = nloc; b.st[1] = nx; }
    const unsigned old = xb_add(&bar[XB_XSUB(b.x)], 1u);
    const unsigned gen = old / nloc;
    if (old + 1u == (gen + 1u) * nloc) {
      __builtin_amdgcn_fence(__ATOMIC_RELEASE, "agent");
      asm volatile("s_waitcnt vmcnt(0)" ::: "memory");
      const unsigned og = xb_add(&bar[XB_TOP], 1u);
      const unsigned tg = og / nx;
      if (og + 1u == (tg + 1u) * nx) xb_add(&bar[XB_TOPGEN], 1u);
      else XB_SPIN(xb_ld(&bar[XB_TOPGEN]) == tg, bar);
      __builtin_amdgcn_fence(__ATOMIC_ACQUIRE, "agent");
      xb_add(&bar[XB_XGEN(b.x)], 1u);
      asm volatile("s_waitcnt vmcnt(0)" ::: "memory");
    } else {
      XB_SPIN(xb_ld(&bar[XB_XGEN(b.x)]) == gen, bar);
      __builtin_amdgcn_fence(__ATOMIC_ACQUIRE, "agent");
      asm volatile("s_waitcnt vmcnt(0)" ::: "memory");
    }
  }
  __syncthreads();
}

constexpr int N_PHASES = 19;
constexpr int LDS_BYTES = 74752;
__global__ void __launch_bounds__(256, 2) mega(Params p, int ph_lo, int ph_hi) {
  __shared__ __attribute__((aligned(16))) char lds[LDS_BYTES];
  const int bid = blockIdx.x, nb = gridDim.x;
  const int gw = bid * 4 + (threadIdx.x >> 6), nw = nb * 4;
  char* ws = p.ws;
  float* out1 = p.out + (size_t)M_P * DM;
  __shared__ uint4 xb_words;
  if (threadIdx.x == 0) xb_words = make_uint4(0u, 0u, 0u, 0u);
  __syncthreads();
  XcdBarrier xb; xb.bar = (unsigned*)(ws + OFF_BAR); xb.x = 0; xb.st = (volatile LAS unsigned*)&xb_words;
  if (ph_hi - ph_lo > 1) xb = xcd_barrier_post((unsigned*)(ws + OFF_BAR), (volatile LAS unsigned*)&xb_words);
  if (ph_lo < 0) cg::this_grid().sync();
#ifndef DUP_MASK
#define DUP_MASK 0
#endif
#define PHASE(k, ...) do { if (ph_lo <= (k) && (k) < ph_hi) { __VA_ARGS__ if ((DUP_MASK >> (k)) & 1) { xcd_barrier(xb); __VA_ARGS__ } } if (ph_lo <= (k) && (k) + 1 < ph_hi) xcd_barrier(xb); } while (0)
  PHASE(0, prep_phase(p, lds, bid, nb););
  PHASE(1, gemm_phase<EPI_BF16>((const u16*)(ws + OFF_H), 1024, (const u16*)(ws + WT_ABIN), 1024, 2560, (u16*)(ws + OFF_PROJ), 2560, nullptr, nullptr, nullptr, lds, bid, nb););
  PHASE(2, rg_phase<false>(p, lds, bid, nb); __syncthreads(); dilated_phase(p, lds, gw, nw););
  PHASE(3, rg_carry_phase(p, bid, nb););
  PHASE(4, rg_phase<true>(p, lds, bid, nb););
  PHASE(5, gemm_phase<EPI_RESID>((const u16*)(ws + OFF_Y), 1024, (const u16*)(ws + WT_ABOUT), 1024, 1024, nullptr, 0, p.xin0, p.xin1, p.out, lds, bid, nb););
  PHASE(6, rmsnorm_phase(p.out, out1, p.norm_ffn, (u16*)(ws + OFF_H), nullptr, gw, nw););
  PHASE(7, gemm_phase<EPI_SWIGLU>((const u16*)(ws + OFF_H), 1024, (const u16*)(ws + WT_GU0), 1024, 5632, (u16*)(ws + OFF_ACT), FH, nullptr, nullptr, nullptr, lds, bid, nb););
  PHASE(8, gemm_phase<EPI_RESID>((const u16*)(ws + OFF_ACT), FH, (const u16*)(ws + WT_DOWN0), FH, 1024, nullptr, 0, p.out, out1, p.out, lds, bid, nb););
  PHASE(9, rmsnorm_phase(p.out, out1, p.norm_mix + 1024, (u16*)(ws + OFF_H), nullptr, gw, nw););
  PHASE(10, gemm_phase<EPI_BF16>((const u16*)(ws + OFF_H), 1024, (const u16*)(ws + WT_MLAIN), 1024, 768, (u16*)(ws + OFF_P2), 768, nullptr, nullptr, nullptr, lds, bid, nb););
  PHASE(11, mla_norm_phase(p, gw, nw););
  PHASE(12, gemm_phase<EPI_BF16>((const u16*)(ws + OFF_CQN), 384, (const u16*)(ws + WT_QB), 384, 1536, (u16*)(ws + OFF_Q), 1536, nullptr, nullptr, nullptr, lds, bid, nb); gemm_phase<EPI_BF16>((const u16*)(ws + OFF_CKVN), 256, (const u16*)(ws + WT_KVB), 256, 2048, (u16*)(ws + OFF_KV), 2048, nullptr, nullptr, nullptr, lds, bid, nb););
  PHASE(13, mla_attn_phase(p, lds, bid, nb););
  PHASE(14, gemm_phase<EPI_RESID>((const u16*)(ws + OFF_O), 1024, (const u16*)(ws + WT_MLAOUT), 1024, 1024, nullptr, 0, p.out, out1, p.out, lds, bid, nb););
  PHASE(15, rmsnorm_phase(p.out, out1, p.norm_ffn + 1024, (u16*)(ws + OFF_H), nullptr, gw, nw););
  PHASE(16, gemm_phase<EPI_SWIGLU>((const u16*)(ws + OFF_H), 1024, (const u16*)(ws + WT_GU1), 1024, 5632, (u16*)(ws + OFF_ACT), FH, nullptr, nullptr, nullptr, lds, bid, nb););
  PHASE(17, gemm_phase<EPI_RESID>((const u16*)(ws + OFF_ACT), FH, (const u16*)(ws + WT_DOWN1), FH, 1024, nullptr, 0, p.out, out1, p.out, lds, bid, nb););
  PHASE(18, rmsnorm_phase(p.out, out1, p.norm_final, nullptr, p.out, gw, nw););
#undef PHASE
}

extern "C" void kernel_launch(void* const* d_in, const int* in_sizes, int n_in, void* d_out, int out_size, void* d_ws, size_t ws_size, hipStream_t stream) {
  static int grid_blocks = 0;
  if (!grid_blocks) {
    int dev = 0, cus = 0, per_cu = 0;
    hipGetDevice(&dev);
    hipDeviceGetAttribute(&cus, hipDeviceAttributeMultiprocessorCount, dev);
    hipOccupancyMaxActiveBlocksPerMultiprocessor(&per_cu, mega, 256, 0);
    if (per_cu > 2) per_cu = 2;
    if (per_cu < 1) per_cu = 1;
    grid_blocks = cus * per_cu;
  }
  if (n_in != 23 || ws_size < WS_NEED) { fprintf(stderr, "kernel_launch: bad inputs n_in=%d ws=%zu\n", n_in, ws_size); return; }
  Params p{};
  p.xin0 = (const float*)d_in[0]; p.xin1 = (const float*)d_in[1];
  p.norm_mix = (const float*)d_in[2]; p.norm_ffn = (const float*)d_in[3]; p.norm_final = (const float*)d_in[4];
  p.ab_w_in = (const float*)d_in[5]; p.conv_w = (const float*)d_in[6]; p.conv_b = (const float*)d_in[7];
  p.w_a = (const float*)d_in[8]; p.b_a = (const float*)d_in[9]; p.w_i = (const float*)d_in[10]; p.b_i = (const float*)d_in[11];
  p.lam = (const float*)d_in[12]; p.ab_w_out = (const float*)d_in[13];
  p.mla_w_in = (const float*)d_in[14]; p.q_norm = (const float*)d_in[15]; p.w_qb = (const float*)d_in[16]; p.kv_norm = (const float*)d_in[17];
  p.w_kvb = (const float*)d_in[18]; p.mla_w_out = (const float*)d_in[19];
  p.w_gate = (const float*)d_in[20]; p.w_up = (const float*)d_in[21]; p.w_down = (const float*)d_in[22];
  p.out = (float*)d_out; p.ws = (char*)d_ws;
#if SINGLE_LAUNCH
  hipMemsetAsync((char*)d_ws + OFF_BAR, 0, XCD_BAR_WORDS * 4, stream);
  int lo = 0, hi = N_PHASES;
  void* args[] = {&p, &lo, &hi};
  hipError_t e = hipLaunchCooperativeKernel((void*)mega, dim3(grid_blocks), dim3(256), args, 0, stream);
  if (e != hipSuccess) fprintf(stderr, "cooperative launch failed: %s (grid %d)\n", hipGetErrorString(e), grid_blocks);
#else
  for (int ph = 0; ph < N_PHASES; ++ph) hipLaunchKernelGGL(mega, dim3(grid_blocks), dim3(256), 0, stream, p, ph, ph + 1);
#endif
}
```

```cpp
#include <hip/hip_runtime.h>
#include <hip/hip_cooperative_groups.h>
#include <cstdint>
#include <cstdio>
namespace cg = cooperative_groups;

#ifndef SINGLE_LAUNCH
#define SINGLE_LAUNCH 1
#endif

typedef unsigned short u16;
typedef short bf16x8 __attribute__((ext_vector_type(8)));
typedef short s16x4 __attribute__((ext_vector_type(4)));
typedef float f32x16 __attribute__((ext_vector_type(16)));
typedef float f32x4 __attribute__((ext_vector_type(4)));
typedef float f32x2 __attribute__((ext_vector_type(2)));
typedef unsigned u32x4 __attribute__((ext_vector_type(4)));
typedef unsigned u32x2 __attribute__((ext_vector_type(2)));
typedef __bf16 bf2_t __attribute__((ext_vector_type(2)));
#define DI __device__ __forceinline__
#define MFMA32(a, b, c) __builtin_amdgcn_mfma_f32_32x32x16_bf16((a), (b), (c), 0, 0, 0)

constexpr int M_TOT = 49152, M_P = 32768, DM = 1024, FH = 2816;
constexpr float LOG2E = 1.4426950408889634f;
constexpr size_t MiB = 1ull << 20;
constexpr size_t WT_ABIN = 0;
constexpr size_t WT_ABOUT = WT_ABIN + 2560ull * 1024 * 2;
constexpr size_t WT_GU0 = WT_ABOUT + 1024ull * 1024 * 2;
constexpr size_t WT_DOWN0 = WT_GU0 + 5632ull * 1024 * 2;
constexpr size_t WT_MLAIN = WT_DOWN0 + 1024ull * 2816 * 2;
constexpr size_t WT_QB = WT_MLAIN + 768ull * 1024 * 2;
constexpr size_t WT_KVB = WT_QB + 1536ull * 384 * 2;
constexpr size_t WT_MLAOUT = WT_KVB + 2048ull * 256 * 2;
constexpr size_t WT_GU1 = WT_MLAOUT + 1024ull * 1024 * 2;
constexpr size_t WT_DOWN1 = WT_GU1 + 5632ull * 1024 * 2;
constexpr size_t WT_GATES = WT_DOWN1 + 1024ull * 2816 * 2;
constexpr size_t WT_END = WT_GATES + 32ull * 4096 * 2;
static_assert(WT_END <= 46 * MiB, "weights region");
constexpr size_t OFF_SUM = 46 * MiB;
constexpr size_t OFF_KR = 46 * MiB;
constexpr size_t OFF_COS = 52 * MiB;
constexpr size_t OFF_SIN = 52 * MiB + 512 * 1024;
constexpr size_t OFF_H = 54 * MiB;
constexpr size_t OFF_CQN = 54 * MiB;
constexpr size_t OFF_CKVN = 90 * MiB;
constexpr size_t OFF_O = 54 * MiB;
constexpr size_t OFF_PROJ = 150 * MiB;
constexpr size_t OFF_ACT = 150 * MiB;
constexpr size_t OFF_P2 = 150 * MiB;
constexpr size_t OFF_Q = 150 * MiB;
constexpr size_t OFF_KV = 294 * MiB;
constexpr size_t OFF_Y = 390 * MiB;
constexpr size_t OFF_CARRY = 486 * MiB;
constexpr size_t OFF_BAR = 489 * MiB;
constexpr size_t WS_NEED = 490 * MiB;

struct Params {
  const float* xin0; const float* xin1;
  const float* norm_mix; const float* norm_ffn; const float* norm_final;
  const float* ab_w_in; const float* conv_w; const float* conv_b;
  const float* w_a; const float* b_a; const float* w_i; const float* b_i; const float* lam; const float* ab_w_out;
  const float* mla_w_in; const float* q_norm; const float* w_qb; const float* kv_norm; const float* w_kvb; const float* mla_w_out;
  const float* w_gate; const float* w_up; const float* w_down;
  float* out; char* ws;
};

DI float bf2f(u16 v) { return __uint_as_float(((unsigned)v) << 16); }
DI float bfs2f(short v) { return __uint_as_float(((unsigned)(u16)v) << 16); }
DI unsigned pk2(float lo, float hi) { f32x2 v = {lo, hi}; bf2_t r = __builtin_convertvector(v, bf2_t); return __builtin_bit_cast(unsigned, r); }
DI u16 f2bf(float a) { return (u16)(pk2(a, 0.f) & 0xffffu); }
DI int crow(int r, int hi) { return (r & 3) + 8 * (r >> 2) + 4 * hi; }
DI float sigmoidf_(float x) { return 1.f / (1.f + __expf(-x)); }
DI float pl32_max(float v) { auto rr = __builtin_amdgcn_permlane32_swap(__float_as_uint(v), __float_as_uint(v), false, false); return fmaxf(__uint_as_float(rr[0]), __uint_as_float(rr[1])); }
DI float pl32_sum(float v) { auto rr = __builtin_amdgcn_permlane32_swap(__float_as_uint(v), __float_as_uint(v), false, false); return __uint_as_float(rr[0]) + __uint_as_float(rr[1]); }
DI s16x4 tr_read(unsigned addr) { s16x4 r; asm volatile("ds_read_b64_tr_b16 %0, %1" : "=&v"(r) : "v"(addr) : "memory"); return r; }
#define LGKM0() do { asm volatile("s_waitcnt lgkmcnt(0)" ::: "memory"); __builtin_amdgcn_sched_barrier(0); } while (0)
DI bf16x8 cat4(s16x4 l, s16x4 h) { return (bf16x8){l[0], l[1], l[2], l[3], h[0], h[1], h[2], h[3]}; }
DI bf16x8 pack8(const f32x16& x, int s) {
  u32x4 w = {pk2(x[8 * s + 0], x[8 * s + 1]), pk2(x[8 * s + 2], x[8 * s + 3]), pk2(x[8 * s + 4], x[8 * s + 5]), pk2(x[8 * s + 6], x[8 * s + 7])};
  return __builtin_bit_cast(bf16x8, w);
}
DI void row_info(int m, int& seq_lo, int& S) { if (m < M_P) { seq_lo = m & ~8191; S = 8192; } else { seq_lo = M_P + ((m - M_P) & ~4095); S = 4096; } }

DI void tr_job(const float* __restrict__ src, int K, int N, u16* __restrict__ dst, int mode, float* tile, int bid, int nb, int& rot) {
  const int tk = K >> 6, tn = (N + 63) >> 6, nt = tk * tn;
  const int tx = threadIdx.x & 63, ty = threadIdx.x >> 6;
  for (int t = (bid + nb - rot) % nb; t < nt; t += nb) {
    const int k0 = (t / tn) << 6, n0 = (t % tn) << 6;
    __syncthreads();
#pragma unroll 4
    for (int r = 0; r < 16; ++r) { const int kk = ty + 4 * r, n = n0 + tx; tile[kk * 65 + tx] = n < N ? src[(size_t)(k0 + kk) * N + n] : 0.f; }
    __syncthreads();
#pragma unroll 4
    for (int r = 0; r < 16; ++r) {
      const int nn = ty + 4 * r, n = n0 + nn;
      if (n < N) { const int row = mode == 0 ? n : ((n >> 5) * 64 + (n & 31) + (mode == 2 ? 32 : 0)); dst[(size_t)row * K + k0 + tx] = f2bf(tile[tx * 65 + nn]); }
    }
  }
  rot = (rot + nt) % nb;
}

DI void rmsnorm_phase(const float* __restrict__ s0, const float* __restrict__ s1, const float* __restrict__ g, u16* outb, float* outf, int gw, int nw) {
  const int lane = threadIdx.x & 63;
  for (int m = gw; m < M_TOT; m += nw) {
    const float* src = m < M_P ? s0 + (size_t)m * DM : s1 + (size_t)(m - M_P) * DM;
    f32x4 v[4];
#pragma unroll
    for (int i = 0; i < 4; ++i) v[i] = *(const f32x4*)(src + i * 256 + lane * 4);
    float ss = 0.f;
#pragma unroll
    for (int i = 0; i < 4; ++i) ss += v[i][0] * v[i][0] + v[i][1] * v[i][1] + v[i][2] * v[i][2] + v[i][3] * v[i][3];
#pragma unroll
    for (int o = 32; o > 0; o >>= 1) ss += __shfl_xor(ss, o);
    const float rs = rsqrtf(ss * (1.f / 1024.f) + 1e-6f);
#pragma unroll
    for (int i = 0; i < 4; ++i) {
      const f32x4 gg = *(const f32x4*)(g + i * 256 + lane * 4);
      const f32x4 y = v[i] * rs * gg;
      if (outb) { u32x2 w = {pk2(y[0], y[1]), pk2(y[2], y[3])}; *(u32x2*)(outb + (size_t)m * DM + i * 256 + lane * 4) = w; }
      else *(f32x4*)(outf + (size_t)m * DM + i * 256 + lane * 4) = y;
    }
  }
}

DI void prep_phase(const Params& p, char* lds, int bid, int nb) {
  float* tile = (float*)lds;
  char* ws = p.ws;
  int rot = 0;
  tr_job(p.ab_w_in, 1024, 2560, (u16*)(ws + WT_ABIN), 0, tile, bid, nb, rot);
  tr_job(p.ab_w_out, 1024, 1024, (u16*)(ws + WT_ABOUT), 0, tile, bid, nb, rot);
  tr_job(p.w_gate, 1024, FH, (u16*)(ws + WT_GU0), 1, tile, bid, nb, rot);
  tr_job(p.w_up, 1024, FH, (u16*)(ws + WT_GU0), 2, tile, bid, nb, rot);
  tr_job(p.w_gate + (size_t)1024 * FH, 1024, FH, (u16*)(ws + WT_GU1), 1, tile, bid, nb, rot);
  tr_job(p.w_up + (size_t)1024 * FH, 1024, FH, (u16*)(ws + WT_GU1), 2, tile, bid, nb, rot);
  tr_job(p.w_down, FH, 1024, (u16*)(ws + WT_DOWN0), 0, tile, bid, nb, rot);
  tr_job(p.w_down + (size_t)FH * 1024, FH, 1024, (u16*)(ws + WT_DOWN1), 0, tile, bid, nb, rot);
  tr_job(p.mla_w_in, 1024, 672, (u16*)(ws + WT_MLAIN), 0, tile, bid, nb, rot);
  tr_job(p.w_qb, 384, 1536, (u16*)(ws + WT_QB), 0, tile, bid, nb, rot);
  tr_job(p.w_kvb, 256, 2048, (u16*)(ws + WT_KVB), 0, tile, bid, nb, rot);
  tr_job(p.mla_w_out, 1024, 1024, (u16*)(ws + WT_MLAOUT), 0, tile, bid, nb, rot);
  for (int dg = 0; dg < 32; ++dg) {
    const int cb = dg & 7, gate = (dg >> 3) & 1, dir = dg >> 4;
    const float* src = (gate == 0 ? p.w_a : p.w_i) + (size_t)(dir * 8 + cb) * 4096;
    tr_job(src, 64, 64, (u16*)(ws + WT_GATES) + (size_t)dg * 4096, 0, tile, bid, nb, rot);
  }
  const int gtid = bid * 256 + threadIdx.x, gn = nb * 256;
  { u16* d = (u16*)(ws + WT_MLAIN) + (size_t)672 * 1024; for (int i = gtid; i < 96 * 1024; i += gn) d[i] = 0; }
  { float* ct = (float*)(ws + OFF_COS); float* st = (float*)(ws + OFF_SIN);
    for (int i = gtid; i < 8192 * 16; i += gn) {
      const int pos = i >> 4, k = i & 15;
      const float inv_freq = 1.0f / powf(10000.0f, (float)(2 * k) / 32.0f);
      const float ang = (float)pos * inv_freq;
      double f = (double)ang * 0.15915494309189535; f -= rint(f);
      ct[i] = __builtin_amdgcn_cosf((float)f); st[i] = __builtin_amdgcn_sinf((float)f);
    } }
  rmsnorm_phase(p.xin0, p.xin1, p.norm_mix, (u16*)(ws + OFF_H), nullptr, bid * 4 + (threadIdx.x >> 6), nb * 4);
}

constexpr int GP = 72;
enum { EPI_BF16 = 0, EPI_RESID = 1, EPI_SWIGLU = 2 };
template <int EPI>
DI void gemm_phase(const u16* __restrict__ A, int lda, const u16* __restrict__ Bt, int K, int N, u16* outb, int ldo,
                   const float* r0, const float* r1, float* outf, char* lds, int bid, int nb) {
  const int tid = threadIdx.x, lane = tid & 63, wid = tid >> 6, wr = wid >> 1, wc = wid & 1, r32 = lane & 31, hi = lane >> 5;
  u16* As = (u16*)lds; u16* Bs = As + 2 * 128 * GP;
  const int nN = N >> 7, nT = (M_TOT >> 7) * nN, nk = K >> 6;
  const int lrow = tid >> 3, lch = tid & 7;
  const bool swz = (nb == 512);
  const int GN = (nN & 3) == 0 ? 4 : 2, GM = 64 / GN, nSN = nN / GN, nST = ((M_TOT >> 7) / GM) * nSN;
  const int xcd = bid & 7, jb = bid >> 3;
  const int nIter = swz ? (nST - xcd + 7) / 8 : (nT - bid + nb - 1) / nb;
  for (int it = 0; it < nIter; ++it) {
    int tm, tn;
    if (swz) { const int st = xcd + 8 * it, sm = st / nSN, sn = st - sm * nSN; tm = sm * GM + jb / GN; tn = sn * GN + (jb % GN); }
    else { const int t = bid + it * nb; tm = t / nN; tn = t - tm * nN; }
    const u16* Ag = A + (size_t)(tm * 128 + lrow) * lda + lch * 8;
    const u16* Bg = Bt + (size_t)(tn * 128 + lrow) * K + lch * 8;
    f32x16 acc00 = {}, acc01 = {}, acc10 = {}, acc11 = {};
    u32x4 ra0[4], rb0[4], ra1[4], rb1[4];
#define G_LOAD(RA, RB, KT) do { _Pragma("unroll") for (int i = 0; i < 4; ++i) { RA[i] = *(const u32x4*)(Ag + (size_t)i * 32 * lda + (KT) * 64); RB[i] = *(const u32x4*)(Bg + (size_t)i * 32 * K + (KT) * 64); } } while (0)
#define G_STORE(RA, RB, BUF) do { u16* ad = As + (BUF) * 128 * GP; u16* bd = Bs + (BUF) * 128 * GP; _Pragma("unroll") for (int i = 0; i < 4; ++i) { *(u32x4*)(ad + (lrow + 32 * i) * GP + lch * 8) = RA[i]; *(u32x4*)(bd + (lrow + 32 * i) * GP + lch * 8) = RB[i]; } } while (0)
#define G_COMPUTE(BUF) do { const u16* as = As + (BUF) * 128 * GP + (wr * 64 + r32) * GP + hi * 8; const u16* bs = Bs + (BUF) * 128 * GP + (wc * 64 + r32) * GP + hi * 8; \
      _Pragma("unroll") for (int ks = 0; ks < 4; ++ks) { \
        const bf16x8 a0 = *(const bf16x8*)(as + ks * 16), a1 = *(const bf16x8*)(as + 32 * GP + ks * 16); \
        const bf16x8 b0 = *(const bf16x8*)(bs + ks * 16), b1 = *(const bf16x8*)(bs + 32 * GP + ks * 16); \
        acc00 = MFMA32(a0, b0, acc00); acc01 = MFMA32(a0, b1, acc01); acc10 = MFMA32(a1, b0, acc10); acc11 = MFMA32(a1, b1, acc11); } } while (0)
    G_LOAD(ra0, rb0, 0);
    G_LOAD(ra1, rb1, 1);
    G_STORE(ra0, rb0, 0);
    __syncthreads();
    for (int kt = 0; kt < nk; kt += 2) {
      if (kt + 2 < nk) G_LOAD(ra0, rb0, kt + 2);
      G_COMPUTE(0);
      G_STORE(ra1, rb1, 1);
      __syncthreads();
      if (kt + 3 < nk) G_LOAD(ra1, rb1, kt + 3);
      G_COMPUTE(1);
      if (kt + 2 < nk) G_STORE(ra0, rb0, 0);
      __syncthreads();
    }
#undef G_LOAD
#undef G_STORE
#undef G_COMPUTE
    const int mrow = tm * 128 + wr * 64;
    if constexpr (EPI == EPI_BF16) {
      const int col = tn * 128 + wc * 64 + r32;
#pragma unroll
      for (int reg = 0; reg < 16; ++reg) {
        const int rr = crow(reg, hi);
        u16* o0 = outb + (size_t)(mrow + rr) * ldo + col; u16* o1 = outb + (size_t)(mrow + 32 + rr) * ldo + col;
        o0[0] = f2bf(acc00[reg]); o0[32] = f2bf(acc01[reg]); o1[0] = f2bf(acc10[reg]); o1[32] = f2bf(acc11[reg]);
      }
    } else if constexpr (EPI == EPI_RESID) {
      const int col = tn * 128 + wc * 64 + r32;
      const float* rb_ = (tm * 128 < M_P) ? r0 : (r1 - (size_t)M_P * DM);
#pragma unroll
      for (int reg = 0; reg < 16; ++reg) {
        const int rr = crow(reg, hi);
        const size_t i0 = (size_t)(mrow + rr) * DM + col, i1 = (size_t)(mrow + 32 + rr) * DM + col;
        const float x00 = rb_[i0], x01 = rb_[i0 + 32], x10 = rb_[i1], x11 = rb_[i1 + 32];
        outf[i0] = x00 + acc00[reg]; outf[i0 + 32] = x01 + acc01[reg]; outf[i1] = x10 + acc10[reg]; outf[i1 + 32] = x11 + acc11[reg];
      }
    } else {
      const int col = (tn * 2 + wc) * 32 + r32;
#pragma unroll
      for (int reg = 0; reg < 16; ++reg) {
        const int rr = crow(reg, hi);
        const float g0 = acc00[reg], u0 = acc01[reg], g1 = acc10[reg], u1 = acc11[reg];
        outb[(size_t)(mrow + rr) * ldo + col] = f2bf(g0 * sigmoidf_(g0) * u0);
        outb[(size_t)(mrow + 32 + rr) * ldo + col] = f2bf(g1 * sigmoidf_(g1) * u1);
      }
    }
  }
}

template <bool FINAL>
DI void rg_phase(const Params& p, char* lds, int bid, int nb) {
  const int tid = threadIdx.x, lane = tid & 63, wid = tid >> 6, r32 = lane & 31, hi = lane >> 5;
  float* xcf = (float*)lds;
  u16* xcb = (u16*)(lds + 16384);
  float* Ab = (float*)(lds + 25600);
  float* U0 = (float*)(lds + 41984);
  float* U1 = (float*)(lds + 58368);
  const u16* PROJ = (const u16*)(p.ws + OFF_PROJ);
  const u16* WG = (const u16*)(p.ws + WT_GATES);
  float* SUM = (float*)(p.ws + OFF_SUM);
  const float* CARRY = (const float*)(p.ws + OFF_CARRY);
  u16* Y = (u16*)(p.ws + OFF_Y);
  for (int it = bid; it < 768 * 8; it += nb) {
    const int gc = it >> 3, cb = it & 7, m0 = gc * 64;
    int seq_lo, S; row_info(m0, seq_lo, S); const int seq_hi = seq_lo + S;
    __syncthreads();
    {
      const int ch = tid & 63, tq = tid >> 6, c = cb * 64 + ch;
      const float w0 = p.conv_w[c], w1 = p.conv_w[512 + c], w2 = p.conv_w[1024 + c], w3 = p.conv_w[1536 + c], cbias = p.conv_b[c];
      const int t0 = tq * 16;
      auto ld = [&](int t) -> float { const int m = m0 + t; return (m >= seq_lo && m < seq_hi) ? bf2f(PROJ[(size_t)m * 2560 + c]) : 0.f; };
      float xm2 = ld(t0 - 2), xm1 = ld(t0 - 1), x0 = ld(t0);
#pragma unroll 4
      for (int t = t0; t < t0 + 16; ++t) {
        const float xp1 = ld(t + 1);
        const float xc = w0 * xm2 + w1 * xm1 + w2 * x0 + w3 * xp1 + cbias;
        xcf[t * 64 + ch] = xc; xcb[t * 72 + ch] = f2bf(xc);
        xm2 = xm1; xm1 = x0; x0 = xp1;
      }
    }
    __syncthreads();
#pragma unroll 1
    for (int dir = 0; dir < 2; ++dir) {
      float* Ub = dir == 0 ? U0 : U1;
      {
        const int mt = wid >> 1, nt = wid & 1;
        f32x16 aa = {}, ai = {};
        const u16* wa = WG + (size_t)((dir * 2 + 0) * 8 + cb) * 4096 + (nt * 32 + r32) * 64 + 8 * hi;
        const u16* wi = WG + (size_t)((dir * 2 + 1) * 8 + cb) * 4096 + (nt * 32 + r32) * 64 + 8 * hi;
#pragma unroll
        for (int ks = 0; ks < 4; ++ks) {
          const bf16x8 af = *(const bf16x8*)(xcb + (mt * 32 + r32) * 72 + ks * 16 + 8 * hi);
          const bf16x8 ba = *(const bf16x8*)(wa + ks * 16), bi = *(const bf16x8*)(wi + ks * 16);
          aa = MFMA32(af, ba, aa); ai = MFMA32(af, bi, ai);
        }
        const int ch = nt * 32 + r32, c = cb * 64 + ch;
        const float bav = p.b_a[dir * 512 + c], biv = p.b_i[dir * 512 + c];
        const float sp = log1pf(__expf(-p.lam[dir * 512 + c]));
#pragma unroll
        for (int reg = 0; reg < 16; ++reg) {
          const int tok = mt * 32 + crow(reg, hi);
          const float r = sigmoidf_(aa[reg] + bav), gi = sigmoidf_(ai[reg] + biv);
          const float la = -8.f * r * sp, a = __expf(la);
          const float mult = sqrtf(fmaxf(0.f, 1.f - __expf(2.f * la)));
          Ab[tok * 64 + ch] = a; Ub[tok * 64 + ch] = mult * gi * xcf[tok * 64 + ch];
        }
      }
      __syncthreads();
      if (tid < 64) {
        const int ch = tid, c = cb * 64 + ch;
        if (!FINAL) {
          float h = 0.f, P = 1.f;
#pragma unroll 8
          for (int k = 0; k < 64; ++k) { const int t = dir == 0 ? k : 63 - k; const float a = Ab[t * 64 + ch], u = Ub[t * 64 + ch]; h = a * h + u; P *= a; }
          SUM[(size_t)((gc * 2 + dir) * 2 + 0) * 512 + c] = P; SUM[(size_t)((gc * 2 + dir) * 2 + 1) * 512 + c] = h;
        } else {
          float h = CARRY[(size_t)(gc * 2 + dir) * 512 + c];
          if (dir == 0) {
#pragma unroll 8
            for (int t = 0; t < 64; ++t) { const float a = Ab[t * 64 + ch], u = Ub[t * 64 + ch]; h = a * h + u; Ub[t * 64 + ch] = h; }
          } else {
#pragma unroll 8
            for (int k = 0; k < 64; ++k) {
              const int t = 63 - k; const float a = Ab[t * 64 + ch], u = Ub[t * 64 + ch]; h = a * h + u;
              const float gt = bf2f(PROJ[(size_t)(m0 + t) * 2560 + 512 + c]);
              const float ge = gt * sigmoidf_(1.5957691216057308f * (gt + 0.044715f * gt * gt * gt));
              Y[(size_t)(m0 + t) * 1024 + c] = f2bf(ge * (U0[t * 64 + ch] + h));
            }
          }
        }
      }
      __syncthreads();
    }
  }
}

DI void rg_carry_phase(const Params& p, int bid, int nb) {
  const float* __restrict__ SUM = (const float*)(p.ws + OFF_SUM);
  float* __restrict__ CARRY = (float*)(p.ws + OFF_CARRY);
  for (int idx = bid * 256 + threadIdx.x; idx < 8192; idx += nb * 256) {
    const int c = idx & 511, dir = (idx >> 9) & 1, seq = idx >> 10;
    const int gc0 = seq < 4 ? seq * 128 : 512 + (seq - 4) * 64, nch = seq < 4 ? 128 : 64;
    float carry = 0.f;
    for (int k0 = 0; k0 < nch; k0 += 8) {
      float P[8], Hh[8];
#pragma unroll
      for (int j = 0; j < 8; ++j) { const int k = k0 + j, gc = dir == 0 ? gc0 + k : gc0 + nch - 1 - k; P[j] = SUM[(size_t)((gc * 2 + dir) * 2 + 0) * 512 + c]; Hh[j] = SUM[(size_t)((gc * 2 + dir) * 2 + 1) * 512 + c]; }
#pragma unroll
      for (int j = 0; j < 8; ++j) { const int k = k0 + j, gc = dir == 0 ? gc0 + k : gc0 + nch - 1 - k; CARRY[(size_t)(gc * 2 + dir) * 512 + c] = carry; carry = P[j] * carry + Hh[j]; }
    }
  }
}

DI void dil_tile_info(int ti, int m0, int& d, int& u0) {
  if (ti < 5) { d = 16; u0 = m0 - 1024 + ti * 512; } else if (ti < 13) { d = 4; u0 = m0 - 256 + (ti - 5) * 128; } else { d = 1; u0 = m0 - 64 + (ti - 13) * 32; }
}
DI void dilated_phase(const Params& p, char* lds, int gw, int nw) {
  const int lane = threadIdx.x & 63, wid = threadIdx.x >> 6, r32 = lane & 31, hi = lane >> 5;
  u16* Vl = (u16*)(lds + wid * 6144);
  const unsigned vbase = (unsigned)(uintptr_t)Vl;
  const int li = lane & 15, tq = li >> 2, tp = li & 3, g1 = (lane >> 4) & 1;
  const unsigned trb = vbase + (4 * hi + tq) * 192 + (16 * g1 + 4 * tp) * 2;
  const u16* PROJ = (const u16*)(p.ws + OFF_PROJ);
  u16* Y = (u16*)(p.ws + OFF_Y);
  const int vrow = lane >> 3, vch = lane & 7;
  for (int id = gw; id < 12288; id += nw) {
    const int res = id & 15, h = (id >> 4) & 7, sp = id >> 7;
    const int m0 = sp * 512 + res;
    int seq_lo, S; row_info(sp * 512, seq_lo, S); const int seq_hi = seq_lo + S;
    const int mq = m0 + 16 * r32;
    bf16x8 qf[4];
#pragma unroll
    for (int ks = 0; ks < 4; ++ks) qf[ks] = *(const bf16x8*)(PROJ + (size_t)mq * 2560 + 1024 + h * 64 + ks * 16 + 8 * hi);
    const float slope2 = exp2f(-(float)(h + 1)) * LOG2E;
    const float c1 = 0.125f * LOG2E;
    float m_run = -1e30f, l_run = 0.f; f32x16 o0 = {}, o1 = {};
    const u16* kbase = PROJ + 1536 + h * 64 + 8 * hi;
    const u16* vbaseg = PROJ + 2048 + h * 64 + vch * 8;
    bf16x8 kf[4]; u32x4 vr[4];
    { int d, u0; dil_tile_info(0, m0, d, u0);
      const int ur = min(max(u0 + d * r32, seq_lo), seq_hi - 1);
#pragma unroll
      for (int ks = 0; ks < 4; ++ks) kf[ks] = *(const bf16x8*)(kbase + (size_t)ur * 2560 + ks * 16);
#pragma unroll
      for (int i = 0; i < 4; ++i) { const int uv = min(max(u0 + d * (vrow + 8 * i), seq_lo), seq_hi - 1); vr[i] = *(const u32x4*)(vbaseg + (size_t)uv * 2560); } }
#pragma unroll 1
    for (int ti = 0; ti < 33; ++ti) {
      int d, u0; dil_tile_info(ti, m0, d, u0);
#pragma unroll
      for (int i = 0; i < 4; ++i) *(u32x4*)(Vl + (vrow + 8 * i) * 96 + vch * 8) = vr[i];
      f32x16 pt = {};
#pragma unroll
      for (int ks = 0; ks < 4; ++ks) pt = MFMA32(kf[ks], qf[ks], pt);
      if (ti + 1 < 33) {
        int dn, un; dil_tile_info(ti + 1, m0, dn, un);
        const int ur = min(max(un + dn * r32, seq_lo), seq_hi - 1);
#pragma unroll
        for (int ks = 0; ks < 4; ++ks) kf[ks] = *(const bf16x8*)(kbase + (size_t)ur * 2560 + ks * 16);
#pragma unroll
        for (int i = 0; i < 4; ++i) { const int uv = min(max(un + dn * (vrow + 8 * i), seq_lo), seq_hi - 1); vr[i] = *(const u32x4*)(vbaseg + (size_t)uv * 2560); }
      }
      const s16x4 l00 = tr_read(trb), h00 = tr_read(trb + 8 * 192), l01 = tr_read(trb + 64), h01 = tr_read(trb + 8 * 192 + 64);
      const s16x4 l10 = tr_read(trb + 16 * 192), h10 = tr_read(trb + 24 * 192), l11 = tr_read(trb + 16 * 192 + 64), h11 = tr_read(trb + 24 * 192 + 64);
      const int du0 = u0 - mq + d * 4 * hi, lim = 64 * d;
      float pmax = -INFINITY;
#pragma unroll
      for (int reg = 0; reg < 16; ++reg) {
        const int du = du0 + d * ((reg & 3) + 8 * (reg >> 2)), u = mq + du, ad = du < 0 ? -du : du;
        const bool valid = (ad <= lim) && (u >= seq_lo) && (u < seq_hi);
        const float tv = valid ? (pt[reg] * c1 - slope2 * (float)ad) : -INFINITY;
        pt[reg] = tv; pmax = fmaxf(pmax, tv);
      }
      pmax = pl32_max(pmax);
      if (__any(pmax > m_run)) {
        const float mn = fmaxf(m_run, pmax), alpha = __builtin_amdgcn_exp2f(m_run - mn);
        m_run = mn; l_run *= alpha;
#pragma unroll
        for (int reg = 0; reg < 16; ++reg) { o0[reg] *= alpha; o1[reg] *= alpha; }
      }
      float ps = 0.f;
#pragma unroll
      for (int reg = 0; reg < 16; ++reg) { pt[reg] = __builtin_amdgcn_exp2f(pt[reg] - m_run); ps += pt[reg]; }
      ps = pl32_sum(ps);
      l_run += ps;
      const bf16x8 pb0 = pack8(pt, 0), pb1 = pack8(pt, 1);
      LGKM0();
      o0 = MFMA32(cat4(l00, h00), pb0, o0); o0 = MFMA32(cat4(l10, h10), pb1, o0);
      o1 = MFMA32(cat4(l01, h01), pb0, o1); o1 = MFMA32(cat4(l11, h11), pb1, o1);
    }
    const float inv = 1.f / l_run;
    u16* yo = Y + (size_t)mq * 1024 + 512 + h * 64 + 4 * hi;
#pragma unroll
    for (int g = 0; g < 4; ++g) {
      u32x2 w0 = {pk2(o0[4 * g] * inv, o0[4 * g + 1] * inv), pk2(o0[4 * g + 2] * inv, o0[4 * g + 3] * inv)};
      u32x2 w1 = {pk2(o1[4 * g] * inv, o1[4 * g + 1] * inv), pk2(o1[4 * g + 2] * inv, o1[4 * g + 3] * inv)};
      *(u32x2*)(yo + 8 * g) = w0; *(u32x2*)(yo + 32 + 8 * g) = w1;
    }
  }
}

DI void mla_norm_phase(const Params& p, int gw, int nw) {
  const int lane = threadIdx.x & 63;
  const u16* P2 = (const u16*)(p.ws + OFF_P2);
  u16* CQN = (u16*)(p.ws + OFF_CQN); u16* CKVN = (u16*)(p.ws + OFF_CKVN); u16* KR = (u16*)(p.ws + OFF_KR);
  const float* ct = (const float*)(p.ws + OFF_COS); const float* st = (const float*)(p.ws + OFF_SIN);
  for (int m = gw; m < M_TOT; m += nw) {
    const u16* src = P2 + (size_t)m * 768;
    float q[6], kv[4]; float sq = 0.f, skv = 0.f;
#pragma unroll
    for (int i = 0; i < 6; ++i) { q[i] = bf2f(src[i * 64 + lane]); sq += q[i] * q[i]; }
#pragma unroll
    for (int i = 0; i < 4; ++i) { kv[i] = bf2f(src[384 + i * 64 + lane]); skv += kv[i] * kv[i]; }
#pragma unroll
    for (int o = 32; o > 0; o >>= 1) { sq += __shfl_xor(sq, o); skv += __shfl_xor(skv, o); }
    const float rq = rsqrtf(sq * (1.f / 384.f) + 1e-6f), rkv = rsqrtf(skv * (1.f / 256.f) + 1e-6f);
#pragma unroll
    for (int i = 0; i < 6; ++i) CQN[(size_t)m * 384 + i * 64 + lane] = f2bf(q[i] * rq * p.q_norm[i * 64 + lane]);
#pragma unroll
    for (int i = 0; i < 4; ++i) CKVN[(size_t)m * 256 + i * 64 + lane] = f2bf(kv[i] * rkv * p.kv_norm[i * 64 + lane]);
    if (lane < 16) {
      const int pos = m < M_P ? (m & 8191) : ((m - M_P) & 4095);
      const float t1 = bf2f(src[640 + lane]), t2 = bf2f(src[656 + lane]);
      const float c = ct[pos * 16 + lane], s = st[pos * 16 + lane];
      KR[(size_t)m * 32 + lane] = f2bf(t1 * c - t2 * s); KR[(size_t)m * 32 + 16 + lane] = f2bf(t1 * s + t2 * c);
    }
  }
}

constexpr int KP = 104, VP = 96;
DI void mla_unit(const Params& p, char* lds, int seqbase, int S, int h, int qb) {
  const int tid = threadIdx.x, lane = tid & 63, wid = tid >> 6, r32 = lane & 31, hi = lane >> 5;
  u16* Kl = (u16*)lds;
  u16* Vl = (u16*)(lds + 2 * 64 * KP * 2);
  const unsigned vbase = (unsigned)(uintptr_t)Vl;
  const int li = lane & 15, tq = li >> 2, tp = li & 3, g1 = (lane >> 4) & 1;
  const unsigned trb = vbase + (4 * hi + tq) * (VP * 2) + (16 * g1 + 4 * tp) * 2;
  const u16* Q = (const u16*)(p.ws + OFF_Q); const u16* KV = (const u16*)(p.ws + OFF_KV); const u16* KR = (const u16*)(p.ws + OFF_KR);
  u16* O = (u16*)(p.ws + OFF_O);
  const float* ct = (const float*)(p.ws + OFF_COS); const float* st = (const float*)(p.ws + OFF_SIN);
  const int pos = qb * 128 + wid * 32 + r32, qrow = seqbase + pos;
  bf16x8 qf[6];
#pragma unroll
  for (int d0 = 0; d0 < 6; ++d0) qf[d0] = *(const bf16x8*)(Q + (size_t)qrow * 1536 + h * 96 + d0 * 16 + 8 * hi);
  const float C = 0.10206207261596577f * LOG2E;
#pragma unroll
  for (int j = 0; j < 8; ++j) {
    const float c = ct[pos * 16 + 8 * hi + j], s = st[pos * 16 + 8 * hi + j];
    const float t1 = bfs2f(qf[4][j]), t2 = bfs2f(qf[5][j]);
    qf[4][j] = (short)f2bf((t1 * c - t2 * s) * C); qf[5][j] = (short)f2bf((t1 * s + t2 * c) * C);
  }
#pragma unroll
  for (int d0 = 0; d0 < 4; ++d0)
#pragma unroll
    for (int j = 0; j < 8; ++j) qf[d0][j] = (short)f2bf(bfs2f(qf[d0][j]) * C);
  const u16* ksrc[3]; int kdst[3];
#pragma unroll
  for (int i = 0; i < 3; ++i) {
    const int idx = tid + 256 * i, row = idx / 12, c = idx - row * 12;
    ksrc[i] = c < 8 ? KV + (size_t)(seqbase + row) * 2048 + h * 128 + c * 8 : KR + (size_t)(seqbase + row) * 32 + (c - 8) * 8;
    kdst[i] = row * KP + c * 8;
  }
  const int kstride[3] = {0, 0, 0}; (void)kstride;
  const int vrow = tid >> 3, vc = tid & 7;
  const u16* vsrc = KV + (size_t)(seqbase + vrow) * 2048 + h * 128 + 64 + vc * 8;
  const int vdst = vrow * VP + vc * 8;
  size_t kadv[3];
#pragma unroll
  for (int i = 0; i < 3; ++i) { const int idx = tid + 256 * i, row = idx / 12, c = idx - row * 12; (void)row; kadv[i] = c < 8 ? (size_t)64 * 2048 : (size_t)64 * 32; }
  float l_run = 0.f; f32x16 o0 = {}, o1 = {}, negm = {};
  const int nkt = S >> 6;
  u32x4 rk[3], rv[2];
#pragma unroll
  for (int i = 0; i < 3; ++i) rk[i] = *(const u32x4*)(ksrc[i]);
  rv[0] = *(const u32x4*)(vsrc); rv[1] = *(const u32x4*)(vsrc + (size_t)32 * 2048);
#pragma unroll
  for (int i = 0; i < 3; ++i) *(u32x4*)(Kl + kdst[i]) = rk[i];
  *(u32x4*)(Vl + vdst) = rv[0]; *(u32x4*)(Vl + vdst + 32 * VP) = rv[1];
  __syncthreads();
#pragma unroll 1
  for (int kt = 0; kt < nkt; ++kt) {
    const int cur = kt & 1;
    if (kt + 1 < nkt) {
#pragma unroll
      for (int i = 0; i < 3; ++i) rk[i] = *(const u32x4*)(ksrc[i] + (size_t)(kt + 1) * kadv[i]);
      rv[0] = *(const u32x4*)(vsrc + (size_t)(kt + 1) * 64 * 2048); rv[1] = *(const u32x4*)(vsrc + (size_t)(kt + 1) * 64 * 2048 + (size_t)32 * 2048);
    }
    const u16* kl = Kl + cur * 64 * KP + r32 * KP + 8 * hi;
    f32x16 p0, p1;
    { const bf16x8 k0 = *(const bf16x8*)(kl), k1 = *(const bf16x8*)(kl + 32 * KP);
      p0 = MFMA32(k0, qf[0], negm); p1 = MFMA32(k1, qf[0], negm); }
#pragma unroll
    for (int d0 = 1; d0 < 6; ++d0) {
      const bf16x8 k0 = *(const bf16x8*)(kl + d0 * 16), k1 = *(const bf16x8*)(kl + 32 * KP + d0 * 16);
      p0 = MFMA32(k0, qf[d0], p0); p1 = MFMA32(k1, qf[d0], p1);
    }
    const unsigned tb = trb + cur * (64 * VP * 2), tc = tb + 64;
    const s16x4 a0 = tr_read(tb), b0 = tr_read(tb + 8 * VP * 2), a1 = tr_read(tb + 16 * VP * 2), b1 = tr_read(tb + 24 * VP * 2);
    const s16x4 a2 = tr_read(tb + 32 * VP * 2), b2 = tr_read(tb + 40 * VP * 2), a3 = tr_read(tb + 48 * VP * 2), b3 = tr_read(tb + 56 * VP * 2);
    const s16x4 c0 = tr_read(tc), d0_ = tr_read(tc + 8 * VP * 2), c1 = tr_read(tc + 16 * VP * 2), d1 = tr_read(tc + 24 * VP * 2);
    const s16x4 c2 = tr_read(tc + 32 * VP * 2), d2 = tr_read(tc + 40 * VP * 2), c3 = tr_read(tc + 48 * VP * 2), d3 = tr_read(tc + 56 * VP * 2);
    float pmax = fmaxf(p0[0], p1[0]);
#pragma unroll
    for (int r = 1; r < 16; ++r) pmax = fmaxf(pmax, fmaxf(p0[r], p1[r]));
    pmax = pl32_max(pmax);
    if (kt == 0 || __any(pmax > 8.f)) {
      const float delta = kt == 0 ? pmax : fmaxf(pmax, 0.f);
      const float alpha = kt == 0 ? 1.f : __builtin_amdgcn_exp2f(-delta);
#pragma unroll
      for (int r = 0; r < 16; ++r) { negm[r] -= delta; p0[r] -= delta; p1[r] -= delta; o0[r] *= alpha; o1[r] *= alpha; }
      l_run *= alpha;
    }
    float ps = 0.f;
#pragma unroll
    for (int r = 0; r < 16; ++r) { p0[r] = __builtin_amdgcn_exp2f(p0[r]); p1[r] = __builtin_amdgcn_exp2f(p1[r]); ps += p0[r] + p1[r]; }
    ps = pl32_sum(ps);
    l_run += ps;
    const bf16x8 pb0 = pack8(p0, 0), pb1 = pack8(p0, 1), pb2 = pack8(p1, 0), pb3 = pack8(p1, 1);
    LGKM0();
    o0 = MFMA32(cat4(a0, b0), pb0, o0); o1 = MFMA32(cat4(c0, d0_), pb0, o1);
    o0 = MFMA32(cat4(a1, b1), pb1, o0); o1 = MFMA32(cat4(c1, d1), pb1, o1);
    o0 = MFMA32(cat4(a2, b2), pb2, o0); o1 = MFMA32(cat4(c2, d2), pb2, o1);
    o0 = MFMA32(cat4(a3, b3), pb3, o0); o1 = MFMA32(cat4(c3, d3), pb3, o1);
    if (kt + 1 < nkt) {
      u16* kd = Kl + (cur ^ 1) * 64 * KP; u16* vd = Vl + (cur ^ 1) * 64 * VP;
#pragma unroll
      for (int i = 0; i < 3; ++i) *(u32x4*)(kd + kdst[i]) = rk[i];
      *(u32x4*)(vd + vdst) = rv[0]; *(u32x4*)(vd + vdst + 32 * VP) = rv[1];
    }
    __syncthreads();
  }
  const float inv = 1.f / l_run;
  u16* oo = O + (size_t)qrow * 1024 + h * 64 + 4 * hi;
#pragma unroll
  for (int g = 0; g < 4; ++g) {
    u32x2 w0 = {pk2(o0[4 * g] * inv, o0[4 * g + 1] * inv), pk2(o0[4 * g + 2] * inv, o0[4 * g + 3] * inv)};
    u32x2 w1 = {pk2(o1[4 * g] * inv, o1[4 * g + 1] * inv), pk2(o1[4 * g + 2] * inv, o1[4 * g + 3] * inv)};
    *(u32x2*)(oo + 8 * g) = w0; *(u32x2*)(oo + 32 + 8 * g) = w1;
  }
}

DI void mla_attn_phase(const Params& p, char* lds, int bid, int nb) {
  if ((nb & 7) == 0) {
    const int xcd = bid & 7, j = bid >> 3, nper = nb >> 3;
    for (int lu = j; lu < 8 * 64; lu += nper) { const int bh = (lu >> 6) * 8 + xcd, qb = lu & 63; mla_unit(p, lds, (bh >> 4) * 8192, 8192, bh & 15, qb); }
    for (int lu = j; lu < 8 * 32; lu += nper) { const int bh = (lu >> 5) * 8 + xcd, qb = lu & 31; mla_unit(p, lds, M_P + (bh >> 4) * 4096, 4096, bh & 15, qb); }
  } else {
    for (int u = bid; u < 4096; u += nb) { const int bh = u >> 6, qb = u & 63; mla_unit(p, lds, (bh >> 4) * 8192, 8192, bh & 15, qb); }
    for (int u = bid; u < 2048; u += nb) { const int bh = u >> 5, qb = u & 31; mla_unit(p, lds, M_P + (bh >> 4) * 4096, 4096, bh & 15, qb); }
  }
}

#define XB_TMO      128
#define XB_XCNT(j)  (256  + 64 * (j))
#define XB_XSUB(j)  (1280 + 64 * (j))
#define XB_XGEN(j)  (2304 + 64 * (j))
#define XB_TOP      3328
#define XB_TOPGEN   3392
#define XCD_BAR_WORDS 3456
#define XB_SPIN_CAP (1u << 20)
#define LAS __attribute__((address_space(3)))
DI unsigned xb_ld(unsigned* p) { return __hip_atomic_load(p, __ATOMIC_RELAXED, __HIP_MEMORY_SCOPE_AGENT); }
DI unsigned xb_add(unsigned* p, unsigned v) { return __hip_atomic_fetch_add(p, v, __ATOMIC_RELAXED, __HIP_MEMORY_SCOPE_AGENT); }
DI unsigned xb_xcc_id() { return (unsigned)__builtin_amdgcn_s_getreg((3 << 11) | 20) & 0xFu; }
#define XB_SPIN(cond, bar) do { unsigned _sp = 0; while (cond) { __builtin_amdgcn_s_sleep(1); \
    if ((++_sp & 255u) == 0u) { if (xb_ld(&(bar)[XB_TMO])) break; if (_sp > XB_SPIN_CAP) { atomicAdd(&(bar)[XB_TMO], 1u); break; } } } } while (0)
struct XcdBarrier { unsigned* bar; unsigned x; volatile LAS unsigned* st; };
DI XcdBarrier xcd_barrier_post(unsigned* bar, volatile LAS unsigned* st) {
  XcdBarrier b; b.bar = bar; b.x = xb_xcc_id(); b.st = st;
  if (threadIdx.x == 0) (void)xb_add(&bar[XB_XCNT(b.x)], 1u);
  return b;
}
DI void xcd_barrier_complete(unsigned* bar, unsigned x, unsigned& nloc, unsigned& nx) {
  const unsigned G = gridDim.x * gridDim.y * gridDim.z;
  unsigned sum, cnt, mine, sp = 0u;
  for (;;) {
    sum = 0u; cnt = 0u; mine = 0u;
#pragma unroll
    for (unsigned j = 0; j < 16; ++j) { const unsigned c = xb_ld(&bar[XB_XCNT(j)]); sum += c; cnt += (c > 0u) ? 1u : 0u; mine = (j == x) ? c : mine; }
    if (sum == G) break;
    __builtin_amdgcn_s_sleep(1);
    if ((++sp & 255u) == 0u) { if (xb_ld(&bar[XB_TMO])) break; if (sp > XB_SPIN_CAP) { atomicAdd(&bar[XB_TMO], 1u); break; } }
  }
  nloc = mine > 0u ? mine : 1u; nx = cnt > 0u ? cnt : 1u;
}
DI void xcd_barrier(const XcdBarrier& b) {
  asm volatile("s_waitcnt vmcnt(0)" ::: "memory");
  __syncthreads();
  if (threadIdx.x == 0) {
    unsigned* bar = b.bar;
    __builtin_amdgcn_s_waitcnt(0);
    unsigned nloc = b.st[0], nx = b.st[1];
    if (nloc == 0u) { xcd_barrier_complete(bar, b.x, nloc, nx); b.st[0] = nloc; b.st[1] = nx; }
    const unsigned old = xb_add(&bar[XB_XSUB(b.x)], 1u);
    const unsigned gen = old / nloc;
    if (old + 1u == (gen + 1u) * nloc) {
      __builtin_amdgcn_fence(__ATOMIC_RELEASE, "agent");
      asm volatile("s_waitcnt vmcnt(0)" ::: "memory");
      const unsigned og = xb_add(&bar[XB_TOP], 1u);
      const unsigned tg = og / nx;
      if (og + 1u == (tg + 1u) * nx) xb_add(&bar[XB_TOPGEN], 1u);
      else XB_SPIN(xb_ld(&bar[XB_TOPGEN]) == tg, bar);
      __builtin_amdgcn_fence(__ATOMIC_ACQUIRE, "agent");
      xb_add(&bar[XB_XGEN(b.x)], 1u);
      asm volatile("s_waitcnt vmcnt(0)" ::: "memory");
    } else {
      XB_SPIN(xb_ld(&bar[XB_XGEN(b.x)]) == gen, bar);
      __builtin_amdgcn_fence(__ATOMIC_ACQUIRE, "agent");
      asm volatile("s_waitcnt vmcnt(0)" ::: "memory");
    }
  }
  __syncthreads();
}

constexpr int N_PHASES = 19;
constexpr int LDS_BYTES = 74752;
__global__ void __launch_bounds__(256, 2) mega(Params p, int ph_lo, int ph_hi) {
  __shared__ __attribute__((aligned(16))) char lds[LDS_BYTES];
  const int bid = blockIdx.x, nb = gridDim.x;
  const int gw = bid * 4 + (threadIdx.x >> 6), nw = nb * 4;
  char* ws = p.ws;
  float* out1 = p.out + (size_t)M_P * DM;
  __shared__ uint4 xb_words;
  if (threadIdx.x == 0) xb_words = make_uint4(0u, 0u, 0u, 0u);
  __syncthreads();
  XcdBarrier xb; xb.bar = (unsigned*)(ws + OFF_BAR); xb.x = 0; xb.st = (volatile LAS unsigned*)&xb_words;
  if (ph_hi - ph_lo > 1) xb = xcd_barrier_post((unsigned*)(ws + OFF_BAR), (volatile LAS unsigned*)&xb_words);
  if (ph_lo < 0) cg::this_grid().sync();
#ifndef DUP_MASK
#define DUP_MASK 0
#endif
#define PHASE(k, ...) do { if (ph_lo <= (k) && (k) < ph_hi) { __VA_ARGS__ if ((DUP_MASK >> (k)) & 1) { xcd_barrier(xb); __VA_ARGS__ } } if (ph_lo <= (k) && (k) + 1 < ph_hi) xcd_barrier(xb); } while (0)
  PHASE(0, prep_phase(p, lds, bid, nb););
  PHASE(1, gemm_phase<EPI_BF16>((const u16*)(ws + OFF_H), 1024, (const u16*)(ws + WT_ABIN), 1024, 2560, (u16*)(ws + OFF_PROJ), 2560, nullptr, nullptr, nullptr, lds, bid, nb););
  PHASE(2, rg_phase<false>(p, lds, bid, nb); __syncthreads(); dilated_phase(p, lds, gw, nw););
  PHASE(3, rg_carry_phase(p, bid, nb););
  PHASE(4, rg_phase<true>(p, lds, bid, nb););
  PHASE(5, gemm_phase<EPI_RESID>((const u16*)(ws + OFF_Y), 1024, (const u16*)(ws + WT_ABOUT), 1024, 1024, nullptr, 0, p.xin0, p.xin1, p.out, lds, bid, nb););
  PHASE(6, rmsnorm_phase(p.out, out1, p.norm_ffn, (u16*)(ws + OFF_H), nullptr, gw, nw););
  PHASE(7, gemm_phase<EPI_SWIGLU>((const u16*)(ws + OFF_H), 1024, (const u16*)(ws + WT_GU0), 1024, 5632, (u16*)(ws + OFF_ACT), FH, nullptr, nullptr, nullptr, lds, bid, nb););
  PHASE(8, gemm_phase<EPI_RESID>((const u16*)(ws + OFF_ACT), FH, (const u16*)(ws + WT_DOWN0), FH, 1024, nullptr, 0, p.out, out1, p.out, lds, bid, nb););
  PHASE(9, rmsnorm_phase(p.out, out1, p.norm_mix + 1024, (u16*)(ws + OFF_H), nullptr, gw, nw););
  PHASE(10, gemm_phase<EPI_BF16>((const u16*)(ws + OFF_H), 1024, (const u16*)(ws + WT_MLAIN), 1024, 768, (u16*)(ws + OFF_P2), 768, nullptr, nullptr, nullptr, lds, bid, nb););
  PHASE(11, mla_norm_phase(p, gw, nw););
  PHASE(12, gemm_phase<EPI_BF16>((const u16*)(ws + OFF_CQN), 384, (const u16*)(ws + WT_QB), 384, 1536, (u16*)(ws + OFF_Q), 1536, nullptr, nullptr, nullptr, lds, bid, nb); gemm_phase<EPI_BF16>((const u16*)(ws + OFF_CKVN), 256, (const u16*)(ws + WT_KVB), 256, 2048, (u16*)(ws + OFF_KV), 2048, nullptr, nullptr, nullptr, lds, bid, nb););
  PHASE(13, mla_attn_phase(p, lds, bid, nb););
  PHASE(14, gemm_phase<EPI_RESID>((const u16*)(ws + OFF_O), 1024, (const u16*)(ws + WT_MLAOUT), 1024, 1024, nullptr, 0, p.out, out1, p.out, lds, bid, nb););
  PHASE(15, rmsnorm_phase(p.out, out1, p.norm_ffn + 1024, (u16*)(ws + OFF_H), nullptr, gw, nw););
  PHASE(16, gemm_phase<EPI_SWIGLU>((const u16*)(ws + OFF_H), 1024, (const u16*)(ws + WT_GU1), 1024, 5632, (u16*)(ws + OFF_ACT), FH, nullptr, nullptr, nullptr, lds, bid, nb););
  PHASE(17, gemm_phase<EPI_RESID>((const u16*)(ws + OFF_ACT), FH, (const u16*)(ws + WT_DOWN1), FH, 1024, nullptr, 0, p.out, out1, p.out, lds, bid, nb););
  PHASE(18, rmsnorm_phase(p.out, out1, p.norm_final, nullptr, p.out, gw, nw););
#undef PHASE
}

extern "C" void kernel_launch(void* const* d_in, const int* in_sizes, int n_in, void* d_out, int out_size, void* d_ws, size_t ws_size, hipStream_t stream) {
  static int grid_blocks = 0;
  if (!grid_blocks) {
    int dev = 0, cus = 0, per_cu = 0;
    hipGetDevice(&dev);
    hipDeviceGetAttribute(&cus, hipDeviceAttributeMultiprocessorCount, dev);
    hipOccupancyMaxActiveBlocksPerMultiprocessor(&per_cu, mega, 256, 0);
    if (per_cu > 2) per_cu = 2;
    if (per_cu < 1) per_cu = 1;
    grid_blocks = cus * per_cu;
  }
  if (n_in != 23 || ws_size < WS_NEED) { fprintf(stderr, "kernel_launch: bad inputs n_in=%d ws=%zu\n", n_in, ws_size); return; }
  Params p{};
  p.xin0 = (const float*)d_in[0]; p.xin1 = (const float*)d_in[1];
  p.norm_mix = (const float*)d_in[2]; p.norm_ffn = (const float*)d_in[3]; p.norm_final = (const float*)d_in[4];
  p.ab_w_in = (const float*)d_in[5]; p.conv_w = (const float*)d_in[6]; p.conv_b = (const float*)d_in[7];
  p.w_a = (const float*)d_in[8]; p.b_a = (const float*)d_in[9]; p.w_i = (const float*)d_in[10]; p.b_i = (const float*)d_in[11];
  p.lam = (const float*)d_in[12]; p.ab_w_out = (const float*)d_in[13];
  p.mla_w_in = (const float*)d_in[14]; p.q_norm = (const float*)d_in[15]; p.w_qb = (const float*)d_in[16]; p.kv_norm = (const float*)d_in[17];
  p.w_kvb = (const float*)d_in[18]; p.mla_w_out = (const float*)d_in[19];
  p.w_gate = (const float*)d_in[20]; p.w_up = (const float*)d_in[21]; p.w_down = (const float*)d_in[22];
  p.out = (float*)d_out; p.ws = (char*)d_ws;
#if SINGLE_LAUNCH
  hipMemsetAsync((char*)d_ws + OFF_BAR, 0, XCD_BAR_WORDS * 4, stream);
  int lo = 0, hi = N_PHASES;
  void* args[] = {&p, &lo, &hi};
  hipError_t e = hipLaunchCooperativeKernel((void*)mega, dim3(grid_blocks), dim3(256), args, 0, stream);
  if (e != hipSuccess) fprintf(stderr, "cooperative launch failed: %s (grid %d)\n", hipGetErrorString(e), grid_blocks);
#else
  for (int ph = 0; ph < N_PHASES; ++ph) hipLaunchKernelGGL(mega, dim3(grid_blocks), dim3(256), 0, stream, p, ph, ph + 1);
#endif
}
```

```cpp
#include <hip/hip_runtime.h>
#include <hip/hip_cooperative_groups.h>
#include <cstdint>
#include <cstdio>
namespace cg = cooperative_groups;

#ifndef SINGLE_LAUNCH
#define SINGLE_LAUNCH 1
#endif

typedef unsigned short u16;
typedef short bf16x8 __attribute__((ext_vector_type(8)));
typedef short s16x4 __attribute__((ext_vector_type(4)));
typedef float f32x16 __attribute__((ext_vector_type(16)));
typedef float f32x4 __attribute__((ext_vector_type(4)));
typedef float f32x2 __attribute__((ext_vector_type(2)));
typedef unsigned u32x4 __attribute__((ext_vector_type(4)));
typedef unsigned u32x2 __attribute__((ext_vector_type(2)));
typedef __bf16 bf2_t __attribute__((ext_vector_type(2)));
#define DI __device__ __forceinline__
#define VT ((int)(threadIdx.x & 255))
#define MFMA32(a, b, c) __builtin_amdgcn_mfma_f32_32x32x16_bf16((a), (b), (c), 0, 0, 0)

constexpr int M_TOT = 49152, M_P = 32768, DM = 1024, FH = 2816;
constexpr float LOG2E = 1.4426950408889634f;
constexpr size_t MiB = 1ull << 20;
constexpr size_t WT_ABIN = 0;
constexpr size_t WT_ABOUT = WT_ABIN + 2560ull * 1024 * 2;
constexpr size_t WT_GU0 = WT_ABOUT + 1024ull * 1024 * 2;
constexpr size_t WT_DOWN0 = WT_GU0 + 5632ull * 1024 * 2;
constexpr size_t WT_MLAIN = WT_DOWN0 + 1024ull * 2816 * 2;
constexpr size_t WT_QB = WT_MLAIN + 768ull * 1024 * 2;
constexpr size_t WT_KVB = WT_QB + 1536ull * 384 * 2;
constexpr size_t WT_MLAOUT = WT_KVB + 2048ull * 256 * 2;
constexpr size_t WT_GU1 = WT_MLAOUT + 1024ull * 1024 * 2;
constexpr size_t WT_DOWN1 = WT_GU1 + 5632ull * 1024 * 2;
constexpr size_t WT_GATES = WT_DOWN1 + 1024ull * 2816 * 2;
constexpr size_t WT_END = WT_GATES + 32ull * 4096 * 2;
static_assert(WT_END <= 46 * MiB, "weights region");
constexpr size_t OFF_SUM = 46 * MiB;
constexpr size_t OFF_KR = 46 * MiB;
constexpr size_t OFF_COS = 52 * MiB;
constexpr size_t OFF_SIN = 52 * MiB + 512 * 1024;
constexpr size_t OFF_H = 54 * MiB;
constexpr size_t OFF_CQN = 54 * MiB;
constexpr size_t OFF_CKVN = 90 * MiB;
constexpr size_t OFF_O = 54 * MiB;
constexpr size_t OFF_PROJ = 150 * MiB;
constexpr size_t OFF_ACT = 150 * MiB;
constexpr size_t OFF_P2 = 150 * MiB;
constexpr size_t OFF_Q = 150 * MiB;
constexpr size_t OFF_KV = 294 * MiB;
constexpr size_t OFF_Y = 390 * MiB;
constexpr size_t OFF_CARRY = 486 * MiB;
constexpr size_t OFF_BAR = 489 * MiB;
constexpr size_t WS_NEED = 490 * MiB;

struct Params {
  const float* xin0; const float* xin1;
  const float* norm_mix; const float* norm_ffn; const float* norm_final;
  const float* ab_w_in; const float* conv_w; const float* conv_b;
  const float* w_a; const float* b_a; const float* w_i; const float* b_i; const float* lam; const float* ab_w_out;
  const float* mla_w_in; const float* q_norm; const float* w_qb; const float* kv_norm; const float* w_kvb; const float* mla_w_out;
  const float* w_gate; const float* w_up; const float* w_down;
  float* out; char* ws;
};

DI float bf2f(u16 v) { return __uint_as_float(((unsigned)v) << 16); }
DI float bfs2f(short v) { return __uint_as_float(((unsigned)(u16)v) << 16); }
DI unsigned pk2(float lo, float hi) { f32x2 v = {lo, hi}; bf2_t r = __builtin_convertvector(v, bf2_t); return __builtin_bit_cast(unsigned, r); }
DI u16 f2bf(float a) { return (u16)(pk2(a, 0.f) & 0xffffu); }
DI int crow(int r, int hi) { return (r & 3) + 8 * (r >> 2) + 4 * hi; }
DI float sigmoidf_(float x) { return 1.f / (1.f + __expf(-x)); }
DI float pl32_max(float v) { auto rr = __builtin_amdgcn_permlane32_swap(__float_as_uint(v), __float_as_uint(v), false, false); return fmaxf(__uint_as_float(rr[0]), __uint_as_float(rr[1])); }
DI float pl32_sum(float v) { auto rr = __builtin_amdgcn_permlane32_swap(__float_as_uint(v), __float_as_uint(v), false, false); return __uint_as_float(rr[0]) + __uint_as_float(rr[1]); }
DI s16x4 tr_read(unsigned addr) { s16x4 r; asm volatile("ds_read_b64_tr_b16 %0, %1" : "=&v"(r) : "v"(addr) : "memory"); return r; }
#define LGKM0() do { asm volatile("s_waitcnt lgkmcnt(0)" ::: "memory"); __builtin_amdgcn_sched_barrier(0); } while (0)
DI bf16x8 cat4(s16x4 l, s16x4 h) { return (bf16x8){l[0], l[1], l[2], l[3], h[0], h[1], h[2], h[3]}; }
DI bf16x8 pack8(const f32x16& x, int s) {
  u32x4 w = {pk2(x[8 * s + 0], x[8 * s + 1]), pk2(x[8 * s + 2], x[8 * s + 3]), pk2(x[8 * s + 4], x[8 * s + 5]), pk2(x[8 * s + 6], x[8 * s + 7])};
  return __builtin_bit_cast(bf16x8, w);
}
DI void row_info(int m, int& seq_lo, int& S) { if (m < M_P) { seq_lo = m & ~8191; S = 8192; } else { seq_lo = M_P + ((m - M_P) & ~4095); S = 4096; } }

DI void tr_job(const float* __restrict__ src, int K, int N, u16* __restrict__ dst, int mode, float* tile, int bid, int nb, int& rot) {
  const int tk = K >> 6, tn = (N + 63) >> 6, nt = tk * tn;
  const int tx = VT & 63, ty = VT >> 6;
  const int t0 = (bid + nb - rot) % nb, nit = (nt + nb - 1) / nb;
  for (int i = 0; i < nit; ++i) {
    const int t = t0 + i * nb; const bool act = t < nt;
    const int k0 = (t / tn) << 6, n0 = (t % tn) << 6;
    __syncthreads();
    if (act) {
#pragma unroll 4
      for (int r = 0; r < 16; ++r) { const int kk = ty + 4 * r, n = n0 + tx; tile[kk * 65 + tx] = n < N ? src[(size_t)(k0 + kk) * N + n] : 0.f; }
    }
    __syncthreads();
    if (act) {
#pragma unroll 4
      for (int r = 0; r < 16; ++r) {
        const int nn = ty + 4 * r, n = n0 + nn;
        if (n < N) { const int row = mode == 0 ? n : ((n >> 5) * 64 + (n & 31) + (mode == 2 ? 32 : 0)); dst[(size_t)row * K + k0 + tx] = f2bf(tile[tx * 65 + nn]); }
      }
    }
  }
  rot = (rot + nt) % nb;
}

DI void rmsnorm_phase(const float* __restrict__ s0, const float* __restrict__ s1, const float* __restrict__ g, u16* outb, float* outf, int gw, int nw) {
  const int lane = threadIdx.x & 63;
  for (int m = gw; m < M_TOT; m += nw) {
    const float* src = m < M_P ? s0 + (size_t)m * DM : s1 + (size_t)(m - M_P) * DM;
    f32x4 v[4];
#pragma unroll
    for (int i = 0; i < 4; ++i) v[i] = *(const f32x4*)(src + i * 256 + lane * 4);
    float ss = 0.f;
#pragma unroll
    for (int i = 0; i < 4; ++i) ss += v[i][0] * v[i][0] + v[i][1] * v[i][1] + v[i][2] * v[i][2] + v[i][3] * v[i][3];
#pragma unroll
    for (int o = 32; o > 0; o >>= 1) ss += __shfl_xor(ss, o);
    const float rs = rsqrtf(ss * (1.f / 1024.f) + 1e-6f);
#pragma unroll
    for (int i = 0; i < 4; ++i) {
      const f32x4 gg = *(const f32x4*)(g + i * 256 + lane * 4);
      const f32x4 y = v[i] * rs * gg;
      if (outb) { u32x2 w = {pk2(y[0], y[1]), pk2(y[2], y[3])}; *(u32x2*)(outb + (size_t)m * DM + i * 256 + lane * 4) = w; }
      else *(f32x4*)(outf + (size_t)m * DM + i * 256 + lane * 4) = y;
    }
  }
}

DI void prep_phase(const Params& p, char* lds, int bid, int nb) {
  float* tile = (float*)lds;
  char* ws = p.ws;
  int rot = 0;
  tr_job(p.ab_w_in, 1024, 2560, (u16*)(ws + WT_ABIN), 0, tile, bid, nb, rot);
  tr_job(p.ab_w_out, 1024, 1024, (u16*)(ws + WT_ABOUT), 0, tile, bid, nb, rot);
  tr_job(p.w_gate, 1024, FH, (u16*)(ws + WT_GU0), 1, tile, bid, nb, rot);
  tr_job(p.w_up, 1024, FH, (u16*)(ws + WT_GU0), 2, tile, bid, nb, rot);
  tr_job(p.w_gate + (size_t)1024 * FH, 1024, FH, (u16*)(ws + WT_GU1), 1, tile, bid, nb, rot);
  tr_job(p.w_up + (size_t)1024 * FH, 1024, FH, (u16*)(ws + WT_GU1), 2, tile, bid, nb, rot);
  tr_job(p.w_down, FH, 1024, (u16*)(ws + WT_DOWN0), 0, tile, bid, nb, rot);
  tr_job(p.w_down + (size_t)FH * 1024, FH, 1024, (u16*)(ws + WT_DOWN1), 0, tile, bid, nb, rot);
  tr_job(p.mla_w_in, 1024, 672, (u16*)(ws + WT_MLAIN), 0, tile, bid, nb, rot);
  tr_job(p.w_qb, 384, 1536, (u16*)(ws + WT_QB), 0, tile, bid, nb, rot);
  tr_job(p.w_kvb, 256, 2048, (u16*)(ws + WT_KVB), 0, tile, bid, nb, rot);
  tr_job(p.mla_w_out, 1024, 1024, (u16*)(ws + WT_MLAOUT), 0, tile, bid, nb, rot);
  for (int dg = 0; dg < 32; ++dg) {
    const int cb = dg & 7, gate = (dg >> 3) & 1, dir = dg >> 4;
    const float* src = (gate == 0 ? p.w_a : p.w_i) + (size_t)(dir * 8 + cb) * 4096;
    tr_job(src, 64, 64, (u16*)(ws + WT_GATES) + (size_t)dg * 4096, 0, tile, bid, nb, rot);
  }
  const int gtid = bid * 256 + VT, gn = nb * 256;
  { u16* d = (u16*)(ws + WT_MLAIN) + (size_t)672 * 1024; for (int i = gtid; i < 96 * 1024; i += gn) d[i] = 0; }
  { float* ct = (float*)(ws + OFF_COS); float* st = (float*)(ws + OFF_SIN);
    for (int i = gtid; i < 8192 * 16; i += gn) {
      const int pos = i >> 4, k = i & 15;
      const float inv_freq = 1.0f / powf(10000.0f, (float)(2 * k) / 32.0f);
      const float ang = (float)pos * inv_freq;
      double f = (double)ang * 0.15915494309189535; f -= rint(f);
      ct[i] = __builtin_amdgcn_cosf((float)f); st[i] = __builtin_amdgcn_sinf((float)f);
    } }
  rmsnorm_phase(p.xin0, p.xin1, p.norm_mix, (u16*)(ws + OFF_H), nullptr, bid * 4 + (VT >> 6), nb * 4);
}

constexpr int GP = 72;
enum { EPI_BF16 = 0, EPI_RESID = 1, EPI_SWIGLU = 2 };
template <int EPI>
DI void gemm_phase(const u16* __restrict__ A, int lda, const u16* __restrict__ Bt, int K, int N, u16* outb, int ldo,
                   const float* r0, const float* r1, float* outf, char* lds, int bid, int nb) {
  const int tid = threadIdx.x, lane = tid & 63, wid = tid >> 6, wr = wid >> 2, wc = wid & 3, r32 = lane & 31, hi = lane >> 5;
  u16* As = (u16*)lds; u16* Bs = As + 2 * 256 * GP;
  const int nN = N >> 8, nM = M_TOT >> 8, nT = nM * nN, nk = K >> 6;
  const int lrow = tid >> 3, lch = tid & 7;
  const bool swz = (nb == 256);
  const int GN = (nN & 1) == 0 ? 2 : 1, GM = 32 / GN, nSN = nN / GN, nST = (nM / GM) * nSN;
  const int xcd = bid & 7, jb = bid >> 3;
  const int nIter = swz ? (nST - xcd + 7) / 8 : (nT - bid + nb - 1) / nb;
  for (int it = 0; it < nIter; ++it) {
    int tm, tn;
    if (swz) { const int st = xcd + 8 * it, sm = st / nSN, sn = st - sm * nSN; tm = sm * GM + jb / GN; tn = sn * GN + (jb % GN); }
    else { const int t = bid + it * nb; tm = t / nN; tn = t - tm * nN; }
    const u16* Ag = A + (size_t)(tm * 256 + lrow) * lda + lch * 8;
    const u16* Bg = Bt + (size_t)(tn * 256 + lrow) * K + lch * 8;
    f32x16 acc[4][2];
#pragma unroll
    for (int i = 0; i < 4; ++i) { acc[i][0] = f32x16{}; acc[i][1] = f32x16{}; }
    u32x4 ra0[4], rb0[4], ra1[4], rb1[4];
#define SB() __builtin_amdgcn_sched_barrier(0)
#define G_LOAD(RA, RB, KT) do { _Pragma("unroll") for (int i = 0; i < 4; ++i) { RA[i] = *(const u32x4*)(Ag + (size_t)i * 64 * lda + (KT) * 64); RB[i] = *(const u32x4*)(Bg + (size_t)i * 64 * K + (KT) * 64); } } while (0)
#define G_STORE_A(RA, BUF) do { u16* ad = As + (BUF) * 256 * GP; _Pragma("unroll") for (int i = 0; i < 4; ++i) *(u32x4*)(ad + (lrow + 64 * i) * GP + lch * 8) = RA[i]; } while (0)
#define G_STORE_B(RB, BUF) do { u16* bd = Bs + (BUF) * 256 * GP; _Pragma("unroll") for (int i = 0; i < 4; ++i) *(u32x4*)(bd + (lrow + 64 * i) * GP + lch * 8) = RB[i]; } while (0)
#define G_MMA(BUF, KS) do { const u16* as = As + (BUF) * 256 * GP + (wr * 128 + r32) * GP + hi * 8 + (KS) * 16; const u16* bs = Bs + (BUF) * 256 * GP + (wc * 64 + r32) * GP + hi * 8 + (KS) * 16; \
        const bf16x8 b0 = *(const bf16x8*)(bs), b1 = *(const bf16x8*)(bs + 32 * GP); \
        _Pragma("unroll") for (int i = 0; i < 4; ++i) { const bf16x8 a = *(const bf16x8*)(as + i * 32 * GP); \
          acc[i][0] = MFMA32(a, b0, acc[i][0]); acc[i][1] = MFMA32(a, b1, acc[i][1]); } } while (0)
#define G_ITER(BUF, RAC, RBC, RAN, RBN, KT) do { \
      if ((KT) + 2 < nk) G_LOAD(RAC, RBC, (KT) + 2); \
      SB(); G_MMA(BUF, 0); SB(); \
      if ((KT) + 1 < nk) G_STORE_A(RAN, (BUF) ^ 1); \
      SB(); G_MMA(BUF, 1); SB(); \
      if ((KT) + 1 < nk) G_STORE_B(RBN, (BUF) ^ 1); \
      SB(); G_MMA(BUF, 2); G_MMA(BUF, 3); SB(); \
      __syncthreads(); } while (0)
    G_LOAD(ra0, rb0, 0);
    G_LOAD(ra1, rb1, 1);
    G_STORE_A(ra0, 0); G_STORE_B(rb0, 0);
    __syncthreads();
    for (int kt = 0; kt < nk; kt += 2) {
      G_ITER(0, ra0, rb0, ra1, rb1, kt);
      G_ITER(1, ra1, rb1, ra0, rb0, kt + 1);
    }
#undef G_LOAD
#undef G_STORE_A
#undef G_STORE_B
#undef G_MMA
#undef G_ITER
    const int mrow = tm * 256 + wr * 128;
    if constexpr (EPI == EPI_BF16) {
      const int col = tn * 256 + wc * 64 + r32;
#pragma unroll
      for (int i = 0; i < 4; ++i)
#pragma unroll
        for (int reg = 0; reg < 16; ++reg) {
          u16* o0 = outb + (size_t)(mrow + i * 32 + crow(reg, hi)) * ldo + col;
          o0[0] = f2bf(acc[i][0][reg]); o0[32] = f2bf(acc[i][1][reg]);
        }
    } else if constexpr (EPI == EPI_RESID) {
      const int col = tn * 256 + wc * 64 + r32;
      const float* rb_ = (tm * 256 < M_P) ? r0 : (r1 - (size_t)M_P * DM);
#pragma unroll
      for (int i = 0; i < 4; ++i)
#pragma unroll
        for (int reg = 0; reg < 16; ++reg) {
          const size_t i0 = (size_t)(mrow + i * 32 + crow(reg, hi)) * DM + col;
          const float x0 = rb_[i0], x1 = rb_[i0 + 32];
          outf[i0] = x0 + acc[i][0][reg]; outf[i0 + 32] = x1 + acc[i][1][reg];
        }
    } else {
      const int col = (tn * 4 + wc) * 32 + r32;
#pragma unroll
      for (int i = 0; i < 4; ++i)
#pragma unroll
        for (int reg = 0; reg < 16; ++reg) {
          const float g0 = acc[i][0][reg], u0 = acc[i][1][reg];
          outb[(size_t)(mrow + i * 32 + crow(reg, hi)) * ldo + col] = f2bf(g0 * sigmoidf_(g0) * u0);
        }
    }
  }
}

template <bool FINAL>
DI void rg_phase(const Params& p, char* lds, int bid, int nb) {
  const int tid = VT, lane = tid & 63, wid = tid >> 6, r32 = lane & 31, hi = lane >> 5;
  u16* xcb = (u16*)lds;
  float* A0 = (float*)(lds + 9216);
  float* U0 = (float*)(lds + 9216 + 16384);
  float* A1 = (float*)(lds + 9216 + 32768);
  float* U1 = (float*)(lds + 9216 + 49152);
  u16* raw = (u16*)A1;
  const u16* PROJ = (const u16*)(p.ws + OFF_PROJ);
  const u16* WG = (const u16*)(p.ws + WT_GATES);
  float* SUM = (float*)(p.ws + OFF_SUM);
  const float* CARRY = (const float*)(p.ws + OFF_CARRY);
  u16* Y = (u16*)(p.ws + OFF_Y);
  const int NIT = 768 * 8, nit = (NIT + nb - 1) / nb;
  const int mt = wid >> 1, nt = wid & 1;
  int cb_loaded = -1;
  bf16x8 bfr[2][2][4];
  float w0 = 0.f, w1 = 0.f, w2 = 0.f, w3 = 0.f, cbias = 0.f, bav[2] = {0.f, 0.f}, biv[2] = {0.f, 0.f}, spv[2] = {0.f, 0.f};
  u32x4 rr[3], rg[2], rrn[3], rgn[2];
  auto load_item = [&](int it, u32x4 (&xr)[3], u32x4 (&xg)[2]) {
    const int gc = it >> 3, cb = it & 7, m0 = gc * 64;
    int seq_lo, S; row_info(m0, seq_lo, S); const int seq_hi = seq_lo + S;
#pragma unroll
    for (int i = 0; i < 3; ++i) {
      const int c = tid + 256 * i, row = c >> 3, ch8 = c & 7, m = m0 - 2 + row;
      xr[i] = (c < 536 && m >= seq_lo && m < seq_hi) ? *(const u32x4*)(PROJ + (size_t)m * 2560 + cb * 64 + ch8 * 8) : (u32x4){0u, 0u, 0u, 0u};
    }
    if (FINAL) {
#pragma unroll
      for (int i = 0; i < 2; ++i) { const int c = tid + 256 * i, row = c >> 3, ch8 = c & 7; xg[i] = *(const u32x4*)(PROJ + (size_t)(m0 + row) * 2560 + 512 + cb * 64 + ch8 * 8); }
    }
  };
  { const int it = bid < NIT ? bid : NIT - 1; load_item(it, rr, rg); }
  for (int k = 0; k < nit; ++k) {
    const int it0 = bid + k * nb, it = it0 < NIT ? it0 : NIT - 1;
    const int gc = it >> 3, cb = it & 7, m0 = gc * 64;
    if (cb != cb_loaded) {
      cb_loaded = cb;
#pragma unroll
      for (int dir = 0; dir < 2; ++dir)
#pragma unroll
        for (int g = 0; g < 2; ++g)
#pragma unroll
          for (int ks = 0; ks < 4; ++ks)
            bfr[dir][g][ks] = *(const bf16x8*)(WG + (size_t)((dir * 2 + g) * 8 + cb) * 4096 + (nt * 32 + r32) * 64 + ks * 16 + 8 * hi);
      const int cc = cb * 64 + (tid & 63);
      w0 = p.conv_w[cc]; w1 = p.conv_w[512 + cc]; w2 = p.conv_w[1024 + cc]; w3 = p.conv_w[1536 + cc]; cbias = p.conv_b[cc];
      const int cg_ = cb * 64 + nt * 32 + r32;
#pragma unroll
      for (int dir = 0; dir < 2; ++dir) { bav[dir] = p.b_a[dir * 512 + cg_]; biv[dir] = p.b_i[dir * 512 + cg_]; spv[dir] = log1pf(__expf(-p.lam[dir * 512 + cg_])); }
    }
    __syncthreads();
#pragma unroll
    for (int i = 0; i < 3; ++i) { const int c = tid + 256 * i; if (c < 536) *(u32x4*)(raw + c * 8) = rr[i]; }
    { const int itn0 = bid + (k + 1) * nb, itn = itn0 < NIT ? itn0 : NIT - 1; load_item(itn, rrn, rgn); }
    __syncthreads();
    {
      const int ch = tid & 63, t0 = (tid >> 6) * 16;
      float xm2 = bf2f(raw[(t0) * 64 + ch]), xm1 = bf2f(raw[(t0 + 1) * 64 + ch]), x0 = bf2f(raw[(t0 + 2) * 64 + ch]);
#pragma unroll
      for (int t = t0; t < t0 + 16; ++t) {
        const float xp1 = bf2f(raw[(t + 3) * 64 + ch]);
        xcb[t * 72 + ch] = f2bf(w0 * xm2 + w1 * xm1 + w2 * x0 + w3 * xp1 + cbias);
        xm2 = xm1; xm1 = x0; x0 = xp1;
      }
    }
    __syncthreads();
    {
      bf16x8 af[4];
#pragma unroll
      for (int ks = 0; ks < 4; ++ks) af[ks] = *(const bf16x8*)(xcb + (mt * 32 + r32) * 72 + ks * 16 + 8 * hi);
      const int ch = nt * 32 + r32;
      float xc[16];
#pragma unroll
      for (int reg = 0; reg < 16; ++reg) xc[reg] = bf2f(xcb[(mt * 32 + crow(reg, hi)) * 72 + ch]);
#pragma unroll
      for (int dir = 0; dir < 2; ++dir) {
        f32x16 aa = {}, ai = {};
#pragma unroll
        for (int ks = 0; ks < 4; ++ks) { aa = MFMA32(af[ks], bfr[dir][0][ks], aa); ai = MFMA32(af[ks], bfr[dir][1][ks], ai); }
        float* Ab = dir == 0 ? A0 : A1; float* Ub = dir == 0 ? U0 : U1;
#pragma unroll
        for (int reg = 0; reg < 16; ++reg) {
          const int tok = mt * 32 + crow(reg, hi);
          const float r = sigmoidf_(aa[reg] + bav[dir]), gi = sigmoidf_(ai[reg] + biv[dir]);
          const float la = -8.f * r * spv[dir], a = __expf(la);
          const float mult = sqrtf(fmaxf(0.f, 1.f - __expf(2.f * la)));
          Ab[tok * 64 + ch] = a; Ub[tok * 64 + ch] = mult * gi * xc[reg];
        }
      }
    }
    __syncthreads();
    if (wid < 2) {
      const int dir = wid, ch = lane, c = cb * 64 + ch;
      float* Ab = dir == 0 ? A0 : A1; float* Ub = dir == 0 ? U0 : U1;
      if (!FINAL) {
        float h = 0.f, P = 1.f;
#pragma unroll 16
        for (int kk = 0; kk < 64; ++kk) { const int t = dir == 0 ? kk : 63 - kk; const float a = Ab[t * 64 + ch], u = Ub[t * 64 + ch]; h = a * h + u; P *= a; }
        SUM[(size_t)((gc * 2 + dir) * 2 + 0) * 512 + c] = P; SUM[(size_t)((gc * 2 + dir) * 2 + 1) * 512 + c] = h;
      } else {
        float h = CARRY[(size_t)(gc * 2 + dir) * 512 + c];
#pragma unroll 16
        for (int kk = 0; kk < 64; ++kk) { const int t = dir == 0 ? kk : 63 - kk; const float a = Ab[t * 64 + ch], u = Ub[t * 64 + ch]; h = a * h + u; Ub[t * 64 + ch] = h; }
      }
    }
    if (FINAL) {
      __syncthreads();
#pragma unroll
      for (int i = 0; i < 2; ++i) {
        const int c = tid + 256 * i, t = c >> 3, ch8 = c & 7;
        const f32x4 ha = *(const f32x4*)(U0 + t * 64 + ch8 * 8), hb = *(const f32x4*)(U0 + t * 64 + ch8 * 8 + 4);
        const f32x4 hc = *(const f32x4*)(U1 + t * 64 + ch8 * 8), hd = *(const f32x4*)(U1 + t * 64 + ch8 * 8 + 4);
        float hs[8] = {ha[0] + hc[0], ha[1] + hc[1], ha[2] + hc[2], ha[3] + hc[3], hb[0] + hd[0], hb[1] + hd[1], hb[2] + hd[2], hb[3] + hd[3]};
        float yv[8];
#pragma unroll
        for (int j = 0; j < 8; ++j) {
          const unsigned wv = rg[i][j >> 1];
          const float gt = __uint_as_float((j & 1) ? (wv & 0xffff0000u) : (wv << 16));
          const float ge = gt * sigmoidf_(1.5957691216057308f * (gt + 0.044715f * gt * gt * gt));
          yv[j] = ge * hs[j];
        }
        u32x4 o = {pk2(yv[0], yv[1]), pk2(yv[2], yv[3]), pk2(yv[4], yv[5]), pk2(yv[6], yv[7])};
        *(u32x4*)(Y + (size_t)(m0 + t) * 1024 + cb * 64 + ch8 * 8) = o;
      }
    }
#pragma unroll
    for (int i = 0; i < 3; ++i) rr[i] = rrn[i];
#pragma unroll
    for (int i = 0; i < 2; ++i) rg[i] = rgn[i];
  }
}

DI void rg_carry_phase(const Params& p, int bid, int nb) {
  const float* __restrict__ SUM = (const float*)(p.ws + OFF_SUM);
  float* __restrict__ CARRY = (float*)(p.ws + OFF_CARRY);
  for (int idx = bid * 256 + VT; idx < 8192; idx += nb * 256) {
    const int c = idx & 511, dir = (idx >> 9) & 1, seq = idx >> 10;
    const int gc0 = seq < 4 ? seq * 128 : 512 + (seq - 4) * 64, nch = seq < 4 ? 128 : 64;
    float carry = 0.f;
    for (int k0 = 0; k0 < nch; k0 += 8) {
      float P[8], Hh[8];
#pragma unroll
      for (int j = 0; j < 8; ++j) { const int k = k0 + j, gc = dir == 0 ? gc0 + k : gc0 + nch - 1 - k; P[j] = SUM[(size_t)((gc * 2 + dir) * 2 + 0) * 512 + c]; Hh[j] = SUM[(size_t)((gc * 2 + dir) * 2 + 1) * 512 + c]; }
#pragma unroll
      for (int j = 0; j < 8; ++j) { const int k = k0 + j, gc = dir == 0 ? gc0 + k : gc0 + nch - 1 - k; CARRY[(size_t)(gc * 2 + dir) * 512 + c] = carry; carry = P[j] * carry + Hh[j]; }
    }
  }
}

DI void dil_tile_info(int ti, int m0, int& d, int& u0) {
  if (ti < 5) { d = 16; u0 = m0 - 1024 + ti * 512; } else if (ti < 13) { d = 4; u0 = m0 - 256 + (ti - 5) * 128; } else { d = 1; u0 = m0 - 64 + (ti - 13) * 32; }
}
DI void dilated_phase(const Params& p, char* lds, int gw, int nw) {
  const int lane = VT & 63, wid = VT >> 6, r32 = lane & 31, hi = lane >> 5;
  u16* Vl = (u16*)(lds + wid * 6144);
  const unsigned vbase = (unsigned)(uintptr_t)Vl;
  const int li = lane & 15, tq = li >> 2, tp = li & 3, g1 = (lane >> 4) & 1;
  const unsigned trb = vbase + (4 * hi + tq) * 192 + (16 * g1 + 4 * tp) * 2;
  const u16* PROJ = (const u16*)(p.ws + OFF_PROJ);
  u16* Y = (u16*)(p.ws + OFF_Y);
  const int vrow = lane >> 3, vch = lane & 7;
  for (int id = gw; id < 12288; id += nw) {
    const int res = id & 15, h = (id >> 4) & 7, sp = id >> 7;
    const int m0 = sp * 512 + res;
    int seq_lo, S; row_info(sp * 512, seq_lo, S); const int seq_hi = seq_lo + S;
    const int mq = m0 + 16 * r32;
    bf16x8 qf[4];
#pragma unroll
    for (int ks = 0; ks < 4; ++ks) qf[ks] = *(const bf16x8*)(PROJ + (size_t)mq * 2560 + 1024 + h * 64 + ks * 16 + 8 * hi);
    const float slope2 = exp2f(-(float)(h + 1)) * LOG2E;
    const float c1 = 0.125f * LOG2E;
    float m_run = -1e30f, l_run = 0.f; f32x16 o0 = {}, o1 = {};
    const u16* kbase = PROJ + 1536 + h * 64 + 8 * hi;
    const u16* vbaseg = PROJ + 2048 + h * 64 + vch * 8;
    bf16x8 kf[4]; u32x4 vr[4];
    { int d, u0; dil_tile_info(0, m0, d, u0);
      const int ur = min(max(u0 + d * r32, seq_lo), seq_hi - 1);
#pragma unroll
      for (int ks = 0; ks < 4; ++ks) kf[ks] = *(const bf16x8*)(kbase + (size_t)ur * 2560 + ks * 16);
#pragma unroll
      for (int i = 0; i < 4; ++i) { const int uv = min(max(u0 + d * (vrow + 8 * i), seq_lo), seq_hi - 1); vr[i] = *(const u32x4*)(vbaseg + (size_t)uv * 2560); } }
#pragma unroll 1
    for (int ti = 0; ti < 33; ++ti) {
      int d, u0; dil_tile_info(ti, m0, d, u0);
#pragma unroll
      for (int i = 0; i < 4; ++i) *(u32x4*)(Vl + (vrow + 8 * i) * 96 + vch * 8) = vr[i];
      f32x16 pt = {};
#pragma unroll
      for (int ks = 0; ks < 4; ++ks) pt = MFMA32(kf[ks], qf[ks], pt);
      if (ti + 1 < 33) {
        int dn, un; dil_tile_info(ti + 1, m0, dn, un);
        const int ur = min(max(un + dn * r32, seq_lo), seq_hi - 1);
#pragma unroll
        for (int ks = 0; ks < 4; ++ks) kf[ks] = *(const bf16x8*)(kbase + (size_t)ur * 2560 + ks * 16);
#pragma unroll
        for (int i = 0; i < 4; ++i) { const int uv = min(max(un + dn * (vrow + 8 * i), seq_lo), seq_hi - 1); vr[i] = *(const u32x4*)(vbaseg + (size_t)uv * 2560); }
      }
      const s16x4 l00 = tr_read(trb), h00 = tr_read(trb + 8 * 192), l01 = tr_read(trb + 64), h01 = tr_read(trb + 8 * 192 + 64);
      const s16x4 l10 = tr_read(trb + 16 * 192), h10 = tr_read(trb + 24 * 192), l11 = tr_read(trb + 16 * 192 + 64), h11 = tr_read(trb + 24 * 192 + 64);
      const int du0 = u0 - mq + d * 4 * hi, lim = 64 * d;
      float pmax = -INFINITY;
#pragma unroll
      for (int reg = 0; reg < 16; ++reg) {
        const int du = du0 + d * ((reg & 3) + 8 * (reg >> 2)), u = mq + du, ad = du < 0 ? -du : du;
        const bool valid = (ad <= lim) && (u >= seq_lo) && (u < seq_hi);
        const float tv = valid ? (pt[reg] * c1 - slope2 * (float)ad) : -INFINITY;
        pt[reg] = tv; pmax = fmaxf(pmax, tv);
      }
      pmax = pl32_max(pmax);
      if (__any(pmax > m_run)) {
        const float mn = fmaxf(m_run, pmax), alpha = __builtin_amdgcn_exp2f(m_run - mn);
        m_run = mn; l_run *= alpha;
#pragma unroll
        for (int reg = 0; reg < 16; ++reg) { o0[reg] *= alpha; o1[reg] *= alpha; }
      }
      float ps = 0.f;
#pragma unroll
      for (int reg = 0; reg < 16; ++reg) { pt[reg] = __builtin_amdgcn_exp2f(pt[reg] - m_run); ps += pt[reg]; }
      ps = pl32_sum(ps);
      l_run += ps;
      const bf16x8 pb0 = pack8(pt, 0), pb1 = pack8(pt, 1);
      LGKM0();
      o0 = MFMA32(cat4(l00, h00), pb0, o0); o0 = MFMA32(cat4(l10, h10), pb1, o0);
      o1 = MFMA32(cat4(l01, h01), pb0, o1); o1 = MFMA32(cat4(l11, h11), pb1, o1);
    }
    const float inv = 1.f / l_run;
    u16* yo = Y + (size_t)mq * 1024 + 512 + h * 64 + 4 * hi;
#pragma unroll
    for (int g = 0; g < 4; ++g) {
      u32x2 w0 = {pk2(o0[4 * g] * inv, o0[4 * g + 1] * inv), pk2(o0[4 * g + 2] * inv, o0[4 * g + 3] * inv)};
      u32x2 w1 = {pk2(o1[4 * g] * inv, o1[4 * g + 1] * inv), pk2(o1[4 * g + 2] * inv, o1[4 * g + 3] * inv)};
      *(u32x2*)(yo + 8 * g) = w0; *(u32x2*)(yo + 32 + 8 * g) = w1;
    }
  }
}

DI void mla_norm_phase(const Params& p, int gw, int nw) {
  const int lane = threadIdx.x & 63;
  const u16* P2 = (const u16*)(p.ws + OFF_P2);
  u16* CQN = (u16*)(p.ws + OFF_CQN); u16* CKVN = (u16*)(p.ws + OFF_CKVN); u16* KR = (u16*)(p.ws + OFF_KR);
  const float* ct = (const float*)(p.ws + OFF_COS); const float* st = (const float*)(p.ws + OFF_SIN);
  for (int m = gw; m < M_TOT; m += nw) {
    const u16* src = P2 + (size_t)m * 768;
    float q[6], kv[4]; float sq = 0.f, skv = 0.f;
#pragma unroll
    for (int i = 0; i < 6; ++i) { q[i] = bf2f(src[i * 64 + lane]); sq += q[i] * q[i]; }
#pragma unroll
    for (int i = 0; i < 4; ++i) { kv[i] = bf2f(src[384 + i * 64 + lane]); skv += kv[i] * kv[i]; }
#pragma unroll
    for (int o = 32; o > 0; o >>= 1) { sq += __shfl_xor(sq, o); skv += __shfl_xor(skv, o); }
    const float rq = rsqrtf(sq * (1.f / 384.f) + 1e-6f), rkv = rsqrtf(skv * (1.f / 256.f) + 1e-6f);
#pragma unroll
    for (int i = 0; i < 6; ++i) CQN[(size_t)m * 384 + i * 64 + lane] = f2bf(q[i] * rq * p.q_norm[i * 64 + lane]);
#pragma unroll
    for (int i = 0; i < 4; ++i) CKVN[(size_t)m * 256 + i * 64 + lane] = f2bf(kv[i] * rkv * p.kv_norm[i * 64 + lane]);
    if (lane < 16) {
      const int pos = m < M_P ? (m & 8191) : ((m - M_P) & 4095);
      const float t1 = bf2f(src[640 + lane]), t2 = bf2f(src[656 + lane]);
      const float c = ct[pos * 16 + lane], s = st[pos * 16 + lane];
      KR[(size_t)m * 32 + lane] = f2bf(t1 * c - t2 * s); KR[(size_t)m * 32 + 16 + lane] = f2bf(t1 * s + t2 * c);
    }
  }
}

constexpr int KP = 104, VP = 96;
DI void mla_unit(const Params& p, char* lds, int seqbase, int S, int h, int qb) {
  const int tid = VT, lane = tid & 63, wid = tid >> 6, r32 = lane & 31, hi = lane >> 5;
  u16* Kl = (u16*)lds;
  u16* Vl = (u16*)(lds + 2 * 64 * KP * 2);
  const unsigned vbase = (unsigned)(uintptr_t)Vl;
  const int li = lane & 15, tq = li >> 2, tp = li & 3, g1 = (lane >> 4) & 1;
  const unsigned trb = vbase + (4 * hi + tq) * (VP * 2) + (16 * g1 + 4 * tp) * 2;
  const u16* Q = (const u16*)(p.ws + OFF_Q); const u16* KV = (const u16*)(p.ws + OFF_KV); const u16* KR = (const u16*)(p.ws + OFF_KR);
  u16* O = (u16*)(p.ws + OFF_O);
  const float* ct = (const float*)(p.ws + OFF_COS); const float* st = (const float*)(p.ws + OFF_SIN);
  const int pos = qb * 128 + wid * 32 + r32, qrow = seqbase + pos;
  bf16x8 qf[6];
#pragma unroll
  for (int d0 = 0; d0 < 6; ++d0) qf[d0] = *(const bf16x8*)(Q + (size_t)qrow * 1536 + h * 96 + d0 * 16 + 8 * hi);
  const float C = 0.10206207261596577f * LOG2E;
#pragma unroll
  for (int j = 0; j < 8; ++j) {
    const float c = ct[pos * 16 + 8 * hi + j], s = st[pos * 16 + 8 * hi + j];
    const float t1 = bfs2f(qf[4][j]), t2 = bfs2f(qf[5][j]);
    qf[4][j] = (short)f2bf((t1 * c - t2 * s) * C); qf[5][j] = (short)f2bf((t1 * s + t2 * c) * C);
  }
#pragma unroll
  for (int d0 = 0; d0 < 4; ++d0)
#pragma unroll
    for (int j = 0; j < 8; ++j) qf[d0][j] = (short)f2bf(bfs2f(qf[d0][j]) * C);
  const u16* ksrc[3]; int kdst[3];
#pragma unroll
  for (int i = 0; i < 3; ++i) {
    const int idx = tid + 256 * i, row = idx / 12, c = idx - row * 12;
    ksrc[i] = c < 8 ? KV + (size_t)(seqbase + row) * 2048 + h * 128 + c * 8 : KR + (size_t)(seqbase + row) * 32 + (c - 8) * 8;
    kdst[i] = row * KP + c * 8;
  }
  const int kstride[3] = {0, 0, 0}; (void)kstride;
  const int vrow = tid >> 3, vc = tid & 7;
  const u16* vsrc = KV + (size_t)(seqbase + vrow) * 2048 + h * 128 + 64 + vc * 8;
  const int vdst = vrow * VP + vc * 8;
  size_t kadv[3];
#pragma unroll
  for (int i = 0; i < 3; ++i) { const int idx = tid + 256 * i, row = idx / 12, c = idx - row * 12; (void)row; kadv[i] = c < 8 ? (size_t)64 * 2048 : (size_t)64 * 32; }
  float l_run = 0.f; f32x16 o0 = {}, o1 = {}, negm = {};
  const int nkt = S >> 6;
  u32x4 rk[3], rv[2];
#pragma unroll
  for (int i = 0; i < 3; ++i) rk[i] = *(const u32x4*)(ksrc[i]);
  rv[0] = *(const u32x4*)(vsrc); rv[1] = *(const u32x4*)(vsrc + (size_t)32 * 2048);
#pragma unroll
  for (int i = 0; i < 3; ++i) *(u32x4*)(Kl + kdst[i]) = rk[i];
  *(u32x4*)(Vl + vdst) = rv[0]; *(u32x4*)(Vl + vdst + 32 * VP) = rv[1];
  __syncthreads();
#pragma unroll 1
  for (int kt = 0; kt < nkt; ++kt) {
    const int cur = kt & 1;
    if (kt + 1 < nkt) {
#pragma unroll
      for (int i = 0; i < 3; ++i) rk[i] = *(const u32x4*)(ksrc[i] + (size_t)(kt + 1) * kadv[i]);
      rv[0] = *(const u32x4*)(vsrc + (size_t)(kt + 1) * 64 * 2048); rv[1] = *(const u32x4*)(vsrc + (size_t)(kt + 1) * 64 * 2048 + (size_t)32 * 2048);
    }
    const u16* kl = Kl + cur * 64 * KP + r32 * KP + 8 * hi;
    f32x16 p0, p1;
    { const bf16x8 k0 = *(const bf16x8*)(kl), k1 = *(const bf16x8*)(kl + 32 * KP);
      p0 = MFMA32(k0, qf[0], negm); p1 = MFMA32(k1, qf[0], negm); }
#pragma unroll
    for (int d0 = 1; d0 < 6; ++d0) {
      const bf16x8 k0 = *(const bf16x8*)(kl + d0 * 16), k1 = *(const bf16x8*)(kl + 32 * KP + d0 * 16);
      p0 = MFMA32(k0, qf[d0], p0); p1 = MFMA32(k1, qf[d0], p1);
    }
    const unsigned tb = trb + cur * (64 * VP * 2), tc = tb + 64;
    const s16x4 a0 = tr_read(tb), b0 = tr_read(tb + 8 * VP * 2), a1 = tr_read(tb + 16 * VP * 2), b1 = tr_read(tb + 24 * VP * 2);
    const s16x4 a2 = tr_read(tb + 32 * VP * 2), b2 = tr_read(tb + 40 * VP * 2), a3 = tr_read(tb + 48 * VP * 2), b3 = tr_read(tb + 56 * VP * 2);
    const s16x4 c0 = tr_read(tc), d0_ = tr_read(tc + 8 * VP * 2), c1 = tr_read(tc + 16 * VP * 2), d1 = tr_read(tc + 24 * VP * 2);
    const s16x4 c2 = tr_read(tc + 32 * VP * 2), d2 = tr_read(tc + 40 * VP * 2), c3 = tr_read(tc + 48 * VP * 2), d3 = tr_read(tc + 56 * VP * 2);
    float pmax = fmaxf(p0[0], p1[0]);
#pragma unroll
    for (int r = 1; r < 16; ++r) pmax = fmaxf(pmax, fmaxf(p0[r], p1[r]));
    pmax = pl32_max(pmax);
    if (kt == 0 || __any(pmax > 8.f)) {
      const float delta = kt == 0 ? pmax : fmaxf(pmax, 0.f);
      const float alpha = kt == 0 ? 1.f : __builtin_amdgcn_exp2f(-delta);
#pragma unroll
      for (int r = 0; r < 16; ++r) { negm[r] -= delta; p0[r] -= delta; p1[r] -= delta; o0[r] *= alpha; o1[r] *= alpha; }
      l_run *= alpha;
    }
    float ps = 0.f;
#pragma unroll
    for (int r = 0; r < 16; ++r) { p0[r] = __builtin_amdgcn_exp2f(p0[r]); p1[r] = __builtin_amdgcn_exp2f(p1[r]); ps += p0[r] + p1[r]; }
    ps = pl32_sum(ps);
    l_run += ps;
    const bf16x8 pb0 = pack8(p0, 0), pb1 = pack8(p0, 1), pb2 = pack8(p1, 0), pb3 = pack8(p1, 1);
    LGKM0();
    o0 = MFMA32(cat4(a0, b0), pb0, o0); o1 = MFMA32(cat4(c0, d0_), pb0, o1);
    o0 = MFMA32(cat4(a1, b1), pb1, o0); o1 = MFMA32(cat4(c1, d1), pb1, o1);
    o0 = MFMA32(cat4(a2, b2), pb2, o0); o1 = MFMA32(cat4(c2, d2), pb2, o1);
    o0 = MFMA32(cat4(a3, b3), pb3, o0); o1 = MFMA32(cat4(c3, d3), pb3, o1);
    if (kt + 1 < nkt) {
      u16* kd = Kl + (cur ^ 1) * 64 * KP; u16* vd = Vl + (cur ^ 1) * 64 * VP;
#pragma unroll
      for (int i = 0; i < 3; ++i) *(u32x4*)(kd + kdst[i]) = rk[i];
      *(u32x4*)(vd + vdst) = rv[0]; *(u32x4*)(vd + vdst + 32 * VP) = rv[1];
    }
    __syncthreads();
  }
  const float inv = 1.f / l_run;
  u16* oo = O + (size_t)qrow * 1024 + h * 64 + 4 * hi;
#pragma unroll
  for (int g = 0; g < 4; ++g) {
    u32x2 w0 = {pk2(o0[4 * g] * inv, o0[4 * g + 1] * inv), pk2(o0[4 * g + 2] * inv, o0[4 * g + 3] * inv)};
    u32x2 w1 = {pk2(o1[4 * g] * inv, o1[4 * g + 1] * inv), pk2(o1[4 * g + 2] * inv, o1[4 * g + 3] * inv)};
    *(u32x2*)(oo + 8 * g) = w0; *(u32x2*)(oo + 32 + 8 * g) = w1;
  }
}

DI void mla_attn_phase(const Params& p, char* lds, int xcd, int j, int nper) {
  for (int lu0 = j; lu0 - j < 8 * 64; lu0 += nper) { const int lu = lu0 < 8 * 64 ? lu0 : 8 * 64 - 1; const int bh = (lu >> 6) * 8 + xcd, qb = lu & 63; mla_unit(p, lds, (bh >> 4) * 8192, 8192, bh & 15, qb); }
  for (int lu0 = j; lu0 - j < 8 * 32; lu0 += nper) { const int lu = lu0 < 8 * 32 ? lu0 : 8 * 32 - 1; const int bh = (lu >> 5) * 8 + xcd, qb = lu & 31; mla_unit(p, lds, M_P + (bh >> 4) * 4096, 4096, bh & 15, qb); }
}

#define XB_TMO      128
#define XB_XCNT(j)  (256  + 64 * (j))
#define XB_XSUB(j)  (1280 + 64 * (j))
#define XB_XGEN(j)  (2304 + 64 * (j))
#define XB_TOP      3328
#define XB_TOPGEN   3392
#define XCD_BAR_WORDS 3456
#define XB_SPIN_CAP (1u << 20)
#define LAS __attribute__((address_space(3)))
DI unsigned xb_ld(unsigned* p) { return __hip_atomic_load(p, __ATOMIC_RELAXED, __HIP_MEMORY_SCOPE_AGENT); }
DI unsigned xb_add(unsigned* p, unsigned v) { return __hip_atomic_fetch_add(p, v, __ATOMIC_RELAXED, __HIP_MEMORY_SCOPE_AGENT); }
DI unsigned xb_xcc_id() { return (unsigned)__builtin_amdgcn_s_getreg((3 << 11) | 20) & 0xFu; }
#define XB_SPIN(cond, bar) do { unsigned _sp = 0; while (cond) { __builtin_amdgcn_s_sleep(1); \
    if ((++_sp & 255u) == 0u) { if (xb_ld(&(bar)[XB_TMO])) break; if (_sp > XB_SPIN_CAP) { atomicAdd(&(bar)[XB_TMO], 1u); break; } } } } while (0)
struct XcdBarrier { unsigned* bar; unsigned x; volatile LAS unsigned* st; };
DI XcdBarrier xcd_barrier_post(unsigned* bar, volatile LAS unsigned* st) {
  XcdBarrier b; b.bar = bar; b.x = xb_xcc_id(); b.st = st;
  if (threadIdx.x == 0) (void)xb_add(&bar[XB_XCNT(b.x)], 1u);
  return b;
}
DI void xcd_barrier_complete(unsigned* bar, unsigned x, unsigned& nloc, unsigned& nx) {
  const unsigned G = gridDim.x * gridDim.y * gridDim.z;
  unsigned sum, cnt, mine, sp = 0u;
  for (;;) {
    sum = 0u; cnt = 0u; mine = 0u;
#pragma unroll
    for (unsigned j = 0; j < 16; ++j) { const unsigned c = xb_ld(&bar[XB_XCNT(j)]); sum += c; cnt += (c > 0u) ? 1u : 0u; mine = (j == x) ? c : mine; }
    if (sum == G) break;
    __builtin_amdgcn_s_sleep(1);
    if ((++sp & 255u) == 0u) { if (xb_ld(&bar[XB_TMO])) break; if (sp > XB_SPIN_CAP) { atomicAdd(&bar[XB_TMO], 1u); break; } }
  }
  nloc = mine > 0u ? mine : 1u; nx = cnt > 0u ? cnt : 1u;
}
DI void xcd_barrier(const XcdBarrier& b) {
  asm volatile("s_waitcnt vmcnt(0)" ::: "memory");
  __syncthreads();
  if (threadIdx.x == 0) {
    unsigned* bar = b.bar;
    __builtin_amdgcn_s_waitcnt(0);
    unsigned nloc = b.st[0], nx = b.st[1];
    if (nloc == 0u) { xcd_barrier_complete(bar, b.x, nloc, nx); b.st[0] = nloc; b.st[1] = nx; }
    const unsigned old = xb_add(&bar[XB_XSUB(b.x)], 1u);
    const unsigned gen = old / nloc;
    if (old + 1u == (gen + 1u) * nloc) {
      __builtin_amdgcn_fence(__ATOMIC_RELEASE, "agent");
      asm volatile("s_waitcnt vmcnt(0)" ::: "memory");
      const unsigned og = xb_add(&bar[XB_TOP], 1u);
      const unsigned tg = og / nx;
      if (og + 1u == (tg + 1u) * nx) xb_add(&bar[XB_TOPGEN], 1u);
      else XB_SPIN(xb_ld(&bar[XB_TOPGEN]) == tg, bar);
      __builtin_amdgcn_fence(__ATOMIC_ACQUIRE, "agent");
      xb_add(&bar[XB_XGEN(b.x)], 1u);
      asm volatile("s_waitcnt vmcnt(0)" ::: "memory");
    } else {
      XB_SPIN(xb_ld(&bar[XB_XGEN(b.x)]) == gen, bar);
      __builtin_amdgcn_fence(__ATOMIC_ACQUIRE, "agent");
      asm volatile("s_waitcnt vmcnt(0)" ::: "memory");
    }
  }
  __syncthreads();
}

constexpr int N_PHASES = 19;
constexpr int HALF_LDS = 74752;
constexpr int LDS_BYTES = 2 * HALF_LDS;
__global__ void __launch_bounds__(512, 2) mega(Params p, int ph_lo, int ph_hi) {
  __shared__ __attribute__((aligned(16))) char lds_all[LDS_BYTES];
  const int rbid = blockIdx.x, rnb = gridDim.x;
  const int half = __builtin_amdgcn_readfirstlane((int)(threadIdx.x >> 8));
  const int bid = rbid * 2 + half, nb = rnb * 2;
  char* lds = lds_all + half * HALF_LDS;
  const int gw = bid * 4 + __builtin_amdgcn_readfirstlane(VT >> 6), nw = nb * 4;
  char* ws = p.ws;
  float* out1 = p.out + (size_t)M_P * DM;
  __shared__ uint4 xb_words;
  if (threadIdx.x == 0) xb_words = make_uint4(0u, 0u, 0u, 0u);
  __syncthreads();
  XcdBarrier xb; xb.bar = (unsigned*)(ws + OFF_BAR); xb.x = 0; xb.st = (volatile LAS unsigned*)&xb_words;
  if (ph_hi - ph_lo > 1) xb = xcd_barrier_post((unsigned*)(ws + OFF_BAR), (volatile LAS unsigned*)&xb_words);
  if (ph_lo < 0) cg::this_grid().sync();
#ifndef DUP_MASK
#define DUP_MASK 0
#endif
#define PHASE(k, ...) do { if (ph_lo <= (k) && (k) < ph_hi) { __VA_ARGS__ if ((DUP_MASK >> (k)) & 1) { xcd_barrier(xb); __VA_ARGS__ } } if (ph_lo <= (k) && (k) + 1 < ph_hi) xcd_barrier(xb); } while (0)
  PHASE(0, prep_phase(p, lds, bid, nb););
  PHASE(1, gemm_phase<EPI_BF16>((const u16*)(ws + OFF_H), 1024, (const u16*)(ws + WT_ABIN), 1024, 2560, (u16*)(ws + OFF_PROJ), 2560, nullptr, nullptr, nullptr, lds_all, rbid, rnb););
  PHASE(2, rg_phase<false>(p, lds, bid, nb); __syncthreads(); dilated_phase(p, lds, gw, nw););
  PHASE(3, rg_carry_phase(p, bid, nb););
  PHASE(4, rg_phase<true>(p, lds, bid, nb););
  PHASE(5, gemm_phase<EPI_RESID>((const u16*)(ws + OFF_Y), 1024, (const u16*)(ws + WT_ABOUT), 1024, 1024, nullptr, 0, p.xin0, p.xin1, p.out, lds_all, rbid, rnb););
  PHASE(6, rmsnorm_phase(p.out, out1, p.norm_ffn, (u16*)(ws + OFF_H), nullptr, gw, nw););
  PHASE(7, gemm_phase<EPI_SWIGLU>((const u16*)(ws + OFF_H), 1024, (const u16*)(ws + WT_GU0), 1024, 5632, (u16*)(ws + OFF_ACT), FH, nullptr, nullptr, nullptr, lds_all, rbid, rnb););
  PHASE(8, gemm_phase<EPI_RESID>((const u16*)(ws + OFF_ACT), FH, (const u16*)(ws + WT_DOWN0), FH, 1024, nullptr, 0, p.out, out1, p.out, lds_all, rbid, rnb););
  PHASE(9, rmsnorm_phase(p.out, out1, p.norm_mix + 1024, (u16*)(ws + OFF_H), nullptr, gw, nw););
  PHASE(10, gemm_phase<EPI_BF16>((const u16*)(ws + OFF_H), 1024, (const u16*)(ws + WT_MLAIN), 1024, 768, (u16*)(ws + OFF_P2), 768, nullptr, nullptr, nullptr, lds_all, rbid, rnb););
  PHASE(11, mla_norm_phase(p, gw, nw););
  PHASE(12, gemm_phase<EPI_BF16>((const u16*)(ws + OFF_CQN), 384, (const u16*)(ws + WT_QB), 384, 1536, (u16*)(ws + OFF_Q), 1536, nullptr, nullptr, nullptr, lds_all, rbid, rnb); gemm_phase<EPI_BF16>((const u16*)(ws + OFF_CKVN), 256, (const u16*)(ws + WT_KVB), 256, 2048, (u16*)(ws + OFF_KV), 2048, nullptr, nullptr, nullptr, lds_all, rbid, rnb););
  PHASE(13, mla_attn_phase(p, lds, rbid & 7, (rbid >> 3) * 2 + half, (rnb >> 3) * 2););
  PHASE(14, gemm_phase<EPI_RESID>((const u16*)(ws + OFF_O), 1024, (const u16*)(ws + WT_MLAOUT), 1024, 1024, nullptr, 0, p.out, out1, p.out, lds_all, rbid, rnb););
  PHASE(15, rmsnorm_phase(p.out, out1, p.norm_ffn + 1024, (u16*)(ws + OFF_H), nullptr, gw, nw););
  PHASE(16, gemm_phase<EPI_SWIGLU>((const u16*)(ws + OFF_H), 1024, (const u16*)(ws + WT_GU1), 1024, 5632, (u16*)(ws + OFF_ACT), FH, nullptr, nullptr, nullptr, lds_all, rbid, rnb););
  PHASE(17, gemm_phase<EPI_RESID>((const u16*)(ws + OFF_ACT), FH, (const u16*)(ws + WT_DOWN1), FH, 1024, nullptr, 0, p.out, out1, p.out, lds_all, rbid, rnb););
  PHASE(18, rmsnorm_phase(p.out, out1, p.norm_final, nullptr, p.out, gw, nw););
#undef PHASE
}

extern "C" void kernel_launch(void* const* d_in, const int* in_sizes, int n_in, void* d_out, int out_size, void* d_ws, size_t ws_size, hipStream_t stream) {
  static int grid_blocks = 0;
  if (!grid_blocks) {
    int dev = 0, cus = 0, per_cu = 0;
    hipGetDevice(&dev);
    hipDeviceGetAttribute(&cus, hipDeviceAttributeMultiprocessorCount, dev);
    hipOccupancyMaxActiveBlocksPerMultiprocessor(&per_cu, mega, 512, 0);
    if (per_cu > 1) per_cu = 1;
    if (per_cu < 1) per_cu = 1;
    grid_blocks = cus * per_cu;
  }
  if (n_in != 23 || ws_size < WS_NEED) { fprintf(stderr, "kernel_launch: bad inputs n_in=%d ws=%zu\n", n_in, ws_size); return; }
  Params p{};
  p.xin0 = (const float*)d_in[0]; p.xin1 = (const float*)d_in[1];
  p.norm_mix = (const float*)d_in[2]; p.norm_ffn = (const float*)d_in[3]; p.norm_final = (const float*)d_in[4];
  p.ab_w_in = (const float*)d_in[5]; p.conv_w = (const float*)d_in[6]; p.conv_b = (const float*)d_in[7];
  p.w_a = (const float*)d_in[8]; p.b_a = (const float*)d_in[9]; p.w_i = (const float*)d_in[10]; p.b_i = (const float*)d_in[11];
  p.lam = (const float*)d_in[12]; p.ab_w_out = (const float*)d_in[13];
  p.mla_w_in = (const float*)d_in[14]; p.q_norm = (const float*)d_in[15]; p.w_qb = (const float*)d_in[16]; p.kv_norm = (const float*)d_in[17];
  p.w_kvb = (const float*)d_in[18]; p.mla_w_out = (const float*)d_in[19];
  p.w_gate = (const float*)d_in[20]; p.w_up = (const float*)d_in[21]; p.w_down = (const float*)d_in[22];
  p.out = (float*)d_out; p.ws = (char*)d_ws;
#if SINGLE_LAUNCH
  hipMemsetAsync((char*)d_ws + OFF_BAR, 0, XCD_BAR_WORDS * 4, stream);
  int lo = 0, hi = N_PHASES;
  void* args[] = {&p, &lo, &hi};
  hipError_t e = hipLaunchCooperativeKernel((void*)mega, dim3(grid_blocks), dim3(512), args, 0, stream);
  if (e != hipSuccess) fprintf(stderr, "cooperative launch failed: %s (grid %d)\n", hipGetErrorString(e), grid_blocks);
#else
  for (int ph = 0; ph < N_PHASES; ++ph) hipLaunchKernelGGL(mega, dim3(grid_blocks), dim3(512), 0, stream, p, ph, ph + 1);
#endif
}
```

```cpp
#include <hip/hip_runtime.h>
#include <hip/hip_cooperative_groups.h>
#include <cstdint>
#include <cstdio>
namespace cg = cooperative_groups;

#ifndef SINGLE_LAUNCH
#define SINGLE_LAUNCH 1
#endif

typedef unsigned short u16;
typedef short bf16x8 __attribute__((ext_vector_type(8)));
typedef short s16x4 __attribute__((ext_vector_type(4)));
typedef float f32x16 __attribute__((ext_vector_type(16)));
typedef float f32x4 __attribute__((ext_vector_type(4)));
typedef float f32x2 __attribute__((ext_vector_type(2)));
typedef unsigned u32x4 __attribute__((ext_vector_type(4)));
typedef unsigned u32x2 __attribute__((ext_vector_type(2)));
typedef __bf16 bf2_t __attribute__((ext_vector_type(2)));
#define DI __device__ __forceinline__
#define VT ((int)(threadIdx.x & 255))
#define MFMA32(a, b, c) __builtin_amdgcn_mfma_f32_32x32x16_bf16((a), (b), (c), 0, 0, 0)

constexpr int M_TOT = 49152, M_P = 32768, DM = 1024, FH = 2816;
constexpr float LOG2E = 1.4426950408889634f;
constexpr size_t MiB = 1ull << 20;
constexpr size_t WT_ABIN = 0;
constexpr size_t WT_ABOUT = WT_ABIN + 2560ull * 1024 * 2;
constexpr size_t WT_GU0 = WT_ABOUT + 1024ull * 1024 * 2;
constexpr size_t WT_DOWN0 = WT_GU0 + 5632ull * 1024 * 2;
constexpr size_t WT_MLAIN = WT_DOWN0 + 1024ull * 2816 * 2;
constexpr size_t WT_QB = WT_MLAIN + 768ull * 1024 * 2;
constexpr size_t WT_KVB = WT_QB + 1536ull * 384 * 2;
constexpr size_t WT_MLAOUT = WT_KVB + 2048ull * 256 * 2;
constexpr size_t WT_GU1 = WT_MLAOUT + 1024ull * 1024 * 2;
constexpr size_t WT_DOWN1 = WT_GU1 + 5632ull * 1024 * 2;
constexpr size_t WT_GATES = WT_DOWN1 + 1024ull * 2816 * 2;
constexpr size_t WT_END = WT_GATES + 32ull * 4096 * 2;
static_assert(WT_END <= 46 * MiB, "weights region");
constexpr size_t OFF_SUM = 46 * MiB;
constexpr size_t OFF_KR = 46 * MiB;
constexpr size_t OFF_COS = 52 * MiB;
constexpr size_t OFF_SIN = 52 * MiB + 512 * 1024;
constexpr size_t OFF_H = 54 * MiB;
constexpr size_t OFF_CQN = 54 * MiB;
constexpr size_t OFF_CKVN = 90 * MiB;
constexpr size_t OFF_O = 54 * MiB;
constexpr size_t OFF_PROJ = 150 * MiB;
constexpr size_t OFF_ACT = 150 * MiB;
constexpr size_t OFF_P2 = 150 * MiB;
constexpr size_t OFF_Q = 150 * MiB;
constexpr size_t OFF_KV = 294 * MiB;
constexpr size_t OFF_Y = 390 * MiB;
constexpr size_t OFF_CARRY = 486 * MiB;
constexpr size_t OFF_BAR = 489 * MiB;
constexpr size_t WS_NEED = 490 * MiB;

struct Params {
  const float* xin0; const float* xin1;
  const float* norm_mix; const float* norm_ffn; const float* norm_final;
  const float* ab_w_in; const float* conv_w; const float* conv_b;
  const float* w_a; const float* b_a; const float* w_i; const float* b_i; const float* lam; const float* ab_w_out;
  const float* mla_w_in; const float* q_norm; const float* w_qb; const float* kv_norm; const float* w_kvb; const float* mla_w_out;
  const float* w_gate; const float* w_up; const float* w_down;
  float* out; char* ws;
};

DI float bf2f(u16 v) { return __uint_as_float(((unsigned)v) << 16); }
DI float bfs2f(short v) { return __uint_as_float(((unsigned)(u16)v) << 16); }
DI unsigned pk2(float lo, float hi) { f32x2 v = {lo, hi}; bf2_t r = __builtin_convertvector(v, bf2_t); return __builtin_bit_cast(unsigned, r); }
DI u16 f2bf(float a) { return (u16)(pk2(a, 0.f) & 0xffffu); }
DI int crow(int r, int hi) { return (r & 3) + 8 * (r >> 2) + 4 * hi; }
DI float sigmoidf_(float x) { return 1.f / (1.f + __expf(-x)); }
DI float pl32_max(float v) { auto rr = __builtin_amdgcn_permlane32_swap(__float_as_uint(v), __float_as_uint(v), false, false); return fmaxf(__uint_as_float(rr[0]), __uint_as_float(rr[1])); }
DI float pl32_sum(float v) { auto rr = __builtin_amdgcn_permlane32_swap(__float_as_uint(v), __float_as_uint(v), false, false); return __uint_as_float(rr[0]) + __uint_as_float(rr[1]); }
DI s16x4 tr_read(unsigned addr) { s16x4 r; asm volatile("ds_read_b64_tr_b16 %0, %1" : "=&v"(r) : "v"(addr) : "memory"); return r; }
#define LGKM0() do { asm volatile("s_waitcnt lgkmcnt(0)" ::: "memory"); __builtin_amdgcn_sched_barrier(0); } while (0)
DI bf16x8 cat4(s16x4 l, s16x4 h) { return (bf16x8){l[0], l[1], l[2], l[3], h[0], h[1], h[2], h[3]}; }
DI bf16x8 pack8(const f32x16& x, int s) {
  u32x4 w = {pk2(x[8 * s + 0], x[8 * s + 1]), pk2(x[8 * s + 2], x[8 * s + 3]), pk2(x[8 * s + 4], x[8 * s + 5]), pk2(x[8 * s + 6], x[8 * s + 7])};
  return __builtin_bit_cast(bf16x8, w);
}
DI void row_info(int m, int& seq_lo, int& S) { if (m < M_P) { seq_lo = m & ~8191; S = 8192; } else { seq_lo = M_P + ((m - M_P) & ~4095); S = 4096; } }

DI void tr_job(const float* __restrict__ src, int K, int N, u16* __restrict__ dst, int mode, float* tile, int bid, int nb, int& rot) {
  const int tk = K >> 6, tn = (N + 63) >> 6, nt = tk * tn;
  const int tx = VT & 63, ty = VT >> 6;
  const int t0 = (bid + nb - rot) % nb, nit = (nt + nb - 1) / nb;
  for (int i = 0; i < nit; ++i) {
    const int t = t0 + i * nb; const bool act = t < nt;
    const int k0 = (t / tn) << 6, n0 = (t % tn) << 6;
    __syncthreads();
    if (act) {
#pragma unroll 4
      for (int r = 0; r < 16; ++r) { const int kk = ty + 4 * r, n = n0 + tx; tile[kk * 65 + tx] = n < N ? src[(size_t)(k0 + kk) * N + n] : 0.f; }
    }
    __syncthreads();
    if (act) {
#pragma unroll 4
      for (int r = 0; r < 16; ++r) {
        const int nn = ty + 4 * r, n = n0 + nn;
        if (n < N) { const int row = mode == 0 ? n : ((n >> 5) * 64 + (n & 31) + (mode == 2 ? 32 : 0)); dst[(size_t)row * K + k0 + tx] = f2bf(tile[tx * 65 + nn]); }
      }
    }
  }
  rot = (rot + nt) % nb;
}

DI void rmsnorm_phase(const float* __restrict__ s0, const float* __restrict__ s1, const float* __restrict__ g, u16* outb, float* outf, int gw, int nw) {
  const int lane = threadIdx.x & 63;
  for (int m = gw; m < M_TOT; m += nw) {
    const float* src = m < M_P ? s0 + (size_t)m * DM : s1 + (size_t)(m - M_P) * DM;
    f32x4 v[4];
#pragma unroll
    for (int i = 0; i < 4; ++i) v[i] = *(const f32x4*)(src + i * 256 + lane * 4);
    float ss = 0.f;
#pragma unroll
    for (int i = 0; i < 4; ++i) ss += v[i][0] * v[i][0] + v[i][1] * v[i][1] + v[i][2] * v[i][2] + v[i][3] * v[i][3];
#pragma unroll
    for (int o = 32; o > 0; o >>= 1) ss += __shfl_xor(ss, o);
    const float rs = rsqrtf(ss * (1.f / 1024.f) + 1e-6f);
#pragma unroll
    for (int i = 0; i < 4; ++i) {
      const f32x4 gg = *(const f32x4*)(g + i * 256 + lane * 4);
      const f32x4 y = v[i] * rs * gg;
      if (outb) { u32x2 w = {pk2(y[0], y[1]), pk2(y[2], y[3])}; *(u32x2*)(outb + (size_t)m * DM + i * 256 + lane * 4) = w; }
      else *(f32x4*)(outf + (size_t)m * DM + i * 256 + lane * 4) = y;
    }
  }
}

DI void prep_phase(const Params& p, char* lds, int bid, int nb) {
  float* tile = (float*)lds;
  char* ws = p.ws;
  int rot = 0;
  tr_job(p.ab_w_in, 1024, 2560, (u16*)(ws + WT_ABIN), 0, tile, bid, nb, rot);
  tr_job(p.ab_w_out, 1024, 1024, (u16*)(ws + WT_ABOUT), 0, tile, bid, nb, rot);
  tr_job(p.w_gate, 1024, FH, (u16*)(ws + WT_GU0), 1, tile, bid, nb, rot);
  tr_job(p.w_up, 1024, FH, (u16*)(ws + WT_GU0), 2, tile, bid, nb, rot);
  tr_job(p.w_gate + (size_t)1024 * FH, 1024, FH, (u16*)(ws + WT_GU1), 1, tile, bid, nb, rot);
  tr_job(p.w_up + (size_t)1024 * FH, 1024, FH, (u16*)(ws + WT_GU1), 2, tile, bid, nb, rot);
  tr_job(p.w_down, FH, 1024, (u16*)(ws + WT_DOWN0), 0, tile, bid, nb, rot);
  tr_job(p.w_down + (size_t)FH * 1024, FH, 1024, (u16*)(ws + WT_DOWN1), 0, tile, bid, nb, rot);
  tr_job(p.mla_w_in, 1024, 672, (u16*)(ws + WT_MLAIN), 0, tile, bid, nb, rot);
  tr_job(p.w_qb, 384, 1536, (u16*)(ws + WT_QB), 0, tile, bid, nb, rot);
  tr_job(p.w_kvb, 256, 2048, (u16*)(ws + WT_KVB), 0, tile, bid, nb, rot);
  tr_job(p.mla_w_out, 1024, 1024, (u16*)(ws + WT_MLAOUT), 0, tile, bid, nb, rot);
  for (int dg = 0; dg < 32; ++dg) {
    const int cb = dg & 7, gate = (dg >> 3) & 1, dir = dg >> 4;
    const float* src = (gate == 0 ? p.w_a : p.w_i) + (size_t)(dir * 8 + cb) * 4096;
    tr_job(src, 64, 64, (u16*)(ws + WT_GATES) + (size_t)dg * 4096, 0, tile, bid, nb, rot);
  }
  const int gtid = bid * 256 + VT, gn = nb * 256;
  { u16* d = (u16*)(ws + WT_MLAIN) + (size_t)672 * 1024; for (int i = gtid; i < 96 * 1024; i += gn) d[i] = 0; }
  { float* ct = (float*)(ws + OFF_COS); float* st = (float*)(ws + OFF_SIN);
    for (int i = gtid; i < 8192 * 16; i += gn) {
      const int pos = i >> 4, k = i & 15;
      const float inv_freq = 1.0f / powf(10000.0f, (float)(2 * k) / 32.0f);
      const float ang = (float)pos * inv_freq;
      double f = (double)ang * 0.15915494309189535; f -= rint(f);
      ct[i] = __builtin_amdgcn_cosf((float)f); st[i] = __builtin_amdgcn_sinf((float)f);
    } }
  rmsnorm_phase(p.xin0, p.xin1, p.norm_mix, (u16*)(ws + OFF_H), nullptr, bid * 4 + (VT >> 6), nb * 4);
}

constexpr int GP = 72;
enum { EPI_BF16 = 0, EPI_RESID = 1, EPI_SWIGLU = 2 };
template <int EPI>
DI void gemm_phase(const u16* __restrict__ A, int lda, const u16* __restrict__ Bt, int K, int N, u16* outb, int ldo,
                   const float* r0, const float* r1, float* outf, char* lds, int bid, int nb) {
  const int tid = threadIdx.x, lane = tid & 63, wid = tid >> 6, wr = wid >> 2, wc = wid & 3, r32 = lane & 31, hi = lane >> 5;
  u16* As = (u16*)lds; u16* Bs = As + 2 * 256 * GP;
  const int nN = N >> 8, nM = M_TOT >> 8, nT = nM * nN, nk = K >> 6;
  const int lrow = tid >> 3, lch = tid & 7;
  const bool swz = (nb == 256);
  const int GN = (nN & 1) == 0 ? 2 : 1, GM = 32 / GN, nSN = nN / GN, nST = (nM / GM) * nSN;
  const int xcd = bid & 7, jb = bid >> 3;
  const int nIter = swz ? (nST - xcd + 7) / 8 : (nT - bid + nb - 1) / nb;
  for (int it = 0; it < nIter; ++it) {
    int tm, tn;
    if (swz) { const int st = xcd + 8 * it, sm = st / nSN, sn = st - sm * nSN; tm = sm * GM + jb / GN; tn = sn * GN + (jb % GN); }
    else { const int t = bid + it * nb; tm = t / nN; tn = t - tm * nN; }
    const u16* Ag = A + (size_t)(tm * 256 + lrow) * lda + lch * 8;
    const u16* Bg = Bt + (size_t)(tn * 256 + lrow) * K + lch * 8;
    f32x16 acc[4][2];
#pragma unroll
    for (int i = 0; i < 4; ++i) { acc[i][0] = f32x16{}; acc[i][1] = f32x16{}; }
    u32x4 ra0[4], rb0[4], ra1[4], rb1[4];
#define SB() __builtin_amdgcn_sched_barrier(0)
#define G_LOAD(RA, RB, KT) do { _Pragma("unroll") for (int i = 0; i < 4; ++i) { RA[i] = *(const u32x4*)(Ag + (size_t)i * 64 * lda + (KT) * 64); RB[i] = *(const u32x4*)(Bg + (size_t)i * 64 * K + (KT) * 64); } } while (0)
#define G_STORE_A(RA, BUF) do { u16* ad = As + (BUF) * 256 * GP; _Pragma("unroll") for (int i = 0; i < 4; ++i) *(u32x4*)(ad + (lrow + 64 * i) * GP + lch * 8) = RA[i]; } while (0)
#define G_STORE_B(RB, BUF) do { u16* bd = Bs + (BUF) * 256 * GP; _Pragma("unroll") for (int i = 0; i < 4; ++i) *(u32x4*)(bd + (lrow + 64 * i) * GP + lch * 8) = RB[i]; } while (0)
#define G_MMA(BUF, KS) do { const u16* as = As + (BUF) * 256 * GP + (wr * 128 + r32) * GP + hi * 8 + (KS) * 16; const u16* bs = Bs + (BUF) * 256 * GP + (wc * 64 + r32) * GP + hi * 8 + (KS) * 16; \
        const bf16x8 b0 = *(const bf16x8*)(bs), b1 = *(const bf16x8*)(bs + 32 * GP); \
        bf16x8 a_[4]; _Pragma("unroll") for (int i = 0; i < 4; ++i) a_[i] = *(const bf16x8*)(as + i * 32 * GP); \
        __builtin_amdgcn_s_setprio(1); \
        _Pragma("unroll") for (int i = 0; i < 4; ++i) { acc[i][0] = MFMA32(a_[i], b0, acc[i][0]); acc[i][1] = MFMA32(a_[i], b1, acc[i][1]); } \
        __builtin_amdgcn_s_setprio(0); } while (0)
#define G_ITER(BUF, RAC, RBC, RAN, RBN, KT) do { \
      if ((KT) + 2 < nk) G_LOAD(RAC, RBC, (KT) + 2); \
      SB(); G_MMA(BUF, 0); SB(); \
      if ((KT) + 1 < nk) G_STORE_A(RAN, (BUF) ^ 1); \
      SB(); G_MMA(BUF, 1); SB(); \
      if ((KT) + 1 < nk) G_STORE_B(RBN, (BUF) ^ 1); \
      SB(); G_MMA(BUF, 2); G_MMA(BUF, 3); SB(); \
      __syncthreads(); } while (0)
    G_LOAD(ra0, rb0, 0);
    G_LOAD(ra1, rb1, 1);
    G_STORE_A(ra0, 0); G_STORE_B(rb0, 0);
    __syncthreads();
    for (int kt = 0; kt < nk; kt += 2) {
      G_ITER(0, ra0, rb0, ra1, rb1, kt);
      G_ITER(1, ra1, rb1, ra0, rb0, kt + 1);
    }
#undef G_LOAD
#undef G_STORE_A
#undef G_STORE_B
#undef G_MMA
#undef G_ITER
    const int mrow = tm * 256 + wr * 128;
    if constexpr (EPI == EPI_BF16) {
      const int col = tn * 256 + wc * 64 + r32;
#pragma unroll
      for (int i = 0; i < 4; ++i)
#pragma unroll
        for (int reg = 0; reg < 16; ++reg) {
          u16* o0 = outb + (size_t)(mrow + i * 32 + crow(reg, hi)) * ldo + col;
          o0[0] = f2bf(acc[i][0][reg]); o0[32] = f2bf(acc[i][1][reg]);
        }
    } else if constexpr (EPI == EPI_RESID) {
      const int col = tn * 256 + wc * 64 + r32;
      const float* rb_ = (tm * 256 < M_P) ? r0 : (r1 - (size_t)M_P * DM);
#pragma unroll
      for (int i = 0; i < 4; ++i)
#pragma unroll
        for (int reg = 0; reg < 16; ++reg) {
          const size_t i0 = (size_t)(mrow + i * 32 + crow(reg, hi)) * DM + col;
          const float x0 = rb_[i0], x1 = rb_[i0 + 32];
          outf[i0] = x0 + acc[i][0][reg]; outf[i0 + 32] = x1 + acc[i][1][reg];
        }
    } else {
      const int col = (tn * 4 + wc) * 32 + r32;
#pragma unroll
      for (int i = 0; i < 4; ++i)
#pragma unroll
        for (int reg = 0; reg < 16; ++reg) {
          const float g0 = acc[i][0][reg], u0 = acc[i][1][reg];
          outb[(size_t)(mrow + i * 32 + crow(reg, hi)) * ldo + col] = f2bf(g0 * sigmoidf_(g0) * u0);
        }
    }
  }
}

template <bool FINAL>
DI void rg_phase(const Params& p, char* lds, int bid, int nb) {
  const int tid = VT, lane = tid & 63, wid = tid >> 6, r32 = lane & 31, hi = lane >> 5;
  u16* xcb = (u16*)lds;
  float* A0 = (float*)(lds + 9216);
  float* U0 = (float*)(lds + 9216 + 16384);
  float* A1 = (float*)(lds + 9216 + 32768);
  float* U1 = (float*)(lds + 9216 + 49152);
  u16* raw = (u16*)A1;
  const u16* PROJ = (const u16*)(p.ws + OFF_PROJ);
  const u16* WG = (const u16*)(p.ws + WT_GATES);
  float* SUM = (float*)(p.ws + OFF_SUM);
  const float* CARRY = (const float*)(p.ws + OFF_CARRY);
  u16* Y = (u16*)(p.ws + OFF_Y);
  const int NIT = 768 * 8, nit = (NIT + nb - 1) / nb;
  const int mt = wid >> 1, nt = wid & 1;
  int cb_loaded = -1;
  bf16x8 bfr[2][2][4];
  float w0 = 0.f, w1 = 0.f, w2 = 0.f, w3 = 0.f, cbias = 0.f, bav[2] = {0.f, 0.f}, biv[2] = {0.f, 0.f}, spv[2] = {0.f, 0.f};
  u32x4 rr[3], rg[2], rrn[3], rgn[2];
  auto load_item = [&](int it, u32x4 (&xr)[3], u32x4 (&xg)[2]) {
    const int gc = it >> 3, cb = it & 7, m0 = gc * 64;
    int seq_lo, S; row_info(m0, seq_lo, S); const int seq_hi = seq_lo + S;
#pragma unroll
    for (int i = 0; i < 3; ++i) {
      const int c = tid + 256 * i, row = c >> 3, ch8 = c & 7, m = m0 - 2 + row;
      xr[i] = (c < 536 && m >= seq_lo && m < seq_hi) ? *(const u32x4*)(PROJ + (size_t)m * 2560 + cb * 64 + ch8 * 8) : (u32x4){0u, 0u, 0u, 0u};
    }
    if (FINAL) {
#pragma unroll
      for (int i = 0; i < 2; ++i) { const int c = tid + 256 * i, row = c >> 3, ch8 = c & 7; xg[i] = *(const u32x4*)(PROJ + (size_t)(m0 + row) * 2560 + 512 + cb * 64 + ch8 * 8); }
    }
  };
  { const int it = bid < NIT ? bid : NIT - 1; load_item(it, rr, rg); }
  for (int k = 0; k < nit; ++k) {
    const int it0 = bid + k * nb, it = it0 < NIT ? it0 : NIT - 1;
    const int gc = it >> 3, cb = it & 7, m0 = gc * 64;
    if (cb != cb_loaded) {
      cb_loaded = cb;
#pragma unroll
      for (int dir = 0; dir < 2; ++dir)
#pragma unroll
        for (int g = 0; g < 2; ++g)
#pragma unroll
          for (int ks = 0; ks < 4; ++ks)
            bfr[dir][g][ks] = *(const bf16x8*)(WG + (size_t)((dir * 2 + g) * 8 + cb) * 4096 + (nt * 32 + r32) * 64 + ks * 16 + 8 * hi);
      const int cc = cb * 64 + (tid & 63);
      w0 = p.conv_w[cc]; w1 = p.conv_w[512 + cc]; w2 = p.conv_w[1024 + cc]; w3 = p.conv_w[1536 + cc]; cbias = p.conv_b[cc];
      const int cg_ = cb * 64 + nt * 32 + r32;
#pragma unroll
      for (int dir = 0; dir < 2; ++dir) { bav[dir] = p.b_a[dir * 512 + cg_]; biv[dir] = p.b_i[dir * 512 + cg_]; spv[dir] = log1pf(__expf(-p.lam[dir * 512 + cg_])); }
    }
    __syncthreads();
#pragma unroll
    for (int i = 0; i < 3; ++i) { const int c = tid + 256 * i; if (c < 536) *(u32x4*)(raw + c * 8) = rr[i]; }
    { const int itn0 = bid + (k + 1) * nb, itn = itn0 < NIT ? itn0 : NIT - 1; load_item(itn, rrn, rgn); }
    __syncthreads();
    {
      const int ch = tid & 63, t0 = (tid >> 6) * 16;
      float xm2 = bf2f(raw[(t0) * 64 + ch]), xm1 = bf2f(raw[(t0 + 1) * 64 + ch]), x0 = bf2f(raw[(t0 + 2) * 64 + ch]);
#pragma unroll
      for (int t = t0; t < t0 + 16; ++t) {
        const float xp1 = bf2f(raw[(t + 3) * 64 + ch]);
        xcb[t * 72 + ch] = f2bf(w0 * xm2 + w1 * xm1 + w2 * x0 + w3 * xp1 + cbias);
        xm2 = xm1; xm1 = x0; x0 = xp1;
      }
    }
    __syncthreads();
    {
      bf16x8 af[4];
#pragma unroll
      for (int ks = 0; ks < 4; ++ks) af[ks] = *(const bf16x8*)(xcb + (mt * 32 + r32) * 72 + ks * 16 + 8 * hi);
      const int ch = nt * 32 + r32;
      float xc[16];
#pragma unroll
      for (int reg = 0; reg < 16; ++reg) xc[reg] = bf2f(xcb[(mt * 32 + crow(reg, hi)) * 72 + ch]);
#pragma unroll
      for (int dir = 0; dir < 2; ++dir) {
        f32x16 aa = {}, ai = {};
#pragma unroll
        for (int ks = 0; ks < 4; ++ks) { aa = MFMA32(af[ks], bfr[dir][0][ks], aa); ai = MFMA32(af[ks], bfr[dir][1][ks], ai); }
        float* Ab = dir == 0 ? A0 : A1; float* Ub = dir == 0 ? U0 : U1;
#pragma unroll
        for (int reg = 0; reg < 16; ++reg) {
          const int tok = mt * 32 + crow(reg, hi);
          const float r = sigmoidf_(aa[reg] + bav[dir]), gi = sigmoidf_(ai[reg] + biv[dir]);
          const float la = -8.f * r * spv[dir], a = __expf(la);
          const float mult = sqrtf(fmaxf(0.f, 1.f - __expf(2.f * la)));
          Ab[tok * 64 + ch] = a; Ub[tok * 64 + ch] = mult * gi * xc[reg];
        }
      }
    }
    __syncthreads();
    if (wid < 2) {
      const int dir = wid, ch = lane, c = cb * 64 + ch;
      float* Ab = dir == 0 ? A0 : A1; float* Ub = dir == 0 ? U0 : U1;
      if (!FINAL) {
        float h = 0.f, P = 1.f;
#pragma unroll 16
        for (int kk = 0; kk < 64; ++kk) { const int t = dir == 0 ? kk : 63 - kk; const float a = Ab[t * 64 + ch], u = Ub[t * 64 + ch]; h = a * h + u; P *= a; }
        SUM[(size_t)((gc * 2 + dir) * 2 + 0) * 512 + c] = P; SUM[(size_t)((gc * 2 + dir) * 2 + 1) * 512 + c] = h;
      } else {
        float h = CARRY[(size_t)(gc * 2 + dir) * 512 + c];
#pragma unroll 16
        for (int kk = 0; kk < 64; ++kk) { const int t = dir == 0 ? kk : 63 - kk; const float a = Ab[t * 64 + ch], u = Ub[t * 64 + ch]; h = a * h + u; Ub[t * 64 + ch] = h; }
      }
    }
    if (FINAL) {
      __syncthreads();
#pragma unroll
      for (int i = 0; i < 2; ++i) {
        const int c = tid + 256 * i, t = c >> 3, ch8 = c & 7;
        const f32x4 ha = *(const f32x4*)(U0 + t * 64 + ch8 * 8), hb = *(const f32x4*)(U0 + t * 64 + ch8 * 8 + 4);
        const f32x4 hc = *(const f32x4*)(U1 + t * 64 + ch8 * 8), hd = *(const f32x4*)(U1 + t * 64 + ch8 * 8 + 4);
        float hs[8] = {ha[0] + hc[0], ha[1] + hc[1], ha[2] + hc[2], ha[3] + hc[3], hb[0] + hd[0], hb[1] + hd[1], hb[2] + hd[2], hb[3] + hd[3]};
        float yv[8];
#pragma unroll
        for (int j = 0; j < 8; ++j) {
          const unsigned wv = rg[i][j >> 1];
          const float gt = __uint_as_float((j & 1) ? (wv & 0xffff0000u) : (wv << 16));
          const float ge = gt * sigmoidf_(1.5957691216057308f * (gt + 0.044715f * gt * gt * gt));
          yv[j] = ge * hs[j];
        }
        u32x4 o = {pk2(yv[0], yv[1]), pk2(yv[2], yv[3]), pk2(yv[4], yv[5]), pk2(yv[6], yv[7])};
        *(u32x4*)(Y + (size_t)(m0 + t) * 1024 + cb * 64 + ch8 * 8) = o;
      }
    }
#pragma unroll
    for (int i = 0; i < 3; ++i) rr[i] = rrn[i];
#pragma unroll
    for (int i = 0; i < 2; ++i) rg[i] = rgn[i];
  }
}

DI void rg_carry_phase(const Params& p, int bid, int nb) {
  const float* __restrict__ SUM = (const float*)(p.ws + OFF_SUM);
  float* __restrict__ CARRY = (float*)(p.ws + OFF_CARRY);
  for (int idx = bid * 256 + VT; idx < 8192; idx += nb * 256) {
    const int c = idx & 511, dir = (idx >> 9) & 1, seq = idx >> 10;
    const int gc0 = seq < 4 ? seq * 128 : 512 + (seq - 4) * 64, nch = seq < 4 ? 128 : 64;
    float carry = 0.f;
    for (int k0 = 0; k0 < nch; k0 += 8) {
      float P[8], Hh[8];
#pragma unroll
      for (int j = 0; j < 8; ++j) { const int k = k0 + j, gc = dir == 0 ? gc0 + k : gc0 + nch - 1 - k; P[j] = SUM[(size_t)((gc * 2 + dir) * 2 + 0) * 512 + c]; Hh[j] = SUM[(size_t)((gc * 2 + dir) * 2 + 1) * 512 + c]; }
#pragma unroll
      for (int j = 0; j < 8; ++j) { const int k = k0 + j, gc = dir == 0 ? gc0 + k : gc0 + nch - 1 - k; CARRY[(size_t)(gc * 2 + dir) * 512 + c] = carry; carry = P[j] * carry + Hh[j]; }
    }
  }
}

DI void dil_tile_info(int ti, int m0, int& d, int& u0) {
  if (ti < 5) { d = 16; u0 = m0 - 1024 + ti * 512; } else if (ti < 13) { d = 4; u0 = m0 - 256 + (ti - 5) * 128; } else { d = 1; u0 = m0 - 64 + (ti - 13) * 32; }
}
DI void dilated_phase(const Params& p, char* lds, int gw, int nw) {
  const int lane = VT & 63, wid = VT >> 6, r32 = lane & 31, hi = lane >> 5;
  u16* Vl = (u16*)(lds + wid * 6144);
  const unsigned vbase = (unsigned)(uintptr_t)Vl;
  const int li = lane & 15, tq = li >> 2, tp = li & 3, g1 = (lane >> 4) & 1;
  const unsigned trb = vbase + (4 * hi + tq) * 192 + (16 * g1 + 4 * tp) * 2;
  const u16* PROJ = (const u16*)(p.ws + OFF_PROJ);
  u16* Y = (u16*)(p.ws + OFF_Y);
  const int vrow = lane >> 3, vch = lane & 7;
  for (int id = gw; id < 12288; id += nw) {
    const int res = id & 15, h = (id >> 4) & 7, sp = id >> 7;
    const int m0 = sp * 512 + res;
    int seq_lo, S; row_info(sp * 512, seq_lo, S); const int seq_hi = seq_lo + S;
    const int mq = m0 + 16 * r32;
    bf16x8 qf[4];
#pragma unroll
    for (int ks = 0; ks < 4; ++ks) qf[ks] = *(const bf16x8*)(PROJ + (size_t)mq * 2560 + 1024 + h * 64 + ks * 16 + 8 * hi);
    const float slope2 = exp2f(-(float)(h + 1)) * LOG2E;
    const float c1 = 0.125f * LOG2E;
    float m_run = -1e30f, l_run = 0.f; f32x16 o0 = {}, o1 = {};
    const u16* kbase = PROJ + 1536 + h * 64 + 8 * hi;
    const u16* vbaseg = PROJ + 2048 + h * 64 + vch * 8;
    bf16x8 kf[4]; u32x4 vr[4];
    { int d, u0; dil_tile_info(0, m0, d, u0);
      const int ur = min(max(u0 + d * r32, seq_lo), seq_hi - 1);
#pragma unroll
      for (int ks = 0; ks < 4; ++ks) kf[ks] = *(const bf16x8*)(kbase + (size_t)ur * 2560 + ks * 16);
#pragma unroll
      for (int i = 0; i < 4; ++i) { const int uv = min(max(u0 + d * (vrow + 8 * i), seq_lo), seq_hi - 1); vr[i] = *(const u32x4*)(vbaseg + (size_t)uv * 2560); } }
#pragma unroll 1
    for (int ti = 0; ti < 33; ++ti) {
      int d, u0; dil_tile_info(ti, m0, d, u0);
#pragma unroll
      for (int i = 0; i < 4; ++i) *(u32x4*)(Vl + (vrow + 8 * i) * 96 + vch * 8) = vr[i];
      f32x16 pt = {};
#pragma unroll
      for (int ks = 0; ks < 4; ++ks) pt = MFMA32(kf[ks], qf[ks], pt);
      if (ti + 1 < 33) {
        int dn, un; dil_tile_info(ti + 1, m0, dn, un);
        const int ur = min(max(un + dn * r32, seq_lo), seq_hi - 1);
#pragma unroll
        for (int ks = 0; ks < 4; ++ks) kf[ks] = *(const bf16x8*)(kbase + (size_t)ur * 2560 + ks * 16);
#pragma unroll
        for (int i = 0; i < 4; ++i) { const int uv = min(max(un + dn * (vrow + 8 * i), seq_lo), seq_hi - 1); vr[i] = *(const u32x4*)(vbaseg + (size_t)uv * 2560); }
      }
      const s16x4 l00 = tr_read(trb), h00 = tr_read(trb + 8 * 192), l01 = tr_read(trb + 64), h01 = tr_read(trb + 8 * 192 + 64);
      const s16x4 l10 = tr_read(trb + 16 * 192), h10 = tr_read(trb + 24 * 192), l11 = tr_read(trb + 16 * 192 + 64), h11 = tr_read(trb + 24 * 192 + 64);
      const int du0 = u0 - mq + d * 4 * hi, lim = 64 * d;
      float pmax = -INFINITY;
#pragma unroll
      for (int reg = 0; reg < 16; ++reg) {
        const int du = du0 + d * ((reg & 3) + 8 * (reg >> 2)), u = mq + du, ad = du < 0 ? -du : du;
        const bool valid = (ad <= lim) && (u >= seq_lo) && (u < seq_hi);
        const float tv = valid ? (pt[reg] * c1 - slope2 * (float)ad) : -INFINITY;
        pt[reg] = tv; pmax = fmaxf(pmax, tv);
      }
      pmax = pl32_max(pmax);
      if (__any(pmax > m_run)) {
        const float mn = fmaxf(m_run, pmax), alpha = __builtin_amdgcn_exp2f(m_run - mn);
        m_run = mn; l_run *= alpha;
#pragma unroll
        for (int reg = 0; reg < 16; ++reg) { o0[reg] *= alpha; o1[reg] *= alpha; }
      }
      float ps = 0.f;
#pragma unroll
      for (int reg = 0; reg < 16; ++reg) { pt[reg] = __builtin_amdgcn_exp2f(pt[reg] - m_run); ps += pt[reg]; }
      ps = pl32_sum(ps);
      l_run += ps;
      const bf16x8 pb0 = pack8(pt, 0), pb1 = pack8(pt, 1);
      LGKM0();
      o0 = MFMA32(cat4(l00, h00), pb0, o0); o0 = MFMA32(cat4(l10, h10), pb1, o0);
      o1 = MFMA32(cat4(l01, h01), pb0, o1); o1 = MFMA32(cat4(l11, h11), pb1, o1);
    }
    const float inv = 1.f / l_run;
    u16* yo = Y + (size_t)mq * 1024 + 512 + h * 64 + 4 * hi;
#pragma unroll
    for (int g = 0; g < 4; ++g) {
      u32x2 w0 = {pk2(o0[4 * g] * inv, o0[4 * g + 1] * inv), pk2(o0[4 * g + 2] * inv, o0[4 * g + 3] * inv)};
      u32x2 w1 = {pk2(o1[4 * g] * inv, o1[4 * g + 1] * inv), pk2(o1[4 * g + 2] * inv, o1[4 * g + 3] * inv)};
      *(u32x2*)(yo + 8 * g) = w0; *(u32x2*)(yo + 32 + 8 * g) = w1;
    }
  }
}

DI void mla_norm_phase(const Params& p, int gw, int nw) {
  const int lane = threadIdx.x & 63;
  const u16* P2 = (const u16*)(p.ws + OFF_P2);
  u16* CQN = (u16*)(p.ws + OFF_CQN); u16* CKVN = (u16*)(p.ws + OFF_CKVN); u16* KR = (u16*)(p.ws + OFF_KR);
  const float* ct = (const float*)(p.ws + OFF_COS); const float* st = (const float*)(p.ws + OFF_SIN);
  for (int m = gw; m < M_TOT; m += nw) {
    const u16* src = P2 + (size_t)m * 768;
    float q[6], kv[4]; float sq = 0.f, skv = 0.f;
#pragma unroll
    for (int i = 0; i < 6; ++i) { q[i] = bf2f(src[i * 64 + lane]); sq += q[i] * q[i]; }
#pragma unroll
    for (int i = 0; i < 4; ++i) { kv[i] = bf2f(src[384 + i * 64 + lane]); skv += kv[i] * kv[i]; }
#pragma unroll
    for (int o = 32; o > 0; o >>= 1) { sq += __shfl_xor(sq, o); skv += __shfl_xor(skv, o); }
    const float rq = rsqrtf(sq * (1.f / 384.f) + 1e-6f), rkv = rsqrtf(skv * (1.f / 256.f) + 1e-6f);
#pragma unroll
    for (int i = 0; i < 6; ++i) CQN[(size_t)m * 384 + i * 64 + lane] = f2bf(q[i] * rq * p.q_norm[i * 64 + lane]);
#pragma unroll
    for (int i = 0; i < 4; ++i) CKVN[(size_t)m * 256 + i * 64 + lane] = f2bf(kv[i] * rkv * p.kv_norm[i * 64 + lane]);
    if (lane < 16) {
      const int pos = m < M_P ? (m & 8191) : ((m - M_P) & 4095);
      const float t1 = bf2f(src[640 + lane]), t2 = bf2f(src[656 + lane]);
      const float c = ct[pos * 16 + lane], s = st[pos * 16 + lane];
      KR[(size_t)m * 32 + lane] = f2bf(t1 * c - t2 * s); KR[(size_t)m * 32 + 16 + lane] = f2bf(t1 * s + t2 * c);
    }
  }
}

constexpr int KP = 104, VP = 96;
DI void mla_unit(const Params& p, char* lds, int seqbase, int S, int h, int qb) {
  const int tid = VT, lane = tid & 63, wid = tid >> 6, r32 = lane & 31, hi = lane >> 5;
  u16* Kl = (u16*)lds;
  u16* Vl = (u16*)(lds + 2 * 64 * KP * 2);
  const unsigned vbase = (unsigned)(uintptr_t)Vl;
  const int li = lane & 15, tq = li >> 2, tp = li & 3, g1 = (lane >> 4) & 1;
  const unsigned trb = vbase + (4 * hi + tq) * (VP * 2) + (16 * g1 + 4 * tp) * 2;
  const u16* Q = (const u16*)(p.ws + OFF_Q); const u16* KV = (const u16*)(p.ws + OFF_KV); const u16* KR = (const u16*)(p.ws + OFF_KR);
  u16* O = (u16*)(p.ws + OFF_O);
  const float* ct = (const float*)(p.ws + OFF_COS); const float* st = (const float*)(p.ws + OFF_SIN);
  const int pos = qb * 128 + wid * 32 + r32, qrow = seqbase + pos;
  bf16x8 qf[6];
#pragma unroll
  for (int d0 = 0; d0 < 6; ++d0) qf[d0] = *(const bf16x8*)(Q + (size_t)qrow * 1536 + h * 96 + d0 * 16 + 8 * hi);
  const float C = 0.10206207261596577f * LOG2E;
#pragma unroll
  for (int j = 0; j < 8; ++j) {
    const float c = ct[pos * 16 + 8 * hi + j], s = st[pos * 16 + 8 * hi + j];
    const float t1 = bfs2f(qf[4][j]), t2 = bfs2f(qf[5][j]);
    qf[4][j] = (short)f2bf((t1 * c - t2 * s) * C); qf[5][j] = (short)f2bf((t1 * s + t2 * c) * C);
  }
#pragma unroll
  for (int d0 = 0; d0 < 4; ++d0)
#pragma unroll
    for (int j = 0; j < 8; ++j) qf[d0][j] = (short)f2bf(bfs2f(qf[d0][j]) * C);
  const u16* ksrc[3]; int kdst[3];
#pragma unroll
  for (int i = 0; i < 3; ++i) {
    const int idx = tid + 256 * i, row = idx / 12, c = idx - row * 12;
    ksrc[i] = c < 8 ? KV + (size_t)(seqbase + row) * 2048 + h * 128 + c * 8 : KR + (size_t)(seqbase + row) * 32 + (c - 8) * 8;
    kdst[i] = row * KP + c * 8;
  }
  const int kstride[3] = {0, 0, 0}; (void)kstride;
  const int vrow = tid >> 3, vc = tid & 7;
  const u16* vsrc = KV + (size_t)(seqbase + vrow) * 2048 + h * 128 + 64 + vc * 8;
  const int vdst = vrow * VP + vc * 8;
  size_t kadv[3];
#pragma unroll
  for (int i = 0; i < 3; ++i) { const int idx = tid + 256 * i, row = idx / 12, c = idx - row * 12; (void)row; kadv[i] = c < 8 ? (size_t)64 * 2048 : (size_t)64 * 32; }
  float l_run = 0.f; f32x16 o0 = {}, o1 = {}, negm = {};
  const int nkt = S >> 6;
  u32x4 rk[3], rv[2];
#pragma unroll
  for (int i = 0; i < 3; ++i) rk[i] = *(const u32x4*)(ksrc[i]);
  rv[0] = *(const u32x4*)(vsrc); rv[1] = *(const u32x4*)(vsrc + (size_t)32 * 2048);
#pragma unroll
  for (int i = 0; i < 3; ++i) *(u32x4*)(Kl + kdst[i]) = rk[i];
  *(u32x4*)(Vl + vdst) = rv[0]; *(u32x4*)(Vl + vdst + 32 * VP) = rv[1];
  __syncthreads();
#pragma unroll 1
  for (int kt = 0; kt < nkt; ++kt) {
    const int cur = kt & 1;
    if (kt + 1 < nkt) {
#pragma unroll
      for (int i = 0; i < 3; ++i) rk[i] = *(const u32x4*)(ksrc[i] + (size_t)(kt + 1) * kadv[i]);
      rv[0] = *(const u32x4*)(vsrc + (size_t)(kt + 1) * 64 * 2048); rv[1] = *(const u32x4*)(vsrc + (size_t)(kt + 1) * 64 * 2048 + (size_t)32 * 2048);
    }
    const u16* kl = Kl + cur * 64 * KP + r32 * KP + 8 * hi;
    f32x16 p0, p1;
    { const bf16x8 k0 = *(const bf16x8*)(kl), k1 = *(const bf16x8*)(kl + 32 * KP);
      p0 = MFMA32(k0, qf[0], negm); p1 = MFMA32(k1, qf[0], negm); }
#pragma unroll
    for (int d0 = 1; d0 < 6; ++d0) {
      const bf16x8 k0 = *(const bf16x8*)(kl + d0 * 16), k1 = *(const bf16x8*)(kl + 32 * KP + d0 * 16);
      p0 = MFMA32(k0, qf[d0], p0); p1 = MFMA32(k1, qf[d0], p1);
    }
    const unsigned tb = trb + cur * (64 * VP * 2), tc = tb + 64;
    const s16x4 a0 = tr_read(tb), b0 = tr_read(tb + 8 * VP * 2), a1 = tr_read(tb + 16 * VP * 2), b1 = tr_read(tb + 24 * VP * 2);
    const s16x4 a2 = tr_read(tb + 32 * VP * 2), b2 = tr_read(tb + 40 * VP * 2), a3 = tr_read(tb + 48 * VP * 2), b3 = tr_read(tb + 56 * VP * 2);
    const s16x4 c0 = tr_read(tc), d0_ = tr_read(tc + 8 * VP * 2), c1 = tr_read(tc + 16 * VP * 2), d1 = tr_read(tc + 24 * VP * 2);
    const s16x4 c2 = tr_read(tc + 32 * VP * 2), d2 = tr_read(tc + 40 * VP * 2), c3 = tr_read(tc + 48 * VP * 2), d3 = tr_read(tc + 56 * VP * 2);
    float pmax = fmaxf(p0[0], p1[0]);
#pragma unroll
    for (int r = 1; r < 16; ++r) pmax = fmaxf(pmax, fmaxf(p0[r], p1[r]));
    pmax = pl32_max(pmax);
    if (kt == 0 || __any(pmax > 8.f)) {
      const float delta = kt == 0 ? pmax : fmaxf(pmax, 0.f);
      const float alpha = kt == 0 ? 1.f : __builtin_amdgcn_exp2f(-delta);
#pragma unroll
      for (int r = 0; r < 16; ++r) { negm[r] -= delta; p0[r] -= delta; p1[r] -= delta; o0[r] *= alpha; o1[r] *= alpha; }
      l_run *= alpha;
    }
    float ps = 0.f;
#pragma unroll
    for (int r = 0; r < 16; ++r) { p0[r] = __builtin_amdgcn_exp2f(p0[r]); p1[r] = __builtin_amdgcn_exp2f(p1[r]); ps += p0[r] + p1[r]; }
    ps = pl32_sum(ps);
    l_run += ps;
    const bf16x8 pb0 = pack8(p0, 0), pb1 = pack8(p0, 1), pb2 = pack8(p1, 0), pb3 = pack8(p1, 1);
    LGKM0();
    o0 = MFMA32(cat4(a0, b0), pb0, o0); o1 = MFMA32(cat4(c0, d0_), pb0, o1);
    o0 = MFMA32(cat4(a1, b1), pb1, o0); o1 = MFMA32(cat4(c1, d1), pb1, o1);
    o0 = MFMA32(cat4(a2, b2), pb2, o0); o1 = MFMA32(cat4(c2, d2), pb2, o1);
    o0 = MFMA32(cat4(a3, b3), pb3, o0); o1 = MFMA32(cat4(c3, d3), pb3, o1);
    if (kt + 1 < nkt) {
      u16* kd = Kl + (cur ^ 1) * 64 * KP; u16* vd = Vl + (cur ^ 1) * 64 * VP;
#pragma unroll
      for (int i = 0; i < 3; ++i) *(u32x4*)(kd + kdst[i]) = rk[i];
      *(u32x4*)(vd + vdst) = rv[0]; *(u32x4*)(vd + vdst + 32 * VP) = rv[1];
    }
    __syncthreads();
  }
  const float inv = 1.f / l_run;
  u16* oo = O + (size_t)qrow * 1024 + h * 64 + 4 * hi;
#pragma unroll
  for (int g = 0; g < 4; ++g) {
    u32x2 w0 = {pk2(o0[4 * g] * inv, o0[4 * g + 1] * inv), pk2(o0[4 * g + 2] * inv, o0[4 * g + 3] * inv)};
    u32x2 w1 = {pk2(o1[4 * g] * inv, o1[4 * g + 1] * inv), pk2(o1[4 * g + 2] * inv, o1[4 * g + 3] * inv)};
    *(u32x2*)(oo + 8 * g) = w0; *(u32x2*)(oo + 32 + 8 * g) = w1;
  }
}

DI void mla_attn_phase(const Params& p, char* lds, int xcd, int j, int nper) {
  for (int lu0 = j; lu0 - j < 8 * 64; lu0 += nper) { const int lu = lu0 < 8 * 64 ? lu0 : 8 * 64 - 1; const int bh = (lu >> 6) * 8 + xcd, qb = lu & 63; mla_unit(p, lds, (bh >> 4) * 8192, 8192, bh & 15, qb); }
  for (int lu0 = j; lu0 - j < 8 * 32; lu0 += nper) { const int lu = lu0 < 8 * 32 ? lu0 : 8 * 32 - 1; const int bh = (lu >> 5) * 8 + xcd, qb = lu & 31; mla_unit(p, lds, M_P + (bh >> 4) * 4096, 4096, bh & 15, qb); }
}

#define XB_TMO      128
#define XB_XCNT(j)  (256  + 64 * (j))
#define XB_XSUB(j)  (1280 + 64 * (j))
#define XB_XGEN(j)  (2304 + 64 * (j))
#define XB_TOP      3328
#define XB_TOPGEN   3392
#define XCD_BAR_WORDS 3456
#define XB_SPIN_CAP (1u << 20)
#define LAS __attribute__((address_space(3)))
DI unsigned xb_ld(unsigned* p) { return __hip_atomic_load(p, __ATOMIC_RELAXED, __HIP_MEMORY_SCOPE_AGENT); }
DI unsigned xb_add(unsigned* p, unsigned v) { return __hip_atomic_fetch_add(p, v, __ATOMIC_RELAXED, __HIP_MEMORY_SCOPE_AGENT); }
DI unsigned xb_xcc_id() { return (unsigned)__builtin_amdgcn_s_getreg((3 << 11) | 20) & 0xFu; }
#define XB_SPIN(cond, bar) do { unsigned _sp = 0; while (cond) { __builtin_amdgcn_s_sleep(1); \
    if ((++_sp & 255u) == 0u) { if (xb_ld(&(bar)[XB_TMO])) break; if (_sp > XB_SPIN_CAP) { atomicAdd(&(bar)[XB_TMO], 1u); break; } } } } while (0)
struct XcdBarrier { unsigned* bar; unsigned x; volatile LAS unsigned* st; };
DI XcdBarrier xcd_barrier_post(unsigned* bar, volatile LAS unsigned* st) {
  XcdBarrier b; b.bar = bar; b.x = xb_xcc_id(); b.st = st;
  if (threadIdx.x == 0) (void)xb_add(&bar[XB_XCNT(b.x)], 1u);
  return b;
}
DI void xcd_barrier_complete(unsigned* bar, unsigned x, unsigned& nloc, unsigned& nx) {
  const unsigned G = gridDim.x * gridDim.y * gridDim.z;
  unsigned sum, cnt, mine, sp = 0u;
  for (;;) {
    sum = 0u; cnt = 0u; mine = 0u;
#pragma unroll
    for (unsigned j = 0; j < 16; ++j) { const unsigned c = xb_ld(&bar[XB_XCNT(j)]); sum += c; cnt += (c > 0u) ? 1u : 0u; mine = (j == x) ? c : mine; }
    if (sum == G) break;
    __builtin_amdgcn_s_sleep(1);
    if ((++sp & 255u) == 0u) { if (xb_ld(&bar[XB_TMO])) break; if (sp > XB_SPIN_CAP) { atomicAdd(&bar[XB_TMO], 1u); break; } }
  }
  nloc = mine > 0u ? mine : 1u; nx = cnt > 0u ? cnt : 1u;
}
DI void xcd_barrier(const XcdBarrier& b) {
  asm volatile("s_waitcnt vmcnt(0)" ::: "memory");
  __syncthreads();
  if (threadIdx.x == 0) {
    unsigned* bar = b.bar;
    __builtin_amdgcn_s_waitcnt(0);
    unsigned nloc = b.st[0], nx = b.st[1];
    if (nloc == 0u) { xcd_barrier_complete(bar, b.x, nloc, nx); b.st[0] = nloc; b.st[1] = nx; }
    const unsigned old = xb_add(&bar[XB_XSUB(b.x)], 1u);
    const unsigned gen = old / nloc;
    if (old + 1u == (gen + 1u) * nloc) {
      __builtin_amdgcn_fence(__ATOMIC_RELEASE, "agent");
      asm volatile("s_waitcnt vmcnt(0)" ::: "memory");
      const unsigned og = xb_add(&bar[XB_TOP], 1u);
      const unsigned tg = og / nx;
      if (og + 1u == (tg + 1u) * nx) xb_add(&bar[XB_TOPGEN], 1u);
      else XB_SPIN(xb_ld(&bar[XB_TOPGEN]) == tg, bar);
      __builtin_amdgcn_fence(__ATOMIC_ACQUIRE, "agent");
      xb_add(&bar[XB_XGEN(b.x)], 1u);
      asm volatile("s_waitcnt vmcnt(0)" ::: "memory");
    } else {
      XB_SPIN(xb_ld(&bar[XB_XGEN(b.x)]) == gen, bar);
      __builtin_amdgcn_fence(__ATOMIC_ACQUIRE, "agent");
      asm volatile("s_waitcnt vmcnt(0)" ::: "memory");
    }
  }
  __syncthreads();
}

constexpr int N_PHASES = 19;
constexpr int HALF_LDS = 74752;
constexpr int LDS_BYTES = 2 * HALF_LDS;
__global__ void __launch_bounds__(512, 2) mega(Params p, int ph_lo, int ph_hi) {
  __shared__ __attribute__((aligned(16))) char lds_all[LDS_BYTES];
  const int rbid = blockIdx.x, rnb = gridDim.x;
  const int half = __builtin_amdgcn_readfirstlane((int)(threadIdx.x >> 8));
  const int bid = rbid * 2 + half, nb = rnb * 2;
  char* lds = lds_all + half * HALF_LDS;
  const int gw = bid * 4 + __builtin_amdgcn_readfirstlane(VT >> 6), nw = nb * 4;
  char* ws = p.ws;
  float* out1 = p.out + (size_t)M_P * DM;
  __shared__ uint4 xb_words;
  if (threadIdx.x == 0) xb_words = make_uint4(0u, 0u, 0u, 0u);
  __syncthreads();
  XcdBarrier xb; xb.bar = (unsigned*)(ws + OFF_BAR); xb.x = 0; xb.st = (volatile LAS unsigned*)&xb_words;
  if (ph_hi - ph_lo > 1) xb = xcd_barrier_post((unsigned*)(ws + OFF_BAR), (volatile LAS unsigned*)&xb_words);
  if (ph_lo < 0) cg::this_grid().sync();
#ifndef DUP_MASK
#define DUP_MASK 0
#endif
#define PHASE(k, ...) do { if (ph_lo <= (k) && (k) < ph_hi) { __VA_ARGS__ if ((DUP_MASK >> (k)) & 1) { xcd_barrier(xb); __VA_ARGS__ } } if (ph_lo <= (k) && (k) + 1 < ph_hi) xcd_barrier(xb); } while (0)
  PHASE(0, prep_phase(p, lds, bid, nb););
  PHASE(1, gemm_phase<EPI_BF16>((const u16*)(ws + OFF_H), 1024, (const u16*)(ws + WT_ABIN), 1024, 2560, (u16*)(ws + OFF_PROJ), 2560, nullptr, nullptr, nullptr, lds_all, rbid, rnb););
  PHASE(2, rg_phase<false>(p, lds, bid, nb); __syncthreads(); dilated_phase(p, lds, gw, nw););
  PHASE(3, rg_carry_phase(p, bid, nb););
  PHASE(4, rg_phase<true>(p, lds, bid, nb););
  PHASE(5, gemm_phase<EPI_RESID>((const u16*)(ws + OFF_Y), 1024, (const u16*)(ws + WT_ABOUT), 1024, 1024, nullptr, 0, p.xin0, p.xin1, p.out, lds_all, rbid, rnb););
  PHASE(6, rmsnorm_phase(p.out, out1, p.norm_ffn, (u16*)(ws + OFF_H), nullptr, gw, nw););
  PHASE(7, gemm_phase<EPI_SWIGLU>((const u16*)(ws + OFF_H), 1024, (const u16*)(ws + WT_GU0), 1024, 5632, (u16*)(ws + OFF_ACT), FH, nullptr, nullptr, nullptr, lds_all, rbid, rnb););
  PHASE(8, gemm_phase<EPI_RESID>((const u16*)(ws + OFF_ACT), FH, (const u16*)(ws + WT_DOWN0), FH, 1024, nullptr, 0, p.out, out1, p.out, lds_all, rbid, rnb););
  PHASE(9, rmsnorm_phase(p.out, out1, p.norm_mix + 1024, (u16*)(ws + OFF_H), nullptr, gw, nw););
  PHASE(10, gemm_phase<EPI_BF16>((const u16*)(ws + OFF_H), 1024, (const u16*)(ws + WT_MLAIN), 1024, 768, (u16*)(ws + OFF_P2), 768, nullptr, nullptr, nullptr, lds_all, rbid, rnb););
  PHASE(11, mla_norm_phase(p, gw, nw););
  PHASE(12, gemm_phase<EPI_BF16>((const u16*)(ws + OFF_CQN), 384, (const u16*)(ws + WT_QB), 384, 1536, (u16*)(ws + OFF_Q), 1536, nullptr, nullptr, nullptr, lds_all, rbid, rnb); gemm_phase<EPI_BF16>((const u16*)(ws + OFF_CKVN), 256, (const u16*)(ws + WT_KVB), 256, 2048, (u16*)(ws + OFF_KV), 2048, nullptr, nullptr, nullptr, lds_all, rbid, rnb););
  PHASE(13, mla_attn_phase(p, lds, rbid & 7, (rbid >> 3) * 2 + half, (rnb >> 3) * 2););
  PHASE(14, gemm_phase<EPI_RESID>((const u16*)(ws + OFF_O), 1024, (const u16*)(ws + WT_MLAOUT), 1024, 1024, nullptr, 0, p.out, out1, p.out, lds_all, rbid, rnb););
  PHASE(15, rmsnorm_phase(p.out, out1, p.norm_ffn + 1024, (u16*)(ws + OFF_H), nullptr, gw, nw););
  PHASE(16, gemm_phase<EPI_SWIGLU>((const u16*)(ws + OFF_H), 1024, (const u16*)(ws + WT_GU1), 1024, 5632, (u16*)(ws + OFF_ACT), FH, nullptr, nullptr, nullptr, lds_all, rbid, rnb););
  PHASE(17, gemm_phase<EPI_RESID>((const u16*)(ws + OFF_ACT), FH, (const u16*)(ws + WT_DOWN1), FH, 1024, nullptr, 0, p.out, out1, p.out, lds_all, rbid, rnb););
  PHASE(18, rmsnorm_phase(p.out, out1, p.norm_final, nullptr, p.out, gw, nw););
#undef PHASE
}

extern "C" void kernel_launch(void* const* d_in, const int* in_sizes, int n_in, void* d_out, int out_size, void* d_ws, size_t ws_size, hipStream_t stream) {
  static int grid_blocks = 0;
  if (!grid_blocks) {
    int dev = 0, cus = 0, per_cu = 0;
    hipGetDevice(&dev);
    hipDeviceGetAttribute(&cus, hipDeviceAttributeMultiprocessorCount, dev);
    hipOccupancyMaxActiveBlocksPerMultiprocessor(&per_cu, mega, 512, 0);
    if (per_cu > 1) per_cu = 1;
    if (per_cu < 1) per_cu = 1;
    grid_blocks = cus * per_cu;
  }
  if (n_in != 23 || ws_size < WS_NEED) { fprintf(stderr, "kernel_launch: bad inputs n_in=%d ws=%zu\n", n_in, ws_size); return; }
  Params p{};
  p.xin0 = (const float*)d_in[0]; p.xin1 = (const float*)d_in[1];
  p.norm_mix = (const float*)d_in[2]; p.norm_ffn = (const float*)d_in[3]; p.norm_final = (const float*)d_in[4];
  p.ab_w_in = (const float*)d_in[5]; p.conv_w = (const float*)d_in[6]; p.conv_b = (const float*)d_in[7];
  p.w_a = (const float*)d_in[8]; p.b_a = (const float*)d_in[9]; p.w_i = (const float*)d_in[10]; p.b_i = (const float*)d_in[11];
  p.lam = (const float*)d_in[12]; p.ab_w_out = (const float*)d_in[13];
  p.mla_w_in = (const float*)d_in[14]; p.q_norm = (const float*)d_in[15]; p.w_qb = (const float*)d_in[16]; p.kv_norm = (const float*)d_in[17];
  p.w_kvb = (const float*)d_in[18]; p.mla_w_out = (const float*)d_in[19];
  p.w_gate = (const float*)d_in[20]; p.w_up = (const float*)d_in[21]; p.w_down = (const float*)d_in[22];
  p.out = (float*)d_out; p.ws = (char*)d_ws;
#if SINGLE_LAUNCH
  hipMemsetAsync((char*)d_ws + OFF_BAR, 0, XCD_BAR_WORDS * 4, stream);
  int lo = 0, hi = N_PHASES;
  void* args[] = {&p, &lo, &hi};
  hipError_t e = hipLaunchCooperativeKernel((void*)mega, dim3(grid_blocks), dim3(512), args, 0, stream);
  if (e != hipSuccess) fprintf(stderr, "cooperative launch failed: %s (grid %d)\n", hipGetErrorString(e), grid_blocks);
#else
  for (int ph = 0; ph < N_PHASES; ++ph) hipLaunchKernelGGL(mega, dim3(grid_blocks), dim3(512), 0, stream, p, ph, ph + 1);
#endif
}
```

```cpp
#include <hip/hip_runtime.h>
#include <hip/hip_cooperative_groups.h>
#include <cstdint>
#include <cstdio>
namespace cg = cooperative_groups;

#ifndef SINGLE_LAUNCH
#define SINGLE_LAUNCH 1
#endif

typedef unsigned short u16;
typedef short bf16x8 __attribute__((ext_vector_type(8)));
typedef short s16x4 __attribute__((ext_vector_type(4)));
typedef float f32x16 __attribute__((ext_vector_type(16)));
typedef float f32x4 __attribute__((ext_vector_type(4)));
typedef float f32x2 __attribute__((ext_vector_type(2)));
typedef unsigned u32x4 __attribute__((ext_vector_type(4)));
typedef unsigned u32x2 __attribute__((ext_vector_type(2)));
typedef __bf16 bf2_t __attribute__((ext_vector_type(2)));
#define DI __device__ __forceinline__
#define VT ((int)(threadIdx.x & 255))
#define MFMA32(a, b, c) __builtin_amdgcn_mfma_f32_32x32x16_bf16((a), (b), (c), 0, 0, 0)

constexpr int M_TOT = 49152, M_P = 32768, DM = 1024, FH = 2816;
constexpr float LOG2E = 1.4426950408889634f;
constexpr size_t MiB = 1ull << 20;
constexpr size_t WT_ABIN = 0;
constexpr size_t WT_ABOUT = WT_ABIN + 2560ull * 1024 * 2;
constexpr size_t WT_GU0 = WT_ABOUT + 1024ull * 1024 * 2;
constexpr size_t WT_DOWN0 = WT_GU0 + 5632ull * 1024 * 2;
constexpr size_t WT_MLAIN = WT_DOWN0 + 1024ull * 2816 * 2;
constexpr size_t WT_QB = WT_MLAIN + 768ull * 1024 * 2;
constexpr size_t WT_KVB = WT_QB + 1536ull * 384 * 2;
constexpr size_t WT_MLAOUT = WT_KVB + 2048ull * 256 * 2;
constexpr size_t WT_GU1 = WT_MLAOUT + 1024ull * 1024 * 2;
constexpr size_t WT_DOWN1 = WT_GU1 + 5632ull * 1024 * 2;
constexpr size_t WT_GATES = WT_DOWN1 + 1024ull * 2816 * 2;
constexpr size_t WT_END = WT_GATES + 32ull * 4096 * 2;
static_assert(WT_END <= 46 * MiB, "weights region");
constexpr size_t OFF_SUM = 46 * MiB;
constexpr size_t OFF_KR = 46 * MiB;
constexpr size_t OFF_COS = 52 * MiB;
constexpr size_t OFF_SIN = 52 * MiB + 512 * 1024;
constexpr size_t OFF_H = 54 * MiB;
constexpr size_t OFF_CQN = 54 * MiB;
constexpr size_t OFF_CKVN = 90 * MiB;
constexpr size_t OFF_O = 54 * MiB;
constexpr size_t OFF_PROJ = 150 * MiB;
constexpr size_t OFF_ACT = 150 * MiB;
constexpr size_t OFF_P2 = 150 * MiB;
constexpr size_t OFF_Q = 150 * MiB;
constexpr size_t OFF_KV = 294 * MiB;
constexpr size_t OFF_Y = 390 * MiB;
constexpr size_t OFF_CARRY = 486 * MiB;
constexpr size_t OFF_BAR = 489 * MiB;
constexpr size_t WS_NEED = 490 * MiB;

struct Params {
  const float* xin0; const float* xin1;
  const float* norm_mix; const float* norm_ffn; const float* norm_final;
  const float* ab_w_in; const float* conv_w; const float* conv_b;
  const float* w_a; const float* b_a; const float* w_i; const float* b_i; const float* lam; const float* ab_w_out;
  const float* mla_w_in; const float* q_norm; const float* w_qb; const float* kv_norm; const float* w_kvb; const float* mla_w_out;
  const float* w_gate; const float* w_up; const float* w_down;
  float* out; char* ws;
};

DI float bf2f(u16 v) { return __uint_as_float(((unsigned)v) << 16); }
DI float bfs2f(short v) { return __uint_as_float(((unsigned)(u16)v) << 16); }
DI unsigned pk2(float lo, float hi) { f32x2 v = {lo, hi}; bf2_t r = __builtin_convertvector(v, bf2_t); return __builtin_bit_cast(unsigned, r); }
DI u16 f2bf(float a) { return (u16)(pk2(a, 0.f) & 0xffffu); }
DI int crow(int r, int hi) { return (r & 3) + 8 * (r >> 2) + 4 * hi; }
DI float sigmoidf_(float x) { return __builtin_amdgcn_rcpf(1.f + __builtin_amdgcn_exp2f(-1.4426950408889634f * x)); }
DI float pl32_max(float v) { auto rr = __builtin_amdgcn_permlane32_swap(__float_as_uint(v), __float_as_uint(v), false, false); return fmaxf(__uint_as_float(rr[0]), __uint_as_float(rr[1])); }
DI float pl32_sum(float v) { auto rr = __builtin_amdgcn_permlane32_swap(__float_as_uint(v), __float_as_uint(v), false, false); return __uint_as_float(rr[0]) + __uint_as_float(rr[1]); }
DI s16x4 tr_read(unsigned addr) { s16x4 r; asm volatile("ds_read_b64_tr_b16 %0, %1" : "=&v"(r) : "v"(addr) : "memory"); return r; }
template <int OFF> DI s16x4 tr_read_o(unsigned addr) { s16x4 r; asm volatile("ds_read_b64_tr_b16 %0, %1 offset:%2" : "=&v"(r) : "v"(addr), "i"(OFF) : "memory"); return r; }
DI float max_nn(float a, float b) { return __builtin_amdgcn_fmed3f(a, b, __builtin_inff()); }
#define LGKM0() do { asm volatile("s_waitcnt lgkmcnt(0)" ::: "memory"); __builtin_amdgcn_sched_barrier(0); } while (0)
DI bf16x8 cat4(s16x4 l, s16x4 h) { return (bf16x8){l[0], l[1], l[2], l[3], h[0], h[1], h[2], h[3]}; }
DI bf16x8 pack8(const f32x16& x, int s) {
  u32x4 w = {pk2(x[8 * s + 0], x[8 * s + 1]), pk2(x[8 * s + 2], x[8 * s + 3]), pk2(x[8 * s + 4], x[8 * s + 5]), pk2(x[8 * s + 6], x[8 * s + 7])};
  return __builtin_bit_cast(bf16x8, w);
}
DI void row_info(int m, int& seq_lo, int& S) { if (m < M_P) { seq_lo = m & ~8191; S = 8192; } else { seq_lo = M_P + ((m - M_P) & ~4095); S = 4096; } }

DI void tr_job(const float* __restrict__ src, int K, int N, u16* __restrict__ dst, int mode, float* tile, int bid, int nb, int& rot) {
  const int tk = K >> 6, tn = (N + 63) >> 6, nt = tk * tn;
  const int tx = VT & 63, ty = VT >> 6;
  const int t0 = (bid + nb - rot) % nb, nit = (nt + nb - 1) / nb;
  for (int i = 0; i < nit; ++i) {
    const int t = t0 + i * nb; const bool act = t < nt;
    const int k0 = (t / tn) << 6, n0 = (t % tn) << 6;
    __syncthreads();
    if (act) {
#pragma unroll 4
      for (int r = 0; r < 16; ++r) { const int kk = ty + 4 * r, n = n0 + tx; tile[kk * 65 + tx] = n < N ? src[(size_t)(k0 + kk) * N + n] : 0.f; }
    }
    __syncthreads();
    if (act) {
#pragma unroll 4
      for (int r = 0; r < 16; ++r) {
        const int nn = ty + 4 * r, n = n0 + nn;
        if (n < N) { const int row = mode == 0 ? n : ((n >> 5) * 64 + (n & 31) + (mode == 2 ? 32 : 0)); dst[(size_t)row * K + k0 + tx] = f2bf(tile[tx * 65 + nn]); }
      }
    }
  }
  rot = (rot + nt) % nb;
}

DI void rmsnorm_phase(const float* __restrict__ s0, const float* __restrict__ s1, const float* __restrict__ g, u16* outb, float* outf, int gw, int nw) {
  const int lane = threadIdx.x & 63;
  for (int m = gw; m < M_TOT; m += nw) {
    const float* src = m < M_P ? s0 + (size_t)m * DM : s1 + (size_t)(m - M_P) * DM;
    f32x4 v[4];
#pragma unroll
    for (int i = 0; i < 4; ++i) v[i] = *(const f32x4*)(src + i * 256 + lane * 4);
    float ss = 0.f;
#pragma unroll
    for (int i = 0; i < 4; ++i) ss += v[i][0] * v[i][0] + v[i][1] * v[i][1] + v[i][2] * v[i][2] + v[i][3] * v[i][3];
#pragma unroll
    for (int o = 32; o > 0; o >>= 1) ss += __shfl_xor(ss, o);
    const float rs = rsqrtf(ss * (1.f / 1024.f) + 1e-6f);
#pragma unroll
    for (int i = 0; i < 4; ++i) {
      const f32x4 gg = *(const f32x4*)(g + i * 256 + lane * 4);
      const f32x4 y = v[i] * rs * gg;
      if (outb) { u32x2 w = {pk2(y[0], y[1]), pk2(y[2], y[3])}; *(u32x2*)(outb + (size_t)m * DM + i * 256 + lane * 4) = w; }
      else *(f32x4*)(outf + (size_t)m * DM + i * 256 + lane * 4) = y;
    }
  }
}

DI void prep_phase(const Params& p, char* lds, int bid, int nb) {
  float* tile = (float*)lds;
  char* ws = p.ws;
  int rot = 0;
  tr_job(p.ab_w_in, 1024, 2560, (u16*)(ws + WT_ABIN), 0, tile, bid, nb, rot);
  tr_job(p.ab_w_out, 1024, 1024, (u16*)(ws + WT_ABOUT), 0, tile, bid, nb, rot);
  tr_job(p.w_gate, 1024, FH, (u16*)(ws + WT_GU0), 1, tile, bid, nb, rot);
  tr_job(p.w_up, 1024, FH, (u16*)(ws + WT_GU0), 2, tile, bid, nb, rot);
  tr_job(p.w_gate + (size_t)1024 * FH, 1024, FH, (u16*)(ws + WT_GU1), 1, tile, bid, nb, rot);
  tr_job(p.w_up + (size_t)1024 * FH, 1024, FH, (u16*)(ws + WT_GU1), 2, tile, bid, nb, rot);
  tr_job(p.w_down, FH, 1024, (u16*)(ws + WT_DOWN0), 0, tile, bid, nb, rot);
  tr_job(p.w_down + (size_t)FH * 1024, FH, 1024, (u16*)(ws + WT_DOWN1), 0, tile, bid, nb, rot);
  tr_job(p.mla_w_in, 1024, 672, (u16*)(ws + WT_MLAIN), 0, tile, bid, nb, rot);
  tr_job(p.w_qb, 384, 1536, (u16*)(ws + WT_QB), 0, tile, bid, nb, rot);
  tr_job(p.w_kvb, 256, 2048, (u16*)(ws + WT_KVB), 0, tile, bid, nb, rot);
  tr_job(p.mla_w_out, 1024, 1024, (u16*)(ws + WT_MLAOUT), 0, tile, bid, nb, rot);
  for (int dg = 0; dg < 32; ++dg) {
    const int cb = dg & 7, gate = (dg >> 3) & 1, dir = dg >> 4;
    const float* src = (gate == 0 ? p.w_a : p.w_i) + (size_t)(dir * 8 + cb) * 4096;
    tr_job(src, 64, 64, (u16*)(ws + WT_GATES) + (size_t)dg * 4096, 0, tile, bid, nb, rot);
  }
  const int gtid = bid * 256 + VT, gn = nb * 256;
  { u16* d = (u16*)(ws + WT_MLAIN) + (size_t)672 * 1024; for (int i = gtid; i < 96 * 1024; i += gn) d[i] = 0; }
  { float* ct = (float*)(ws + OFF_COS); float* st = (float*)(ws + OFF_SIN);
    for (int i = gtid; i < 8192 * 16; i += gn) {
      const int pos = i >> 4, k = i & 15;
      const float inv_freq = 1.0f / powf(10000.0f, (float)(2 * k) / 32.0f);
      const float ang = (float)pos * inv_freq;
      double f = (double)ang * 0.15915494309189535; f -= rint(f);
      ct[i] = __builtin_amdgcn_cosf((float)f); st[i] = __builtin_amdgcn_sinf((float)f);
    } }
  rmsnorm_phase(p.xin0, p.xin1, p.norm_mix, (u16*)(ws + OFF_H), nullptr, bid * 4 + (VT >> 6), nb * 4);
}

constexpr int GP = 72;
enum { EPI_BF16 = 0, EPI_RESID = 1, EPI_SWIGLU = 2 };
template <int EPI>
DI void gemm_phase(const u16* __restrict__ A, int lda, const u16* __restrict__ Bt, int K, int N, u16* outb, int ldo,
                   const float* r0, const float* r1, float* outf, char* lds, int bid, int nb) {
  const int tid = threadIdx.x, lane = tid & 63, wid = tid >> 6, wr = wid >> 2, wc = wid & 3, r32 = lane & 31, hi = lane >> 5;
  u16* As = (u16*)lds; u16* Bs = As + 2 * 256 * GP;
  const int nN = N >> 8, nM = M_TOT >> 8, nT = nM * nN, nk = K >> 6;
  const int lrow = tid >> 3, lch = tid & 7;
  const bool swz = (nb == 256);
  const int GN = (nN & 1) == 0 ? 2 : 1, GM = 32 / GN, nSN = nN / GN, nST = (nM / GM) * nSN;
  const int xcd = bid & 7, jb = bid >> 3;
  const int nIter = swz ? (nST - xcd + 7) / 8 : (nT - bid + nb - 1) / nb;
  for (int it = 0; it < nIter; ++it) {
    int tm, tn;
    if (swz) { const int st = xcd + 8 * it, sm = st / nSN, sn = st - sm * nSN; tm = sm * GM + jb / GN; tn = sn * GN + (jb % GN); }
    else { const int t = bid + it * nb; tm = t / nN; tn = t - tm * nN; }
    const u16* Ag = A + (size_t)(tm * 256 + lrow) * lda + lch * 8;
    const u16* Bg = Bt + (size_t)(tn * 256 + lrow) * K + lch * 8;
    f32x16 acc[4][2];
#pragma unroll
    for (int i = 0; i < 4; ++i) { acc[i][0] = f32x16{}; acc[i][1] = f32x16{}; }
    u32x4 ra0[4], rb0[4], ra1[4], rb1[4];
#define SB() __builtin_amdgcn_sched_barrier(0)
#define G_LOAD(RA, RB, KT) do { _Pragma("unroll") for (int i = 0; i < 4; ++i) { RA[i] = *(const u32x4*)(Ag + (size_t)i * 64 * lda + (KT) * 64); RB[i] = *(const u32x4*)(Bg + (size_t)i * 64 * K + (KT) * 64); } } while (0)
#define G_STORE_A(RA, BUF) do { u16* ad = As + (BUF) * 256 * GP; _Pragma("unroll") for (int i = 0; i < 4; ++i) *(u32x4*)(ad + (lrow + 64 * i) * GP + lch * 8) = RA[i]; } while (0)
#define G_STORE_B(RB, BUF) do { u16* bd = Bs + (BUF) * 256 * GP; _Pragma("unroll") for (int i = 0; i < 4; ++i) *(u32x4*)(bd + (lrow + 64 * i) * GP + lch * 8) = RB[i]; } while (0)
#define G_MMA(BUF, KS) do { const u16* as = As + (BUF) * 256 * GP + (wr * 128 + r32) * GP + hi * 8 + (KS) * 16; const u16* bs = Bs + (BUF) * 256 * GP + (wc * 64 + r32) * GP + hi * 8 + (KS) * 16; \
        const bf16x8 b0 = *(const bf16x8*)(bs), b1 = *(const bf16x8*)(bs + 32 * GP); \
        bf16x8 a_[4]; _Pragma("unroll") for (int i = 0; i < 4; ++i) a_[i] = *(const bf16x8*)(as + i * 32 * GP); \
        __builtin_amdgcn_s_setprio(1); \
        _Pragma("unroll") for (int i = 0; i < 4; ++i) { acc[i][0] = MFMA32(a_[i], b0, acc[i][0]); acc[i][1] = MFMA32(a_[i], b1, acc[i][1]); } \
        __builtin_amdgcn_s_setprio(0); } while (0)
#define G_ITER(BUF, RAC, RBC, RAN, RBN, KT) do { \
      if ((KT) + 2 < nk) G_LOAD(RAC, RBC, (KT) + 2); \
      SB(); G_MMA(BUF, 0); SB(); \
      if ((KT) + 1 < nk) G_STORE_A(RAN, (BUF) ^ 1); \
      SB(); G_MMA(BUF, 1); SB(); \
      if ((KT) + 1 < nk) G_STORE_B(RBN, (BUF) ^ 1); \
      SB(); G_MMA(BUF, 2); G_MMA(BUF, 3); SB(); \
      __syncthreads(); } while (0)
    G_LOAD(ra0, rb0, 0);
    G_LOAD(ra1, rb1, 1);
    G_STORE_A(ra0, 0); G_STORE_B(rb0, 0);
    __syncthreads();
    for (int kt = 0; kt < nk; kt += 2) {
      G_ITER(0, ra0, rb0, ra1, rb1, kt);
      G_ITER(1, ra1, rb1, ra0, rb0, kt + 1);
    }
#undef G_LOAD
#undef G_STORE_A
#undef G_STORE_B
#undef G_MMA
#undef G_ITER
    const int mrow = tm * 256 + wr * 128;
    if constexpr (EPI == EPI_BF16) {
      const int col = tn * 256 + wc * 64 + r32;
#pragma unroll
      for (int i = 0; i < 4; ++i)
#pragma unroll
        for (int reg = 0; reg < 16; ++reg) {
          u16* o0 = outb + (size_t)(mrow + i * 32 + crow(reg, hi)) * ldo + col;
          o0[0] = f2bf(acc[i][0][reg]); o0[32] = f2bf(acc[i][1][reg]);
        }
    } else if constexpr (EPI == EPI_RESID) {
      const int col = tn * 256 + wc * 64 + r32;
      const float* rb_ = (tm * 256 < M_P) ? r0 : (r1 - (size_t)M_P * DM);
#pragma unroll
      for (int i = 0; i < 4; ++i)
#pragma unroll
        for (int reg = 0; reg < 16; ++reg) {
          const size_t i0 = (size_t)(mrow + i * 32 + crow(reg, hi)) * DM + col;
          const float x0 = rb_[i0], x1 = rb_[i0 + 32];
          outf[i0] = x0 + acc[i][0][reg]; outf[i0 + 32] = x1 + acc[i][1][reg];
        }
    } else {
      const int col = (tn * 4 + wc) * 32 + r32;
#pragma unroll
      for (int i = 0; i < 4; ++i)
#pragma unroll
        for (int reg = 0; reg < 16; ++reg) {
          const float g0 = acc[i][0][reg], u0 = acc[i][1][reg];
          outb[(size_t)(mrow + i * 32 + crow(reg, hi)) * ldo + col] = f2bf(g0 * sigmoidf_(g0) * u0);
        }
    }
  }
}

template <bool FINAL>
DI void rg_phase(const Params& p, char* lds, int bid, int nb) {
  const int tid = VT, lane = tid & 63, wid = tid >> 6, r32 = lane & 31, hi = lane >> 5;
  u16* xcb = (u16*)lds;
  float* A0 = (float*)(lds + 9216);
  float* U0 = (float*)(lds + 9216 + 16384);
  float* A1 = (float*)(lds + 9216 + 32768);
  float* U1 = (float*)(lds + 9216 + 49152);
  u16* raw = (u16*)A1;
  const u16* PROJ = (const u16*)(p.ws + OFF_PROJ);
  const u16* WG = (const u16*)(p.ws + WT_GATES);
  float* SUM = (float*)(p.ws + OFF_SUM);
  const float* CARRY = (const float*)(p.ws + OFF_CARRY);
  u16* Y = (u16*)(p.ws + OFF_Y);
  const int NIT = 768 * 8, nit = (NIT + nb - 1) / nb;
  const int mt = wid >> 1, nt = wid & 1;
  int cb_loaded = -1;
  float w0 = 0.f, w1 = 0.f, w2 = 0.f, w3 = 0.f, cbias = 0.f, bav[2] = {0.f, 0.f}, biv[2] = {0.f, 0.f}, spv[2] = {0.f, 0.f};
  u32x4 rr[3], rg[2], rrn[3], rgn[2];
  auto load_item = [&](int it, u32x4 (&xr)[3], u32x4 (&xg)[2]) {
    const int gc = it >> 3, cb = it & 7, m0 = gc * 64;
    int seq_lo, S; row_info(m0, seq_lo, S); const int seq_hi = seq_lo + S;
#pragma unroll
    for (int i = 0; i < 3; ++i) {
      const int c = tid + 256 * i, row = c >> 3, ch8 = c & 7, m = m0 - 2 + row;
      xr[i] = (c < 536 && m >= seq_lo && m < seq_hi) ? *(const u32x4*)(PROJ + (size_t)m * 2560 + cb * 64 + ch8 * 8) : (u32x4){0u, 0u, 0u, 0u};
    }
    if (FINAL) {
#pragma unroll
      for (int i = 0; i < 2; ++i) { const int c = tid + 256 * i, row = c >> 3, ch8 = c & 7; xg[i] = *(const u32x4*)(PROJ + (size_t)(m0 + row) * 2560 + 512 + cb * 64 + ch8 * 8); }
    }
  };
  { const int it = bid < NIT ? bid : NIT - 1; load_item(it, rr, rg); }
  for (int k = 0; k < nit; ++k) {
    const int it0 = bid + k * nb, it = it0 < NIT ? it0 : NIT - 1;
    const int gc = it >> 3, cb = it & 7, m0 = gc * 64;
    if (cb != cb_loaded) {
      cb_loaded = cb;
      const int cc = cb * 64 + (tid & 63);
      w0 = p.conv_w[cc]; w1 = p.conv_w[512 + cc]; w2 = p.conv_w[1024 + cc]; w3 = p.conv_w[1536 + cc]; cbias = p.conv_b[cc];
      const int cg_ = cb * 64 + nt * 32 + r32;
#pragma unroll
      for (int dir = 0; dir < 2; ++dir) { bav[dir] = p.b_a[dir * 512 + cg_]; biv[dir] = p.b_i[dir * 512 + cg_]; spv[dir] = log1pf(__expf(-p.lam[dir * 512 + cg_])); }
    }
    __syncthreads();
#pragma unroll
    for (int i = 0; i < 3; ++i) { const int c = tid + 256 * i; if (c < 536) *(u32x4*)(raw + c * 8) = rr[i]; }
    { const int itn0 = bid + (k + 1) * nb, itn = itn0 < NIT ? itn0 : NIT - 1; load_item(itn, rrn, rgn); }
    __syncthreads();
    {
      const int ch = tid & 63, t0 = (tid >> 6) * 16;
      float xm2 = bf2f(raw[(t0) * 64 + ch]), xm1 = bf2f(raw[(t0 + 1) * 64 + ch]), x0 = bf2f(raw[(t0 + 2) * 64 + ch]);
#pragma unroll
      for (int t = t0; t < t0 + 16; ++t) {
        const float xp1 = bf2f(raw[(t + 3) * 64 + ch]);
        xcb[t * 72 + ch] = f2bf(w0 * xm2 + w1 * xm1 + w2 * x0 + w3 * xp1 + cbias);
        xm2 = xm1; xm1 = x0; x0 = xp1;
      }
    }
    __syncthreads();
    {
      bf16x8 af[4];
#pragma unroll
      for (int ks = 0; ks < 4; ++ks) af[ks] = *(const bf16x8*)(xcb + (mt * 32 + r32) * 72 + ks * 16 + 8 * hi);
      const int ch = nt * 32 + r32;
      float xc[16];
#pragma unroll
      for (int reg = 0; reg < 16; ++reg) xc[reg] = bf2f(xcb[(mt * 32 + crow(reg, hi)) * 72 + ch]);
#pragma unroll
      for (int dir = 0; dir < 2; ++dir) {
        f32x16 aa = {}, ai = {};
        const u16* wga = WG + (size_t)((dir * 2 + 0) * 8 + cb) * 4096 + (nt * 32 + r32) * 64 + 8 * hi;
        const u16* wgi = WG + (size_t)((dir * 2 + 1) * 8 + cb) * 4096 + (nt * 32 + r32) * 64 + 8 * hi;
#pragma unroll
        for (int ks = 0; ks < 4; ++ks) { const bf16x8 ba = *(const bf16x8*)(wga + ks * 16), bi = *(const bf16x8*)(wgi + ks * 16); aa = MFMA32(af[ks], ba, aa); ai = MFMA32(af[ks], bi, ai); }
        float* Ab = dir == 0 ? A0 : A1; float* Ub = dir == 0 ? U0 : U1;
#pragma unroll
        for (int reg = 0; reg < 16; ++reg) {
          const int tok = mt * 32 + crow(reg, hi);
          const float r = sigmoidf_(aa[reg] + bav[dir]), gi = sigmoidf_(ai[reg] + biv[dir]);
          const float la2 = -8.f * 1.4426950408889634f * r * spv[dir], a = __builtin_amdgcn_exp2f(la2);
          const float mult = __builtin_amdgcn_sqrtf(fmaxf(0.f, 1.f - a * a));
          Ab[tok * 64 + ch] = a; Ub[tok * 64 + ch] = mult * gi * xc[reg];
        }
      }
    }
    __syncthreads();
    if (wid < 2) {
      const int dir = wid, ch = lane, c = cb * 64 + ch;
      float* Ab = dir == 0 ? A0 : A1; float* Ub = dir == 0 ? U0 : U1;
      if (!FINAL) {
        float h = 0.f, P = 1.f;
#pragma unroll 16
        for (int kk = 0; kk < 64; ++kk) { const int t = dir == 0 ? kk : 63 - kk; const float a = Ab[t * 64 + ch], u = Ub[t * 64 + ch]; h = a * h + u; P *= a; }
        SUM[(size_t)((gc * 2 + dir) * 2 + 0) * 512 + c] = P; SUM[(size_t)((gc * 2 + dir) * 2 + 1) * 512 + c] = h;
      } else {
        float h = CARRY[(size_t)(gc * 2 + dir) * 512 + c];
#pragma unroll 16
        for (int kk = 0; kk < 64; ++kk) { const int t = dir == 0 ? kk : 63 - kk; const float a = Ab[t * 64 + ch], u = Ub[t * 64 + ch]; h = a * h + u; Ub[t * 64 + ch] = h; }
      }
    }
    if (FINAL) {
      __syncthreads();
#pragma unroll
      for (int i = 0; i < 2; ++i) {
        const int c = tid + 256 * i, t = c >> 3, ch8 = c & 7;
        const f32x4 ha = *(const f32x4*)(U0 + t * 64 + ch8 * 8), hb = *(const f32x4*)(U0 + t * 64 + ch8 * 8 + 4);
        const f32x4 hc = *(const f32x4*)(U1 + t * 64 + ch8 * 8), hd = *(const f32x4*)(U1 + t * 64 + ch8 * 8 + 4);
        float hs[8] = {ha[0] + hc[0], ha[1] + hc[1], ha[2] + hc[2], ha[3] + hc[3], hb[0] + hd[0], hb[1] + hd[1], hb[2] + hd[2], hb[3] + hd[3]};
        float yv[8];
#pragma unroll
        for (int j = 0; j < 8; ++j) {
          const unsigned wv = rg[i][j >> 1];
          const float gt = __uint_as_float((j & 1) ? (wv & 0xffff0000u) : (wv << 16));
          const float ge = gt * sigmoidf_(1.5957691216057308f * (gt + 0.044715f * gt * gt * gt));
          yv[j] = ge * hs[j];
        }
        u32x4 o = {pk2(yv[0], yv[1]), pk2(yv[2], yv[3]), pk2(yv[4], yv[5]), pk2(yv[6], yv[7])};
        *(u32x4*)(Y + (size_t)(m0 + t) * 1024 + cb * 64 + ch8 * 8) = o;
      }
    }
#pragma unroll
    for (int i = 0; i < 3; ++i) rr[i] = rrn[i];
#pragma unroll
    for (int i = 0; i < 2; ++i) rg[i] = rgn[i];
  }
}

DI void rg_carry_phase(const Params& p, int bid, int nb) {
  const float* __restrict__ SUM = (const float*)(p.ws + OFF_SUM);
  float* __restrict__ CARRY = (float*)(p.ws + OFF_CARRY);
  for (int idx = bid * 256 + VT; idx < 8192; idx += nb * 256) {
    const int c = idx & 511, dir = (idx >> 9) & 1, seq = idx >> 10;
    const int gc0 = seq < 4 ? seq * 128 : 512 + (seq - 4) * 64, nch = seq < 4 ? 128 : 64;
    float carry = 0.f;
    for (int k0 = 0; k0 < nch; k0 += 8) {
      float P[8], Hh[8];
#pragma unroll
      for (int j = 0; j < 8; ++j) { const int k = k0 + j, gc = dir == 0 ? gc0 + k : gc0 + nch - 1 - k; P[j] = SUM[(size_t)((gc * 2 + dir) * 2 + 0) * 512 + c]; Hh[j] = SUM[(size_t)((gc * 2 + dir) * 2 + 1) * 512 + c]; }
#pragma unroll
      for (int j = 0; j < 8; ++j) { const int k = k0 + j, gc = dir == 0 ? gc0 + k : gc0 + nch - 1 - k; CARRY[(size_t)(gc * 2 + dir) * 512 + c] = carry; carry = P[j] * carry + Hh[j]; }
    }
  }
}

DI void dil_tile_info(int ti, int m0, int& d, int& u0) {
  if (ti < 5) { d = 16; u0 = m0 - 1024 + ti * 512; } else if (ti < 13) { d = 4; u0 = m0 - 256 + (ti - 5) * 128; } else { d = 1; u0 = m0 - 64 + (ti - 13) * 32; }
}
DI void dilated_phase(const Params& p, char* lds, int gw, int nw) {
  const int lane = VT & 63, wid = VT >> 6, r32 = lane & 31, hi = lane >> 5;
  u16* Vl = (u16*)(lds + wid * 6144);
  const unsigned vbase = (unsigned)(uintptr_t)Vl;
  const int li = lane & 15, tq = li >> 2, tp = li & 3, g1 = (lane >> 4) & 1;
  const unsigned trb = vbase + (4 * hi + tq) * 192 + (16 * g1 + 4 * tp) * 2;
  const u16* PROJ = (const u16*)(p.ws + OFF_PROJ);
  u16* Y = (u16*)(p.ws + OFF_Y);
  const int vrow = lane >> 3, vch = lane & 7;
  for (int id = gw; id < 12288; id += nw) {
    const int res = id & 15, h = (id >> 4) & 7, sp = id >> 7;
    const int m0 = sp * 512 + res;
    int seq_lo, S; row_info(sp * 512, seq_lo, S); const int seq_hi = seq_lo + S;
    const int mq = m0 + 16 * r32;
    bf16x8 qf[4];
#pragma unroll
    for (int ks = 0; ks < 4; ++ks) qf[ks] = *(const bf16x8*)(PROJ + (size_t)mq * 2560 + 1024 + h * 64 + ks * 16 + 8 * hi);
    const float slope2 = exp2f(-(float)(h + 1)) * LOG2E;
    const float c1 = 0.125f * LOG2E;
    float m_run = -1e30f, l_run = 0.f; f32x16 o0 = {}, o1 = {};
    const u16* kbase = PROJ + 1536 + h * 64 + 8 * hi;
    const u16* vbaseg = PROJ + 2048 + h * 64 + vch * 8;
    bf16x8 kf[4]; u32x4 vr[4];
    { int d, u0; dil_tile_info(0, m0, d, u0);
      const int ur = min(max(u0 + d * r32, seq_lo), seq_hi - 1);
#pragma unroll
      for (int ks = 0; ks < 4; ++ks) kf[ks] = *(const bf16x8*)(kbase + (size_t)ur * 2560 + ks * 16);
#pragma unroll
      for (int i = 0; i < 4; ++i) { const int uv = min(max(u0 + d * (vrow + 8 * i), seq_lo), seq_hi - 1); vr[i] = *(const u32x4*)(vbaseg + (size_t)uv * 2560); } }
#pragma unroll 1
    for (int ti = 0; ti < 33; ++ti) {
      int d, u0; dil_tile_info(ti, m0, d, u0);
#pragma unroll
      for (int i = 0; i < 4; ++i) *(u32x4*)(Vl + (vrow + 8 * i) * 96 + vch * 8) = vr[i];
      f32x16 pt = {};
#pragma unroll
      for (int ks = 0; ks < 4; ++ks) pt = MFMA32(kf[ks], qf[ks], pt);
      if (ti + 1 < 33) {
        int dn, un; dil_tile_info(ti + 1, m0, dn, un);
        const int ur = min(max(un + dn * r32, seq_lo), seq_hi - 1);
#pragma unroll
        for (int ks = 0; ks < 4; ++ks) kf[ks] = *(const bf16x8*)(kbase + (size_t)ur * 2560 + ks * 16);
#pragma unroll
        for (int i = 0; i < 4; ++i) { const int uv = min(max(un + dn * (vrow + 8 * i), seq_lo), seq_hi - 1); vr[i] = *(const u32x4*)(vbaseg + (size_t)uv * 2560); }
      }
      const s16x4 l00 = tr_read_o<0>(trb), h00 = tr_read_o<8 * 192>(trb), l01 = tr_read_o<64>(trb), h01 = tr_read_o<8 * 192 + 64>(trb);
      const s16x4 l10 = tr_read_o<16 * 192>(trb), h10 = tr_read_o<24 * 192>(trb), l11 = tr_read_o<16 * 192 + 64>(trb), h11 = tr_read_o<24 * 192 + 64>(trb);
      const int du0 = u0 - mq + d * 4 * hi, lim = 64 * d;
      float pmax = -INFINITY;
#pragma unroll
      for (int reg = 0; reg < 16; ++reg) {
        const int du = du0 + d * ((reg & 3) + 8 * (reg >> 2)), u = mq + du, ad = du < 0 ? -du : du;
        const bool valid = (ad <= lim) && (u >= seq_lo) && (u < seq_hi);
        const float tv = valid ? (pt[reg] * c1 - slope2 * (float)ad) : -INFINITY;
        pt[reg] = tv; pmax = fmaxf(pmax, tv);
      }
      pmax = pl32_max(pmax);
      if (__any(pmax > m_run)) {
        const float mn = fmaxf(m_run, pmax), alpha = __builtin_amdgcn_exp2f(m_run - mn);
        m_run = mn; l_run *= alpha;
#pragma unroll
        for (int reg = 0; reg < 16; ++reg) { o0[reg] *= alpha; o1[reg] *= alpha; }
      }
      float ps = 0.f;
#pragma unroll
      for (int reg = 0; reg < 16; ++reg) { pt[reg] = __builtin_amdgcn_exp2f(pt[reg] - m_run); ps += pt[reg]; }
      ps = pl32_sum(ps);
      l_run += ps;
      const bf16x8 pb0 = pack8(pt, 0), pb1 = pack8(pt, 1);
      LGKM0();
      o0 = MFMA32(cat4(l00, h00), pb0, o0); o0 = MFMA32(cat4(l10, h10), pb1, o0);
      o1 = MFMA32(cat4(l01, h01), pb0, o1); o1 = MFMA32(cat4(l11, h11), pb1, o1);
    }
    const float inv = 1.f / l_run;
    u16* yo = Y + (size_t)mq * 1024 + 512 + h * 64 + 4 * hi;
#pragma unroll
    for (int g = 0; g < 4; ++g) {
      u32x2 w0 = {pk2(o0[4 * g] * inv, o0[4 * g + 1] * inv), pk2(o0[4 * g + 2] * inv, o0[4 * g + 3] * inv)};
      u32x2 w1 = {pk2(o1[4 * g] * inv, o1[4 * g + 1] * inv), pk2(o1[4 * g + 2] * inv, o1[4 * g + 3] * inv)};
      *(u32x2*)(yo + 8 * g) = w0; *(u32x2*)(yo + 32 + 8 * g) = w1;
    }
  }
}

DI void mla_norm_phase(const Params& p, int gw, int nw) {
  const int lane = threadIdx.x & 63;
  const u16* P2 = (const u16*)(p.ws + OFF_P2);
  u16* CQN = (u16*)(p.ws + OFF_CQN); u16* CKVN = (u16*)(p.ws + OFF_CKVN); u16* KR = (u16*)(p.ws + OFF_KR);
  const float* ct = (const float*)(p.ws + OFF_COS); const float* st = (const float*)(p.ws + OFF_SIN);
  for (int m = gw; m < M_TOT; m += nw) {
    const u16* src = P2 + (size_t)m * 768;
    float q[6], kv[4]; float sq = 0.f, skv = 0.f;
#pragma unroll
    for (int i = 0; i < 6; ++i) { q[i] = bf2f(src[i * 64 + lane]); sq += q[i] * q[i]; }
#pragma unroll
    for (int i = 0; i < 4; ++i) { kv[i] = bf2f(src[384 + i * 64 + lane]); skv += kv[i] * kv[i]; }
#pragma unroll
    for (int o = 32; o > 0; o >>= 1) { sq += __shfl_xor(sq, o); skv += __shfl_xor(skv, o); }
    const float rq = rsqrtf(sq * (1.f / 384.f) + 1e-6f), rkv = rsqrtf(skv * (1.f / 256.f) + 1e-6f);
#pragma unroll
    for (int i = 0; i < 6; ++i) CQN[(size_t)m * 384 + i * 64 + lane] = f2bf(q[i] * rq * p.q_norm[i * 64 + lane]);
#pragma unroll
    for (int i = 0; i < 4; ++i) CKVN[(size_t)m * 256 + i * 64 + lane] = f2bf(kv[i] * rkv * p.kv_norm[i * 64 + lane]);
    if (lane < 16) {
      const int pos = m < M_P ? (m & 8191) : ((m - M_P) & 4095);
      const float t1 = bf2f(src[640 + lane]), t2 = bf2f(src[656 + lane]);
      const float c = ct[pos * 16 + lane], s = st[pos * 16 + lane];
      KR[(size_t)m * 32 + lane] = f2bf(t1 * c - t2 * s); KR[(size_t)m * 32 + 16 + lane] = f2bf(t1 * s + t2 * c);
    }
  }
}

constexpr int KP = 104, VP = 96;
DI void mla_unit(const Params& p, char* lds, int seqbase, int S, int h, int qb, int half) {
  const int tid = VT, lane = tid & 63, wid = tid >> 6, r32 = lane & 31, hi = lane >> 5;
  u16* Kl = (u16*)lds;
  u16* Vl = (u16*)(lds + 3 * 64 * KP * 2);
  const unsigned vbase = (unsigned)(uintptr_t)Vl;
  const int li = lane & 15, tq = li >> 2, tp = li & 3, g1 = (lane >> 4) & 1;
  const unsigned trb = vbase + (4 * hi + tq) * (VP * 2) + (16 * g1 + 4 * tp) * 2;
  const u16* Q = (const u16*)(p.ws + OFF_Q); const u16* KV = (const u16*)(p.ws + OFF_KV); const u16* KR = (const u16*)(p.ws + OFF_KR);
  u16* O = (u16*)(p.ws + OFF_O);
  const float* ct = (const float*)(p.ws + OFF_COS); const float* st = (const float*)(p.ws + OFF_SIN);
  const int pos = qb * 128 + wid * 32 + r32, qrow = seqbase + pos;
  bf16x8 qf[6];
#pragma unroll
  for (int d0 = 0; d0 < 6; ++d0) qf[d0] = *(const bf16x8*)(Q + (size_t)qrow * 1536 + h * 96 + d0 * 16 + 8 * hi);
  const float C = 0.10206207261596577f * LOG2E;
#pragma unroll
  for (int j = 0; j < 8; ++j) {
    const float c = ct[pos * 16 + 8 * hi + j], s = st[pos * 16 + 8 * hi + j];
    const float t1 = bfs2f(qf[4][j]), t2 = bfs2f(qf[5][j]);
    qf[4][j] = (short)f2bf((t1 * c - t2 * s) * C); qf[5][j] = (short)f2bf((t1 * s + t2 * c) * C);
  }
#pragma unroll
  for (int d0 = 0; d0 < 4; ++d0)
#pragma unroll
    for (int j = 0; j < 8; ++j) qf[d0][j] = (short)f2bf(bfs2f(qf[d0][j]) * C);
  const u16* ksrc[3]; int kdst[3];
#pragma unroll
  for (int i = 0; i < 3; ++i) {
    const int idx = tid + 256 * i, row = idx / 12, c = idx - row * 12;
    ksrc[i] = c < 8 ? KV + (size_t)(seqbase + row) * 2048 + h * 128 + c * 8 : KR + (size_t)(seqbase + row) * 32 + (c - 8) * 8;
    kdst[i] = row * KP + c * 8;
  }
  const int kstride[3] = {0, 0, 0}; (void)kstride;
  const int vrow = tid >> 3, vc = tid & 7;
  const u16* vsrc = KV + (size_t)(seqbase + vrow) * 2048 + h * 128 + 64 + vc * 8;
  const int vdst = vrow * VP + vc * 8;
  size_t kadv[3];
#pragma unroll
  for (int i = 0; i < 3; ++i) { const int idx = tid + 256 * i, row = idx / 12, c = idx - row * 12; (void)row; kadv[i] = c < 8 ? (size_t)64 * 2048 : (size_t)64 * 32; }
  float l_run = 0.f; f32x16 o0 = {}, o1 = {}, negm = {};
  const int nkt = S >> 6;
  u32x4 rk[3], rv[2];
#define MLA_GLOAD(T) do { _Pragma("unroll") for (int i = 0; i < 3; ++i) rk[i] = *(const u32x4*)(ksrc[i] + (size_t)(T) * kadv[i]); \
    rv[0] = *(const u32x4*)(vsrc + (size_t)(T) * 64 * 2048); rv[1] = *(const u32x4*)(vsrc + (size_t)(T) * 64 * 2048 + (size_t)32 * 2048); } while (0)
#define MLA_LSTORE(B) do { u16* kd = Kl + (B) * 64 * KP; u16* vd = Vl + (B) * 64 * VP; _Pragma("unroll") for (int i = 0; i < 3; ++i) *(u32x4*)(kd + kdst[i]) = rk[i]; \
    *(u32x4*)(vd + vdst) = rv[0]; *(u32x4*)(vd + vdst + 32 * VP) = rv[1]; } while (0)
  MLA_GLOAD(0); MLA_LSTORE(0);
  MLA_GLOAD(1); MLA_LSTORE(1);
  __syncthreads();
  int cur = 0, nx2 = 2;
#pragma unroll 1
  for (int kt = 0; kt < nkt; ++kt) {
    if (kt + 2 < nkt) MLA_GLOAD(kt + 2);
    const u16* kl = Kl + cur * 64 * KP + r32 * KP + 8 * hi;
    f32x16 p0, p1;
    { const bf16x8 k0 = *(const bf16x8*)(kl), k1 = *(const bf16x8*)(kl + 32 * KP);
      p0 = MFMA32(k0, qf[0], negm); p1 = MFMA32(k1, qf[0], negm); }
#pragma unroll
    for (int d0 = 1; d0 < 6; ++d0) {
      const bf16x8 k0 = *(const bf16x8*)(kl + d0 * 16), k1 = *(const bf16x8*)(kl + 32 * KP + d0 * 16);
      p0 = MFMA32(k0, qf[d0], p0); p1 = MFMA32(k1, qf[d0], p1);
    }
    const unsigned tb = trb + cur * (64 * VP * 2);
    constexpr int R8 = 8 * VP * 2;
    const s16x4 a0 = tr_read_o<0>(tb), b0 = tr_read_o<R8>(tb), a1 = tr_read_o<2 * R8>(tb), b1 = tr_read_o<3 * R8>(tb);
    const s16x4 a2 = tr_read_o<4 * R8>(tb), b2 = tr_read_o<5 * R8>(tb), a3 = tr_read_o<6 * R8>(tb), b3 = tr_read_o<7 * R8>(tb);
    const s16x4 c0 = tr_read_o<64>(tb), d0_ = tr_read_o<R8 + 64>(tb), c1 = tr_read_o<2 * R8 + 64>(tb), d1 = tr_read_o<3 * R8 + 64>(tb);
    const s16x4 c2 = tr_read_o<4 * R8 + 64>(tb), d2 = tr_read_o<5 * R8 + 64>(tb), c3 = tr_read_o<6 * R8 + 64>(tb), d3 = tr_read_o<7 * R8 + 64>(tb);
    if (half == 1) __syncthreads();
    float pmax = max_nn(p0[0], p1[0]);
#pragma unroll
    for (int r = 1; r < 16; ++r) pmax = max_nn(pmax, max_nn(p0[r], p1[r]));
    pmax = pl32_max(pmax);
    if (kt == 0 || __any(pmax > 8.f)) {
      const float delta = kt == 0 ? pmax : fmaxf(pmax, 0.f);
      const float alpha = kt == 0 ? 1.f : __builtin_amdgcn_exp2f(-delta);
#pragma unroll
      for (int r = 0; r < 16; ++r) { negm[r] -= delta; p0[r] -= delta; p1[r] -= delta; o0[r] *= alpha; o1[r] *= alpha; }
      l_run *= alpha;
    }
    float ps = 0.f;
#pragma unroll
    for (int r = 0; r < 16; ++r) { p0[r] = __builtin_amdgcn_exp2f(p0[r]); p1[r] = __builtin_amdgcn_exp2f(p1[r]); ps += p0[r] + p1[r]; }
    ps = pl32_sum(ps);
    l_run += ps;
    const bf16x8 pb0 = pack8(p0, 0), pb1 = pack8(p0, 1), pb2 = pack8(p1, 0), pb3 = pack8(p1, 1);
    LGKM0();
    o0 = MFMA32(cat4(a0, b0), pb0, o0); o1 = MFMA32(cat4(c0, d0_), pb0, o1);
    o0 = MFMA32(cat4(a1, b1), pb1, o0); o1 = MFMA32(cat4(c1, d1), pb1, o1);
    o0 = MFMA32(cat4(a2, b2), pb2, o0); o1 = MFMA32(cat4(c2, d2), pb2, o1);
    o0 = MFMA32(cat4(a3, b3), pb3, o0); o1 = MFMA32(cat4(c3, d3), pb3, o1);
    if (half == 0) __syncthreads();
    if (kt + 2 < nkt) MLA_LSTORE(nx2);
    cur = cur == 2 ? 0 : cur + 1; nx2 = nx2 == 2 ? 0 : nx2 + 1;
  }
  __syncthreads();
#undef MLA_GLOAD
#undef MLA_LSTORE
  const float inv = 1.f / l_run;
  u16* oo = O + (size_t)qrow * 1024 + h * 64 + 4 * hi;
#pragma unroll
  for (int g = 0; g < 4; ++g) {
    u32x2 w0 = {pk2(o0[4 * g] * inv, o0[4 * g + 1] * inv), pk2(o0[4 * g + 2] * inv, o0[4 * g + 3] * inv)};
    u32x2 w1 = {pk2(o1[4 * g] * inv, o1[4 * g + 1] * inv), pk2(o1[4 * g + 2] * inv, o1[4 * g + 3] * inv)};
    *(u32x2*)(oo + 8 * g) = w0; *(u32x2*)(oo + 32 + 8 * g) = w1;
  }
}

DI void mla_attn_phase(const Params& p, char* lds, int xcd, int j, int nper, int half) {
  for (int lu0 = j; lu0 - j < 8 * 64; lu0 += nper) { const int lu = lu0 < 8 * 64 ? lu0 : 8 * 64 - 1; const int bh = (lu >> 6) * 8 + xcd, qb = lu & 63; mla_unit(p, lds, (bh >> 4) * 8192, 8192, bh & 15, qb, half); }
  for (int lu0 = j; lu0 - j < 8 * 32; lu0 += nper) { const int lu = lu0 < 8 * 32 ? lu0 : 8 * 32 - 1; const int bh = (lu >> 5) * 8 + xcd, qb = lu & 31; mla_unit(p, lds, M_P + (bh >> 4) * 4096, 4096, bh & 15, qb, half); }
}

#define XB_TMO      128
#define XB_XCNT(j)  (256  + 64 * (j))
#define XB_XSUB(j)  (1280 + 64 * (j))
#define XB_XGEN(j)  (2304 + 64 * (j))
#define XB_TOP      3328
#define XB_TOPGEN   3392
#define XCD_BAR_WORDS 3456
#define XB_SPIN_CAP (1u << 20)
#define LAS __attribute__((address_space(3)))
DI unsigned xb_ld(unsigned* p) { return __hip_atomic_load(p, __ATOMIC_RELAXED, __HIP_MEMORY_SCOPE_AGENT); }
DI unsigned xb_add(unsigned* p, unsigned v) { return __hip_atomic_fetch_add(p, v, __ATOMIC_RELAXED, __HIP_MEMORY_SCOPE_AGENT); }
DI unsigned xb_xcc_id() { return (unsigned)__builtin_amdgcn_s_getreg((3 << 11) | 20) & 0xFu; }
#define XB_SPIN(cond, bar) do { unsigned _sp = 0; while (cond) { __builtin_amdgcn_s_sleep(1); \
    if ((++_sp & 255u) == 0u) { if (xb_ld(&(bar)[XB_TMO])) break; if (_sp > XB_SPIN_CAP) { atomicAdd(&(bar)[XB_TMO], 1u); break; } } } } while (0)
struct XcdBarrier { unsigned* bar; unsigned x; volatile LAS unsigned* st; };
DI XcdBarrier xcd_barrier_post(unsigned* bar, volatile LAS unsigned* st) {
  XcdBarrier b; b.bar = bar; b.x = xb_xcc_id(); b.st = st;
  if (threadIdx.x == 0) (void)xb_add(&bar[XB_XCNT(b.x)], 1u);
  return b;
}
DI void xcd_barrier_complete(unsigned* bar, unsigned x, unsigned& nloc, unsigned& nx) {
  const unsigned G = gridDim.x * gridDim.y * gridDim.z;
  unsigned sum, cnt, mine, sp = 0u;
  for (;;) {
    sum = 0u; cnt = 0u; mine = 0u;
#pragma unroll
    for (unsigned j = 0; j < 16; ++j) { const unsigned c = xb_ld(&bar[XB_XCNT(j)]); sum += c; cnt += (c > 0u) ? 1u : 0u; mine = (j == x) ? c : mine; }
    if (sum == G) break;
    __builtin_amdgcn_s_sleep(1);
    if ((++sp & 255u) == 0u) { if (xb_ld(&bar[XB_TMO])) break; if (sp > XB_SPIN_CAP) { atomicAdd(&bar[XB_TMO], 1u); break; } }
  }
  nloc = mine > 0u ? mine : 1u; nx = cnt > 0u ? cnt : 1u;
}
DI void xcd_barrier(const XcdBarrier& b) {
  asm volatile("s_waitcnt vmcnt(0)" ::: "memory");
  __syncthreads();
  if (threadIdx.x == 0) {
    unsigned* bar = b.bar;
    __builtin_amdgcn_s_waitcnt(0);
    unsigned nloc = b.st[0], nx = b.st[1];
    if (nloc == 0u) { xcd_barrier_complete(bar, b.x, nloc, nx); b.st[0] = nloc; b.st[1] = nx; }
    const unsigned old = xb_add(&bar[XB_XSUB(b.x)], 1u);
    const unsigned gen = old / nloc;
    if (old + 1u == (gen + 1u) * nloc) {
      __builtin_amdgcn_fence(__ATOMIC_RELEASE, "agent");
      asm volatile("s_waitcnt vmcnt(0)" ::: "memory");
      const unsigned og = xb_add(&bar[XB_TOP], 1u);
      const unsigned tg = og / nx;
      if (og + 1u == (tg + 1u) * nx) xb_add(&bar[XB_TOPGEN], 1u);
      else XB_SPIN(xb_ld(&bar[XB_TOPGEN]) == tg, bar);
      __builtin_amdgcn_fence(__ATOMIC_ACQUIRE, "agent");
      xb_add(&bar[XB_XGEN(b.x)], 1u);
      asm volatile("s_waitcnt vmcnt(0)" ::: "memory");
    } else {
      XB_SPIN(xb_ld(&bar[XB_XGEN(b.x)]) == gen, bar);
      __builtin_amdgcn_fence(__ATOMIC_ACQUIRE, "agent");
      asm volatile("s_waitcnt vmcnt(0)" ::: "memory");
    }
  }
  __syncthreads();
}

constexpr int N_PHASES = 19;
constexpr int HALF_LDS = 76800;
constexpr int LDS_BYTES = 2 * HALF_LDS;
__global__ void __launch_bounds__(512, 2) mega(Params p, int ph_lo, int ph_hi) {
  __shared__ __attribute__((aligned(16))) char lds_all[LDS_BYTES];
  const int rbid = blockIdx.x, rnb = gridDim.x;
  const int half = __builtin_amdgcn_readfirstlane((int)(threadIdx.x >> 8));
  const int bid = rbid * 2 + half, nb = rnb * 2;
  char* lds = lds_all + half * HALF_LDS;
  const int gw = bid * 4 + __builtin_amdgcn_readfirstlane(VT >> 6), nw = nb * 4;
  char* ws = p.ws;
  float* out1 = p.out + (size_t)M_P * DM;
  __shared__ uint4 xb_words;
  if (threadIdx.x == 0) xb_words = make_uint4(0u, 0u, 0u, 0u);
  __syncthreads();
  XcdBarrier xb; xb.bar = (unsigned*)(ws + OFF_BAR); xb.x = 0; xb.st = (volatile LAS unsigned*)&xb_words;
  if (ph_hi - ph_lo > 1) xb = xcd_barrier_post((unsigned*)(ws + OFF_BAR), (volatile LAS unsigned*)&xb_words);
  if (ph_lo < 0) cg::this_grid().sync();
#ifndef DUP_MASK
#define DUP_MASK 0
#endif
#define PHASE(k, ...) do { if (ph_lo <= (k) && (k) < ph_hi) { __VA_ARGS__ if ((DUP_MASK >> (k)) & 1) { xcd_barrier(xb); __VA_ARGS__ } } if (ph_lo <= (k) && (k) + 1 < ph_hi) xcd_barrier(xb); } while (0)
  PHASE(0, prep_phase(p, lds, bid, nb););
  PHASE(1, gemm_phase<EPI_BF16>((const u16*)(ws + OFF_H), 1024, (const u16*)(ws + WT_ABIN), 1024, 2560, (u16*)(ws + OFF_PROJ), 2560, nullptr, nullptr, nullptr, lds_all, rbid, rnb););
  PHASE(2, rg_phase<false>(p, lds, bid, nb); __syncthreads(); dilated_phase(p, lds, gw, nw););
  PHASE(3, rg_carry_phase(p, bid, nb););
  PHASE(4, rg_phase<true>(p, lds, bid, nb););
  PHASE(5, gemm_phase<EPI_RESID>((const u16*)(ws + OFF_Y), 1024, (const u16*)(ws + WT_ABOUT), 1024, 1024, nullptr, 0, p.xin0, p.xin1, p.out, lds_all, rbid, rnb););
  PHASE(6, rmsnorm_phase(p.out, out1, p.norm_ffn, (u16*)(ws + OFF_H), nullptr, gw, nw););
  PHASE(7, gemm_phase<EPI_SWIGLU>((const u16*)(ws + OFF_H), 1024, (const u16*)(ws + WT_GU0), 1024, 5632, (u16*)(ws + OFF_ACT), FH, nullptr, nullptr, nullptr, lds_all, rbid, rnb););
  PHASE(8, gemm_phase<EPI_RESID>((const u16*)(ws + OFF_ACT), FH, (const u16*)(ws + WT_DOWN0), FH, 1024, nullptr, 0, p.out, out1, p.out, lds_all, rbid, rnb););
  PHASE(9, rmsnorm_phase(p.out, out1, p.norm_mix + 1024, (u16*)(ws + OFF_H), nullptr, gw, nw););
  PHASE(10, gemm_phase<EPI_BF16>((const u16*)(ws + OFF_H), 1024, (const u16*)(ws + WT_MLAIN), 1024, 768, (u16*)(ws + OFF_P2), 768, nullptr, nullptr, nullptr, lds_all, rbid, rnb););
  PHASE(11, mla_norm_phase(p, gw, nw););
  PHASE(12, gemm_phase<EPI_BF16>((const u16*)(ws + OFF_CQN), 384, (const u16*)(ws + WT_QB), 384, 1536, (u16*)(ws + OFF_Q), 1536, nullptr, nullptr, nullptr, lds_all, rbid, rnb); gemm_phase<EPI_BF16>((const u16*)(ws + OFF_CKVN), 256, (const u16*)(ws + WT_KVB), 256, 2048, (u16*)(ws + OFF_KV), 2048, nullptr, nullptr, nullptr, lds_all, rbid, rnb););
  PHASE(13, mla_attn_phase(p, lds, rbid & 7, (rbid >> 3) * 2 + half, (rnb >> 3) * 2, half););
  PHASE(14, gemm_phase<EPI_RESID>((const u16*)(ws + OFF_O), 1024, (const u16*)(ws + WT_MLAOUT), 1024, 1024, nullptr, 0, p.out, out1, p.out, lds_all, rbid, rnb););
  PHASE(15, rmsnorm_phase(p.out, out1, p.norm_ffn + 1024, (u16*)(ws + OFF_H), nullptr, gw, nw););
  PHASE(16, gemm_phase<EPI_SWIGLU>((const u16*)(ws + OFF_H), 1024, (const u16*)(ws + WT_GU1), 1024, 5632, (u16*)(ws + OFF_ACT), FH, nullptr, nullptr, nullptr, lds_all, rbid, rnb););
  PHASE(17, gemm_phase<EPI_RESID>((const u16*)(ws + OFF_ACT), FH, (const u16*)(ws + WT_DOWN1), FH, 1024, nullptr, 0, p.out, out1, p.out, lds_all, rbid, rnb););
  PHASE(18, rmsnorm_phase(p.out, out1, p.norm_final, nullptr, p.out, gw, nw););
#undef PHASE
}

extern "C" void kernel_launch(void* const* d_in, const int* in_sizes, int n_in, void* d_out, int out_size, void* d_ws, size_t ws_size, hipStream_t stream) {
  static int grid_blocks = 0;
  if (!grid_blocks) {
    int dev = 0, cus = 0, per_cu = 0;
    hipGetDevice(&dev);
    hipDeviceGetAttribute(&cus, hipDeviceAttributeMultiprocessorCount, dev);
    hipOccupancyMaxActiveBlocksPerMultiprocessor(&per_cu, mega, 512, 0);
    if (per_cu > 1) per_cu = 1;
    if (per_cu < 1) per_cu = 1;
    grid_blocks = cus * per_cu;
  }
  if (n_in != 23 || ws_size < WS_NEED) { fprintf(stderr, "kernel_launch: bad inputs n_in=%d ws=%zu\n", n_in, ws_size); return; }
  Params p{};
  p.xin0 = (const float*)d_in[0]; p.xin1 = (const float*)d_in[1];
  p.norm_mix = (const float*)d_in[2]; p.norm_ffn = (const float*)d_in[3]; p.norm_final = (const float*)d_in[4];
  p.ab_w_in = (const float*)d_in[5]; p.conv_w = (const float*)d_in[6]; p.conv_b = (const float*)d_in[7];
  p.w_a = (const float*)d_in[8]; p.b_a = (const float*)d_in[9]; p.w_i = (const float*)d_in[10]; p.b_i = (const float*)d_in[11];
  p.lam = (const float*)d_in[12]; p.ab_w_out = (const float*)d_in[13];
  p.mla_w_in = (const float*)d_in[14]; p.q_norm = (const float*)d_in[15]; p.w_qb = (const float*)d_in[16]; p.kv_norm = (const float*)d_in[17];
  p.w_kvb = (const float*)d_in[18]; p.mla_w_out = (const float*)d_in[19];
  p.w_gate = (const float*)d_in[20]; p.w_up = (const float*)d_in[21]; p.w_down = (const float*)d_in[22];
  p.out = (float*)d_out; p.ws = (char*)d_ws;
#if SINGLE_LAUNCH
  hipMemsetAsync((char*)d_ws + OFF_BAR, 0, XCD_BAR_WORDS * 4, stream);
  int lo = 0, hi = N_PHASES;
  void* args[] = {&p, &lo, &hi};
  hipError_t e = hipLaunchCooperativeKernel((void*)mega, dim3(grid_blocks), dim3(512), args, 0, stream);
  if (e != hipSuccess) fprintf(stderr, "cooperative launch failed: %s (grid %d)\n", hipGetErrorString(e), grid_blocks);
#else
  for (int ph = 0; ph < N_PHASES; ++ph) hipLaunchKernelGGL(mega, dim3(grid_blocks), dim3(512), 0, stream, p, ph, ph + 1);
#endif
}
```

```cpp
#include <hip/hip_runtime.h>
#include <hip/hip_cooperative_groups.h>
#include <cstdint>
#include <cstdio>
namespace cg = cooperative_groups;

#ifndef SINGLE_LAUNCH
#define SINGLE_LAUNCH 1
#endif

typedef unsigned short u16;
typedef short bf16x8 __attribute__((ext_vector_type(8)));
typedef short s16x4 __attribute__((ext_vector_type(4)));
typedef float f32x16 __attribute__((ext_vector_type(16)));
typedef float f32x4 __attribute__((ext_vector_type(4)));
typedef float f32x2 __attribute__((ext_vector_type(2)));
typedef unsigned u32x4 __attribute__((ext_vector_type(4)));
typedef unsigned u32x2 __attribute__((ext_vector_type(2)));
typedef __bf16 bf2_t __attribute__((ext_vector_type(2)));
#define DI __device__ __forceinline__
#define VT ((int)(threadIdx.x & 255))
#define MFMA32(a, b, c) __builtin_amdgcn_mfma_f32_32x32x16_bf16((a), (b), (c), 0, 0, 0)

constexpr int M_TOT = 49152, M_P = 32768, DM = 1024, FH = 2816;
constexpr float LOG2E = 1.4426950408889634f;
constexpr size_t MiB = 1ull << 20;
constexpr size_t WT_ABIN = 0;
constexpr size_t WT_ABOUT = WT_ABIN + 2560ull * 1024 * 2;
constexpr size_t WT_GU0 = WT_ABOUT + 1024ull * 1024 * 2;
constexpr size_t WT_DOWN0 = WT_GU0 + 5632ull * 1024 * 2;
constexpr size_t WT_MLAIN = WT_DOWN0 + 1024ull * 2816 * 2;
constexpr size_t WT_QB = WT_MLAIN + 768ull * 1024 * 2;
constexpr size_t WT_KVB = WT_QB + 1536ull * 384 * 2;
constexpr size_t WT_MLAOUT = WT_KVB + 2048ull * 256 * 2;
constexpr size_t WT_GU1 = WT_MLAOUT + 1024ull * 1024 * 2;
constexpr size_t WT_DOWN1 = WT_GU1 + 5632ull * 1024 * 2;
constexpr size_t WT_GATES = WT_DOWN1 + 1024ull * 2816 * 2;
constexpr size_t WT_END = WT_GATES + 32ull * 4096 * 2;
static_assert(WT_END <= 46 * MiB, "weights region");
constexpr size_t OFF_SUM = 46 * MiB;
constexpr size_t OFF_KR = 46 * MiB;
constexpr size_t OFF_COS = 52 * MiB;
constexpr size_t OFF_SIN = 52 * MiB + 512 * 1024;
constexpr size_t OFF_H = 54 * MiB;
constexpr size_t OFF_CQN = 54 * MiB;
constexpr size_t OFF_CKVN = 90 * MiB;
constexpr size_t OFF_O = 54 * MiB;
constexpr size_t OFF_PROJ = 150 * MiB;
constexpr size_t OFF_ACT = 150 * MiB;
constexpr size_t OFF_P2 = 150 * MiB;
constexpr size_t OFF_Q = 150 * MiB;
constexpr size_t OFF_KV = 294 * MiB;
constexpr size_t OFF_Y = 390 * MiB;
constexpr size_t OFF_CARRY = 486 * MiB;
constexpr size_t OFF_BAR = 489 * MiB;
constexpr size_t WS_NEED = 490 * MiB;

struct Params {
  const float* xin0; const float* xin1;
  const float* norm_mix; const float* norm_ffn; const float* norm_final;
  const float* ab_w_in; const float* conv_w; const float* conv_b;
  const float* w_a; const float* b_a; const float* w_i; const float* b_i; const float* lam; const float* ab_w_out;
  const float* mla_w_in; const float* q_norm; const float* w_qb; const float* kv_norm; const float* w_kvb; const float* mla_w_out;
  const float* w_gate; const float* w_up; const float* w_down;
  float* out; char* ws;
};

DI float bf2f(u16 v) { return __uint_as_float(((unsigned)v) << 16); }
DI float bfs2f(short v) { return __uint_as_float(((unsigned)(u16)v) << 16); }
DI unsigned pk2(float lo, float hi) { f32x2 v = {lo, hi}; bf2_t r = __builtin_convertvector(v, bf2_t); return __builtin_bit_cast(unsigned, r); }
DI u16 f2bf(float a) { return (u16)(pk2(a, 0.f) & 0xffffu); }
DI int crow(int r, int hi) { return (r & 3) + 8 * (r >> 2) + 4 * hi; }
DI float sigmoidf_(float x) { return __builtin_amdgcn_rcpf(1.f + __builtin_amdgcn_exp2f(-1.4426950408889634f * x)); }
DI float pl32_max(float v) { auto rr = __builtin_amdgcn_permlane32_swap(__float_as_uint(v), __float_as_uint(v), false, false); return fmaxf(__uint_as_float(rr[0]), __uint_as_float(rr[1])); }
DI float pl32_sum(float v) { auto rr = __builtin_amdgcn_permlane32_swap(__float_as_uint(v), __float_as_uint(v), false, false); return __uint_as_float(rr[0]) + __uint_as_float(rr[1]); }
DI s16x4 tr_read(unsigned addr) { s16x4 r; asm volatile("ds_read_b64_tr_b16 %0, %1" : "=&v"(r) : "v"(addr) : "memory"); return r; }
template <int OFF> DI s16x4 tr_read_o(unsigned addr) { s16x4 r; asm volatile("ds_read_b64_tr_b16 %0, %1 offset:%2" : "=&v"(r) : "v"(addr), "i"(OFF) : "memory"); return r; }
DI float max_nn(float a, float b) { return __builtin_amdgcn_fmed3f(a, b, __builtin_inff()); }
#define LGKM0() do { asm volatile("s_waitcnt lgkmcnt(0)" ::: "memory"); __builtin_amdgcn_sched_barrier(0); } while (0)
DI bf16x8 cat4(s16x4 l, s16x4 h) { return (bf16x8){l[0], l[1], l[2], l[3], h[0], h[1], h[2], h[3]}; }
DI bf16x8 pack8(const f32x16& x, int s) {
  u32x4 w = {pk2(x[8 * s + 0], x[8 * s + 1]), pk2(x[8 * s + 2], x[8 * s + 3]), pk2(x[8 * s + 4], x[8 * s + 5]), pk2(x[8 * s + 6], x[8 * s + 7])};
  return __builtin_bit_cast(bf16x8, w);
}
DI void row_info(int m, int& seq_lo, int& S) { if (m < M_P) { seq_lo = m & ~8191; S = 8192; } else { seq_lo = M_P + ((m - M_P) & ~4095); S = 4096; } }

DI void tr_job(const float* __restrict__ src, int K, int N, u16* __restrict__ dst, int mode, float* tile, int bid, int nb, int& rot) {
  const int tk = K >> 6, tn = (N + 63) >> 6, nt = tk * tn;
  const int tx = VT & 63, ty = VT >> 6;
  const int t0 = (bid + nb - rot) % nb, nit = (nt + nb - 1) / nb;
  (void)tx; (void)ty;
  for (int i = 0; i < nit; ++i) {
    const int t = t0 + i * nb; const bool act = t < nt;
    const int k0 = (t / tn) << 6, n0 = (t % tn) << 6;
    __syncthreads();
    if (act) {
#pragma unroll
      for (int r = 0; r < 4; ++r) {
        const int idx = VT + 256 * r, kk = idx >> 4, c4 = idx & 15, n = n0 + c4 * 4;
        const f32x4 v = n < N ? *(const f32x4*)(src + (size_t)(k0 + kk) * N + n) : (f32x4){0.f, 0.f, 0.f, 0.f};
        float* tp = tile + kk * 65 + c4 * 4;
        tp[0] = v[0]; tp[1] = v[1]; tp[2] = v[2]; tp[3] = v[3];
      }
    }
    __syncthreads();
    if (act) {
#pragma unroll
      for (int r = 0; r < 2; ++r) {
        const int idx = VT + 256 * r, nn = idx >> 3, kc = idx & 7, n = n0 + nn;
        if (n < N) {
          const int row = mode == 0 ? n : ((n >> 5) * 64 + (n & 31) + (mode == 2 ? 32 : 0));
          const float* tp = tile + (kc * 8) * 65 + nn;
          u32x4 w = {pk2(tp[0], tp[65]), pk2(tp[2 * 65], tp[3 * 65]), pk2(tp[4 * 65], tp[5 * 65]), pk2(tp[6 * 65], tp[7 * 65])};
          *(u32x4*)(dst + (size_t)row * K + k0 + kc * 8) = w;
        }
      }
    }
  }
  rot = (rot + nt) % nb;
}

DI void rmsnorm_phase(const float* __restrict__ s0, const float* __restrict__ s1, const float* __restrict__ g, u16* outb, float* outf, int gw, int nw) {
  const int lane = threadIdx.x & 63;
  for (int m = gw; m < M_TOT; m += nw) {
    const float* src = m < M_P ? s0 + (size_t)m * DM : s1 + (size_t)(m - M_P) * DM;
    f32x4 v[4];
#pragma unroll
    for (int i = 0; i < 4; ++i) v[i] = *(const f32x4*)(src + i * 256 + lane * 4);
    float ss = 0.f;
#pragma unroll
    for (int i = 0; i < 4; ++i) ss += v[i][0] * v[i][0] + v[i][1] * v[i][1] + v[i][2] * v[i][2] + v[i][3] * v[i][3];
#pragma unroll
    for (int o = 32; o > 0; o >>= 1) ss += __shfl_xor(ss, o);
    const float rs = rsqrtf(ss * (1.f / 1024.f) + 1e-6f);
#pragma unroll
    for (int i = 0; i < 4; ++i) {
      const f32x4 gg = *(const f32x4*)(g + i * 256 + lane * 4);
      const f32x4 y = v[i] * rs * gg;
      if (outb) { u32x2 w = {pk2(y[0], y[1]), pk2(y[2], y[3])}; *(u32x2*)(outb + (size_t)m * DM + i * 256 + lane * 4) = w; }
      else *(f32x4*)(outf + (size_t)m * DM + i * 256 + lane * 4) = y;
    }
  }
}

DI void prep_phase(const Params& p, char* lds, int bid, int nb) {
  float* tile = (float*)lds;
  char* ws = p.ws;
  int rot = 0;
  tr_job(p.ab_w_in, 1024, 2560, (u16*)(ws + WT_ABIN), 0, tile, bid, nb, rot);
  tr_job(p.ab_w_out, 1024, 1024, (u16*)(ws + WT_ABOUT), 0, tile, bid, nb, rot);
  tr_job(p.w_gate, 1024, FH, (u16*)(ws + WT_GU0), 1, tile, bid, nb, rot);
  tr_job(p.w_up, 1024, FH, (u16*)(ws + WT_GU0), 2, tile, bid, nb, rot);
  tr_job(p.w_gate + (size_t)1024 * FH, 1024, FH, (u16*)(ws + WT_GU1), 1, tile, bid, nb, rot);
  tr_job(p.w_up + (size_t)1024 * FH, 1024, FH, (u16*)(ws + WT_GU1), 2, tile, bid, nb, rot);
  tr_job(p.w_down, FH, 1024, (u16*)(ws + WT_DOWN0), 0, tile, bid, nb, rot);
  tr_job(p.w_down + (size_t)FH * 1024, FH, 1024, (u16*)(ws + WT_DOWN1), 0, tile, bid, nb, rot);
  tr_job(p.mla_w_in, 1024, 672, (u16*)(ws + WT_MLAIN), 0, tile, bid, nb, rot);
  tr_job(p.w_qb, 384, 1536, (u16*)(ws + WT_QB), 0, tile, bid, nb, rot);
  tr_job(p.w_kvb, 256, 2048, (u16*)(ws + WT_KVB), 0, tile, bid, nb, rot);
  tr_job(p.mla_w_out, 1024, 1024, (u16*)(ws + WT_MLAOUT), 0, tile, bid, nb, rot);
  for (int dg = 0; dg < 32; ++dg) {
    const int cb = dg & 7, gate = (dg >> 3) & 1, dir = dg >> 4;
    const float* src = (gate == 0 ? p.w_a : p.w_i) + (size_t)(dir * 8 + cb) * 4096;
    tr_job(src, 64, 64, (u16*)(ws + WT_GATES) + (size_t)dg * 4096, 0, tile, bid, nb, rot);
  }
  const int gtid = bid * 256 + VT, gn = nb * 256;
  { u16* d = (u16*)(ws + WT_MLAIN) + (size_t)672 * 1024; for (int i = gtid; i < 96 * 1024; i += gn) d[i] = 0; }
  { float* ct = (float*)(ws + OFF_COS); float* st = (float*)(ws + OFF_SIN);
    for (int i = gtid; i < 8192 * 16; i += gn) {
      const int pos = i >> 4, k = i & 15;
      const float inv_freq = 1.0f / powf(10000.0f, (float)(2 * k) / 32.0f);
      const float ang = (float)pos * inv_freq;
      double f = (double)ang * 0.15915494309189535; f -= rint(f);
      ct[i] = __builtin_amdgcn_cosf((float)f); st[i] = __builtin_amdgcn_sinf((float)f);
    } }
  rmsnorm_phase(p.xin0, p.xin1, p.norm_mix, (u16*)(ws + OFF_H), nullptr, bid * 4 + (VT >> 6), nb * 4);
}

constexpr int GP = 72;
enum { EPI_BF16 = 0, EPI_RESID = 1, EPI_SWIGLU = 2 };
template <int EPI>
DI void gemm_phase(const u16* __restrict__ A, int lda, const u16* __restrict__ Bt, int K, int N, u16* outb, int ldo,
                   const float* r0, const float* r1, float* outf, char* lds, int bid, int nb) {
  const int tid = threadIdx.x, lane = tid & 63, wid = tid >> 6, wr = wid >> 2, wc = wid & 3, r32 = lane & 31, hi = lane >> 5;
  u16* As = (u16*)lds; u16* Bs = As + 2 * 256 * GP;
  const int nN = N >> 8, nM = M_TOT >> 8, nT = nM * nN, nk = K >> 6;
  const int lrow = tid >> 3, lch = tid & 7;
  const bool swz = (nb == 256);
  const int GN = (nN & 1) == 0 ? 2 : 1, GM = 32 / GN, nSN = nN / GN, nST = (nM / GM) * nSN;
  const int xcd = bid & 7, jb = bid >> 3;
  const int nIter = swz ? (nST - xcd + 7) / 8 : (nT - bid + nb - 1) / nb;
  for (int it = 0; it < nIter; ++it) {
    int tm, tn;
    if (swz) { const int st = xcd + 8 * it, sm = st / nSN, sn = st - sm * nSN; tm = sm * GM + jb / GN; tn = sn * GN + (jb % GN); }
    else { const int t = bid + it * nb; tm = t / nN; tn = t - tm * nN; }
    const u16* Ag = A + (size_t)(tm * 256 + lrow) * lda + lch * 8;
    const u16* Bg = Bt + (size_t)(tn * 256 + lrow) * K + lch * 8;
    f32x16 acc[4][2];
#pragma unroll
    for (int i = 0; i < 4; ++i) { acc[i][0] = f32x16{}; acc[i][1] = f32x16{}; }
    u32x4 ra0[4], rb0[4], ra1[4], rb1[4];
#define SB() __builtin_amdgcn_sched_barrier(0)
#define G_LOAD(RA, RB, KT) do { _Pragma("unroll") for (int i = 0; i < 4; ++i) { RA[i] = *(const u32x4*)(Ag + (size_t)i * 64 * lda + (KT) * 64); RB[i] = *(const u32x4*)(Bg + (size_t)i * 64 * K + (KT) * 64); } } while (0)
#define G_STORE_A(RA, BUF) do { u16* ad = As + (BUF) * 256 * GP; _Pragma("unroll") for (int i = 0; i < 4; ++i) *(u32x4*)(ad + (lrow + 64 * i) * GP + lch * 8) = RA[i]; } while (0)
#define G_STORE_B(RB, BUF) do { u16* bd = Bs + (BUF) * 256 * GP; _Pragma("unroll") for (int i = 0; i < 4; ++i) *(u32x4*)(bd + (lrow + 64 * i) * GP + lch * 8) = RB[i]; } while (0)
#define G_MMA(BUF, KS) do { const u16* as = As + (BUF) * 256 * GP + (wr * 128 + r32) * GP + hi * 8 + (KS) * 16; const u16* bs = Bs + (BUF) * 256 * GP + (wc * 64 + r32) * GP + hi * 8 + (KS) * 16; \
        const bf16x8 b0 = *(const bf16x8*)(bs), b1 = *(const bf16x8*)(bs + 32 * GP); \
        bf16x8 a_[4]; _Pragma("unroll") for (int i = 0; i < 4; ++i) a_[i] = *(const bf16x8*)(as + i * 32 * GP); \
        __builtin_amdgcn_s_setprio(1); \
        _Pragma("unroll") for (int i = 0; i < 4; ++i) { acc[i][0] = MFMA32(a_[i], b0, acc[i][0]); acc[i][1] = MFMA32(a_[i], b1, acc[i][1]); } \
        __builtin_amdgcn_s_setprio(0); } while (0)
#define G_ITER(BUF, RAC, RBC, RAN, RBN, KT) do { \
      if ((KT) + 2 < nk) G_LOAD(RAC, RBC, (KT) + 2); \
      SB(); G_MMA(BUF, 0); SB(); \
      if ((KT) + 1 < nk) G_STORE_A(RAN, (BUF) ^ 1); \
      SB(); G_MMA(BUF, 1); SB(); \
      if ((KT) + 1 < nk) G_STORE_B(RBN, (BUF) ^ 1); \
      SB(); G_MMA(BUF, 2); G_MMA(BUF, 3); SB(); \
      __syncthreads(); } while (0)
    G_LOAD(ra0, rb0, 0);
    G_LOAD(ra1, rb1, 1);
    G_STORE_A(ra0, 0); G_STORE_B(rb0, 0);
    __syncthreads();
    for (int kt = 0; kt < nk; kt += 2) {
      G_ITER(0, ra0, rb0, ra1, rb1, kt);
      G_ITER(1, ra1, rb1, ra0, rb0, kt + 1);
    }
#undef G_LOAD
#undef G_STORE_A
#undef G_STORE_B
#undef G_MMA
#undef G_ITER
    const int mrow = tm * 256 + wr * 128;
    if constexpr (EPI == EPI_BF16) {
      const int col = tn * 256 + wc * 64 + r32;
#pragma unroll
      for (int i = 0; i < 4; ++i)
#pragma unroll
        for (int reg = 0; reg < 16; ++reg) {
          u16* o0 = outb + (size_t)(mrow + i * 32 + crow(reg, hi)) * ldo + col;
          o0[0] = f2bf(acc[i][0][reg]); o0[32] = f2bf(acc[i][1][reg]);
        }
    } else if constexpr (EPI == EPI_RESID) {
      const int col = tn * 256 + wc * 64 + r32;
      const float* rb_ = (tm * 256 < M_P) ? r0 : (r1 - (size_t)M_P * DM);
#pragma unroll
      for (int i = 0; i < 4; ++i)
#pragma unroll
        for (int reg = 0; reg < 16; ++reg) {
          const size_t i0 = (size_t)(mrow + i * 32 + crow(reg, hi)) * DM + col;
          const float x0 = rb_[i0], x1 = rb_[i0 + 32];
          outf[i0] = x0 + acc[i][0][reg]; outf[i0 + 32] = x1 + acc[i][1][reg];
        }
    } else {
      const int col = (tn * 4 + wc) * 32 + r32;
#pragma unroll
      for (int i = 0; i < 4; ++i)
#pragma unroll
        for (int reg = 0; reg < 16; ++reg) {
          const float g0 = acc[i][0][reg], u0 = acc[i][1][reg];
          outb[(size_t)(mrow + i * 32 + crow(reg, hi)) * ldo + col] = f2bf(g0 * sigmoidf_(g0) * u0);
        }
    }
  }
}

template <bool FINAL>
DI void rg_phase(const Params& p, char* lds, int bid, int nb) {
  const int tid = VT, lane = tid & 63, wid = tid >> 6, r32 = lane & 31, hi = lane >> 5;
  u16* xcb = (u16*)lds;
  float* A0 = (float*)(lds + 9216);
  float* U0 = (float*)(lds + 9216 + 16384);
  float* A1 = (float*)(lds + 9216 + 32768);
  float* U1 = (float*)(lds + 9216 + 49152);
  u16* raw = (u16*)A1;
  const u16* PROJ = (const u16*)(p.ws + OFF_PROJ);
  const u16* WG = (const u16*)(p.ws + WT_GATES);
  float* SUM = (float*)(p.ws + OFF_SUM);
  const float* CARRY = (const float*)(p.ws + OFF_CARRY);
  u16* Y = (u16*)(p.ws + OFF_Y);
  const int NIT = 768 * 8, nit = (NIT + nb - 1) / nb;
  const int mt = wid >> 1, nt = wid & 1;
  int cb_loaded = -1;
  float w0 = 0.f, w1 = 0.f, w2 = 0.f, w3 = 0.f, cbias = 0.f, bav[2] = {0.f, 0.f}, biv[2] = {0.f, 0.f}, spv[2] = {0.f, 0.f};
  u32x4 rr[3], rg[2], rrn[3], rgn[2];
  auto load_item = [&](int it, u32x4 (&xr)[3], u32x4 (&xg)[2]) {
    const int gc = it >> 3, cb = it & 7, m0 = gc * 64;
    int seq_lo, S; row_info(m0, seq_lo, S); const int seq_hi = seq_lo + S;
#pragma unroll
    for (int i = 0; i < 3; ++i) {
      const int c = tid + 256 * i, row = c >> 3, ch8 = c & 7, m = m0 - 2 + row;
      xr[i] = (c < 536 && m >= seq_lo && m < seq_hi) ? *(const u32x4*)(PROJ + (size_t)m * 2560 + cb * 64 + ch8 * 8) : (u32x4){0u, 0u, 0u, 0u};
    }
    if (FINAL) {
#pragma unroll
      for (int i = 0; i < 2; ++i) { const int c = tid + 256 * i, row = c >> 3, ch8 = c & 7; xg[i] = *(const u32x4*)(PROJ + (size_t)(m0 + row) * 2560 + 512 + cb * 64 + ch8 * 8); }
    }
  };
  { const int it = bid < NIT ? bid : NIT - 1; load_item(it, rr, rg); }
  for (int k = 0; k < nit; ++k) {
    const int it0 = bid + k * nb, it = it0 < NIT ? it0 : NIT - 1;
    const int gc = it >> 3, cb = it & 7, m0 = gc * 64;
    if (cb != cb_loaded) {
      cb_loaded = cb;
      const int cc = cb * 64 + (tid & 63);
      w0 = p.conv_w[cc]; w1 = p.conv_w[512 + cc]; w2 = p.conv_w[1024 + cc]; w3 = p.conv_w[1536 + cc]; cbias = p.conv_b[cc];
      const int cg_ = cb * 64 + nt * 32 + r32;
#pragma unroll
      for (int dir = 0; dir < 2; ++dir) { bav[dir] = p.b_a[dir * 512 + cg_]; biv[dir] = p.b_i[dir * 512 + cg_]; spv[dir] = log1pf(__expf(-p.lam[dir * 512 + cg_])); }
    }
    __syncthreads();
#pragma unroll
    for (int i = 0; i < 3; ++i) { const int c = tid + 256 * i; if (c < 536) *(u32x4*)(raw + c * 8) = rr[i]; }
    { const int itn0 = bid + (k + 1) * nb, itn = itn0 < NIT ? itn0 : NIT - 1; load_item(itn, rrn, rgn); }
    __syncthreads();
    {
      const int ch = tid & 63, t0 = (tid >> 6) * 16;
      float xm2 = bf2f(raw[(t0) * 64 + ch]), xm1 = bf2f(raw[(t0 + 1) * 64 + ch]), x0 = bf2f(raw[(t0 + 2) * 64 + ch]);
#pragma unroll
      for (int t = t0; t < t0 + 16; ++t) {
        const float xp1 = bf2f(raw[(t + 3) * 64 + ch]);
        xcb[t * 72 + ch] = f2bf(w0 * xm2 + w1 * xm1 + w2 * x0 + w3 * xp1 + cbias);
        xm2 = xm1; xm1 = x0; x0 = xp1;
      }
    }
    __syncthreads();
    {
      bf16x8 af[4];
#pragma unroll
      for (int ks = 0; ks < 4; ++ks) af[ks] = *(const bf16x8*)(xcb + (mt * 32 + r32) * 72 + ks * 16 + 8 * hi);
      const int ch = nt * 32 + r32;
      float xc[16];
#pragma unroll
      for (int reg = 0; reg < 16; ++reg) xc[reg] = bf2f(xcb[(mt * 32 + crow(reg, hi)) * 72 + ch]);
#pragma unroll
      for (int dir = 0; dir < 2; ++dir) {
        f32x16 aa = {}, ai = {};
        const u16* wga = WG + (size_t)((dir * 2 + 0) * 8 + cb) * 4096 + (nt * 32 + r32) * 64 + 8 * hi;
        const u16* wgi = WG + (size_t)((dir * 2 + 1) * 8 + cb) * 4096 + (nt * 32 + r32) * 64 + 8 * hi;
#pragma unroll
        for (int ks = 0; ks < 4; ++ks) { const bf16x8 ba = *(const bf16x8*)(wga + ks * 16), bi = *(const bf16x8*)(wgi + ks * 16); aa = MFMA32(af[ks], ba, aa); ai = MFMA32(af[ks], bi, ai); }
        float* Ab = dir == 0 ? A0 : A1; float* Ub = dir == 0 ? U0 : U1;
#pragma unroll
        for (int reg = 0; reg < 16; ++reg) {
          const int tok = mt * 32 + crow(reg, hi);
          const float r = sigmoidf_(aa[reg] + bav[dir]), gi = sigmoidf_(ai[reg] + biv[dir]);
          const float la2 = -8.f * 1.4426950408889634f * r * spv[dir], a = __builtin_amdgcn_exp2f(la2);
          const float mult = __builtin_amdgcn_sqrtf(fmaxf(0.f, 1.f - a * a));
          Ab[tok * 64 + ch] = a; Ub[tok * 64 + ch] = mult * gi * xc[reg];
        }
      }
    }
    __syncthreads();
    if (wid < 2) {
      const int dir = wid, ch = lane, c = cb * 64 + ch;
      float* Ab = dir == 0 ? A0 : A1; float* Ub = dir == 0 ? U0 : U1;
      if (!FINAL) {
        float h = 0.f, P = 1.f;
#pragma unroll 16
        for (int kk = 0; kk < 64; ++kk) { const int t = dir == 0 ? kk : 63 - kk; const float a = Ab[t * 64 + ch], u = Ub[t * 64 + ch]; h = a * h + u; P *= a; }
        SUM[(size_t)((gc * 2 + dir) * 2 + 0) * 512 + c] = P; SUM[(size_t)((gc * 2 + dir) * 2 + 1) * 512 + c] = h;
      } else {
        float h = CARRY[(size_t)(gc * 2 + dir) * 512 + c];
#pragma unroll 16
        for (int kk = 0; kk < 64; ++kk) { const int t = dir == 0 ? kk : 63 - kk; const float a = Ab[t * 64 + ch], u = Ub[t * 64 + ch]; h = a * h + u; Ub[t * 64 + ch] = h; }
      }
    }
    if (FINAL) {
      __syncthreads();
#pragma unroll
      for (int i = 0; i < 2; ++i) {
        const int c = tid + 256 * i, t = c >> 3, ch8 = c & 7;
        const f32x4 ha = *(const f32x4*)(U0 + t * 64 + ch8 * 8), hb = *(const f32x4*)(U0 + t * 64 + ch8 * 8 + 4);
        const f32x4 hc = *(const f32x4*)(U1 + t * 64 + ch8 * 8), hd = *(const f32x4*)(U1 + t * 64 + ch8 * 8 + 4);
        float hs[8] = {ha[0] + hc[0], ha[1] + hc[1], ha[2] + hc[2], ha[3] + hc[3], hb[0] + hd[0], hb[1] + hd[1], hb[2] + hd[2], hb[3] + hd[3]};
        float yv[8];
#pragma unroll
        for (int j = 0; j < 8; ++j) {
          const unsigned wv = rg[i][j >> 1];
          const float gt = __uint_as_float((j & 1) ? (wv & 0xffff0000u) : (wv << 16));
          const float ge = gt * sigmoidf_(1.5957691216057308f * (gt + 0.044715f * gt * gt * gt));
          yv[j] = ge * hs[j];
        }
        u32x4 o = {pk2(yv[0], yv[1]), pk2(yv[2], yv[3]), pk2(yv[4], yv[5]), pk2(yv[6], yv[7])};
        *(u32x4*)(Y + (size_t)(m0 + t) * 1024 + cb * 64 + ch8 * 8) = o;
      }
    }
#pragma unroll
    for (int i = 0; i < 3; ++i) rr[i] = rrn[i];
#pragma unroll
    for (int i = 0; i < 2; ++i) rg[i] = rgn[i];
  }
}

DI void rg_carry_phase(const Params& p, int bid, int nb) {
  const float* __restrict__ SUM = (const float*)(p.ws + OFF_SUM);
  float* __restrict__ CARRY = (float*)(p.ws + OFF_CARRY);
  for (int idx = bid * 256 + VT; idx < 8192; idx += nb * 256) {
    const int c = idx & 511, dir = (idx >> 9) & 1, seq = idx >> 10;
    const int gc0 = seq < 4 ? seq * 128 : 512 + (seq - 4) * 64, nch = seq < 4 ? 128 : 64;
    float carry = 0.f;
    for (int k0 = 0; k0 < nch; k0 += 8) {
      float P[8], Hh[8];
#pragma unroll
      for (int j = 0; j < 8; ++j) { const int k = k0 + j, gc = dir == 0 ? gc0 + k : gc0 + nch - 1 - k; P[j] = SUM[(size_t)((gc * 2 + dir) * 2 + 0) * 512 + c]; Hh[j] = SUM[(size_t)((gc * 2 + dir) * 2 + 1) * 512 + c]; }
#pragma unroll
      for (int j = 0; j < 8; ++j) { const int k = k0 + j, gc = dir == 0 ? gc0 + k : gc0 + nch - 1 - k; CARRY[(size_t)(gc * 2 + dir) * 512 + c] = carry; carry = P[j] * carry + Hh[j]; }
    }
  }
}

DI void dil_tile_info(int ti, int m0, int& d, int& u0) {
  if (ti < 5) { d = 16; u0 = m0 - 1024 + ti * 512; } else if (ti < 13) { d = 4; u0 = m0 - 256 + (ti - 5) * 128; } else { d = 1; u0 = m0 - 64 + (ti - 13) * 32; }
}
DI void dilated_phase(const Params& p, char* lds, int gw, int nw) {
  const int lane = VT & 63, wid = VT >> 6, r32 = lane & 31, hi = lane >> 5;
  u16* Vl = (u16*)(lds + wid * 6144);
  const unsigned vbase = (unsigned)(uintptr_t)Vl;
  const int li = lane & 15, tq = li >> 2, tp = li & 3, g1 = (lane >> 4) & 1;
  const unsigned trb = vbase + (4 * hi + tq) * 192 + (16 * g1 + 4 * tp) * 2;
  const u16* PROJ = (const u16*)(p.ws + OFF_PROJ);
  u16* Y = (u16*)(p.ws + OFF_Y);
  const int vrow = lane >> 3, vch = lane & 7;
  for (int id = gw; id < 12288; id += nw) {
    const int res = id & 15, h = (id >> 4) & 7, sp = id >> 7;
    const int m0 = sp * 512 + res;
    int seq_lo, S; row_info(sp * 512, seq_lo, S); const int seq_hi = seq_lo + S;
    const int mq = m0 + 16 * r32;
    bf16x8 qf[4];
#pragma unroll
    for (int ks = 0; ks < 4; ++ks) qf[ks] = *(const bf16x8*)(PROJ + (size_t)mq * 2560 + 1024 + h * 64 + ks * 16 + 8 * hi);
    const float slope2 = exp2f(-(float)(h + 1)) * LOG2E;
    const float c1 = 0.125f * LOG2E;
    float m_run = -1e30f, l_run = 0.f; f32x16 o0 = {}, o1 = {};
    const u16* kbase = PROJ + 1536 + h * 64 + 8 * hi;
    const u16* vbaseg = PROJ + 2048 + h * 64 + vch * 8;
    bf16x8 kf[4]; u32x4 vr[4];
    { int d, u0; dil_tile_info(0, m0, d, u0);
      const int ur = min(max(u0 + d * r32, seq_lo), seq_hi - 1);
#pragma unroll
      for (int ks = 0; ks < 4; ++ks) kf[ks] = *(const bf16x8*)(kbase + (size_t)ur * 2560 + ks * 16);
#pragma unroll
      for (int i = 0; i < 4; ++i) { const int uv = min(max(u0 + d * (vrow + 8 * i), seq_lo), seq_hi - 1); vr[i] = *(const u32x4*)(vbaseg + (size_t)uv * 2560); } }
#pragma unroll 1
    for (int ti = 0; ti < 33; ++ti) {
      int d, u0; dil_tile_info(ti, m0, d, u0);
#pragma unroll
      for (int i = 0; i < 4; ++i) *(u32x4*)(Vl + (vrow + 8 * i) * 96 + vch * 8) = vr[i];
      f32x16 pt = {};
#pragma unroll
      for (int ks = 0; ks < 4; ++ks) pt = MFMA32(kf[ks], qf[ks], pt);
      if (ti + 1 < 33) {
        int dn, un; dil_tile_info(ti + 1, m0, dn, un);
        const int ur = min(max(un + dn * r32, seq_lo), seq_hi - 1);
#pragma unroll
        for (int ks = 0; ks < 4; ++ks) kf[ks] = *(const bf16x8*)(kbase + (size_t)ur * 2560 + ks * 16);
#pragma unroll
        for (int i = 0; i < 4; ++i) { const int uv = min(max(un + dn * (vrow + 8 * i), seq_lo), seq_hi - 1); vr[i] = *(const u32x4*)(vbaseg + (size_t)uv * 2560); }
      }
      const s16x4 l00 = tr_read_o<0>(trb), h00 = tr_read_o<8 * 192>(trb), l01 = tr_read_o<64>(trb), h01 = tr_read_o<8 * 192 + 64>(trb);
      const s16x4 l10 = tr_read_o<16 * 192>(trb), h10 = tr_read_o<24 * 192>(trb), l11 = tr_read_o<16 * 192 + 64>(trb), h11 = tr_read_o<24 * 192 + 64>(trb);
      const float fd = (float)d, lim = 64.f * fd;
      const float fdu0 = (float)(u0 - mq + d * 4 * hi);
      const float lo_ = fmaxf((float)(seq_lo - mq), -lim), hi_ = fminf((float)(seq_hi - 1 - mq), lim);
      const float mid = 0.5f * (lo_ + hi_), hw = 0.5f * (hi_ - lo_);
      const float gdu0 = fdu0 - mid;
      float pmax = -INFINITY;
#pragma unroll
      for (int reg = 0; reg < 16; ++reg) {
        const float cf = (float)((reg & 3) + 8 * (reg >> 2));
        const float du = fmaf(fd, cf, fdu0), g = fmaf(fd, cf, gdu0);
        const float tv = (__builtin_fabsf(g) <= hw) ? fmaf(__builtin_fabsf(du), -slope2, pt[reg] * c1) : -INFINITY;
        pt[reg] = tv; pmax = max_nn(pmax, tv);
      }
      pmax = pl32_max(pmax);
      if (__any(pmax > m_run)) {
        const float mn = fmaxf(m_run, pmax), alpha = __builtin_amdgcn_exp2f(m_run - mn);
        m_run = mn; l_run *= alpha;
#pragma unroll
        for (int reg = 0; reg < 16; ++reg) { o0[reg] *= alpha; o1[reg] *= alpha; }
      }
      float ps = 0.f;
#pragma unroll
      for (int reg = 0; reg < 16; ++reg) { pt[reg] = __builtin_amdgcn_exp2f(pt[reg] - m_run); ps += pt[reg]; }
      ps = pl32_sum(ps);
      l_run += ps;
      const bf16x8 pb0 = pack8(pt, 0), pb1 = pack8(pt, 1);
      LGKM0();
      o0 = MFMA32(cat4(l00, h00), pb0, o0); o0 = MFMA32(cat4(l10, h10), pb1, o0);
      o1 = MFMA32(cat4(l01, h01), pb0, o1); o1 = MFMA32(cat4(l11, h11), pb1, o1);
    }
    const float inv = 1.f / l_run;
    u16* yo = Y + (size_t)mq * 1024 + 512 + h * 64 + 4 * hi;
#pragma unroll
    for (int g = 0; g < 4; ++g) {
      u32x2 w0 = {pk2(o0[4 * g] * inv, o0[4 * g + 1] * inv), pk2(o0[4 * g + 2] * inv, o0[4 * g + 3] * inv)};
      u32x2 w1 = {pk2(o1[4 * g] * inv, o1[4 * g + 1] * inv), pk2(o1[4 * g + 2] * inv, o1[4 * g + 3] * inv)};
      *(u32x2*)(yo + 8 * g) = w0; *(u32x2*)(yo + 32 + 8 * g) = w1;
    }
  }
}

DI void mla_norm_phase(const Params& p, int gw, int nw) {
  const int lane = threadIdx.x & 63;
  const u16* P2 = (const u16*)(p.ws + OFF_P2);
  u16* CQN = (u16*)(p.ws + OFF_CQN); u16* CKVN = (u16*)(p.ws + OFF_CKVN); u16* KR = (u16*)(p.ws + OFF_KR);
  const float* ct = (const float*)(p.ws + OFF_COS); const float* st = (const float*)(p.ws + OFF_SIN);
  for (int m = gw; m < M_TOT; m += nw) {
    const u16* src = P2 + (size_t)m * 768;
    float q[6], kv[4]; float sq = 0.f, skv = 0.f;
#pragma unroll
    for (int i = 0; i < 6; ++i) { q[i] = bf2f(src[i * 64 + lane]); sq += q[i] * q[i]; }
#pragma unroll
    for (int i = 0; i < 4; ++i) { kv[i] = bf2f(src[384 + i * 64 + lane]); skv += kv[i] * kv[i]; }
#pragma unroll
    for (int o = 32; o > 0; o >>= 1) { sq += __shfl_xor(sq, o); skv += __shfl_xor(skv, o); }
    const float rq = rsqrtf(sq * (1.f / 384.f) + 1e-6f), rkv = rsqrtf(skv * (1.f / 256.f) + 1e-6f);
#pragma unroll
    for (int i = 0; i < 6; ++i) CQN[(size_t)m * 384 + i * 64 + lane] = f2bf(q[i] * rq * p.q_norm[i * 64 + lane]);
#pragma unroll
    for (int i = 0; i < 4; ++i) CKVN[(size_t)m * 256 + i * 64 + lane] = f2bf(kv[i] * rkv * p.kv_norm[i * 64 + lane]);
    if (lane < 16) {
      const int pos = m < M_P ? (m & 8191) : ((m - M_P) & 4095);
      const float t1 = bf2f(src[640 + lane]), t2 = bf2f(src[656 + lane]);
      const float c = ct[pos * 16 + lane], s = st[pos * 16 + lane];
      KR[(size_t)m * 32 + lane] = f2bf(t1 * c - t2 * s); KR[(size_t)m * 32 + 16 + lane] = f2bf(t1 * s + t2 * c);
    }
  }
}

constexpr int KP = 104, VP = 96;
DI void mla_unit(const Params& p, char* lds, int seqbase, int S, int h, int qb, int half) {
  const int tid = VT, lane = tid & 63, wid = tid >> 6, r32 = lane & 31, hi = lane >> 5;
  u16* Kl = (u16*)lds;
  u16* Vl = (u16*)(lds + 3 * 64 * KP * 2);
  const unsigned vbase = (unsigned)(uintptr_t)Vl;
  const int li = lane & 15, tq = li >> 2, tp = li & 3, g1 = (lane >> 4) & 1;
  const unsigned trb = vbase + (4 * hi + tq) * (VP * 2) + (16 * g1 + 4 * tp) * 2;
  const u16* Q = (const u16*)(p.ws + OFF_Q); const u16* KV = (const u16*)(p.ws + OFF_KV); const u16* KR = (const u16*)(p.ws + OFF_KR);
  u16* O = (u16*)(p.ws + OFF_O);
  const float* ct = (const float*)(p.ws + OFF_COS); const float* st = (const float*)(p.ws + OFF_SIN);
  const int pos = qb * 128 + wid * 32 + r32, qrow = seqbase + pos;
  bf16x8 qf[6];
#pragma unroll
  for (int d0 = 0; d0 < 6; ++d0) qf[d0] = *(const bf16x8*)(Q + (size_t)qrow * 1536 + h * 96 + d0 * 16 + 8 * hi);
  const float C = 0.10206207261596577f * LOG2E;
#pragma unroll
  for (int j = 0; j < 8; ++j) {
    const float c = ct[pos * 16 + 8 * hi + j], s = st[pos * 16 + 8 * hi + j];
    const float t1 = bfs2f(qf[4][j]), t2 = bfs2f(qf[5][j]);
    qf[4][j] = (short)f2bf((t1 * c - t2 * s) * C); qf[5][j] = (short)f2bf((t1 * s + t2 * c) * C);
  }
#pragma unroll
  for (int d0 = 0; d0 < 4; ++d0)
#pragma unroll
    for (int j = 0; j < 8; ++j) qf[d0][j] = (short)f2bf(bfs2f(qf[d0][j]) * C);
  const u16* ksrc[3]; int kdst[3];
#pragma unroll
  for (int i = 0; i < 3; ++i) {
    const int idx = tid + 256 * i, row = idx / 12, c = idx - row * 12;
    ksrc[i] = c < 8 ? KV + (size_t)(seqbase + row) * 2048 + h * 128 + c * 8 : KR + (size_t)(seqbase + row) * 32 + (c - 8) * 8;
    kdst[i] = row * KP + c * 8;
  }
  const int kstride[3] = {0, 0, 0}; (void)kstride;
  const int vrow = tid >> 3, vc = tid & 7;
  const u16* vsrc = KV + (size_t)(seqbase + vrow) * 2048 + h * 128 + 64 + vc * 8;
  const int vdst = vrow * VP + vc * 8;
  size_t kadv[3];
#pragma unroll
  for (int i = 0; i < 3; ++i) { const int idx = tid + 256 * i, row = idx / 12, c = idx - row * 12; (void)row; kadv[i] = c < 8 ? (size_t)64 * 2048 : (size_t)64 * 32; }
  float l_run = 0.f; f32x16 o0 = {}, o1 = {}, negm = {};
  const int nkt = S >> 6;
  u32x4 rk[3], rv[2];
#define MLA_GLOAD(T) do { _Pragma("unroll") for (int i = 0; i < 3; ++i) rk[i] = *(const u32x4*)(ksrc[i] + (size_t)(T) * kadv[i]); \
    rv[0] = *(const u32x4*)(vsrc + (size_t)(T) * 64 * 2048); rv[1] = *(const u32x4*)(vsrc + (size_t)(T) * 64 * 2048 + (size_t)32 * 2048); } while (0)
#define MLA_LSTORE(B) do { u16* kd = Kl + (B) * 64 * KP; u16* vd = Vl + (B) * 64 * VP; _Pragma("unroll") for (int i = 0; i < 3; ++i) *(u32x4*)(kd + kdst[i]) = rk[i]; \
    *(u32x4*)(vd + vdst) = rv[0]; *(u32x4*)(vd + vdst + 32 * VP) = rv[1]; } while (0)
  MLA_GLOAD(0); MLA_LSTORE(0);
  MLA_GLOAD(1); MLA_LSTORE(1);
  __syncthreads();
  int cur = 0, nx2 = 2;
#pragma unroll 1
  for (int kt = 0; kt < nkt; ++kt) {
    if (kt + 2 < nkt) MLA_GLOAD(kt + 2);
    const u16* kl = Kl + cur * 64 * KP + r32 * KP + 8 * hi;
    f32x16 p0, p1;
    { const bf16x8 k0 = *(const bf16x8*)(kl), k1 = *(const bf16x8*)(kl + 32 * KP);
      p0 = MFMA32(k0, qf[0], negm); p1 = MFMA32(k1, qf[0], negm); }
#pragma unroll
    for (int d0 = 1; d0 < 6; ++d0) {
      const bf16x8 k0 = *(const bf16x8*)(kl + d0 * 16), k1 = *(const bf16x8*)(kl + 32 * KP + d0 * 16);
      p0 = MFMA32(k0, qf[d0], p0); p1 = MFMA32(k1, qf[d0], p1);
    }
    const unsigned tb = trb + cur * (64 * VP * 2);
    constexpr int R8 = 8 * VP * 2;
    const s16x4 a0 = tr_read_o<0>(tb), b0 = tr_read_o<R8>(tb), a1 = tr_read_o<2 * R8>(tb), b1 = tr_read_o<3 * R8>(tb);
    const s16x4 a2 = tr_read_o<4 * R8>(tb), b2 = tr_read_o<5 * R8>(tb), a3 = tr_read_o<6 * R8>(tb), b3 = tr_read_o<7 * R8>(tb);
    const s16x4 c0 = tr_read_o<64>(tb), d0_ = tr_read_o<R8 + 64>(tb), c1 = tr_read_o<2 * R8 + 64>(tb), d1 = tr_read_o<3 * R8 + 64>(tb);
    const s16x4 c2 = tr_read_o<4 * R8 + 64>(tb), d2 = tr_read_o<5 * R8 + 64>(tb), c3 = tr_read_o<6 * R8 + 64>(tb), d3 = tr_read_o<7 * R8 + 64>(tb);
    if (half == 1) __syncthreads();
    float pmax = max_nn(p0[0], p1[0]);
#pragma unroll
    for (int r = 1; r < 16; ++r) pmax = max_nn(pmax, max_nn(p0[r], p1[r]));
    pmax = pl32_max(pmax);
    if (kt == 0 || __any(pmax > 8.f)) {
      const float delta = kt == 0 ? pmax : fmaxf(pmax, 0.f);
      const float alpha = kt == 0 ? 1.f : __builtin_amdgcn_exp2f(-delta);
#pragma unroll
      for (int r = 0; r < 16; ++r) { negm[r] -= delta; p0[r] -= delta; p1[r] -= delta; o0[r] *= alpha; o1[r] *= alpha; }
      l_run *= alpha;
    }
    float ps = 0.f;
#pragma unroll
    for (int r = 0; r < 16; ++r) { p0[r] = __builtin_amdgcn_exp2f(p0[r]); p1[r] = __builtin_amdgcn_exp2f(p1[r]); ps += p0[r] + p1[r]; }
    ps = pl32_sum(ps);
    l_run += ps;
    const bf16x8 pb0 = pack8(p0, 0), pb1 = pack8(p0, 1), pb2 = pack8(p1, 0), pb3 = pack8(p1, 1);
    LGKM0();
    o0 = MFMA32(cat4(a0, b0), pb0, o0); o1 = MFMA32(cat4(c0, d0_), pb0, o1);
    o0 = MFMA32(cat4(a1, b1), pb1, o0); o1 = MFMA32(cat4(c1, d1), pb1, o1);
    o0 = MFMA32(cat4(a2, b2), pb2, o0); o1 = MFMA32(cat4(c2, d2), pb2, o1);
    o0 = MFMA32(cat4(a3, b3), pb3, o0); o1 = MFMA32(cat4(c3, d3), pb3, o1);
    if (half == 0) __syncthreads();
    if (kt + 2 < nkt) MLA_LSTORE(nx2);
    cur = cur == 2 ? 0 : cur + 1; nx2 = nx2 == 2 ? 0 : nx2 + 1;
  }
  __syncthreads();
#undef MLA_GLOAD
#undef MLA_LSTORE
  const float inv = 1.f / l_run;
  u16* oo = O + (size_t)qrow * 1024 + h * 64 + 4 * hi;
#pragma unroll
  for (int g = 0; g < 4; ++g) {
    u32x2 w0 = {pk2(o0[4 * g] * inv, o0[4 * g + 1] * inv), pk2(o0[4 * g + 2] * inv, o0[4 * g + 3] * inv)};
    u32x2 w1 = {pk2(o1[4 * g] * inv, o1[4 * g + 1] * inv), pk2(o1[4 * g + 2] * inv, o1[4 * g + 3] * inv)};
    *(u32x2*)(oo + 8 * g) = w0; *(u32x2*)(oo + 32 + 8 * g) = w1;
  }
}

DI void mla_attn_phase(const Params& p, char* lds, int xcd, int j, int nper, int half) {
  for (int lu0 = j; lu0 - j < 8 * 64; lu0 += nper) { const int lu = lu0 < 8 * 64 ? lu0 : 8 * 64 - 1; const int bh = (lu >> 6) * 8 + xcd, qb = lu & 63; mla_unit(p, lds, (bh >> 4) * 8192, 8192, bh & 15, qb, half); }
  for (int lu0 = j; lu0 - j < 8 * 32; lu0 += nper) { const int lu = lu0 < 8 * 32 ? lu0 : 8 * 32 - 1; const int bh = (lu >> 5) * 8 + xcd, qb = lu & 31; mla_unit(p, lds, M_P + (bh >> 4) * 4096, 4096, bh & 15, qb, half); }
}

#define XB_TMO      128
#define XB_XCNT(j)  (256  + 64 * (j))
#define XB_XSUB(j)  (1280 + 64 * (j))
#define XB_XGEN(j)  (2304 + 64 * (j))
#define XB_TOP      3328
#define XB_TOPGEN   3392
#define XCD_BAR_WORDS 3456
#define XB_SPIN_CAP (1u << 20)
#define LAS __attribute__((address_space(3)))
DI unsigned xb_ld(unsigned* p) { return __hip_atomic_load(p, __ATOMIC_RELAXED, __HIP_MEMORY_SCOPE_AGENT); }
DI unsigned xb_add(unsigned* p, unsigned v) { return __hip_atomic_fetch_add(p, v, __ATOMIC_RELAXED, __HIP_MEMORY_SCOPE_AGENT); }
DI unsigned xb_xcc_id() { return (unsigned)__builtin_amdgcn_s_getreg((3 << 11) | 20) & 0xFu; }
#define XB_SPIN(cond, bar) do { unsigned _sp = 0; while (cond) { __builtin_amdgcn_s_sleep(1); \
    if ((++_sp & 255u) == 0u) { if (xb_ld(&(bar)[XB_TMO])) break; if (_sp > XB_SPIN_CAP) { atomicAdd(&(bar)[XB_TMO], 1u); break; } } } } while (0)
struct XcdBarrier { unsigned* bar; unsigned x; volatile LAS unsigned* st; };
DI XcdBarrier xcd_barrier_post(unsigned* bar, volatile LAS unsigned* st) {
  XcdBarrier b; b.bar = bar; b.x = xb_xcc_id(); b.st = st;
  if (threadIdx.x == 0) (void)xb_add(&bar[XB_XCNT(b.x)], 1u);
  return b;
}
DI void xcd_barrier_complete(unsigned* bar, unsigned x, unsigned& nloc, unsigned& nx) {
  const unsigned G = gridDim.x * gridDim.y * gridDim.z;
  unsigned sum, cnt, mine, sp = 0u;
  for (;;) {
    sum = 0u; cnt = 0u; mine = 0u;
#pragma unroll
    for (unsigned j = 0; j < 16; ++j) { const unsigned c = xb_ld(&bar[XB_XCNT(j)]); sum += c; cnt += (c > 0u) ? 1u : 0u; mine = (j == x) ? c : mine; }
    if (sum == G) break;
    __builtin_amdgcn_s_sleep(1);
    if ((++sp & 255u) == 0u) { if (xb_ld(&bar[XB_TMO])) break; if (sp > XB_SPIN_CAP) { atomicAdd(&bar[XB_TMO], 1u); break; } }
  }
  nloc = mine > 0u ? mine : 1u; nx = cnt > 0u ? cnt : 1u;
}
DI void xcd_barrier(const XcdBarrier& b) {
  asm volatile("s_waitcnt vmcnt(0)" ::: "memory");
  __syncthreads();
  if (threadIdx.x == 0) {
    unsigned* bar = b.bar;
    __builtin_amdgcn_s_waitcnt(0);
    unsigned nloc = b.st[0], nx = b.st[1];
    if (nloc == 0u) { xcd_barrier_complete(bar, b.x, nloc, nx); b.st[0] = nloc; b.st[1] = nx; }
    const unsigned old = xb_add(&bar[XB_XSUB(b.x)], 1u);
    const unsigned gen = old / nloc;
    if (old + 1u == (gen + 1u) * nloc) {
      __builtin_amdgcn_fence(__ATOMIC_RELEASE, "agent");
      asm volatile("s_waitcnt vmcnt(0)" ::: "memory");
      const unsigned og = xb_add(&bar[XB_TOP], 1u);
      const unsigned tg = og / nx;
      if (og + 1u == (tg + 1u) * nx) xb_add(&bar[XB_TOPGEN], 1u);
      else XB_SPIN(xb_ld(&bar[XB_TOPGEN]) == tg, bar);
      __builtin_amdgcn_fence(__ATOMIC_ACQUIRE, "agent");
      xb_add(&bar[XB_XGEN(b.x)], 1u);
      asm volatile("s_waitcnt vmcnt(0)" ::: "memory");
    } else {
      XB_SPIN(xb_ld(&bar[XB_XGEN(b.x)]) == gen, bar);
      __builtin_amdgcn_fence(__ATOMIC_ACQUIRE, "agent");
      asm volatile("s_waitcnt vmcnt(0)" ::: "memory");
    }
  }
  __syncthreads();
}

constexpr int N_PHASES = 19;
constexpr int HALF_LDS = 76800;
constexpr int LDS_BYTES = 2 * HALF_LDS;
__global__ void __launch_bounds__(512, 2) mega(Params p, int ph_lo, int ph_hi) {
  __shared__ __attribute__((aligned(16))) char lds_all[LDS_BYTES];
  const int rbid = blockIdx.x, rnb = gridDim.x;
  const int half = __builtin_amdgcn_readfirstlane((int)(threadIdx.x >> 8));
  const int bid = rbid * 2 + half, nb = rnb * 2;
  char* lds = lds_all + half * HALF_LDS;
  const int gw = bid * 4 + __builtin_amdgcn_readfirstlane(VT >> 6), nw = nb * 4;
  char* ws = p.ws;
  float* out1 = p.out + (size_t)M_P * DM;
  __shared__ uint4 xb_words;
  if (threadIdx.x == 0) xb_words = make_uint4(0u, 0u, 0u, 0u);
  __syncthreads();
  XcdBarrier xb; xb.bar = (unsigned*)(ws + OFF_BAR); xb.x = 0; xb.st = (volatile LAS unsigned*)&xb_words;
  if (ph_hi - ph_lo > 1) xb = xcd_barrier_post((unsigned*)(ws + OFF_BAR), (volatile LAS unsigned*)&xb_words);
  if (ph_lo < 0) cg::this_grid().sync();
#ifndef DUP_MASK
#define DUP_MASK 0
#endif
#define PHASE(k, ...) do { if (ph_lo <= (k) && (k) < ph_hi) { __VA_ARGS__ if ((DUP_MASK >> (k)) & 1) { xcd_barrier(xb); __VA_ARGS__ } } if (ph_lo <= (k) && (k) + 1 < ph_hi) xcd_barrier(xb); } while (0)
  PHASE(0, prep_phase(p, lds, bid, nb););
  PHASE(1, gemm_phase<EPI_BF16>((const u16*)(ws + OFF_H), 1024, (const u16*)(ws + WT_ABIN), 1024, 2560, (u16*)(ws + OFF_PROJ), 2560, nullptr, nullptr, nullptr, lds_all, rbid, rnb););
  PHASE(2, rg_phase<false>(p, lds, bid, nb); __syncthreads(); dilated_phase(p, lds, gw, nw););
  PHASE(3, rg_carry_phase(p, bid, nb););
  PHASE(4, rg_phase<true>(p, lds, bid, nb););
  PHASE(5, gemm_phase<EPI_RESID>((const u16*)(ws + OFF_Y), 1024, (const u16*)(ws + WT_ABOUT), 1024, 1024, nullptr, 0, p.xin0, p.xin1, p.out, lds_all, rbid, rnb););
  PHASE(6, rmsnorm_phase(p.out, out1, p.norm_ffn, (u16*)(ws + OFF_H), nullptr, gw, nw););
  PHASE(7, gemm_phase<EPI_SWIGLU>((const u16*)(ws + OFF_H), 1024, (const u16*)(ws + WT_GU0), 1024, 5632, (u16*)(ws + OFF_ACT), FH, nullptr, nullptr, nullptr, lds_all, rbid, rnb););
  PHASE(8, gemm_phase<EPI_RESID>((const u16*)(ws + OFF_ACT), FH, (const u16*)(ws + WT_DOWN0), FH, 1024, nullptr, 0, p.out, out1, p.out, lds_all, rbid, rnb););
  PHASE(9, rmsnorm_phase(p.out, out1, p.norm_mix + 1024, (u16*)(ws + OFF_H), nullptr, gw, nw););
  PHASE(10, gemm_phase<EPI_BF16>((const u16*)(ws + OFF_H), 1024, (const u16*)(ws + WT_MLAIN), 1024, 768, (u16*)(ws + OFF_P2), 768, nullptr, nullptr, nullptr, lds_all, rbid, rnb););
  PHASE(11, mla_norm_phase(p, gw, nw););
  PHASE(12, gemm_phase<EPI_BF16>((const u16*)(ws + OFF_CQN), 384, (const u16*)(ws + WT_QB), 384, 1536, (u16*)(ws + OFF_Q), 1536, nullptr, nullptr, nullptr, lds_all, rbid, rnb); gemm_phase<EPI_BF16>((const u16*)(ws + OFF_CKVN), 256, (const u16*)(ws + WT_KVB), 256, 2048, (u16*)(ws + OFF_KV), 2048, nullptr, nullptr, nullptr, lds_all, rbid, rnb););
  PHASE(13, mla_attn_phase(p, lds, rbid & 7, (rbid >> 3) * 2 + half, (rnb >> 3) * 2, half););
  PHASE(14, gemm_phase<EPI_RESID>((const u16*)(ws + OFF_O), 1024, (const u16*)(ws + WT_MLAOUT), 1024, 1024, nullptr, 0, p.out, out1, p.out, lds_all, rbid, rnb););
  PHASE(15, rmsnorm_phase(p.out, out1, p.norm_ffn + 1024, (u16*)(ws + OFF_H), nullptr, gw, nw););
  PHASE(16, gemm_phase<EPI_SWIGLU>((const u16*)(ws + OFF_H), 1024, (const u16*)(ws + WT_GU1), 1024, 5632, (u16*)(ws + OFF_ACT), FH, nullptr, nullptr, nullptr, lds_all, rbid, rnb););
  PHASE(17, gemm_phase<EPI_RESID>((const u16*)(ws + OFF_ACT), FH, (const u16*)(ws + WT_DOWN1), FH, 1024, nullptr, 0, p.out, out1, p.out, lds_all, rbid, rnb););
  PHASE(18, rmsnorm_phase(p.out, out1, p.norm_final, nullptr, p.out, gw, nw););
#undef PHASE
}

extern "C" void kernel_launch(void* const* d_in, const int* in_sizes, int n_in, void* d_out, int out_size, void* d_ws, size_t ws_size, hipStream_t stream) {
  static int grid_blocks = 0;
  if (!grid_blocks) {
    int dev = 0, cus = 0, per_cu = 0;
    hipGetDevice(&dev);
    hipDeviceGetAttribute(&cus, hipDeviceAttributeMultiprocessorCount, dev);
    hipOccupancyMaxActiveBlocksPerMultiprocessor(&per_cu, mega, 512, 0);
    if (per_cu > 1) per_cu = 1;
    if (per_cu < 1) per_cu = 1;
    grid_blocks = cus * per_cu;
  }
  if (n_in != 23 || ws_size < WS_NEED) { fprintf(stderr, "kernel_launch: bad inputs n_in=%d ws=%zu\n", n_in, ws_size); return; }
  Params p{};
  p.xin0 = (const float*)d_in[0]; p.xin1 = (const float*)d_in[1];
  p.norm_mix = (const float*)d_in[2]; p.norm_ffn = (const float*)d_in[3]; p.norm_final = (const float*)d_in[4];
  p.ab_w_in = (const float*)d_in[5]; p.conv_w = (const float*)d_in[6]; p.conv_b = (const float*)d_in[7];
  p.w_a = (const float*)d_in[8]; p.b_a = (const float*)d_in[9]; p.w_i = (const float*)d_in[10]; p.b_i = (const float*)d_in[11];
  p.lam = (const float*)d_in[12]; p.ab_w_out = (const float*)d_in[13];
  p.mla_w_in = (const float*)d_in[14]; p.q_norm = (const float*)d_in[15]; p.w_qb = (const float*)d_in[16]; p.kv_norm = (const float*)d_in[17];
  p.w_kvb = (const float*)d_in[18]; p.mla_w_out = (const float*)d_in[19];
  p.w_gate = (const float*)d_in[20]; p.w_up = (const float*)d_in[21]; p.w_down = (const float*)d_in[22];
  p.out = (float*)d_out; p.ws = (char*)d_ws;
#if SINGLE_LAUNCH
  hipMemsetAsync((char*)d_ws + OFF_BAR, 0, XCD_BAR_WORDS * 4, stream);
  int lo = 0, hi = N_PHASES;
  void* args[] = {&p, &lo, &hi};
  hipError_t e = hipLaunchCooperativeKernel((void*)mega, dim3(grid_blocks), dim3(512), args, 0, stream);
  if (e != hipSuccess) fprintf(stderr, "cooperative launch failed: %s (grid %d)\n", hipGetErrorString(e), grid_blocks);
#else
  for (int ph = 0; ph < N_PHASES; ++ph) hipLaunchKernelGGL(mega, dim3(grid_blocks), dim3(512), 0, stream, p, ph, ph + 1);
#endif
}
```

```cpp
#include <hip/hip_runtime.h>
#include <hip/hip_cooperative_groups.h>
#include <cstdint>
#include <cstdio>
namespace cg = cooperative_groups;

#ifndef SINGLE_LAUNCH
#define SINGLE_LAUNCH 1
#endif

typedef unsigned short u16;
typedef short bf16x8 __attribute__((ext_vector_type(8)));
typedef short s16x4 __attribute__((ext_vector_type(4)));
typedef float f32x16 __attribute__((ext_vector_type(16)));
typedef float f32x4 __attribute__((ext_vector_type(4)));
typedef float f32x2 __attribute__((ext_vector_type(2)));
typedef unsigned u32x4 __attribute__((ext_vector_type(4)));
typedef unsigned u32x2 __attribute__((ext_vector_type(2)));
typedef __bf16 bf2_t __attribute__((ext_vector_type(2)));
#define DI __device__ __forceinline__
#define VT ((int)(threadIdx.x & 255))
#define MFMA32(a, b, c) __builtin_amdgcn_mfma_f32_32x32x16_bf16((a), (b), (c), 0, 0, 0)

constexpr int M_TOT = 49152, M_P = 32768, DM = 1024, FH = 2816;
constexpr float LOG2E = 1.4426950408889634f;
constexpr size_t MiB = 1ull << 20;
constexpr size_t WT_ABIN = 0;
constexpr size_t WT_ABOUT = WT_ABIN + 2560ull * 1024 * 2;
constexpr size_t WT_GU0 = WT_ABOUT + 1024ull * 1024 * 2;
constexpr size_t WT_DOWN0 = WT_GU0 + 5632ull * 1024 * 2;
constexpr size_t WT_MLAIN = WT_DOWN0 + 1024ull * 2816 * 2;
constexpr size_t WT_QB = WT_MLAIN + 768ull * 1024 * 2;
constexpr size_t WT_KVB = WT_QB + 1536ull * 384 * 2;
constexpr size_t WT_MLAOUT = WT_KVB + 2048ull * 256 * 2;
constexpr size_t WT_GU1 = WT_MLAOUT + 1024ull * 1024 * 2;
constexpr size_t WT_DOWN1 = WT_GU1 + 5632ull * 1024 * 2;
constexpr size_t WT_GATES = WT_DOWN1 + 1024ull * 2816 * 2;
constexpr size_t WT_END = WT_GATES + 32ull * 4096 * 2;
static_assert(WT_END <= 46 * MiB, "weights region");
constexpr size_t OFF_SUM = 46 * MiB;
constexpr size_t OFF_KR = 46 * MiB;
constexpr size_t OFF_COS = 52 * MiB;
constexpr size_t OFF_SIN = 52 * MiB + 512 * 1024;
constexpr size_t OFF_H = 54 * MiB;
constexpr size_t OFF_CQN = 54 * MiB;
constexpr size_t OFF_CKVN = 90 * MiB;
constexpr size_t OFF_O = 54 * MiB;
constexpr size_t OFF_PROJ = 150 * MiB;
constexpr size_t OFF_ACT = 150 * MiB;
constexpr size_t OFF_P2 = 150 * MiB;
constexpr size_t OFF_Q = 150 * MiB;
constexpr size_t OFF_KV = 294 * MiB;
constexpr size_t OFF_Y = 390 * MiB;
constexpr size_t OFF_CARRY = 486 * MiB;
constexpr size_t OFF_BAR = 489 * MiB;
constexpr size_t WS_NEED = 490 * MiB;

struct Params {
  const float* xin0; const float* xin1;
  const float* norm_mix; const float* norm_ffn; const float* norm_final;
  const float* ab_w_in; const float* conv_w; const float* conv_b;
  const float* w_a; const float* b_a; const float* w_i; const float* b_i; const float* lam; const float* ab_w_out;
  const float* mla_w_in; const float* q_norm; const float* w_qb; const float* kv_norm; const float* w_kvb; const float* mla_w_out;
  const float* w_gate; const float* w_up; const float* w_down;
  float* out; char* ws;
};

DI float bf2f(u16 v) { return __uint_as_float(((unsigned)v) << 16); }
DI float bfs2f(short v) { return __uint_as_float(((unsigned)(u16)v) << 16); }
DI unsigned pk2(float lo, float hi) { f32x2 v = {lo, hi}; bf2_t r = __builtin_convertvector(v, bf2_t); return __builtin_bit_cast(unsigned, r); }
DI u16 f2bf(float a) { return (u16)(pk2(a, 0.f) & 0xffffu); }
DI int crow(int r, int hi) { return (r & 3) + 8 * (r >> 2) + 4 * hi; }
DI float sigmoidf_(float x) { return __builtin_amdgcn_rcpf(1.f + __builtin_amdgcn_exp2f(-1.4426950408889634f * x)); }
DI float pl32_max(float v) { auto rr = __builtin_amdgcn_permlane32_swap(__float_as_uint(v), __float_as_uint(v), false, false); return fmaxf(__uint_as_float(rr[0]), __uint_as_float(rr[1])); }
DI float pl32_sum(float v) { auto rr = __builtin_amdgcn_permlane32_swap(__float_as_uint(v), __float_as_uint(v), false, false); return __uint_as_float(rr[0]) + __uint_as_float(rr[1]); }
DI s16x4 tr_read(unsigned addr) { s16x4 r; asm volatile("ds_read_b64_tr_b16 %0, %1" : "=&v"(r) : "v"(addr) : "memory"); return r; }
template <int OFF> DI s16x4 tr_read_o(unsigned addr) { s16x4 r; asm volatile("ds_read_b64_tr_b16 %0, %1 offset:%2" : "=&v"(r) : "v"(addr), "i"(OFF) : "memory"); return r; }
DI float max_nn(float a, float b) { return __builtin_amdgcn_fmed3f(a, b, __builtin_inff()); }
#define LGKM0() do { asm volatile("s_waitcnt lgkmcnt(0)" ::: "memory"); __builtin_amdgcn_sched_barrier(0); } while (0)
DI bf16x8 cat4(s16x4 l, s16x4 h) { return (bf16x8){l[0], l[1], l[2], l[3], h[0], h[1], h[2], h[3]}; }
DI bf16x8 pack8(const f32x16& x, int s) {
  u32x4 w = {pk2(x[8 * s + 0], x[8 * s + 1]), pk2(x[8 * s + 2], x[8 * s + 3]), pk2(x[8 * s + 4], x[8 * s + 5]), pk2(x[8 * s + 6], x[8 * s + 7])};
  return __builtin_bit_cast(bf16x8, w);
}
DI void row_info(int m, int& seq_lo, int& S) { if (m < M_P) { seq_lo = m & ~8191; S = 8192; } else { seq_lo = M_P + ((m - M_P) & ~4095); S = 4096; } }

DI void tr_job(const float* __restrict__ src, int K, int N, u16* __restrict__ dst, int mode, float* tile, int bid, int nb, int& rot) {
  const int tk = K >> 6, tn = (N + 63) >> 6, nt = tk * tn;
  const int tx = VT & 63, ty = VT >> 6;
  const int t0 = (bid + nb - rot) % nb, nit = (nt + nb - 1) / nb;
  (void)tx; (void)ty;
  for (int i = 0; i < nit; ++i) {
    const int t = t0 + i * nb; const bool act = t < nt;
    const int k0 = (t / tn) << 6, n0 = (t % tn) << 6;
    __syncthreads();
    if (act) {
#pragma unroll
      for (int r = 0; r < 4; ++r) {
        const int idx = VT + 256 * r, kk = idx >> 4, c4 = idx & 15, n = n0 + c4 * 4;
        const f32x4 v = n < N ? *(const f32x4*)(src + (size_t)(k0 + kk) * N + n) : (f32x4){0.f, 0.f, 0.f, 0.f};
        float* tp = tile + kk * 65 + c4 * 4;
        tp[0] = v[0]; tp[1] = v[1]; tp[2] = v[2]; tp[3] = v[3];
      }
    }
    __syncthreads();
    if (act) {
#pragma unroll
      for (int r = 0; r < 2; ++r) {
        const int idx = VT + 256 * r, nn = idx >> 3, kc = idx & 7, n = n0 + nn;
        if (n < N) {
          const int row = mode == 0 ? n : ((n >> 5) * 64 + (n & 31) + (mode == 2 ? 32 : 0));
          const float* tp = tile + (kc * 8) * 65 + nn;
          u32x4 w = {pk2(tp[0], tp[65]), pk2(tp[2 * 65], tp[3 * 65]), pk2(tp[4 * 65], tp[5 * 65]), pk2(tp[6 * 65], tp[7 * 65])};
          *(u32x4*)(dst + (size_t)row * K + k0 + kc * 8) = w;
        }
      }
    }
  }
  rot = (rot + nt) % nb;
}

DI void rmsnorm_phase(const float* __restrict__ s0, const float* __restrict__ s1, const float* __restrict__ g, u16* outb, float* outf, int gw, int nw) {
  const int lane = threadIdx.x & 63;
  for (int m = gw; m < M_TOT; m += nw) {
    const float* src = m < M_P ? s0 + (size_t)m * DM : s1 + (size_t)(m - M_P) * DM;
    f32x4 v[4];
#pragma unroll
    for (int i = 0; i < 4; ++i) v[i] = *(const f32x4*)(src + i * 256 + lane * 4);
    float ss = 0.f;
#pragma unroll
    for (int i = 0; i < 4; ++i) ss += v[i][0] * v[i][0] + v[i][1] * v[i][1] + v[i][2] * v[i][2] + v[i][3] * v[i][3];
#pragma unroll
    for (int o = 32; o > 0; o >>= 1) ss += __shfl_xor(ss, o);
    const float rs = rsqrtf(ss * (1.f / 1024.f) + 1e-6f);
#pragma unroll
    for (int i = 0; i < 4; ++i) {
      const f32x4 gg = *(const f32x4*)(g + i * 256 + lane * 4);
      const f32x4 y = v[i] * rs * gg;
      if (outb) { u32x2 w = {pk2(y[0], y[1]), pk2(y[2], y[3])}; *(u32x2*)(outb + (size_t)m * DM + i * 256 + lane * 4) = w; }
      else *(f32x4*)(outf + (size_t)m * DM + i * 256 + lane * 4) = y;
    }
  }
}

DI void prep_phase(const Params& p, char* lds, int bid, int nb) {
  float* tile = (float*)lds;
  char* ws = p.ws;
  int rot = 0;
  tr_job(p.ab_w_in, 1024, 2560, (u16*)(ws + WT_ABIN), 0, tile, bid, nb, rot);
  tr_job(p.ab_w_out, 1024, 1024, (u16*)(ws + WT_ABOUT), 0, tile, bid, nb, rot);
  tr_job(p.w_gate, 1024, FH, (u16*)(ws + WT_GU0), 1, tile, bid, nb, rot);
  tr_job(p.w_up, 1024, FH, (u16*)(ws + WT_GU0), 2, tile, bid, nb, rot);
  tr_job(p.w_gate + (size_t)1024 * FH, 1024, FH, (u16*)(ws + WT_GU1), 1, tile, bid, nb, rot);
  tr_job(p.w_up + (size_t)1024 * FH, 1024, FH, (u16*)(ws + WT_GU1), 2, tile, bid, nb, rot);
  tr_job(p.w_down, FH, 1024, (u16*)(ws + WT_DOWN0), 0, tile, bid, nb, rot);
  tr_job(p.w_down + (size_t)FH * 1024, FH, 1024, (u16*)(ws + WT_DOWN1), 0, tile, bid, nb, rot);
  tr_job(p.mla_w_in, 1024, 672, (u16*)(ws + WT_MLAIN), 0, tile, bid, nb, rot);
  tr_job(p.w_qb, 384, 1536, (u16*)(ws + WT_QB), 0, tile, bid, nb, rot);
  tr_job(p.w_kvb, 256, 2048, (u16*)(ws + WT_KVB), 0, tile, bid, nb, rot);
  tr_job(p.mla_w_out, 1024, 1024, (u16*)(ws + WT_MLAOUT), 0, tile, bid, nb, rot);
  for (int dg = 0; dg < 32; ++dg) {
    const int cb = dg & 7, gate = (dg >> 3) & 1, dir = dg >> 4;
    const float* src = (gate == 0 ? p.w_a : p.w_i) + (size_t)(dir * 8 + cb) * 4096;
    tr_job(src, 64, 64, (u16*)(ws + WT_GATES) + (size_t)dg * 4096, 0, tile, bid, nb, rot);
  }
  const int gtid = bid * 256 + VT, gn = nb * 256;
  { u16* d = (u16*)(ws + WT_MLAIN) + (size_t)672 * 1024; for (int i = gtid; i < 96 * 1024; i += gn) d[i] = 0; }
  { float* ct = (float*)(ws + OFF_COS); float* st = (float*)(ws + OFF_SIN);
    for (int i = gtid; i < 8192 * 16; i += gn) {
      const int pos = i >> 4, k = i & 15;
      const float inv_freq = 1.0f / powf(10000.0f, (float)(2 * k) / 32.0f);
      const float ang = (float)pos * inv_freq;
      double f = (double)ang * 0.15915494309189535; f -= rint(f);
      ct[i] = __builtin_amdgcn_cosf((float)f); st[i] = __builtin_amdgcn_sinf((float)f);
    } }
  rmsnorm_phase(p.xin0, p.xin1, p.norm_mix, (u16*)(ws + OFF_H), nullptr, bid * 4 + (VT >> 6), nb * 4);
}

constexpr int GP = 72;
enum { EPI_BF16 = 0, EPI_RESID = 1, EPI_SWIGLU = 2 };
template <int EPI>
DI void gemm_phase(const u16* __restrict__ A, int lda, const u16* __restrict__ Bt, int K, int N, u16* outb, int ldo,
                   const float* r0, const float* r1, float* outf, char* lds, int bid, int nb) {
  const int tid = threadIdx.x, lane = tid & 63, wid = tid >> 6, wr = wid >> 2, wc = wid & 3, r32 = lane & 31, hi = lane >> 5;
  u16* As = (u16*)lds; u16* Bs = As + 2 * 256 * GP;
  const int nN = N >> 8, nM = M_TOT >> 8, nT = nM * nN, nk = K >> 6;
  const int lrow = tid >> 3, lch = tid & 7;
  const bool swz = (nb == 256);
  const int GN = (nN & 1) == 0 ? 2 : 1, GM = 32 / GN, nSN = nN / GN, nST = (nM / GM) * nSN;
  const int xcd = bid & 7, jb = bid >> 3;
  const int nIter = swz ? (nST - xcd + 7) / 8 : (nT - bid + nb - 1) / nb;
  for (int it = 0; it < nIter; ++it) {
    int tm, tn;
    if (swz) { const int st = xcd + 8 * it, sm = st / nSN, sn = st - sm * nSN; tm = sm * GM + jb / GN; tn = sn * GN + (jb % GN); }
    else { const int t = bid + it * nb; tm = t / nN; tn = t - tm * nN; }
    const u16* Ag = A + (size_t)(tm * 256 + lrow) * lda + lch * 8;
    const u16* Bg = Bt + (size_t)(tn * 256 + lrow) * K + lch * 8;
    f32x16 acc[4][2];
#pragma unroll
    for (int i = 0; i < 4; ++i) { acc[i][0] = f32x16{}; acc[i][1] = f32x16{}; }
    u32x4 ra0[4], rb0[4], ra1[4], rb1[4];
#define SB() __builtin_amdgcn_sched_barrier(0)
#define G_LOAD(RA, RB, KT) do { _Pragma("unroll") for (int i = 0; i < 4; ++i) { RA[i] = *(const u32x4*)(Ag + (size_t)i * 64 * lda + (KT) * 64); RB[i] = *(const u32x4*)(Bg + (size_t)i * 64 * K + (KT) * 64); } } while (0)
#define G_STORE_A(RA, BUF) do { u16* ad = As + (BUF) * 256 * GP; _Pragma("unroll") for (int i = 0; i < 4; ++i) *(u32x4*)(ad + (lrow + 64 * i) * GP + lch * 8) = RA[i]; } while (0)
#define G_STORE_B(RB, BUF) do { u16* bd = Bs + (BUF) * 256 * GP; _Pragma("unroll") for (int i = 0; i < 4; ++i) *(u32x4*)(bd + (lrow + 64 * i) * GP + lch * 8) = RB[i]; } while (0)
#define G_MMA(BUF, KS) do { const u16* as = As + (BUF) * 256 * GP + (wr * 128 + r32) * GP + hi * 8 + (KS) * 16; const u16* bs = Bs + (BUF) * 256 * GP + (wc * 64 + r32) * GP + hi * 8 + (KS) * 16; \
        const bf16x8 b0 = *(const bf16x8*)(bs), b1 = *(const bf16x8*)(bs + 32 * GP); \
        bf16x8 a_[4]; _Pragma("unroll") for (int i = 0; i < 4; ++i) a_[i] = *(const bf16x8*)(as + i * 32 * GP); \
        __builtin_amdgcn_s_setprio(1); \
        _Pragma("unroll") for (int i = 0; i < 4; ++i) { acc[i][0] = MFMA32(a_[i], b0, acc[i][0]); acc[i][1] = MFMA32(a_[i], b1, acc[i][1]); } \
        __builtin_amdgcn_s_setprio(0); } while (0)
#define G_ITER(BUF, RAC, RBC, RAN, RBN, KT) do { \
      if ((KT) + 2 < nk) G_LOAD(RAC, RBC, (KT) + 2); \
      SB(); G_MMA(BUF, 0); SB(); \
      if ((KT) + 1 < nk) G_STORE_A(RAN, (BUF) ^ 1); \
      SB(); G_MMA(BUF, 1); SB(); \
      if ((KT) + 1 < nk) G_STORE_B(RBN, (BUF) ^ 1); \
      SB(); G_MMA(BUF, 2); G_MMA(BUF, 3); SB(); \
      __syncthreads(); } while (0)
    G_LOAD(ra0, rb0, 0);
    G_LOAD(ra1, rb1, 1);
    G_STORE_A(ra0, 0); G_STORE_B(rb0, 0);
    __syncthreads();
    for (int kt = 0; kt < nk; kt += 2) {
      G_ITER(0, ra0, rb0, ra1, rb1, kt);
      G_ITER(1, ra1, rb1, ra0, rb0, kt + 1);
    }
#undef G_LOAD
#undef G_STORE_A
#undef G_STORE_B
#undef G_MMA
#undef G_ITER
    const int mrow = tm * 256 + wr * 128;
    if constexpr (EPI == EPI_BF16) {
      const int col = tn * 256 + wc * 64 + r32;
#pragma unroll
      for (int i = 0; i < 4; ++i)
#pragma unroll
        for (int reg = 0; reg < 16; ++reg) {
          u16* o0 = outb + (size_t)(mrow + i * 32 + crow(reg, hi)) * ldo + col;
          o0[0] = f2bf(acc[i][0][reg]); o0[32] = f2bf(acc[i][1][reg]);
        }
    } else if constexpr (EPI == EPI_RESID) {
      const int col = tn * 256 + wc * 64 + r32;
      const float* rb_ = (tm * 256 < M_P) ? r0 : (r1 - (size_t)M_P * DM);
#pragma unroll
      for (int i = 0; i < 4; ++i)
#pragma unroll
        for (int reg = 0; reg < 16; ++reg) {
          const size_t i0 = (size_t)(mrow + i * 32 + crow(reg, hi)) * DM + col;
          const float x0 = rb_[i0], x1 = rb_[i0 + 32];
          outf[i0] = x0 + acc[i][0][reg]; outf[i0 + 32] = x1 + acc[i][1][reg];
        }
    } else {
      const int col = (tn * 4 + wc) * 32 + r32;
#pragma unroll
      for (int i = 0; i < 4; ++i)
#pragma unroll
        for (int reg = 0; reg < 16; ++reg) {
          const float g0 = acc[i][0][reg], u0 = acc[i][1][reg];
          outb[(size_t)(mrow + i * 32 + crow(reg, hi)) * ldo + col] = f2bf(g0 * sigmoidf_(g0) * u0);
        }
    }
  }
}

template <bool FINAL>
DI void rg_phase(const Params& p, char* lds, int bid, int nb) {
  const int tid = VT, lane = tid & 63, wid = tid >> 6, r32 = lane & 31, hi = lane >> 5;
  u16* xcb = (u16*)lds;
  float* A0 = (float*)(lds + 9216);
  float* U0 = (float*)(lds + 9216 + 16384);
  float* A1 = (float*)(lds + 9216 + 32768);
  float* U1 = (float*)(lds + 9216 + 49152);
  u16* raw = (u16*)A1;
  const u16* PROJ = (const u16*)(p.ws + OFF_PROJ);
  const u16* WG = (const u16*)(p.ws + WT_GATES);
  float* SUM = (float*)(p.ws + OFF_SUM);
  const float* CARRY = (const float*)(p.ws + OFF_CARRY);
  u16* Y = (u16*)(p.ws + OFF_Y);
  const int NIT = 768 * 8, nit = (NIT + nb - 1) / nb;
  const int mt = wid >> 1, nt = wid & 1;
  int cb_loaded = -1;
  float w0 = 0.f, w1 = 0.f, w2 = 0.f, w3 = 0.f, cbias = 0.f, bav[2] = {0.f, 0.f}, biv[2] = {0.f, 0.f}, spv[2] = {0.f, 0.f};
  u32x4 rr[3], rg[2], rrn[3], rgn[2];
  auto load_item = [&](int it, u32x4 (&xr)[3], u32x4 (&xg)[2]) {
    const int gc = it >> 3, cb = it & 7, m0 = gc * 64;
    int seq_lo, S; row_info(m0, seq_lo, S); const int seq_hi = seq_lo + S;
#pragma unroll
    for (int i = 0; i < 3; ++i) {
      const int c = tid + 256 * i, row = c >> 3, ch8 = c & 7, m = m0 - 2 + row;
      xr[i] = (c < 536 && m >= seq_lo && m < seq_hi) ? *(const u32x4*)(PROJ + (size_t)m * 2560 + cb * 64 + ch8 * 8) : (u32x4){0u, 0u, 0u, 0u};
    }
    if (FINAL) {
#pragma unroll
      for (int i = 0; i < 2; ++i) { const int c = tid + 256 * i, row = c >> 3, ch8 = c & 7; xg[i] = *(const u32x4*)(PROJ + (size_t)(m0 + row) * 2560 + 512 + cb * 64 + ch8 * 8); }
    }
  };
  { const int it = bid < NIT ? bid : NIT - 1; load_item(it, rr, rg); }
  for (int k = 0; k < nit; ++k) {
    const int it0 = bid + k * nb, it = it0 < NIT ? it0 : NIT - 1;
    const int gc = it >> 3, cb = it & 7, m0 = gc * 64;
    if (cb != cb_loaded) {
      cb_loaded = cb;
      const int cc = cb * 64 + (tid & 63);
      w0 = p.conv_w[cc]; w1 = p.conv_w[512 + cc]; w2 = p.conv_w[1024 + cc]; w3 = p.conv_w[1536 + cc]; cbias = p.conv_b[cc];
      const int cg_ = cb * 64 + nt * 32 + r32;
#pragma unroll
      for (int dir = 0; dir < 2; ++dir) { bav[dir] = p.b_a[dir * 512 + cg_]; biv[dir] = p.b_i[dir * 512 + cg_]; spv[dir] = log1pf(__expf(-p.lam[dir * 512 + cg_])); }
    }
    __syncthreads();
#pragma unroll
    for (int i = 0; i < 3; ++i) { const int c = tid + 256 * i; if (c < 536) *(u32x4*)(raw + c * 8) = rr[i]; }
    { const int itn0 = bid + (k + 1) * nb, itn = itn0 < NIT ? itn0 : NIT - 1; load_item(itn, rrn, rgn); }
    __syncthreads();
    {
      const int ch = tid & 63, t0 = (tid >> 6) * 16;
      float xm2 = bf2f(raw[(t0) * 64 + ch]), xm1 = bf2f(raw[(t0 + 1) * 64 + ch]), x0 = bf2f(raw[(t0 + 2) * 64 + ch]);
#pragma unroll
      for (int t = t0; t < t0 + 16; ++t) {
        const float xp1 = bf2f(raw[(t + 3) * 64 + ch]);
        xcb[t * 72 + ch] = f2bf(w0 * xm2 + w1 * xm1 + w2 * x0 + w3 * xp1 + cbias);
        xm2 = xm1; xm1 = x0; x0 = xp1;
      }
    }
    __syncthreads();
    {
      bf16x8 af[4];
#pragma unroll
      for (int ks = 0; ks < 4; ++ks) af[ks] = *(const bf16x8*)(xcb + (mt * 32 + r32) * 72 + ks * 16 + 8 * hi);
      const int ch = nt * 32 + r32;
      float xc[16];
#pragma unroll
      for (int reg = 0; reg < 16; ++reg) xc[reg] = bf2f(xcb[(mt * 32 + crow(reg, hi)) * 72 + ch]);
#pragma unroll
      for (int dir = 0; dir < 2; ++dir) {
        f32x16 aa = {}, ai = {};
        const u16* wga = WG + (size_t)((dir * 2 + 0) * 8 + cb) * 4096 + (nt * 32 + r32) * 64 + 8 * hi;
        const u16* wgi = WG + (size_t)((dir * 2 + 1) * 8 + cb) * 4096 + (nt * 32 + r32) * 64 + 8 * hi;
#pragma unroll
        for (int ks = 0; ks < 4; ++ks) { const bf16x8 ba = *(const bf16x8*)(wga + ks * 16), bi = *(const bf16x8*)(wgi + ks * 16); aa = MFMA32(af[ks], ba, aa); ai = MFMA32(af[ks], bi, ai); }
        float* Ab = dir == 0 ? A0 : A1; float* Ub = dir == 0 ? U0 : U1;
#pragma unroll
        for (int reg = 0; reg < 16; ++reg) {
          const int tok = mt * 32 + crow(reg, hi);
          const float r = sigmoidf_(aa[reg] + bav[dir]), gi = sigmoidf_(ai[reg] + biv[dir]);
          const float la2 = -8.f * 1.4426950408889634f * r * spv[dir], a = __builtin_amdgcn_exp2f(la2);
          const float mult = __builtin_amdgcn_sqrtf(fmaxf(0.f, 1.f - a * a));
          Ab[tok * 64 + ch] = a; Ub[tok * 64 + ch] = mult * gi * xc[reg];
        }
      }
    }
    __syncthreads();
    if (wid < 2) {
      const int dir = wid, ch = lane, c = cb * 64 + ch;
      float* Ab = dir == 0 ? A0 : A1; float* Ub = dir == 0 ? U0 : U1;
      if (!FINAL) {
        float h = 0.f, P = 1.f;
#pragma unroll 16
        for (int kk = 0; kk < 64; ++kk) { const int t = dir == 0 ? kk : 63 - kk; const float a = Ab[t * 64 + ch], u = Ub[t * 64 + ch]; h = a * h + u; P *= a; }
        SUM[(size_t)((gc * 2 + dir) * 2 + 0) * 512 + c] = P; SUM[(size_t)((gc * 2 + dir) * 2 + 1) * 512 + c] = h;
      } else {
        float h = CARRY[(size_t)(gc * 2 + dir) * 512 + c];
#pragma unroll 16
        for (int kk = 0; kk < 64; ++kk) { const int t = dir == 0 ? kk : 63 - kk; const float a = Ab[t * 64 + ch], u = Ub[t * 64 + ch]; h = a * h + u; Ub[t * 64 + ch] = h; }
      }
    }
    if (FINAL) {
      __syncthreads();
#pragma unroll
      for (int i = 0; i < 2; ++i) {
        const int c = tid + 256 * i, t = c >> 3, ch8 = c & 7;
        const f32x4 ha = *(const f32x4*)(U0 + t * 64 + ch8 * 8), hb = *(const f32x4*)(U0 + t * 64 + ch8 * 8 + 4);
        const f32x4 hc = *(const f32x4*)(U1 + t * 64 + ch8 * 8), hd = *(const f32x4*)(U1 + t * 64 + ch8 * 8 + 4);
        float hs[8] = {ha[0] + hc[0], ha[1] + hc[1], ha[2] + hc[2], ha[3] + hc[3], hb[0] + hd[0], hb[1] + hd[1], hb[2] + hd[2], hb[3] + hd[3]};
        float yv[8];
#pragma unroll
        for (int j = 0; j < 8; ++j) {
          const unsigned wv = rg[i][j >> 1];
          const float gt = __uint_as_float((j & 1) ? (wv & 0xffff0000u) : (wv << 16));
          const float ge = gt * sigmoidf_(1.5957691216057308f * (gt + 0.044715f * gt * gt * gt));
          yv[j] = ge * hs[j];
        }
        u32x4 o = {pk2(yv[0], yv[1]), pk2(yv[2], yv[3]), pk2(yv[4], yv[5]), pk2(yv[6], yv[7])};
        *(u32x4*)(Y + (size_t)(m0 + t) * 1024 + cb * 64 + ch8 * 8) = o;
      }
    }
#pragma unroll
    for (int i = 0; i < 3; ++i) rr[i] = rrn[i];
#pragma unroll
    for (int i = 0; i < 2; ++i) rg[i] = rgn[i];
  }
}

DI void rg_carry_phase(const Params& p, int bid, int nb) {
  const float* __restrict__ SUM = (const float*)(p.ws + OFF_SUM);
  float* __restrict__ CARRY = (float*)(p.ws + OFF_CARRY);
  for (int idx = bid * 256 + VT; idx < 8192; idx += nb * 256) {
    const int c = idx & 511, dir = (idx >> 9) & 1, seq = idx >> 10;
    const int gc0 = seq < 4 ? seq * 128 : 512 + (seq - 4) * 64, nch = seq < 4 ? 128 : 64;
    float carry = 0.f;
    for (int k0 = 0; k0 < nch; k0 += 8) {
      float P[8], Hh[8];
#pragma unroll
      for (int j = 0; j < 8; ++j) { const int k = k0 + j, gc = dir == 0 ? gc0 + k : gc0 + nch - 1 - k; P[j] = SUM[(size_t)((gc * 2 + dir) * 2 + 0) * 512 + c]; Hh[j] = SUM[(size_t)((gc * 2 + dir) * 2 + 1) * 512 + c]; }
#pragma unroll
      for (int j = 0; j < 8; ++j) { const int k = k0 + j, gc = dir == 0 ? gc0 + k : gc0 + nch - 1 - k; CARRY[(size_t)(gc * 2 + dir) * 512 + c] = carry; carry = P[j] * carry + Hh[j]; }
    }
  }
}

DI void dil_tile_info(int ti, int m0, int& d, int& u0) {
  if (ti < 5) { d = 16; u0 = m0 - 1024 + ti * 512; } else if (ti < 13) { d = 4; u0 = m0 - 256 + (ti - 5) * 128; } else { d = 1; u0 = m0 - 64 + (ti - 13) * 32; }
}
DI void dilated_phase(const Params& p, char* lds, int gw, int nw) {
  const int lane = VT & 63, wid = VT >> 6, r32 = lane & 31, hi = lane >> 5;
  u16* Vl = (u16*)(lds + wid * 6144);
  const unsigned vbase = (unsigned)(uintptr_t)Vl;
  const int li = lane & 15, tq = li >> 2, tp = li & 3, g1 = (lane >> 4) & 1;
  const unsigned trb = vbase + (4 * hi + tq) * 192 + (16 * g1 + 4 * tp) * 2;
  const u16* PROJ = (const u16*)(p.ws + OFF_PROJ);
  u16* Y = (u16*)(p.ws + OFF_Y);
  const int vrow = lane >> 3, vch = lane & 7;
  for (int id = gw; id < 12288; id += nw) {
    const int res = id & 15, h = (id >> 4) & 7, sp = id >> 7;
    const int m0 = sp * 512 + res;
    int seq_lo, S; row_info(sp * 512, seq_lo, S); const int seq_hi = seq_lo + S;
    const int mq = m0 + 16 * r32;
    bf16x8 qf[4];
#pragma unroll
    for (int ks = 0; ks < 4; ++ks) qf[ks] = *(const bf16x8*)(PROJ + (size_t)mq * 2560 + 1024 + h * 64 + ks * 16 + 8 * hi);
    const float slope2 = exp2f(-(float)(h + 1)) * LOG2E;
    const float c1 = 0.125f * LOG2E;
    float m_run = -1e30f, l_run = 0.f; f32x16 o0 = {}, o1 = {};
    const u16* kbase = PROJ + 1536 + h * 64 + 8 * hi;
    const u16* vbaseg = PROJ + 2048 + h * 64 + vch * 8;
    bf16x8 kfA[4], kfB[4]; u32x4 vrA[4], vrB[4];
#define DIL_LOAD(KF, VR, TIV) do { int d_, u_; dil_tile_info((TIV), m0, d_, u_); \
      const int ur_ = min(max(u_ + d_ * r32, seq_lo), seq_hi - 1); \
      _Pragma("unroll") for (int ks = 0; ks < 4; ++ks) KF[ks] = *(const bf16x8*)(kbase + (size_t)ur_ * 2560 + ks * 16); \
      _Pragma("unroll") for (int i = 0; i < 4; ++i) { const int uv_ = min(max(u_ + d_ * (vrow + 8 * i), seq_lo), seq_hi - 1); VR[i] = *(const u32x4*)(vbaseg + (size_t)uv_ * 2560); } } while (0)
#define DIL_TILE(KF, VR, TIV) do { const int ti = (TIV); \
      int d, u0; dil_tile_info(ti, m0, d, u0); \
      _Pragma("unroll") \
      for (int i = 0; i < 4; ++i) *(u32x4*)(Vl + (vrow + 8 * i) * 96 + vch * 8) = VR[i]; \
      f32x16 pt = {}; \
      _Pragma("unroll") \
      for (int ks = 0; ks < 4; ++ks) pt = MFMA32(KF[ks], qf[ks], pt); \
      if (ti + 2 < 33) DIL_LOAD(KF, VR, ti + 2);     \
      const s16x4 l00 = tr_read_o<0>(trb), h00 = tr_read_o<8 * 192>(trb), l01 = tr_read_o<64>(trb), h01 = tr_read_o<8 * 192 + 64>(trb); \
      const s16x4 l10 = tr_read_o<16 * 192>(trb), h10 = tr_read_o<24 * 192>(trb), l11 = tr_read_o<16 * 192 + 64>(trb), h11 = tr_read_o<24 * 192 + 64>(trb); \
      const float fd = (float)d, lim = 64.f * fd; \
      const float fdu0 = (float)(u0 - mq + d * 4 * hi); \
      const float lo_ = fmaxf((float)(seq_lo - mq), -lim), hi_ = fminf((float)(seq_hi - 1 - mq), lim); \
      const float mid = 0.5f * (lo_ + hi_), hw = 0.5f * (hi_ - lo_); \
      const float gdu0 = fdu0 - mid; \
      float pmax = -INFINITY; \
      _Pragma("unroll") \
      for (int reg = 0; reg < 16; ++reg) { \
        const float cf = (float)((reg & 3) + 8 * (reg >> 2)); \
        const float du = fmaf(fd, cf, fdu0), g = fmaf(fd, cf, gdu0); \
        const float tv = (__builtin_fabsf(g) <= hw) ? fmaf(__builtin_fabsf(du), -slope2, pt[reg] * c1) : -INFINITY; \
        pt[reg] = tv; pmax = max_nn(pmax, tv); \
      } \
      pmax = pl32_max(pmax); \
      if (__any(pmax > m_run)) { \
        const float mn = fmaxf(m_run, pmax), alpha = __builtin_amdgcn_exp2f(m_run - mn); \
        m_run = mn; l_run *= alpha; \
      _Pragma("unroll") \
        for (int reg = 0; reg < 16; ++reg) { o0[reg] *= alpha; o1[reg] *= alpha; } \
      } \
      float ps = 0.f; \
      _Pragma("unroll") \
      for (int reg = 0; reg < 16; ++reg) { pt[reg] = __builtin_amdgcn_exp2f(pt[reg] - m_run); ps += pt[reg]; } \
      ps = pl32_sum(ps); \
      l_run += ps; \
      const bf16x8 pb0 = pack8(pt, 0), pb1 = pack8(pt, 1); \
      LGKM0(); \
      o0 = MFMA32(cat4(l00, h00), pb0, o0); o0 = MFMA32(cat4(l10, h10), pb1, o0); \
      o1 = MFMA32(cat4(l01, h01), pb0, o1); o1 = MFMA32(cat4(l11, h11), pb1, o1); \
    } while (0)
    DIL_LOAD(kfA, vrA, 0);
    DIL_LOAD(kfB, vrB, 1);
#pragma unroll 1
    for (int tp2 = 0; tp2 < 32; tp2 += 2) { DIL_TILE(kfA, vrA, tp2); DIL_TILE(kfB, vrB, tp2 + 1); }
    DIL_TILE(kfA, vrA, 32);
#undef DIL_LOAD
#undef DIL_TILE
    const float inv = 1.f / l_run;
    u16* yo = Y + (size_t)mq * 1024 + 512 + h * 64 + 4 * hi;
#pragma unroll
    for (int g = 0; g < 4; ++g) {
      u32x2 w0 = {pk2(o0[4 * g] * inv, o0[4 * g + 1] * inv), pk2(o0[4 * g + 2] * inv, o0[4 * g + 3] * inv)};
      u32x2 w1 = {pk2(o1[4 * g] * inv, o1[4 * g + 1] * inv), pk2(o1[4 * g + 2] * inv, o1[4 * g + 3] * inv)};
      *(u32x2*)(yo + 8 * g) = w0; *(u32x2*)(yo + 32 + 8 * g) = w1;
    }
  }
}

DI void mla_norm_phase(const Params& p, int gw, int nw) {
  const int lane = threadIdx.x & 63;
  const u16* P2 = (const u16*)(p.ws + OFF_P2);
  u16* CQN = (u16*)(p.ws + OFF_CQN); u16* CKVN = (u16*)(p.ws + OFF_CKVN); u16* KR = (u16*)(p.ws + OFF_KR);
  const float* ct = (const float*)(p.ws + OFF_COS); const float* st = (const float*)(p.ws + OFF_SIN);
  float gq[6], gkv[4];
#pragma unroll
  for (int i = 0; i < 6; ++i) gq[i] = p.q_norm[6 * lane + i];
#pragma unroll
  for (int i = 0; i < 4; ++i) gkv[i] = p.kv_norm[4 * lane + i];
  for (int m = gw; m < M_TOT; m += nw) {
    const u16* src = P2 + (size_t)m * 768;
    const unsigned* s32 = (const unsigned*)src;
    const unsigned w0 = s32[3 * lane], w1 = s32[3 * lane + 1], w2 = s32[3 * lane + 2];
    const u32x2 wk = *(const u32x2*)(src + 384 + 4 * lane);
    float q[6] = {__uint_as_float(w0 << 16), __uint_as_float(w0 & 0xffff0000u), __uint_as_float(w1 << 16), __uint_as_float(w1 & 0xffff0000u), __uint_as_float(w2 << 16), __uint_as_float(w2 & 0xffff0000u)};
    float kv[4] = {__uint_as_float(wk[0] << 16), __uint_as_float(wk[0] & 0xffff0000u), __uint_as_float(wk[1] << 16), __uint_as_float(wk[1] & 0xffff0000u)};
    float sq = 0.f, skv = 0.f;
#pragma unroll
    for (int i = 0; i < 6; ++i) sq += q[i] * q[i];
#pragma unroll
    for (int i = 0; i < 4; ++i) skv += kv[i] * kv[i];
#pragma unroll
    for (int o = 32; o > 0; o >>= 1) { sq += __shfl_xor(sq, o); skv += __shfl_xor(skv, o); }
    const float rq = rsqrtf(sq * (1.f / 384.f) + 1e-6f), rkv = rsqrtf(skv * (1.f / 256.f) + 1e-6f);
    unsigned* dq = (unsigned*)(CQN + (size_t)m * 384) + 3 * lane;
    dq[0] = pk2(q[0] * rq * gq[0], q[1] * rq * gq[1]); dq[1] = pk2(q[2] * rq * gq[2], q[3] * rq * gq[3]); dq[2] = pk2(q[4] * rq * gq[4], q[5] * rq * gq[5]);
    u32x2 ok = {pk2(kv[0] * rkv * gkv[0], kv[1] * rkv * gkv[1]), pk2(kv[2] * rkv * gkv[2], kv[3] * rkv * gkv[3])};
    *(u32x2*)(CKVN + (size_t)m * 256 + 4 * lane) = ok;
    if (lane < 16) {
      const int pos = m < M_P ? (m & 8191) : ((m - M_P) & 4095);
      const float t1 = bf2f(src[640 + lane]), t2 = bf2f(src[656 + lane]);
      const float c = ct[pos * 16 + lane], s = st[pos * 16 + lane];
      KR[(size_t)m * 32 + lane] = f2bf(t1 * c - t2 * s); KR[(size_t)m * 32 + 16 + lane] = f2bf(t1 * s + t2 * c);
    }
  }
}

constexpr int KP = 104, VP = 96;
DI void mla_unit(const Params& p, char* lds, int seqbase, int S, int h, int qb) {
  const int tid = threadIdx.x, lane = tid & 63, wid = tid >> 6, r32 = lane & 31, hi = lane >> 5;
  u16* Kl = (u16*)lds;
  u16* Vl = (u16*)(lds + 3 * 64 * KP * 2);
  const unsigned vbase = (unsigned)(uintptr_t)Vl;
  const int li = lane & 15, tq = li >> 2, tp = li & 3, g1 = (lane >> 4) & 1;
  const unsigned trb = vbase + (4 * hi + tq) * (VP * 2) + (16 * g1 + 4 * tp) * 2;
  const u16* Q = (const u16*)(p.ws + OFF_Q); const u16* KV = (const u16*)(p.ws + OFF_KV); const u16* KR = (const u16*)(p.ws + OFF_KR);
  u16* O = (u16*)(p.ws + OFF_O);
  const float* ct = (const float*)(p.ws + OFF_COS); const float* st = (const float*)(p.ws + OFF_SIN);
  const int pos = qb * 256 + wid * 32 + r32, qrow = seqbase + pos;
  bf16x8 qf[6];
#pragma unroll
  for (int d0 = 0; d0 < 6; ++d0) qf[d0] = *(const bf16x8*)(Q + (size_t)qrow * 1536 + h * 96 + d0 * 16 + 8 * hi);
  const float C = 0.10206207261596577f * LOG2E;
#pragma unroll
  for (int j = 0; j < 8; ++j) {
    const float c = ct[pos * 16 + 8 * hi + j], s = st[pos * 16 + 8 * hi + j];
    const float t1 = bfs2f(qf[4][j]), t2 = bfs2f(qf[5][j]);
    qf[4][j] = (short)f2bf((t1 * c - t2 * s) * C); qf[5][j] = (short)f2bf((t1 * s + t2 * c) * C);
  }
#pragma unroll
  for (int d0 = 0; d0 < 4; ++d0)
#pragma unroll
    for (int j = 0; j < 8; ++j) qf[d0][j] = (short)f2bf(bfs2f(qf[d0][j]) * C);
  const int srow = tid >> 3, sc = tid & 7, rrow = (tid >> 2) & 63, rc = tid & 3;
  const bool kr_on = tid < 256;
  const u16* kvsrc = KV + (size_t)(seqbase + srow) * 2048 + h * 128 + sc * 8;
  const u16* krsrc = KR + (size_t)(seqbase + rrow) * 32 + rc * 8;
  const int kdst0 = srow * KP + sc * 8, kdst2 = rrow * KP + 64 + rc * 8, vdst = srow * VP + sc * 8;
  float l_run = 0.f; f32x16 o0 = {}, o1 = {}, negm = {};
  const int nkt = S >> 6;
  u32x4 rkn, rkr, rvv;
#define MLA_GLOAD(T) do { rkn = *(const u32x4*)(kvsrc + (size_t)(T) * 64 * 2048); rvv = *(const u32x4*)(kvsrc + (size_t)(T) * 64 * 2048 + 64); \
    if (kr_on) rkr = *(const u32x4*)(krsrc + (size_t)(T) * 64 * 32); } while (0)
#define MLA_LSTORE(B) do { u16* kd = Kl + (B) * 64 * KP; u16* vd = Vl + (B) * 64 * VP; *(u32x4*)(kd + kdst0) = rkn; *(u32x4*)(vd + vdst) = rvv; \
    if (kr_on) *(u32x4*)(kd + kdst2) = rkr; } while (0)
  MLA_GLOAD(0); MLA_LSTORE(0);
  MLA_GLOAD(1); MLA_LSTORE(1);
  __syncthreads();
  int cur = 0, nx2 = 2;
#pragma unroll 1
  for (int kt = 0; kt < nkt; ++kt) {
    if (kt + 2 < nkt) MLA_GLOAD(kt + 2);
    const u16* kl = Kl + cur * 64 * KP + r32 * KP + 8 * hi;
    f32x16 p0, p1;
    { const bf16x8 k0 = *(const bf16x8*)(kl), k1 = *(const bf16x8*)(kl + 32 * KP);
      p0 = MFMA32(k0, qf[0], negm); p1 = MFMA32(k1, qf[0], negm); }
#pragma unroll
    for (int d0 = 1; d0 < 6; ++d0) {
      const bf16x8 k0 = *(const bf16x8*)(kl + d0 * 16), k1 = *(const bf16x8*)(kl + 32 * KP + d0 * 16);
      p0 = MFMA32(k0, qf[d0], p0); p1 = MFMA32(k1, qf[d0], p1);
    }
    const unsigned tb = trb + cur * (64 * VP * 2);
    constexpr int R8 = 8 * VP * 2;
    const s16x4 a0 = tr_read_o<0>(tb), b0 = tr_read_o<R8>(tb), a1 = tr_read_o<2 * R8>(tb), b1 = tr_read_o<3 * R8>(tb);
    const s16x4 a2 = tr_read_o<4 * R8>(tb), b2 = tr_read_o<5 * R8>(tb), a3 = tr_read_o<6 * R8>(tb), b3 = tr_read_o<7 * R8>(tb);
    const s16x4 c0 = tr_read_o<64>(tb), d0_ = tr_read_o<R8 + 64>(tb), c1 = tr_read_o<2 * R8 + 64>(tb), d1 = tr_read_o<3 * R8 + 64>(tb);
    const s16x4 c2 = tr_read_o<4 * R8 + 64>(tb), d2 = tr_read_o<5 * R8 + 64>(tb), c3 = tr_read_o<6 * R8 + 64>(tb), d3 = tr_read_o<7 * R8 + 64>(tb);
    float pmax = max_nn(p0[0], p1[0]);
#pragma unroll
    for (int r = 1; r < 16; ++r) pmax = max_nn(pmax, max_nn(p0[r], p1[r]));
    pmax = pl32_max(pmax);
    if (kt == 0 || __any(pmax > 8.f)) {
      const float delta = kt == 0 ? pmax : fmaxf(pmax, 0.f);
      const float alpha = kt == 0 ? 1.f : __builtin_amdgcn_exp2f(-delta);
#pragma unroll
      for (int r = 0; r < 16; ++r) { negm[r] -= delta; p0[r] -= delta; p1[r] -= delta; o0[r] *= alpha; o1[r] *= alpha; }
      l_run *= alpha;
    }
    float ps = 0.f;
#pragma unroll
    for (int r = 0; r < 16; ++r) { p0[r] = __builtin_amdgcn_exp2f(p0[r]); p1[r] = __builtin_amdgcn_exp2f(p1[r]); ps += p0[r] + p1[r]; }
    ps = pl32_sum(ps);
    l_run += ps;
    const bf16x8 pb0 = pack8(p0, 0), pb1 = pack8(p0, 1), pb2 = pack8(p1, 0), pb3 = pack8(p1, 1);
    LGKM0();
    o0 = MFMA32(cat4(a0, b0), pb0, o0); o1 = MFMA32(cat4(c0, d0_), pb0, o1);
    o0 = MFMA32(cat4(a1, b1), pb1, o0); o1 = MFMA32(cat4(c1, d1), pb1, o1);
    o0 = MFMA32(cat4(a2, b2), pb2, o0); o1 = MFMA32(cat4(c2, d2), pb2, o1);
    o0 = MFMA32(cat4(a3, b3), pb3, o0); o1 = MFMA32(cat4(c3, d3), pb3, o1);
    __syncthreads();
    if (kt + 2 < nkt) MLA_LSTORE(nx2);
    cur = cur == 2 ? 0 : cur + 1; nx2 = nx2 == 2 ? 0 : nx2 + 1;
  }
  __syncthreads();
#undef MLA_GLOAD
#undef MLA_LSTORE
  const float inv = 1.f / l_run;
  u16* oo = O + (size_t)qrow * 1024 + h * 64 + 4 * hi;
#pragma unroll
  for (int g = 0; g < 4; ++g) {
    u32x2 w0 = {pk2(o0[4 * g] * inv, o0[4 * g + 1] * inv), pk2(o0[4 * g + 2] * inv, o0[4 * g + 3] * inv)};
    u32x2 w1 = {pk2(o1[4 * g] * inv, o1[4 * g + 1] * inv), pk2(o1[4 * g + 2] * inv, o1[4 * g + 3] * inv)};
    *(u32x2*)(oo + 8 * g) = w0; *(u32x2*)(oo + 32 + 8 * g) = w1;
  }
}

DI void mla_attn_phase(const Params& p, char* lds, int xcd, int j, int nper) {
  for (int lu0 = j; lu0 - j < 8 * 32; lu0 += nper) { const int lu = lu0 < 8 * 32 ? lu0 : 8 * 32 - 1; const int bh = (lu >> 5) * 8 + xcd, qb = lu & 31; mla_unit(p, lds, (bh >> 4) * 8192, 8192, bh & 15, qb); }
  for (int lu0 = j; lu0 - j < 8 * 16; lu0 += nper) { const int lu = lu0 < 8 * 16 ? lu0 : 8 * 16 - 1; const int bh = (lu >> 4) * 8 + xcd, qb = lu & 15; mla_unit(p, lds, M_P + (bh >> 4) * 4096, 4096, bh & 15, qb); }
}

#define XB_TMO      128
#define XB_XCNT(j)  (256  + 64 * (j))
#define XB_XSUB(j)  (1280 + 64 * (j))
#define XB_XGEN(j)  (2304 + 64 * (j))
#define XB_TOP      3328
#define XB_TOPGEN   3392
#define XCD_BAR_WORDS 3456
#define XB_SPIN_CAP (1u << 20)
#define LAS __attribute__((address_space(3)))
DI unsigned xb_ld(unsigned* p) { return __hip_atomic_load(p, __ATOMIC_RELAXED, __HIP_MEMORY_SCOPE_AGENT); }
DI unsigned xb_add(unsigned* p, unsigned v) { return __hip_atomic_fetch_add(p, v, __ATOMIC_RELAXED, __HIP_MEMORY_SCOPE_AGENT); }
DI unsigned xb_xcc_id() { return (unsigned)__builtin_amdgcn_s_getreg((3 << 11) | 20) & 0xFu; }
#define XB_SPIN(cond, bar) do { unsigned _sp = 0; while (cond) { __builtin_amdgcn_s_sleep(1); \
    if ((++_sp & 255u) == 0u) { if (xb_ld(&(bar)[XB_TMO])) break; if (_sp > XB_SPIN_CAP) { atomicAdd(&(bar)[XB_TMO], 1u); break; } } } } while (0)
struct XcdBarrier { unsigned* bar; unsigned x; volatile LAS unsigned* st; };
DI XcdBarrier xcd_barrier_post(unsigned* bar, volatile LAS unsigned* st) {
  XcdBarrier b; b.bar = bar; b.x = xb_xcc_id(); b.st = st;
  if (threadIdx.x == 0) (void)xb_add(&bar[XB_XCNT(b.x)], 1u);
  return b;
}
DI void xcd_barrier_complete(unsigned* bar, unsigned x, unsigned& nloc, unsigned& nx) {
  const unsigned G = gridDim.x * gridDim.y * gridDim.z;
  unsigned sum, cnt, mine, sp = 0u;
  for (;;) {
    sum = 0u; cnt = 0u; mine = 0u;
#pragma unroll
    for (unsigned j = 0; j < 16; ++j) { const unsigned c = xb_ld(&bar[XB_XCNT(j)]); sum += c; cnt += (c > 0u) ? 1u : 0u; mine = (j == x) ? c : mine; }
    if (sum == G) break;
    __builtin_amdgcn_s_sleep(1);
    if ((++sp & 255u) == 0u) { if (xb_ld(&bar[XB_TMO])) break; if (sp > XB_SPIN_CAP) { atomicAdd(&bar[XB_TMO], 1u); break; } }
  }
  nloc = mine > 0u ? mine : 1u; nx = cnt > 0u ? cnt : 1u;
}
DI void xcd_barrier(const XcdBarrier& b) {
  asm volatile("s_waitcnt vmcnt(0)" ::: "memory");
  __syncthreads();
  if (threadIdx.x == 0) {
    unsigned* bar = b.bar;
    __builtin_amdgcn_s_waitcnt(0);
    unsigned nloc = b.st[0], nx = b.st[1];
    if (nloc == 0u) { xcd_barrier_complete(bar, b.x, nloc, nx); b.st[0] = nloc; b.st[1] = nx; }
    const unsigned old = xb_add(&bar[XB_XSUB(b.x)], 1u);
    const unsigned gen = old / nloc;
    if (old + 1u == (gen + 1u) * nloc) {
      __builtin_amdgcn_fence(__ATOMIC_RELEASE, "agent");
      asm volatile("s_waitcnt vmcnt(0)" ::: "memory");
      const unsigned og = xb_add(&bar[XB_TOP], 1u);
      const unsigned tg = og / nx;
      if (og + 1u == (tg + 1u) * nx) xb_add(&bar[XB_TOPGEN], 1u);
      else XB_SPIN(xb_ld(&bar[XB_TOPGEN]) == tg, bar);
      __builtin_amdgcn_fence(__ATOMIC_ACQUIRE, "agent");
      xb_add(&bar[XB_XGEN(b.x)], 1u);
      asm volatile("s_waitcnt vmcnt(0)" ::: "memory");
    } else {
      XB_SPIN(xb_ld(&bar[XB_XGEN(b.x)]) == gen, bar);
      __builtin_amdgcn_fence(__ATOMIC_ACQUIRE, "agent");
      asm volatile("s_waitcnt vmcnt(0)" ::: "memory");
    }
  }
  __syncthreads();
}

constexpr int N_PHASES = 19;
constexpr int HALF_LDS = 76800;
constexpr int LDS_BYTES = 2 * HALF_LDS;
__global__ void __launch_bounds__(512, 2) mega(Params p, int ph_lo, int ph_hi) {
  __shared__ __attribute__((aligned(16))) char lds_all[LDS_BYTES];
  const int rbid = blockIdx.x, rnb = gridDim.x;
  const int half = __builtin_amdgcn_readfirstlane((int)(threadIdx.x >> 8));
  const int bid = rbid * 2 + half, nb = rnb * 2;
  char* lds = lds_all + half * HALF_LDS;
  const int gw = bid * 4 + __builtin_amdgcn_readfirstlane(VT >> 6), nw = nb * 4;
  char* ws = p.ws;
  float* out1 = p.out + (size_t)M_P * DM;
  __shared__ uint4 xb_words;
  if (threadIdx.x == 0) xb_words = make_uint4(0u, 0u, 0u, 0u);
  __syncthreads();
  XcdBarrier xb; xb.bar = (unsigned*)(ws + OFF_BAR); xb.x = 0; xb.st = (volatile LAS unsigned*)&xb_words;
  if (ph_hi - ph_lo > 1) xb = xcd_barrier_post((unsigned*)(ws + OFF_BAR), (volatile LAS unsigned*)&xb_words);
  if (ph_lo < 0) cg::this_grid().sync();
#ifndef DUP_MASK
#define DUP_MASK 0
#endif
#define PHASE(k, ...) do { if (ph_lo <= (k) && (k) < ph_hi) { __VA_ARGS__ if ((DUP_MASK >> (k)) & 1) { xcd_barrier(xb); __VA_ARGS__ } } if (ph_lo <= (k) && (k) + 1 < ph_hi) xcd_barrier(xb); } while (0)
  PHASE(0, prep_phase(p, lds, bid, nb););
  PHASE(1, gemm_phase<EPI_BF16>((const u16*)(ws + OFF_H), 1024, (const u16*)(ws + WT_ABIN), 1024, 2560, (u16*)(ws + OFF_PROJ), 2560, nullptr, nullptr, nullptr, lds_all, rbid, rnb););
  PHASE(2, rg_phase<false>(p, lds, bid, nb); __syncthreads(); dilated_phase(p, lds, gw, nw););
  PHASE(3, rg_carry_phase(p, bid, nb););
  PHASE(4, rg_phase<true>(p, lds, bid, nb););
  PHASE(5, gemm_phase<EPI_RESID>((const u16*)(ws + OFF_Y), 1024, (const u16*)(ws + WT_ABOUT), 1024, 1024, nullptr, 0, p.xin0, p.xin1, p.out, lds_all, rbid, rnb););
  PHASE(6, rmsnorm_phase(p.out, out1, p.norm_ffn, (u16*)(ws + OFF_H), nullptr, gw, nw););
  PHASE(7, gemm_phase<EPI_SWIGLU>((const u16*)(ws + OFF_H), 1024, (const u16*)(ws + WT_GU0), 1024, 5632, (u16*)(ws + OFF_ACT), FH, nullptr, nullptr, nullptr, lds_all, rbid, rnb););
  PHASE(8, gemm_phase<EPI_RESID>((const u16*)(ws + OFF_ACT), FH, (const u16*)(ws + WT_DOWN0), FH, 1024, nullptr, 0, p.out, out1, p.out, lds_all, rbid, rnb););
  PHASE(9, rmsnorm_phase(p.out, out1, p.norm_mix + 1024, (u16*)(ws + OFF_H), nullptr, gw, nw););
  PHASE(10, gemm_phase<EPI_BF16>((const u16*)(ws + OFF_H), 1024, (const u16*)(ws + WT_MLAIN), 1024, 768, (u16*)(ws + OFF_P2), 768, nullptr, nullptr, nullptr, lds_all, rbid, rnb););
  PHASE(11, mla_norm_phase(p, gw, nw););
  PHASE(12, gemm_phase<EPI_BF16>((const u16*)(ws + OFF_CQN), 384, (const u16*)(ws + WT_QB), 384, 1536, (u16*)(ws + OFF_Q), 1536, nullptr, nullptr, nullptr, lds_all, rbid, rnb); gemm_phase<EPI_BF16>((const u16*)(ws + OFF_CKVN), 256, (const u16*)(ws + WT_KVB), 256, 2048, (u16*)(ws + OFF_KV), 2048, nullptr, nullptr, nullptr, lds_all, rbid, rnb););
  PHASE(13, mla_attn_phase(p, lds_all, rbid & 7, rbid >> 3, rnb >> 3););
  PHASE(14, gemm_phase<EPI_RESID>((const u16*)(ws + OFF_O), 1024, (const u16*)(ws + WT_MLAOUT), 1024, 1024, nullptr, 0, p.out, out1, p.out, lds_all, rbid, rnb););
  PHASE(15, rmsnorm_phase(p.out, out1, p.norm_ffn + 1024, (u16*)(ws + OFF_H), nullptr, gw, nw););
  PHASE(16, gemm_phase<EPI_SWIGLU>((const u16*)(ws + OFF_H), 1024, (const u16*)(ws + WT_GU1), 1024, 5632, (u16*)(ws + OFF_ACT), FH, nullptr, nullptr, nullptr, lds_all, rbid, rnb););
  PHASE(17, gemm_phase<EPI_RESID>((const u16*)(ws + OFF_ACT), FH, (const u16*)(ws + WT_DOWN1), FH, 1024, nullptr, 0, p.out, out1, p.out, lds_all, rbid, rnb););
  PHASE(18, rmsnorm_phase(p.out, out1, p.norm_final, nullptr, p.out, gw, nw););
#undef PHASE
}

extern "C" void kernel_launch(void* const* d_in, const int* in_sizes, int n_in, void* d_out, int out_size, void* d_ws, size_t ws_size, hipStream_t stream) {
  static int grid_blocks = 0;
  if (!grid_blocks) {
    int dev = 0, cus = 0, per_cu = 0;
    hipGetDevice(&dev);
    hipDeviceGetAttribute(&cus, hipDeviceAttributeMultiprocessorCount, dev);
    hipOccupancyMaxActiveBlocksPerMultiprocessor(&per_cu, mega, 512, 0);
    if (per_cu > 1) per_cu = 1;
    if (per_cu < 1) per_cu = 1;
    grid_blocks = cus * per_cu;
  }
  if (n_in != 23 || ws_size < WS_NEED) { fprintf(stderr, "kernel_launch: bad inputs n_in=%d ws=%zu\n", n_in, ws_size); return; }
  Params p{};
  p.xin0 = (const float*)d_in[0]; p.xin1 = (const float*)d_in[1];
  p.norm_mix = (const float*)d_in[2]; p.norm_ffn = (const float*)d_in[3]; p.norm_final = (const float*)d_in[4];
  p.ab_w_in = (const float*)d_in[5]; p.conv_w = (const float*)d_in[6]; p.conv_b = (const float*)d_in[7];
  p.w_a = (const float*)d_in[8]; p.b_a = (const float*)d_in[9]; p.w_i = (const float*)d_in[10]; p.b_i = (const float*)d_in[11];
  p.lam = (const float*)d_in[12]; p.ab_w_out = (const float*)d_in[13];
  p.mla_w_in = (const float*)d_in[14]; p.q_norm = (const float*)d_in[15]; p.w_qb = (const float*)d_in[16]; p.kv_norm = (const float*)d_in[17];
  p.w_kvb = (const float*)d_in[18]; p.mla_w_out = (const float*)d_in[19];
  p.w_gate = (const float*)d_in[20]; p.w_up = (const float*)d_in[21]; p.w_down = (const float*)d_in[22];
  p.out = (float*)d_out; p.ws = (char*)d_ws;
#if SINGLE_LAUNCH
  hipMemsetAsync((char*)d_ws + OFF_BAR, 0, XCD_BAR_WORDS * 4, stream);
  int lo = 0, hi = N_PHASES;
  void* args[] = {&p, &lo, &hi};
  hipError_t e = hipLaunchCooperativeKernel((void*)mega, dim3(grid_blocks), dim3(512), args, 0, stream);
  if (e != hipSuccess) fprintf(stderr, "cooperative launch failed: %s (grid %d)\n", hipGetErrorString(e), grid_blocks);
#else
  for (int ph = 0; ph < N_PHASES; ++ph) hipLaunchKernelGGL(mega, dim3(grid_blocks), dim3(512), 0, stream, p, ph, ph + 1);
#endif
}
```

```cpp
#include <hip/hip_runtime.h>
#include <hip/hip_cooperative_groups.h>
#include <cstdint>
#include <cstdio>
namespace cg = cooperative_groups;

#ifndef SINGLE_LAUNCH
#define SINGLE_LAUNCH 1
#endif

typedef unsigned short u16;
typedef short bf16x8 __attribute__((ext_vector_type(8)));
typedef short s16x4 __attribute__((ext_vector_type(4)));
typedef float f32x16 __attribute__((ext_vector_type(16)));
typedef float f32x4 __attribute__((ext_vector_type(4)));
typedef float f32x2 __attribute__((ext_vector_type(2)));
typedef unsigned u32x4 __attribute__((ext_vector_type(4)));
typedef unsigned u32x2 __attribute__((ext_vector_type(2)));
typedef __bf16 bf2_t __attribute__((ext_vector_type(2)));
#define DI __device__ __forceinline__
#define VT ((int)(threadIdx.x & 255))
#define MFMA32(a, b, c) __builtin_amdgcn_mfma_f32_32x32x16_bf16((a), (b), (c), 0, 0, 0)

constexpr int M_TOT = 49152, M_P = 32768, DM = 1024, FH = 2816;
constexpr float LOG2E = 1.4426950408889634f;
constexpr size_t MiB = 1ull << 20;
constexpr size_t WT_ABIN = 0;
constexpr size_t WT_ABOUT = WT_ABIN + 2560ull * 1024 * 2;
constexpr size_t WT_GU0 = WT_ABOUT + 1024ull * 1024 * 2;
constexpr size_t WT_DOWN0 = WT_GU0 + 5632ull * 1024 * 2;
constexpr size_t WT_MLAIN = WT_DOWN0 + 1024ull * 2816 * 2;
constexpr size_t WT_QB = WT_MLAIN + 768ull * 1024 * 2;
constexpr size_t WT_KVB = WT_QB + 1536ull * 384 * 2;
constexpr size_t WT_MLAOUT = WT_KVB + 2048ull * 256 * 2;
constexpr size_t WT_GU1 = WT_MLAOUT + 1024ull * 1024 * 2;
constexpr size_t WT_DOWN1 = WT_GU1 + 5632ull * 1024 * 2;
constexpr size_t WT_GATES = WT_DOWN1 + 1024ull * 2816 * 2;
constexpr size_t WT_END = WT_GATES + 32ull * 4096 * 2;
static_assert(WT_END <= 46 * MiB, "weights region");
constexpr size_t OFF_SUM = 46 * MiB;
constexpr size_t OFF_KR = 46 * MiB;
constexpr size_t OFF_COS = 52 * MiB;
constexpr size_t OFF_SIN = 52 * MiB + 512 * 1024;
constexpr size_t OFF_H = 54 * MiB;
constexpr size_t OFF_CQN = 54 * MiB;
constexpr size_t OFF_CKVN = 90 * MiB;
constexpr size_t OFF_O = 54 * MiB;
constexpr size_t OFF_PROJ = 150 * MiB;
constexpr size_t OFF_ACT = 150 * MiB;
constexpr size_t OFF_P2 = 150 * MiB;
constexpr size_t OFF_Q = 150 * MiB;
constexpr size_t OFF_KV = 294 * MiB;
constexpr size_t OFF_Y = 390 * MiB;
constexpr size_t OFF_CARRY = 486 * MiB;
constexpr size_t OFF_BAR = 489 * MiB;
constexpr size_t WS_NEED = 490 * MiB;

struct Params {
  const float* xin0; const float* xin1;
  const float* norm_mix; const float* norm_ffn; const float* norm_final;
  const float* ab_w_in; const float* conv_w; const float* conv_b;
  const float* w_a; const float* b_a; const float* w_i; const float* b_i; const float* lam; const float* ab_w_out;
  const float* mla_w_in; const float* q_norm; const float* w_qb; const float* kv_norm; const float* w_kvb; const float* mla_w_out;
  const float* w_gate; const float* w_up; const float* w_down;
  float* out; char* ws;
};

DI float bf2f(u16 v) { return __uint_as_float(((unsigned)v) << 16); }
DI float bfs2f(short v) { return __uint_as_float(((unsigned)(u16)v) << 16); }
DI unsigned pk2(float lo, float hi) { f32x2 v = {lo, hi}; bf2_t r = __builtin_convertvector(v, bf2_t); return __builtin_bit_cast(unsigned, r); }
DI u16 f2bf(float a) { return (u16)(pk2(a, 0.f) & 0xffffu); }
DI int crow(int r, int hi) { return (r & 3) + 8 * (r >> 2) + 4 * hi; }
DI float sigmoidf_(float x) { return __builtin_amdgcn_rcpf(1.f + __builtin_amdgcn_exp2f(-1.4426950408889634f * x)); }
DI float pl32_max(float v) { auto rr = __builtin_amdgcn_permlane32_swap(__float_as_uint(v), __float_as_uint(v), false, false); return fmaxf(__uint_as_float(rr[0]), __uint_as_float(rr[1])); }
DI float pl32_sum(float v) { auto rr = __builtin_amdgcn_permlane32_swap(__float_as_uint(v), __float_as_uint(v), false, false); return __uint_as_float(rr[0]) + __uint_as_float(rr[1]); }
DI s16x4 tr_read(unsigned addr) { s16x4 r; asm volatile("ds_read_b64_tr_b16 %0, %1" : "=&v"(r) : "v"(addr) : "memory"); return r; }
template <int OFF> DI s16x4 tr_read_o(unsigned addr) { s16x4 r; asm volatile("ds_read_b64_tr_b16 %0, %1 offset:%2" : "=&v"(r) : "v"(addr), "i"(OFF) : "memory"); return r; }
DI float max_nn(float a, float b) { return __builtin_amdgcn_fmed3f(a, b, __builtin_inff()); }
#define LGKM0() do { asm volatile("s_waitcnt lgkmcnt(0)" ::: "memory"); __builtin_amdgcn_sched_barrier(0); } while (0)
DI bf16x8 cat4(s16x4 l, s16x4 h) { return (bf16x8){l[0], l[1], l[2], l[3], h[0], h[1], h[2], h[3]}; }
DI bf16x8 pack8(const f32x16& x, int s) {
  u32x4 w = {pk2(x[8 * s + 0], x[8 * s + 1]), pk2(x[8 * s + 2], x[8 * s + 3]), pk2(x[8 * s + 4], x[8 * s + 5]), pk2(x[8 * s + 6], x[8 * s + 7])};
  return __builtin_bit_cast(bf16x8, w);
}
DI void row_info(int m, int& seq_lo, int& S) { if (m < M_P) { seq_lo = m & ~8191; S = 8192; } else { seq_lo = M_P + ((m - M_P) & ~4095); S = 4096; } }

DI void tr_job(const float* __restrict__ src, int K, int N, u16* __restrict__ dst, int mode, float* tile, int bid, int nb, int& rot) {
  const int tk = K >> 6, tn = (N + 63) >> 6, nt = tk * tn;
  const int tx = VT & 63, ty = VT >> 6;
  const int t0 = (bid + nb - rot) % nb, nit = (nt + nb - 1) / nb;
  (void)tx; (void)ty;
  for (int i = 0; i < nit; ++i) {
    const int t = t0 + i * nb; const bool act = t < nt;
    const int k0 = (t / tn) << 6, n0 = (t % tn) << 6;
    __syncthreads();
    if (act) {
#pragma unroll
      for (int r = 0; r < 4; ++r) {
        const int idx = VT + 256 * r, kk = idx >> 4, c4 = idx & 15, n = n0 + c4 * 4;
        const f32x4 v = n < N ? *(const f32x4*)(src + (size_t)(k0 + kk) * N + n) : (f32x4){0.f, 0.f, 0.f, 0.f};
        float* tp = tile + kk * 65 + c4 * 4;
        tp[0] = v[0]; tp[1] = v[1]; tp[2] = v[2]; tp[3] = v[3];
      }
    }
    __syncthreads();
    if (act) {
#pragma unroll
      for (int r = 0; r < 2; ++r) {
        const int idx = VT + 256 * r, nn = idx >> 3, kc = idx & 7, n = n0 + nn;
        if (n < N) {
          const int row = mode == 0 ? n : ((n >> 5) * 64 + (n & 31) + (mode == 2 ? 32 : 0));
          const float* tp = tile + (kc * 8) * 65 + nn;
          u32x4 w = {pk2(tp[0], tp[65]), pk2(tp[2 * 65], tp[3 * 65]), pk2(tp[4 * 65], tp[5 * 65]), pk2(tp[6 * 65], tp[7 * 65])};
          *(u32x4*)(dst + (size_t)row * K + k0 + kc * 8) = w;
        }
      }
    }
  }
  rot = (rot + nt) % nb;
}

DI void rmsnorm_phase(const float* __restrict__ s0, const float* __restrict__ s1, const float* __restrict__ g, u16* outb, float* outf, int gw, int nw) {
  const int lane = threadIdx.x & 63;
  for (int m = gw; m < M_TOT; m += nw) {
    const float* src = m < M_P ? s0 + (size_t)m * DM : s1 + (size_t)(m - M_P) * DM;
    f32x4 v[4];
#pragma unroll
    for (int i = 0; i < 4; ++i) v[i] = *(const f32x4*)(src + i * 256 + lane * 4);
    float ss = 0.f;
#pragma unroll
    for (int i = 0; i < 4; ++i) ss += v[i][0] * v[i][0] + v[i][1] * v[i][1] + v[i][2] * v[i][2] + v[i][3] * v[i][3];
#pragma unroll
    for (int o = 32; o > 0; o >>= 1) ss += __shfl_xor(ss, o);
    const float rs = rsqrtf(ss * (1.f / 1024.f) + 1e-6f);
#pragma unroll
    for (int i = 0; i < 4; ++i) {
      const f32x4 gg = *(const f32x4*)(g + i * 256 + lane * 4);
      const f32x4 y = v[i] * rs * gg;
      if (outb) { u32x2 w = {pk2(y[0], y[1]), pk2(y[2], y[3])}; *(u32x2*)(outb + (size_t)m * DM + i * 256 + lane * 4) = w; }
      else *(f32x4*)(outf + (size_t)m * DM + i * 256 + lane * 4) = y;
    }
  }
}

DI void prep_phase(const Params& p, char* lds, int bid, int nb) {
  float* tile = (float*)lds;
  char* ws = p.ws;
  int rot = 0;
  tr_job(p.ab_w_in, 1024, 2560, (u16*)(ws + WT_ABIN), 0, tile, bid, nb, rot);
  tr_job(p.ab_w_out, 1024, 1024, (u16*)(ws + WT_ABOUT), 0, tile, bid, nb, rot);
  tr_job(p.w_gate, 1024, FH, (u16*)(ws + WT_GU0), 1, tile, bid, nb, rot);
  tr_job(p.w_up, 1024, FH, (u16*)(ws + WT_GU0), 2, tile, bid, nb, rot);
  tr_job(p.w_gate + (size_t)1024 * FH, 1024, FH, (u16*)(ws + WT_GU1), 1, tile, bid, nb, rot);
  tr_job(p.w_up + (size_t)1024 * FH, 1024, FH, (u16*)(ws + WT_GU1), 2, tile, bid, nb, rot);
  tr_job(p.w_down, FH, 1024, (u16*)(ws + WT_DOWN0), 0, tile, bid, nb, rot);
  tr_job(p.w_down + (size_t)FH * 1024, FH, 1024, (u16*)(ws + WT_DOWN1), 0, tile, bid, nb, rot);
  tr_job(p.mla_w_in, 1024, 672, (u16*)(ws + WT_MLAIN), 0, tile, bid, nb, rot);
  tr_job(p.w_qb, 384, 1536, (u16*)(ws + WT_QB), 0, tile, bid, nb, rot);
  tr_job(p.w_kvb, 256, 2048, (u16*)(ws + WT_KVB), 0, tile, bid, nb, rot);
  tr_job(p.mla_w_out, 1024, 1024, (u16*)(ws + WT_MLAOUT), 0, tile, bid, nb, rot);
  for (int dg = 0; dg < 32; ++dg) {
    const int cb = dg & 7, gate = (dg >> 3) & 1, dir = dg >> 4;
    const float* src = (gate == 0 ? p.w_a : p.w_i) + (size_t)(dir * 8 + cb) * 4096;
    tr_job(src, 64, 64, (u16*)(ws + WT_GATES) + (size_t)dg * 4096, 0, tile, bid, nb, rot);
  }
  const int gtid = bid * 256 + VT, gn = nb * 256;
  { u16* d = (u16*)(ws + WT_MLAIN) + (size_t)672 * 1024; for (int i = gtid; i < 96 * 1024; i += gn) d[i] = 0; }
  { float* ct = (float*)(ws + OFF_COS); float* st = (float*)(ws + OFF_SIN);
    for (int i = gtid; i < 8192 * 16; i += gn) {
      const int pos = i >> 4, k = i & 15;
      const float inv_freq = 1.0f / powf(10000.0f, (float)(2 * k) / 32.0f);
      const float ang = (float)pos * inv_freq;
      double f = (double)ang * 0.15915494309189535; f -= rint(f);
      ct[i] = __builtin_amdgcn_cosf((float)f); st[i] = __builtin_amdgcn_sinf((float)f);
    } }
  rmsnorm_phase(p.xin0, p.xin1, p.norm_mix, (u16*)(ws + OFF_H), nullptr, bid * 4 + (VT >> 6), nb * 4);
}

enum { EPI_BF16 = 0, EPI_RESID = 1, EPI_SWIGLU = 2 };
#define MFMA16(a, b, c) __builtin_amdgcn_mfma_f32_16x16x32_bf16((a), (b), (c), 0, 0, 0)
template <int EPI>
DI void gemm_phase(const u16* __restrict__ A, int lda, const u16* __restrict__ Bt, int K, int N, u16* outb, int ldo,
                   const float* r0, const float* r1, float* outf, char* lds, int bid, int nb) {
  const int tid = threadIdx.x, lane = tid & 63, wid = tid >> 6, wr = wid >> 2, wc = wid & 3, l15 = lane & 15, quad = lane >> 4;
  u16* As = (u16*)lds; u16* Bs = As + 2 * 256 * 64;
  const int nN = N >> 8, nM = M_TOT >> 8, nT = nM * nN, nk = K >> 6;
  const int lrow = tid >> 3, lch = tid & 7;
  const int sto = lrow * 64 + ((lch ^ ((lrow >> 1) & 7)) * 8);
  const int fsw = (l15 >> 1) & 7;
  const int fo0 = ((0 * 4 + quad) ^ fsw) * 8, fo1 = ((1 * 4 + quad) ^ fsw) * 8;
  const bool swz = (nb == 256);
  const int GN = (nN & 1) == 0 ? 2 : 1, GM = 32 / GN, nSN = nN / GN, nST = (nM / GM) * nSN;
  const int xcd = bid & 7, jb = bid >> 3;
  const int nIter = swz ? (nST - xcd + 7) / 8 : (nT - bid + nb - 1) / nb;
  for (int it = 0; it < nIter; ++it) {
    int tm, tn;
    if (swz) { const int st = xcd + 8 * it, sm = st / nSN, sn = st - sm * nSN; tm = sm * GM + jb / GN; tn = sn * GN + (jb % GN); }
    else { const int t = bid + it * nb; tm = t / nN; tn = t - tm * nN; }
    const u16* Ag = A + (size_t)(tm * 256 + lrow) * lda + lch * 8;
    const u16* Bg = Bt + (size_t)(tn * 256 + lrow) * K + lch * 8;
    f32x4 acc[8][4];
#pragma unroll
    for (int i = 0; i < 8; ++i)
#pragma unroll
      for (int j = 0; j < 4; ++j) acc[i][j] = (f32x4){0.f, 0.f, 0.f, 0.f};
    u32x4 ra[4], rb[4];
#define G_LOAD(KT) do { _Pragma("unroll") for (int i = 0; i < 4; ++i) { ra[i] = *(const u32x4*)(Ag + (size_t)i * 64 * lda + (KT) * 64); rb[i] = *(const u32x4*)(Bg + (size_t)i * 64 * K + (KT) * 64); } } while (0)
#define G_STORE(BUF) do { u16* ad = As + (BUF) * 256 * 64 + sto; u16* bd = Bs + (BUF) * 256 * 64 + sto; _Pragma("unroll") for (int i = 0; i < 4; ++i) { *(u32x4*)(ad + i * 64 * 64) = ra[i]; *(u32x4*)(bd + i * 64 * 64) = rb[i]; } } while (0)
#define G_MMA(BUF, FO) do { const u16* as = As + (BUF) * 256 * 64 + (wr * 128 + l15) * 64 + (FO); const u16* bs = Bs + (BUF) * 256 * 64 + (wc * 64 + l15) * 64 + (FO); \
        bf16x8 b_[4], a_[8]; \
        _Pragma("unroll") for (int j = 0; j < 4; ++j) b_[j] = *(const bf16x8*)(bs + j * 16 * 64); \
        _Pragma("unroll") for (int i = 0; i < 8; ++i) a_[i] = *(const bf16x8*)(as + i * 16 * 64); \
        __builtin_amdgcn_s_setprio(1); \
        _Pragma("unroll") for (int i = 0; i < 8; ++i) { _Pragma("unroll") for (int j = 0; j < 4; ++j) acc[i][j] = MFMA16(a_[i], b_[j], acc[i][j]); } \
        __builtin_amdgcn_s_setprio(0); } while (0)
    G_LOAD(0);
    G_STORE(0);
    __syncthreads();
    for (int kt = 0; kt < nk; ++kt) {
      const int cur = kt & 1;
      if (kt + 1 < nk) G_LOAD(kt + 1);
      G_MMA(cur, fo0);
      G_MMA(cur, fo1);
      if (kt + 1 < nk) G_STORE(cur ^ 1);
      __syncthreads();
    }
#undef G_LOAD
#undef G_STORE
#undef G_MMA
    const int mrow = tm * 256 + wr * 128 + quad * 4;
    if constexpr (EPI == EPI_BF16) {
      const int col = tn * 256 + wc * 64 + l15;
#pragma unroll
      for (int i = 0; i < 8; ++i)
#pragma unroll
        for (int r = 0; r < 4; ++r) {
          u16* o0 = outb + (size_t)(mrow + i * 16 + r) * ldo + col;
          o0[0] = f2bf(acc[i][0][r]); o0[16] = f2bf(acc[i][1][r]); o0[32] = f2bf(acc[i][2][r]); o0[48] = f2bf(acc[i][3][r]);
        }
    } else if constexpr (EPI == EPI_RESID) {
      const int col = tn * 256 + wc * 64 + l15;
      const float* rb_ = (tm * 256 < M_P) ? r0 : (r1 - (size_t)M_P * DM);
#pragma unroll
      for (int i = 0; i < 8; ++i)
#pragma unroll
        for (int r = 0; r < 4; ++r) {
          const size_t i0 = (size_t)(mrow + i * 16 + r) * DM + col;
          const float x0 = rb_[i0], x1 = rb_[i0 + 16], x2 = rb_[i0 + 32], x3 = rb_[i0 + 48];
          outf[i0] = x0 + acc[i][0][r]; outf[i0 + 16] = x1 + acc[i][1][r]; outf[i0 + 32] = x2 + acc[i][2][r]; outf[i0 + 48] = x3 + acc[i][3][r];
        }
    } else {
      const int col = (tn * 4 + wc) * 32 + l15;
#pragma unroll
      for (int i = 0; i < 8; ++i)
#pragma unroll
        for (int r = 0; r < 4; ++r) {
          const float g0 = acc[i][0][r], u0 = acc[i][2][r], g1 = acc[i][1][r], u1 = acc[i][3][r];
          u16* o0 = outb + (size_t)(mrow + i * 16 + r) * ldo + col;
          o0[0] = f2bf(g0 * sigmoidf_(g0) * u0); o0[16] = f2bf(g1 * sigmoidf_(g1) * u1);
        }
    }
  }
}

template <bool FINAL>
DI void rg_phase(const Params& p, char* lds, int bid, int nb) {
  const int tid = VT, lane = tid & 63, wid = tid >> 6, r32 = lane & 31, hi = lane >> 5;
  u16* xcb = (u16*)lds;
  float* A0 = (float*)(lds + 9216);
  float* U0 = (float*)(lds + 9216 + 16384);
  float* A1 = (float*)(lds + 9216 + 32768);
  float* U1 = (float*)(lds + 9216 + 49152);
  u16* raw = (u16*)A1;
  const u16* PROJ = (const u16*)(p.ws + OFF_PROJ);
  const u16* WG = (const u16*)(p.ws + WT_GATES);
  float* SUM = (float*)(p.ws + OFF_SUM);
  const float* CARRY = (const float*)(p.ws + OFF_CARRY);
  u16* Y = (u16*)(p.ws + OFF_Y);
  const int NIT = 768 * 8, nit = (NIT + nb - 1) / nb;
  const int mt = wid >> 1, nt = wid & 1;
  int cb_loaded = -1;
  float w0 = 0.f, w1 = 0.f, w2 = 0.f, w3 = 0.f, cbias = 0.f, bav[2] = {0.f, 0.f}, biv[2] = {0.f, 0.f}, spv[2] = {0.f, 0.f};
  u32x4 rr[3], rg[2], rrn[3], rgn[2];
  auto load_item = [&](int it, u32x4 (&xr)[3], u32x4 (&xg)[2]) {
    const int gc = it >> 3, cb = it & 7, m0 = gc * 64;
    int seq_lo, S; row_info(m0, seq_lo, S); const int seq_hi = seq_lo + S;
#pragma unroll
    for (int i = 0; i < 3; ++i) {
      const int c = tid + 256 * i, row = c >> 3, ch8 = c & 7, m = m0 - 2 + row;
      xr[i] = (c < 536 && m >= seq_lo && m < seq_hi) ? *(const u32x4*)(PROJ + (size_t)m * 2560 + cb * 64 + ch8 * 8) : (u32x4){0u, 0u, 0u, 0u};
    }
    if (FINAL) {
#pragma unroll
      for (int i = 0; i < 2; ++i) { const int c = tid + 256 * i, row = c >> 3, ch8 = c & 7; xg[i] = *(const u32x4*)(PROJ + (size_t)(m0 + row) * 2560 + 512 + cb * 64 + ch8 * 8); }
    }
  };
  { const int it = bid < NIT ? bid : NIT - 1; load_item(it, rr, rg); }
  for (int k = 0; k < nit; ++k) {
    const int it0 = bid + k * nb, it = it0 < NIT ? it0 : NIT - 1;
    const int gc = it >> 3, cb = it & 7, m0 = gc * 64;
    if (cb != cb_loaded) {
      cb_loaded = cb;
      const int cc = cb * 64 + (tid & 63);
      w0 = p.conv_w[cc]; w1 = p.conv_w[512 + cc]; w2 = p.conv_w[1024 + cc]; w3 = p.conv_w[1536 + cc]; cbias = p.conv_b[cc];
      const int cg_ = cb * 64 + nt * 32 + r32;
#pragma unroll
      for (int dir = 0; dir < 2; ++dir) { bav[dir] = p.b_a[dir * 512 + cg_]; biv[dir] = p.b_i[dir * 512 + cg_]; spv[dir] = log1pf(__expf(-p.lam[dir * 512 + cg_])); }
    }
    __syncthreads();
#pragma unroll
    for (int i = 0; i < 3; ++i) { const int c = tid + 256 * i; if (c < 536) *(u32x4*)(raw + c * 8) = rr[i]; }
    { const int itn0 = bid + (k + 1) * nb, itn = itn0 < NIT ? itn0 : NIT - 1; load_item(itn, rrn, rgn); }
    __syncthreads();
    {
      const int ch = tid & 63, t0 = (tid >> 6) * 16;
      float xm2 = bf2f(raw[(t0) * 64 + ch]), xm1 = bf2f(raw[(t0 + 1) * 64 + ch]), x0 = bf2f(raw[(t0 + 2) * 64 + ch]);
#pragma unroll
      for (int t = t0; t < t0 + 16; ++t) {
        const float xp1 = bf2f(raw[(t + 3) * 64 + ch]);
        xcb[t * 72 + ch] = f2bf(w0 * xm2 + w1 * xm1 + w2 * x0 + w3 * xp1 + cbias);
        xm2 = xm1; xm1 = x0; x0 = xp1;
      }
    }
    __syncthreads();
    {
      bf16x8 af[4];
#pragma unroll
      for (int ks = 0; ks < 4; ++ks) af[ks] = *(const bf16x8*)(xcb + (mt * 32 + r32) * 72 + ks * 16 + 8 * hi);
      const int ch = nt * 32 + r32;
      float xc[16];
#pragma unroll
      for (int reg = 0; reg < 16; ++reg) xc[reg] = bf2f(xcb[(mt * 32 + crow(reg, hi)) * 72 + ch]);
#pragma unroll
      for (int dir = 0; dir < 2; ++dir) {
        f32x16 aa = {}, ai = {};
        const u16* wga = WG + (size_t)((dir * 2 + 0) * 8 + cb) * 4096 + (nt * 32 + r32) * 64 + 8 * hi;
        const u16* wgi = WG + (size_t)((dir * 2 + 1) * 8 + cb) * 4096 + (nt * 32 + r32) * 64 + 8 * hi;
#pragma unroll
        for (int ks = 0; ks < 4; ++ks) { const bf16x8 ba = *(const bf16x8*)(wga + ks * 16), bi = *(const bf16x8*)(wgi + ks * 16); aa = MFMA32(af[ks], ba, aa); ai = MFMA32(af[ks], bi, ai); }
        float* Ab = dir == 0 ? A0 : A1; float* Ub = dir == 0 ? U0 : U1;
#pragma unroll
        for (int reg = 0; reg < 16; ++reg) {
          const int tok = mt * 32 + crow(reg, hi);
          const float r = sigmoidf_(aa[reg] + bav[dir]), gi = sigmoidf_(ai[reg] + biv[dir]);
          const float la2 = -8.f * 1.4426950408889634f * r * spv[dir], a = __builtin_amdgcn_exp2f(la2);
          const float mult = __builtin_amdgcn_sqrtf(fmaxf(0.f, 1.f - a * a));
          Ab[tok * 64 + ch] = a; Ub[tok * 64 + ch] = mult * gi * xc[reg];
        }
      }
    }
    __syncthreads();
    if (wid < 2) {
      const int dir = wid, ch = lane, c = cb * 64 + ch;
      float* Ab = dir == 0 ? A0 : A1; float* Ub = dir == 0 ? U0 : U1;
      if (!FINAL) {
        float h = 0.f, P = 1.f;
#pragma unroll 16
        for (int kk = 0; kk < 64; ++kk) { const int t = dir == 0 ? kk : 63 - kk; const float a = Ab[t * 64 + ch], u = Ub[t * 64 + ch]; h = a * h + u; P *= a; }
        SUM[(size_t)((gc * 2 + dir) * 2 + 0) * 512 + c] = P; SUM[(size_t)((gc * 2 + dir) * 2 + 1) * 512 + c] = h;
      } else {
        float h = CARRY[(size_t)(gc * 2 + dir) * 512 + c];
#pragma unroll 16
        for (int kk = 0; kk < 64; ++kk) { const int t = dir == 0 ? kk : 63 - kk; const float a = Ab[t * 64 + ch], u = Ub[t * 64 + ch]; h = a * h + u; Ub[t * 64 + ch] = h; }
      }
    }
    if (FINAL) {
      __syncthreads();
#pragma unroll
      for (int i = 0; i < 2; ++i) {
        const int c = tid + 256 * i, t = c >> 3, ch8 = c & 7;
        const f32x4 ha = *(const f32x4*)(U0 + t * 64 + ch8 * 8), hb = *(const f32x4*)(U0 + t * 64 + ch8 * 8 + 4);
        const f32x4 hc = *(const f32x4*)(U1 + t * 64 + ch8 * 8), hd = *(const f32x4*)(U1 + t * 64 + ch8 * 8 + 4);
        float hs[8] = {ha[0] + hc[0], ha[1] + hc[1], ha[2] + hc[2], ha[3] + hc[3], hb[0] + hd[0], hb[1] + hd[1], hb[2] + hd[2], hb[3] + hd[3]};
        float yv[8];
#pragma unroll
        for (int j = 0; j < 8; ++j) {
          const unsigned wv = rg[i][j >> 1];
          const float gt = __uint_as_float((j & 1) ? (wv & 0xffff0000u) : (wv << 16));
          const float ge = gt * sigmoidf_(1.5957691216057308f * (gt + 0.044715f * gt * gt * gt));
          yv[j] = ge * hs[j];
        }
        u32x4 o = {pk2(yv[0], yv[1]), pk2(yv[2], yv[3]), pk2(yv[4], yv[5]), pk2(yv[6], yv[7])};
        *(u32x4*)(Y + (size_t)(m0 + t) * 1024 + cb * 64 + ch8 * 8) = o;
      }
    }
#pragma unroll
    for (int i = 0; i < 3; ++i) rr[i] = rrn[i];
#pragma unroll
    for (int i = 0; i < 2; ++i) rg[i] = rgn[i];
  }
}

DI void rg_carry_phase(const Params& p, int bid, int nb) {
  const float* __restrict__ SUM = (const float*)(p.ws + OFF_SUM);
  float* __restrict__ CARRY = (float*)(p.ws + OFF_CARRY);
  for (int idx = bid * 256 + VT; idx < 8192; idx += nb * 256) {
    const int c = idx & 511, dir = (idx >> 9) & 1, seq = idx >> 10;
    const int gc0 = seq < 4 ? seq * 128 : 512 + (seq - 4) * 64, nch = seq < 4 ? 128 : 64;
    float carry = 0.f;
    for (int k0 = 0; k0 < nch; k0 += 8) {
      float P[8], Hh[8];
#pragma unroll
      for (int j = 0; j < 8; ++j) { const int k = k0 + j, gc = dir == 0 ? gc0 + k : gc0 + nch - 1 - k; P[j] = SUM[(size_t)((gc * 2 + dir) * 2 + 0) * 512 + c]; Hh[j] = SUM[(size_t)((gc * 2 + dir) * 2 + 1) * 512 + c]; }
#pragma unroll
      for (int j = 0; j < 8; ++j) { const int k = k0 + j, gc = dir == 0 ? gc0 + k : gc0 + nch - 1 - k; CARRY[(size_t)(gc * 2 + dir) * 512 + c] = carry; carry = P[j] * carry + Hh[j]; }
    }
  }
}

DI void dil_tile_info(int ti, int m0, int& d, int& u0) {
  if (ti < 5) { d = 16; u0 = m0 - 1024 + ti * 512; } else if (ti < 13) { d = 4; u0 = m0 - 256 + (ti - 5) * 128; } else { d = 1; u0 = m0 - 64 + (ti - 13) * 32; }
}
DI void dilated_phase(const Params& p, char* lds, int gw, int nw) {
  const int lane = VT & 63, wid = VT >> 6, r32 = lane & 31, hi = lane >> 5;
  u16* Vl = (u16*)(lds + wid * 6144);
  const unsigned vbase = (unsigned)(uintptr_t)Vl;
  const int li = lane & 15, tq = li >> 2, tp = li & 3, g1 = (lane >> 4) & 1;
  const unsigned trb = vbase + (4 * hi + tq) * 192 + (16 * g1 + 4 * tp) * 2;
  const u16* PROJ = (const u16*)(p.ws + OFF_PROJ);
  u16* Y = (u16*)(p.ws + OFF_Y);
  const int vrow = lane >> 3, vch = lane & 7;
  for (int id = gw; id < 12288; id += nw) {
    const int res = id & 15, h = (id >> 4) & 7, sp = id >> 7;
    const int m0 = sp * 512 + res;
    int seq_lo, S; row_info(sp * 512, seq_lo, S); const int seq_hi = seq_lo + S;
    const int mq = m0 + 16 * r32;
    bf16x8 qf[4];
#pragma unroll
    for (int ks = 0; ks < 4; ++ks) qf[ks] = *(const bf16x8*)(PROJ + (size_t)mq * 2560 + 1024 + h * 64 + ks * 16 + 8 * hi);
    const float slope2 = exp2f(-(float)(h + 1)) * LOG2E;
    const float c1 = 0.125f * LOG2E;
    float m_run = -1e30f, l_run = 0.f; f32x16 o0 = {}, o1 = {};
    const u16* kbase = PROJ + 1536 + h * 64 + 8 * hi;
    const u16* vbaseg = PROJ + 2048 + h * 64 + vch * 8;
    bf16x8 kfA[4], kfB[4]; u32x4 vrA[4], vrB[4];
#define DIL_LOAD(KF, VR, TIV) do { int d_, u_; dil_tile_info((TIV), m0, d_, u_); \
      const int ur_ = min(max(u_ + d_ * r32, seq_lo), seq_hi - 1); \
      _Pragma("unroll") for (int ks = 0; ks < 4; ++ks) KF[ks] = *(const bf16x8*)(kbase + (size_t)ur_ * 2560 + ks * 16); \
      _Pragma("unroll") for (int i = 0; i < 4; ++i) { const int uv_ = min(max(u_ + d_ * (vrow + 8 * i), seq_lo), seq_hi - 1); VR[i] = *(const u32x4*)(vbaseg + (size_t)uv_ * 2560); } } while (0)
#define DIL_TILE(KF, VR, TIV) do { const int ti = (TIV); \
      int d, u0; dil_tile_info(ti, m0, d, u0); \
      _Pragma("unroll") \
      for (int i = 0; i < 4; ++i) *(u32x4*)(Vl + (vrow + 8 * i) * 96 + vch * 8) = VR[i]; \
      f32x16 pt = {}; \
      _Pragma("unroll") \
      for (int ks = 0; ks < 4; ++ks) pt = MFMA32(KF[ks], qf[ks], pt); \
      if (ti + 2 < 33) DIL_LOAD(KF, VR, ti + 2);     \
      const s16x4 l00 = tr_read_o<0>(trb), h00 = tr_read_o<8 * 192>(trb), l01 = tr_read_o<64>(trb), h01 = tr_read_o<8 * 192 + 64>(trb); \
      const s16x4 l10 = tr_read_o<16 * 192>(trb), h10 = tr_read_o<24 * 192>(trb), l11 = tr_read_o<16 * 192 + 64>(trb), h11 = tr_read_o<24 * 192 + 64>(trb); \
      const float fd = (float)d, lim = 64.f * fd; \
      const float fdu0 = (float)(u0 - mq + d * 4 * hi); \
      const float lo_ = fmaxf((float)(seq_lo - mq), -lim), hi_ = fminf((float)(seq_hi - 1 - mq), lim); \
      const float mid = 0.5f * (lo_ + hi_), hw = 0.5f * (hi_ - lo_); \
      const float gdu0 = fdu0 - mid; \
      float pmax = -INFINITY; \
      _Pragma("unroll") \
      for (int reg = 0; reg < 16; ++reg) { \
        const float cf = (float)((reg & 3) + 8 * (reg >> 2)); \
        const float du = fmaf(fd, cf, fdu0), g = fmaf(fd, cf, gdu0); \
        const float tv = (__builtin_fabsf(g) <= hw) ? fmaf(__builtin_fabsf(du), -slope2, pt[reg] * c1) : -INFINITY; \
        pt[reg] = tv; pmax = max_nn(pmax, tv); \
      } \
      pmax = pl32_max(pmax); \
      if (__any(pmax > m_run)) { \
        const float mn = fmaxf(m_run, pmax), alpha = __builtin_amdgcn_exp2f(m_run - mn); \
        m_run = mn; l_run *= alpha; \
      _Pragma("unroll") \
        for (int reg = 0; reg < 16; ++reg) { o0[reg] *= alpha; o1[reg] *= alpha; } \
      } \
      float ps = 0.f; \
      _Pragma("unroll") \
      for (int reg = 0; reg < 16; ++reg) { pt[reg] = __builtin_amdgcn_exp2f(pt[reg] - m_run); ps += pt[reg]; } \
      ps = pl32_sum(ps); \
      l_run += ps; \
      const bf16x8 pb0 = pack8(pt, 0), pb1 = pack8(pt, 1); \
      LGKM0(); \
      o0 = MFMA32(cat4(l00, h00), pb0, o0); o0 = MFMA32(cat4(l10, h10), pb1, o0); \
      o1 = MFMA32(cat4(l01, h01), pb0, o1); o1 = MFMA32(cat4(l11, h11), pb1, o1); \
    } while (0)
    DIL_LOAD(kfA, vrA, 0);
    DIL_LOAD(kfB, vrB, 1);
#pragma unroll 1
    for (int tp2 = 0; tp2 < 32; tp2 += 2) { DIL_TILE(kfA, vrA, tp2); DIL_TILE(kfB, vrB, tp2 + 1); }
    DIL_TILE(kfA, vrA, 32);
#undef DIL_LOAD
#undef DIL_TILE
    const float inv = 1.f / l_run;
    u16* yo = Y + (size_t)mq * 1024 + 512 + h * 64 + 4 * hi;
#pragma unroll
    for (int g = 0; g < 4; ++g) {
      u32x2 w0 = {pk2(o0[4 * g] * inv, o0[4 * g + 1] * inv), pk2(o0[4 * g + 2] * inv, o0[4 * g + 3] * inv)};
      u32x2 w1 = {pk2(o1[4 * g] * inv, o1[4 * g + 1] * inv), pk2(o1[4 * g + 2] * inv, o1[4 * g + 3] * inv)};
      *(u32x2*)(yo + 8 * g) = w0; *(u32x2*)(yo + 32 + 8 * g) = w1;
    }
  }
}

DI void mla_norm_phase(const Params& p, int gw, int nw) {
  const int lane = threadIdx.x & 63;
  const u16* P2 = (const u16*)(p.ws + OFF_P2);
  u16* CQN = (u16*)(p.ws + OFF_CQN); u16* CKVN = (u16*)(p.ws + OFF_CKVN); u16* KR = (u16*)(p.ws + OFF_KR);
  const float* ct = (const float*)(p.ws + OFF_COS); const float* st = (const float*)(p.ws + OFF_SIN);
  float gq[6], gkv[4];
#pragma unroll
  for (int i = 0; i < 6; ++i) gq[i] = p.q_norm[6 * lane + i];
#pragma unroll
  for (int i = 0; i < 4; ++i) gkv[i] = p.kv_norm[4 * lane + i];
  for (int m = gw; m < M_TOT; m += nw) {
    const u16* src = P2 + (size_t)m * 768;
    const unsigned* s32 = (const unsigned*)src;
    const unsigned w0 = s32[3 * lane], w1 = s32[3 * lane + 1], w2 = s32[3 * lane + 2];
    const u32x2 wk = *(const u32x2*)(src + 384 + 4 * lane);
    float q[6] = {__uint_as_float(w0 << 16), __uint_as_float(w0 & 0xffff0000u), __uint_as_float(w1 << 16), __uint_as_float(w1 & 0xffff0000u), __uint_as_float(w2 << 16), __uint_as_float(w2 & 0xffff0000u)};
    float kv[4] = {__uint_as_float(wk[0] << 16), __uint_as_float(wk[0] & 0xffff0000u), __uint_as_float(wk[1] << 16), __uint_as_float(wk[1] & 0xffff0000u)};
    float sq = 0.f, skv = 0.f;
#pragma unroll
    for (int i = 0; i < 6; ++i) sq += q[i] * q[i];
#pragma unroll
    for (int i = 0; i < 4; ++i) skv += kv[i] * kv[i];
#pragma unroll
    for (int o = 32; o > 0; o >>= 1) { sq += __shfl_xor(sq, o); skv += __shfl_xor(skv, o); }
    const float rq = rsqrtf(sq * (1.f / 384.f) + 1e-6f), rkv = rsqrtf(skv * (1.f / 256.f) + 1e-6f);
    unsigned* dq = (unsigned*)(CQN + (size_t)m * 384) + 3 * lane;
    dq[0] = pk2(q[0] * rq * gq[0], q[1] * rq * gq[1]); dq[1] = pk2(q[2] * rq * gq[2], q[3] * rq * gq[3]); dq[2] = pk2(q[4] * rq * gq[4], q[5] * rq * gq[5]);
    u32x2 ok = {pk2(kv[0] * rkv * gkv[0], kv[1] * rkv * gkv[1]), pk2(kv[2] * rkv * gkv[2], kv[3] * rkv * gkv[3])};
    *(u32x2*)(CKVN + (size_t)m * 256 + 4 * lane) = ok;
    if (lane < 16) {
      const int pos = m < M_P ? (m & 8191) : ((m - M_P) & 4095);
      const float t1 = bf2f(src[640 + lane]), t2 = bf2f(src[656 + lane]);
      const float c = ct[pos * 16 + lane], s = st[pos * 16 + lane];
      KR[(size_t)m * 32 + lane] = f2bf(t1 * c - t2 * s); KR[(size_t)m * 32 + 16 + lane] = f2bf(t1 * s + t2 * c);
    }
  }
}

constexpr int KP = 104, VP = 96;
DI void mla_unit(const Params& p, char* lds, int seqbase, int S, int h, int qb) {
  const int tid = threadIdx.x, lane = tid & 63, wid = tid >> 6, r32 = lane & 31, hi = lane >> 5;
  u16* Kl = (u16*)lds;
  u16* Vl = (u16*)(lds + 3 * 64 * KP * 2);
  const unsigned vbase = (unsigned)(uintptr_t)Vl;
  const int li = lane & 15, tq = li >> 2, tp = li & 3, g1 = (lane >> 4) & 1;
  const unsigned trb = vbase + (4 * hi + tq) * (VP * 2) + (16 * g1 + 4 * tp) * 2;
  const u16* Q = (const u16*)(p.ws + OFF_Q); const u16* KV = (const u16*)(p.ws + OFF_KV); const u16* KR = (const u16*)(p.ws + OFF_KR);
  u16* O = (u16*)(p.ws + OFF_O);
  const float* ct = (const float*)(p.ws + OFF_COS); const float* st = (const float*)(p.ws + OFF_SIN);
  const int pos = qb * 256 + wid * 32 + r32, qrow = seqbase + pos;
  bf16x8 qf[6];
#pragma unroll
  for (int d0 = 0; d0 < 6; ++d0) qf[d0] = *(const bf16x8*)(Q + (size_t)qrow * 1536 + h * 96 + d0 * 16 + 8 * hi);
  const float C = 0.10206207261596577f * LOG2E;
#pragma unroll
  for (int j = 0; j < 8; ++j) {
    const float c = ct[pos * 16 + 8 * hi + j], s = st[pos * 16 + 8 * hi + j];
    const float t1 = bfs2f(qf[4][j]), t2 = bfs2f(qf[5][j]);
    qf[4][j] = (short)f2bf((t1 * c - t2 * s) * C); qf[5][j] = (short)f2bf((t1 * s + t2 * c) * C);
  }
#pragma unroll
  for (int d0 = 0; d0 < 4; ++d0)
#pragma unroll
    for (int j = 0; j < 8; ++j) qf[d0][j] = (short)f2bf(bfs2f(qf[d0][j]) * C);
  const int srow = tid >> 3, sc = tid & 7, rrow = (tid >> 2) & 63, rc = tid & 3;
  const bool kr_on = tid < 256;
  const u16* kvsrc = KV + (size_t)(seqbase + srow) * 2048 + h * 128 + sc * 8;
  const u16* krsrc = KR + (size_t)(seqbase + rrow) * 32 + rc * 8;
  const int kdst0 = srow * KP + sc * 8, kdst2 = rrow * KP + 64 + rc * 8, vdst = srow * VP + sc * 8;
  float l_run = 0.f; f32x16 o0 = {}, o1 = {}, negm = {};
  const int nkt = S >> 6;
  u32x4 rkn, rkr, rvv;
#define MLA_GLOAD(T) do { rkn = *(const u32x4*)(kvsrc + (size_t)(T) * 64 * 2048); rvv = *(const u32x4*)(kvsrc + (size_t)(T) * 64 * 2048 + 64); \
    if (kr_on) rkr = *(const u32x4*)(krsrc + (size_t)(T) * 64 * 32); } while (0)
#define MLA_LSTORE(B) do { u16* kd = Kl + (B) * 64 * KP; u16* vd = Vl + (B) * 64 * VP; *(u32x4*)(kd + kdst0) = rkn; *(u32x4*)(vd + vdst) = rvv; \
    if (kr_on) *(u32x4*)(kd + kdst2) = rkr; } while (0)
  MLA_GLOAD(0); MLA_LSTORE(0);
  MLA_GLOAD(1); MLA_LSTORE(1);
  __syncthreads();
  int cur = 0, nx2 = 2;
#pragma unroll 1
  for (int kt = 0; kt < nkt; ++kt) {
    if (kt + 2 < nkt) MLA_GLOAD(kt + 2);
    const u16* kl = Kl + cur * 64 * KP + r32 * KP + 8 * hi;
    f32x16 p0, p1;
    { const bf16x8 k0 = *(const bf16x8*)(kl), k1 = *(const bf16x8*)(kl + 32 * KP);
      p0 = MFMA32(k0, qf[0], negm); p1 = MFMA32(k1, qf[0], negm); }
#pragma unroll
    for (int d0 = 1; d0 < 6; ++d0) {
      const bf16x8 k0 = *(const bf16x8*)(kl + d0 * 16), k1 = *(const bf16x8*)(kl + 32 * KP + d0 * 16);
      p0 = MFMA32(k0, qf[d0], p0); p1 = MFMA32(k1, qf[d0], p1);
    }
    const unsigned tb = trb + cur * (64 * VP * 2);
    constexpr int R8 = 8 * VP * 2;
    const s16x4 a0 = tr_read_o<0>(tb), b0 = tr_read_o<R8>(tb), a1 = tr_read_o<2 * R8>(tb), b1 = tr_read_o<3 * R8>(tb);
    const s16x4 a2 = tr_read_o<4 * R8>(tb), b2 = tr_read_o<5 * R8>(tb), a3 = tr_read_o<6 * R8>(tb), b3 = tr_read_o<7 * R8>(tb);
    const s16x4 c0 = tr_read_o<64>(tb), d0_ = tr_read_o<R8 + 64>(tb), c1 = tr_read_o<2 * R8 + 64>(tb), d1 = tr_read_o<3 * R8 + 64>(tb);
    const s16x4 c2 = tr_read_o<4 * R8 + 64>(tb), d2 = tr_read_o<5 * R8 + 64>(tb), c3 = tr_read_o<6 * R8 + 64>(tb), d3 = tr_read_o<7 * R8 + 64>(tb);
    float pmax = max_nn(p0[0], p1[0]);
#pragma unroll
    for (int r = 1; r < 16; ++r) pmax = max_nn(pmax, max_nn(p0[r], p1[r]));
    pmax = pl32_max(pmax);
    if (kt == 0 || __any(pmax > 8.f)) {
      const float delta = kt == 0 ? pmax : fmaxf(pmax, 0.f);
      const float alpha = kt == 0 ? 1.f : __builtin_amdgcn_exp2f(-delta);
#pragma unroll
      for (int r = 0; r < 16; ++r) { negm[r] -= delta; p0[r] -= delta; p1[r] -= delta; o0[r] *= alpha; o1[r] *= alpha; }
      l_run *= alpha;
    }
    float ps = 0.f;
#pragma unroll
    for (int r = 0; r < 16; ++r) { p0[r] = __builtin_amdgcn_exp2f(p0[r]); p1[r] = __builtin_amdgcn_exp2f(p1[r]); ps += p0[r] + p1[r]; }
    ps = pl32_sum(ps);
    l_run += ps;
    const bf16x8 pb0 = pack8(p0, 0), pb1 = pack8(p0, 1), pb2 = pack8(p1, 0), pb3 = pack8(p1, 1);
    LGKM0();
    o0 = MFMA32(cat4(a0, b0), pb0, o0); o1 = MFMA32(cat4(c0, d0_), pb0, o1);
    o0 = MFMA32(cat4(a1, b1), pb1, o0); o1 = MFMA32(cat4(c1, d1), pb1, o1);
    o0 = MFMA32(cat4(a2, b2), pb2, o0); o1 = MFMA32(cat4(c2, d2), pb2, o1);
    o0 = MFMA32(cat4(a3, b3), pb3, o0); o1 = MFMA32(cat4(c3, d3), pb3, o1);
    __syncthreads();
    if (kt + 2 < nkt) MLA_LSTORE(nx2);
    cur = cur == 2 ? 0 : cur + 1; nx2 = nx2 == 2 ? 0 : nx2 + 1;
  }
  __syncthreads();
#undef MLA_GLOAD
#undef MLA_LSTORE
  const float inv = 1.f / l_run;
  u16* oo = O + (size_t)qrow * 1024 + h * 64 + 4 * hi;
#pragma unroll
  for (int g = 0; g < 4; ++g) {
    u32x2 w0 = {pk2(o0[4 * g] * inv, o0[4 * g + 1] * inv), pk2(o0[4 * g + 2] * inv, o0[4 * g + 3] * inv)};
    u32x2 w1 = {pk2(o1[4 * g] * inv, o1[4 * g + 1] * inv), pk2(o1[4 * g + 2] * inv, o1[4 * g + 3] * inv)};
    *(u32x2*)(oo + 8 * g) = w0; *(u32x2*)(oo + 32 + 8 * g) = w1;
  }
}

DI void mla_attn_phase(const Params& p, char* lds, int xcd, int j, int nper) {
  for (int lu0 = j; lu0 - j < 8 * 32; lu0 += nper) { const int lu = lu0 < 8 * 32 ? lu0 : 8 * 32 - 1; const int bh = (lu >> 5) * 8 + xcd, qb = lu & 31; mla_unit(p, lds, (bh >> 4) * 8192, 8192, bh & 15, qb); }
  for (int lu0 = j; lu0 - j < 8 * 16; lu0 += nper) { const int lu = lu0 < 8 * 16 ? lu0 : 8 * 16 - 1; const int bh = (lu >> 4) * 8 + xcd, qb = lu & 15; mla_unit(p, lds, M_P + (bh >> 4) * 4096, 4096, bh & 15, qb); }
}

#define XB_TMO      128
#define XB_XCNT(j)  (256  + 64 * (j))
#define XB_XSUB(j)  (1280 + 64 * (j))
#define XB_XGEN(j)  (2304 + 64 * (j))
#define XB_TOP      3328
#define XB_TOPGEN   3392
#define XCD_BAR_WORDS 3456
#define XB_SPIN_CAP (1u << 20)
#define LAS __attribute__((address_space(3)))
DI unsigned xb_ld(unsigned* p) { return __hip_atomic_load(p, __ATOMIC_RELAXED, __HIP_MEMORY_SCOPE_AGENT); }
DI unsigned xb_add(unsigned* p, unsigned v) { return __hip_atomic_fetch_add(p, v, __ATOMIC_RELAXED, __HIP_MEMORY_SCOPE_AGENT); }
DI unsigned xb_xcc_id() { return (unsigned)__builtin_amdgcn_s_getreg((3 << 11) | 20) & 0xFu; }
#define XB_SPIN(cond, bar) do { unsigned _sp = 0; while (cond) { __builtin_amdgcn_s_sleep(1); \
    if ((++_sp & 255u) == 0u) { if (xb_ld(&(bar)[XB_TMO])) break; if (_sp > XB_SPIN_CAP) { atomicAdd(&(bar)[XB_TMO], 1u); break; } } } } while (0)
struct XcdBarrier { unsigned* bar; unsigned x; volatile LAS unsigned* st; };
DI XcdBarrier xcd_barrier_post(unsigned* bar, volatile LAS unsigned* st) {
  XcdBarrier b; b.bar = bar; b.x = xb_xcc_id(); b.st = st;
  if (threadIdx.x == 0) (void)xb_add(&bar[XB_XCNT(b.x)], 1u);
  return b;
}
DI void xcd_barrier_complete(unsigned* bar, unsigned x, unsigned& nloc, unsigned& nx) {
  const unsigned G = gridDim.x * gridDim.y * gridDim.z;
  unsigned sum, cnt, mine, sp = 0u;
  for (;;) {
    sum = 0u; cnt = 0u; mine = 0u;
#pragma unroll
    for (unsigned j = 0; j < 16; ++j) { const unsigned c = xb_ld(&bar[XB_XCNT(j)]); sum += c; cnt += (c > 0u) ? 1u : 0u; mine = (j == x) ? c : mine; }
    if (sum == G) break;
    __builtin_amdgcn_s_sleep(1);
    if ((++sp & 255u) == 0u) { if (xb_ld(&bar[XB_TMO])) break; if (sp > XB_SPIN_CAP) { atomicAdd(&bar[XB_TMO], 1u); break; } }
  }
  nloc = mine > 0u ? mine : 1u; nx = cnt > 0u ? cnt : 1u;
}
DI void xcd_barrier(const XcdBarrier& b) {
  asm volatile("s_waitcnt vmcnt(0)" ::: "memory");
  __syncthreads();
  if (threadIdx.x == 0) {
    unsigned* bar = b.bar;
    __builtin_amdgcn_s_waitcnt(0);
    unsigned nloc = b.st[0], nx = b.st[1];
    if (nloc == 0u) { xcd_barrier_complete(bar, b.x, nloc, nx); b.st[0] = nloc; b.st[1] = nx; }
    const unsigned old = xb_add(&bar[XB_XSUB(b.x)], 1u);
    const unsigned gen = old / nloc;
    if (old + 1u == (gen + 1u) * nloc) {
      __builtin_amdgcn_fence(__ATOMIC_RELEASE, "agent");
      asm volatile("s_waitcnt vmcnt(0)" ::: "memory");
      const unsigned og = xb_add(&bar[XB_TOP], 1u);
      const unsigned tg = og / nx;
      if (og + 1u == (tg + 1u) * nx) xb_add(&bar[XB_TOPGEN], 1u);
      else XB_SPIN(xb_ld(&bar[XB_TOPGEN]) == tg, bar);
      __builtin_amdgcn_fence(__ATOMIC_ACQUIRE, "agent");
      xb_add(&bar[XB_XGEN(b.x)], 1u);
      asm volatile("s_waitcnt vmcnt(0)" ::: "memory");
    } else {
      XB_SPIN(xb_ld(&bar[XB_XGEN(b.x)]) == gen, bar);
      __builtin_amdgcn_fence(__ATOMIC_ACQUIRE, "agent");
      asm volatile("s_waitcnt vmcnt(0)" ::: "memory");
    }
  }
  __syncthreads();
}

constexpr int N_PHASES = 19;
constexpr int HALF_LDS = 76800;
constexpr int LDS_BYTES = 2 * HALF_LDS;
__global__ void __launch_bounds__(512, 2) mega(Params p, int ph_lo, int ph_hi) {
  __shared__ __attribute__((aligned(16))) char lds_all[LDS_BYTES];
  const int rbid = blockIdx.x, rnb = gridDim.x;
  const int half = __builtin_amdgcn_readfirstlane((int)(threadIdx.x >> 8));
  const int bid = rbid * 2 + half, nb = rnb * 2;
  char* lds = lds_all + half * HALF_LDS;
  const int gw = bid * 4 + __builtin_amdgcn_readfirstlane(VT >> 6), nw = nb * 4;
  char* ws = p.ws;
  float* out1 = p.out + (size_t)M_P * DM;
  __shared__ uint4 xb_words;
  if (threadIdx.x == 0) xb_words = make_uint4(0u, 0u, 0u, 0u);
  __syncthreads();
  XcdBarrier xb; xb.bar = (unsigned*)(ws + OFF_BAR); xb.x = 0; xb.st = (volatile LAS unsigned*)&xb_words;
  if (ph_hi - ph_lo > 1) xb = xcd_barrier_post((unsigned*)(ws + OFF_BAR), (volatile LAS unsigned*)&xb_words);
  if (ph_lo < 0) cg::this_grid().sync();
#ifndef DUP_MASK
#define DUP_MASK 0
#endif
#define PHASE(k, ...) do { if (ph_lo <= (k) && (k) < ph_hi) { __VA_ARGS__ if ((DUP_MASK >> (k)) & 1) { xcd_barrier(xb); __VA_ARGS__ } } if (ph_lo <= (k) && (k) + 1 < ph_hi) xcd_barrier(xb); } while (0)
  PHASE(0, prep_phase(p, lds, bid, nb););
  PHASE(1, gemm_phase<EPI_BF16>((const u16*)(ws + OFF_H), 1024, (const u16*)(ws + WT_ABIN), 1024, 2560, (u16*)(ws + OFF_PROJ), 2560, nullptr, nullptr, nullptr, lds_all, rbid, rnb););
  PHASE(2, rg_phase<false>(p, lds, bid, nb); __syncthreads(); dilated_phase(p, lds, gw, nw););
  PHASE(3, rg_carry_phase(p, bid, nb););
  PHASE(4, rg_phase<true>(p, lds, bid, nb););
  PHASE(5, gemm_phase<EPI_RESID>((const u16*)(ws + OFF_Y), 1024, (const u16*)(ws + WT_ABOUT), 1024, 1024, nullptr, 0, p.xin0, p.xin1, p.out, lds_all, rbid, rnb););
  PHASE(6, rmsnorm_phase(p.out, out1, p.norm_ffn, (u16*)(ws + OFF_H), nullptr, gw, nw););
  PHASE(7, gemm_phase<EPI_SWIGLU>((const u16*)(ws + OFF_H), 1024, (const u16*)(ws + WT_GU0), 1024, 5632, (u16*)(ws + OFF_ACT), FH, nullptr, nullptr, nullptr, lds_all, rbid, rnb););
  PHASE(8, gemm_phase<EPI_RESID>((const u16*)(ws + OFF_ACT), FH, (const u16*)(ws + WT_DOWN0), FH, 1024, nullptr, 0, p.out, out1, p.out, lds_all, rbid, rnb););
  PHASE(9, rmsnorm_phase(p.out, out1, p.norm_mix + 1024, (u16*)(ws + OFF_H), nullptr, gw, nw););
  PHASE(10, gemm_phase<EPI_BF16>((const u16*)(ws + OFF_H), 1024, (const u16*)(ws + WT_MLAIN), 1024, 768, (u16*)(ws + OFF_P2), 768, nullptr, nullptr, nullptr, lds_all, rbid, rnb););
  PHASE(11, mla_norm_phase(p, gw, nw););
  PHASE(12, gemm_phase<EPI_BF16>((const u16*)(ws + OFF_CQN), 384, (const u16*)(ws + WT_QB), 384, 1536, (u16*)(ws + OFF_Q), 1536, nullptr, nullptr, nullptr, lds_all, rbid, rnb); gemm_phase<EPI_BF16>((const u16*)(ws + OFF_CKVN), 256, (const u16*)(ws + WT_KVB), 256, 2048, (u16*)(ws + OFF_KV), 2048, nullptr, nullptr, nullptr, lds_all, rbid, rnb););
  PHASE(13, mla_attn_phase(p, lds_all, rbid & 7, rbid >> 3, rnb >> 3););
  PHASE(14, gemm_phase<EPI_RESID>((const u16*)(ws + OFF_O), 1024, (const u16*)(ws + WT_MLAOUT), 1024, 1024, nullptr, 0, p.out, out1, p.out, lds_all, rbid, rnb););
  PHASE(15, rmsnorm_phase(p.out, out1, p.norm_ffn + 1024, (u16*)(ws + OFF_H), nullptr, gw, nw););
  PHASE(16, gemm_phase<EPI_SWIGLU>((const u16*)(ws + OFF_H), 1024, (const u16*)(ws + WT_GU1), 1024, 5632, (u16*)(ws + OFF_ACT), FH, nullptr, nullptr, nullptr, lds_all, rbid, rnb););
  PHASE(17, gemm_phase<EPI_RESID>((const u16*)(ws + OFF_ACT), FH, (const u16*)(ws + WT_DOWN1), FH, 1024, nullptr, 0, p.out, out1, p.out, lds_all, rbid, rnb););
  PHASE(18, rmsnorm_phase(p.out, out1, p.norm_final, nullptr, p.out, gw, nw););
#undef PHASE
}

extern "C" void kernel_launch(void* const* d_in, const int* in_sizes, int n_in, void* d_out, int out_size, void* d_ws, size_t ws_size, hipStream_t stream) {
  static int grid_blocks = 0;
  if (!grid_blocks) {
    int dev = 0, cus = 0, per_cu = 0;
    hipGetDevice(&dev);
    hipDeviceGetAttribute(&cus, hipDeviceAttributeMultiprocessorCount, dev);
    hipOccupancyMaxActiveBlocksPerMultiprocessor(&per_cu, mega, 512, 0);
    if (per_cu > 1) per_cu = 1;
    if (per_cu < 1) per_cu = 1;
    grid_blocks = cus * per_cu;
  }
  if (n_in != 23 || ws_size < WS_NEED) { fprintf(stderr, "kernel_launch: bad inputs n_in=%d ws=%zu\n", n_in, ws_size); return; }
  Params p{};
  p.xin0 = (const float*)d_in[0]; p.xin1 = (const float*)d_in[1];
  p.norm_mix = (const float*)d_in[2]; p.norm_ffn = (const float*)d_in[3]; p.norm_final = (const float*)d_in[4];
  p.ab_w_in = (const float*)d_in[5]; p.conv_w = (const float*)d_in[6]; p.conv_b = (const float*)d_in[7];
  p.w_a = (const float*)d_in[8]; p.b_a = (const float*)d_in[9]; p.w_i = (const float*)d_in[10]; p.b_i = (const float*)d_in[11];
  p.lam = (const float*)d_in[12]; p.ab_w_out = (const float*)d_in[13];
  p.mla_w_in = (const float*)d_in[14]; p.q_norm = (const float*)d_in[15]; p.w_qb = (const float*)d_in[16]; p.kv_norm = (const float*)d_in[17];
  p.w_kvb = (const float*)d_in[18]; p.mla_w_out = (const float*)d_in[19];
  p.w_gate = (const float*)d_in[20]; p.w_up = (const float*)d_in[21]; p.w_down = (const float*)d_in[22];
  p.out = (float*)d_out; p.ws = (char*)d_ws;
#if SINGLE_LAUNCH
  hipMemsetAsync((char*)d_ws + OFF_BAR, 0, XCD_BAR_WORDS * 4, stream);
  int lo = 0, hi = N_PHASES;
  void* args[] = {&p, &lo, &hi};
  hipError_t e = hipLaunchCooperativeKernel((void*)mega, dim3(grid_blocks), dim3(512), args, 0, stream);
  if (e != hipSuccess) fprintf(stderr, "cooperative launch failed: %s (grid %d)\n", hipGetErrorString(e), grid_blocks);
#else
  for (int ph = 0; ph < N_PHASES; ++ph) hipLaunchKernelGGL(mega, dim3(grid_blocks), dim3(512), 0, stream, p, ph, ph + 1);
#endif
}
```

```cpp
#include <hip/hip_runtime.h>
#include <hip/hip_cooperative_groups.h>
#include <cstdint>
#include <cstdio>
namespace cg = cooperative_groups;

#ifndef SINGLE_LAUNCH
#define SINGLE_LAUNCH 1
#endif

typedef unsigned short u16;
typedef short bf16x8 __attribute__((ext_vector_type(8)));
typedef short s16x4 __attribute__((ext_vector_type(4)));
typedef float f32x16 __attribute__((ext_vector_type(16)));
typedef float f32x4 __attribute__((ext_vector_type(4)));
typedef float f32x2 __attribute__((ext_vector_type(2)));
typedef unsigned u32x4 __attribute__((ext_vector_type(4)));
typedef unsigned u32x2 __attribute__((ext_vector_type(2)));
typedef __bf16 bf2_t __attribute__((ext_vector_type(2)));
#define DI __device__ __forceinline__
#define VT ((int)(threadIdx.x & 255))
#define MFMA32(a, b, c) __builtin_amdgcn_mfma_f32_32x32x16_bf16((a), (b), (c), 0, 0, 0)

constexpr int M_TOT = 49152, M_P = 32768, DM = 1024, FH = 2816;
constexpr float LOG2E = 1.4426950408889634f;
constexpr size_t MiB = 1ull << 20;
constexpr size_t WT_ABIN = 0;
constexpr size_t WT_ABOUT = WT_ABIN + 2560ull * 1024 * 2;
constexpr size_t WT_GU0 = WT_ABOUT + 1024ull * 1024 * 2;
constexpr size_t WT_DOWN0 = WT_GU0 + 5632ull * 1024 * 2;
constexpr size_t WT_MLAIN = WT_DOWN0 + 1024ull * 2816 * 2;
constexpr size_t WT_QB = WT_MLAIN + 768ull * 1024 * 2;
constexpr size_t WT_KVB = WT_QB + 1536ull * 384 * 2;
constexpr size_t WT_MLAOUT = WT_KVB + 2048ull * 256 * 2;
constexpr size_t WT_GU1 = WT_MLAOUT + 1024ull * 1024 * 2;
constexpr size_t WT_DOWN1 = WT_GU1 + 5632ull * 1024 * 2;
constexpr size_t WT_GATES = WT_DOWN1 + 1024ull * 2816 * 2;
constexpr size_t WT_END = WT_GATES + 32ull * 4096 * 2;
static_assert(WT_END <= 46 * MiB, "weights region");
constexpr size_t OFF_SUM = 46 * MiB;
constexpr size_t OFF_KR = 46 * MiB;
constexpr size_t OFF_COS = 52 * MiB;
constexpr size_t OFF_SIN = 52 * MiB + 512 * 1024;
constexpr size_t OFF_H = 54 * MiB;
constexpr size_t OFF_CQN = 54 * MiB;
constexpr size_t OFF_CKVN = 90 * MiB;
constexpr size_t OFF_O = 54 * MiB;
constexpr size_t OFF_PROJ = 150 * MiB;
constexpr size_t OFF_ACT = 150 * MiB;
constexpr size_t OFF_P2 = 150 * MiB;
constexpr size_t OFF_Q = 150 * MiB;
constexpr size_t OFF_KV = 294 * MiB;
constexpr size_t OFF_Y = 390 * MiB;
constexpr size_t OFF_CARRY = 486 * MiB;
constexpr size_t OFF_BAR = 53 * MiB;
constexpr size_t WS_NEED = 496 * MiB;
constexpr int KVP = 2112;

struct Params {
  const float* xin0; const float* xin1;
  const float* norm_mix; const float* norm_ffn; const float* norm_final;
  const float* ab_w_in; const float* conv_w; const float* conv_b;
  const float* w_a; const float* b_a; const float* w_i; const float* b_i; const float* lam; const float* ab_w_out;
  const float* mla_w_in; const float* q_norm; const float* w_qb; const float* kv_norm; const float* w_kvb; const float* mla_w_out;
  const float* w_gate; const float* w_up; const float* w_down;
  float* out; char* ws;
};

DI float bf2f(u16 v) { return __uint_as_float(((unsigned)v) << 16); }
DI float bfs2f(short v) { return __uint_as_float(((unsigned)(u16)v) << 16); }
DI unsigned pk2(float lo, float hi) { f32x2 v = {lo, hi}; bf2_t r = __builtin_convertvector(v, bf2_t); return __builtin_bit_cast(unsigned, r); }
DI u16 f2bf(float a) { return (u16)(pk2(a, 0.f) & 0xffffu); }
DI int crow(int r, int hi) { return (r & 3) + 8 * (r >> 2) + 4 * hi; }
DI float sigmoidf_(float x) { return __builtin_amdgcn_rcpf(1.f + __builtin_amdgcn_exp2f(-1.4426950408889634f * x)); }
DI float pl32_max(float v) { auto rr = __builtin_amdgcn_permlane32_swap(__float_as_uint(v), __float_as_uint(v), false, false); return fmaxf(__uint_as_float(rr[0]), __uint_as_float(rr[1])); }
DI float pl32_sum(float v) { auto rr = __builtin_amdgcn_permlane32_swap(__float_as_uint(v), __float_as_uint(v), false, false); return __uint_as_float(rr[0]) + __uint_as_float(rr[1]); }
DI s16x4 tr_read(unsigned addr) { s16x4 r; asm volatile("ds_read_b64_tr_b16 %0, %1" : "=&v"(r) : "v"(addr) : "memory"); return r; }
template <int OFF> DI s16x4 tr_read_o(unsigned addr) { s16x4 r; asm volatile("ds_read_b64_tr_b16 %0, %1 offset:%2" : "=&v"(r) : "v"(addr), "i"(OFF) : "memory"); return r; }
DI float max_nn(float a, float b) { return __builtin_amdgcn_fmed3f(a, b, __builtin_inff()); }
#define LGKM0() do { asm volatile("s_waitcnt lgkmcnt(0)" ::: "memory"); __builtin_amdgcn_sched_barrier(0); } while (0)
DI bf16x8 cat4(s16x4 l, s16x4 h) { return (bf16x8){l[0], l[1], l[2], l[3], h[0], h[1], h[2], h[3]}; }
DI bf16x8 pack8(const f32x16& x, int s) {
  u32x4 w = {pk2(x[8 * s + 0], x[8 * s + 1]), pk2(x[8 * s + 2], x[8 * s + 3]), pk2(x[8 * s + 4], x[8 * s + 5]), pk2(x[8 * s + 6], x[8 * s + 7])};
  return __builtin_bit_cast(bf16x8, w);
}
DI void row_info(int m, int& seq_lo, int& S) { if (m < M_P) { seq_lo = m & ~8191; S = 8192; } else { seq_lo = M_P + ((m - M_P) & ~4095); S = 4096; } }

DI void tr_job(const float* __restrict__ src, int K, int N, u16* __restrict__ dst, int mode, float* tile, int bid, int nb, int& rot) {
  const int tk = K >> 6, tn = (N + 63) >> 6, nt = tk * tn;
  const int tx = VT & 63, ty = VT >> 6;
  const int t0 = (bid + nb - rot) % nb, nit = (nt + nb - 1) / nb;
  (void)tx; (void)ty;
  for (int i = 0; i < nit; ++i) {
    const int t = t0 + i * nb; const bool act = t < nt;
    const int k0 = (t / tn) << 6, n0 = (t % tn) << 6;
    __syncthreads();
    if (act) {
#pragma unroll
      for (int r = 0; r < 4; ++r) {
        const int idx = VT + 256 * r, kk = idx >> 4, c4 = idx & 15, n = n0 + c4 * 4;
        const f32x4 v = n < N ? *(const f32x4*)(src + (size_t)(k0 + kk) * N + n) : (f32x4){0.f, 0.f, 0.f, 0.f};
        float* tp = tile + kk * 65 + c4 * 4;
        tp[0] = v[0]; tp[1] = v[1]; tp[2] = v[2]; tp[3] = v[3];
      }
    }
    __syncthreads();
    if (act) {
#pragma unroll
      for (int r = 0; r < 2; ++r) {
        const int idx = VT + 256 * r, nn = idx >> 3, kc = idx & 7, n = n0 + nn;
        if (n < N) {
          const int row = mode == 0 ? n : ((n >> 5) * 64 + (n & 31) + (mode == 2 ? 32 : 0));
          const float* tp = tile + (kc * 8) * 65 + nn;
          u32x4 w = {pk2(tp[0], tp[65]), pk2(tp[2 * 65], tp[3 * 65]), pk2(tp[4 * 65], tp[5 * 65]), pk2(tp[6 * 65], tp[7 * 65])};
          *(u32x4*)(dst + (size_t)row * K + k0 + kc * 8) = w;
        }
      }
    }
  }
  rot = (rot + nt) % nb;
}

DI void rmsnorm_phase(const float* __restrict__ s0, const float* __restrict__ s1, const float* __restrict__ g, u16* outb, float* outf, int gw, int nw) {
  const int lane = threadIdx.x & 63;
  for (int m = gw; m < M_TOT; m += nw) {
    const float* src = m < M_P ? s0 + (size_t)m * DM : s1 + (size_t)(m - M_P) * DM;
    f32x4 v[4];
#pragma unroll
    for (int i = 0; i < 4; ++i) v[i] = *(const f32x4*)(src + i * 256 + lane * 4);
    float ss = 0.f;
#pragma unroll
    for (int i = 0; i < 4; ++i) ss += v[i][0] * v[i][0] + v[i][1] * v[i][1] + v[i][2] * v[i][2] + v[i][3] * v[i][3];
#pragma unroll
    for (int o = 32; o > 0; o >>= 1) ss += __shfl_xor(ss, o);
    const float rs = rsqrtf(ss * (1.f / 1024.f) + 1e-6f);
#pragma unroll
    for (int i = 0; i < 4; ++i) {
      const f32x4 gg = *(const f32x4*)(g + i * 256 + lane * 4);
      const f32x4 y = v[i] * rs * gg;
      if (outb) { u32x2 w = {pk2(y[0], y[1]), pk2(y[2], y[3])}; *(u32x2*)(outb + (size_t)m * DM + i * 256 + lane * 4) = w; }
      else *(f32x4*)(outf + (size_t)m * DM + i * 256 + lane * 4) = y;
    }
  }
}

DI void prep_phase(const Params& p, char* lds, int bid, int nb) {
  float* tile = (float*)lds;
  char* ws = p.ws;
  int rot = 0;
  tr_job(p.ab_w_in, 1024, 2560, (u16*)(ws + WT_ABIN), 0, tile, bid, nb, rot);
  tr_job(p.ab_w_out, 1024, 1024, (u16*)(ws + WT_ABOUT), 0, tile, bid, nb, rot);
  tr_job(p.w_gate, 1024, FH, (u16*)(ws + WT_GU0), 1, tile, bid, nb, rot);
  tr_job(p.w_up, 1024, FH, (u16*)(ws + WT_GU0), 2, tile, bid, nb, rot);
  tr_job(p.w_gate + (size_t)1024 * FH, 1024, FH, (u16*)(ws + WT_GU1), 1, tile, bid, nb, rot);
  tr_job(p.w_up + (size_t)1024 * FH, 1024, FH, (u16*)(ws + WT_GU1), 2, tile, bid, nb, rot);
  tr_job(p.w_down, FH, 1024, (u16*)(ws + WT_DOWN0), 0, tile, bid, nb, rot);
  tr_job(p.w_down + (size_t)FH * 1024, FH, 1024, (u16*)(ws + WT_DOWN1), 0, tile, bid, nb, rot);
  tr_job(p.mla_w_in, 1024, 672, (u16*)(ws + WT_MLAIN), 0, tile, bid, nb, rot);
  tr_job(p.w_qb, 384, 1536, (u16*)(ws + WT_QB), 0, tile, bid, nb, rot);
  tr_job(p.w_kvb, 256, 2048, (u16*)(ws + WT_KVB), 0, tile, bid, nb, rot);
  tr_job(p.mla_w_out, 1024, 1024, (u16*)(ws + WT_MLAOUT), 0, tile, bid, nb, rot);
  for (int dg = 0; dg < 32; ++dg) {
    const int cb = dg & 7, gate = (dg >> 3) & 1, dir = dg >> 4;
    const float* src = (gate == 0 ? p.w_a : p.w_i) + (size_t)(dir * 8 + cb) * 4096;
    tr_job(src, 64, 64, (u16*)(ws + WT_GATES) + (size_t)dg * 4096, 0, tile, bid, nb, rot);
  }
  const int gtid = bid * 256 + VT, gn = nb * 256;
  { u16* d = (u16*)(ws + WT_MLAIN) + (size_t)672 * 1024; for (int i = gtid; i < 96 * 1024; i += gn) d[i] = 0; }
  { float* ct = (float*)(ws + OFF_COS); float* st = (float*)(ws + OFF_SIN);
    for (int i = gtid; i < 8192 * 16; i += gn) {
      const int pos = i >> 4, k = i & 15;
      const float inv_freq = 1.0f / powf(10000.0f, (float)(2 * k) / 32.0f);
      const float ang = (float)pos * inv_freq;
      double f = (double)ang * 0.15915494309189535; f -= rint(f);
      ct[i] = __builtin_amdgcn_cosf((float)f); st[i] = __builtin_amdgcn_sinf((float)f);
    } }
  rmsnorm_phase(p.xin0, p.xin1, p.norm_mix, (u16*)(ws + OFF_H), nullptr, bid * 4 + (VT >> 6), nb * 4);
}

enum { EPI_BF16 = 0, EPI_RESID = 1, EPI_SWIGLU = 2 };
#define MFMA16(a, b, c) __builtin_amdgcn_mfma_f32_16x16x32_bf16((a), (b), (c), 0, 0, 0)
template <int EPI>
DI void gemm_phase(const u16* __restrict__ A, int lda, const u16* __restrict__ Bt, int K, int N, u16* outb, int ldo,
                   const float* r0, const float* r1, float* outf, char* lds, int bid, int nb) {
  const int tid = threadIdx.x, lane = tid & 63, wid = tid >> 6, wr = wid >> 2, wc = wid & 3, l15 = lane & 15, quad = lane >> 4;
  u16* As = (u16*)lds; u16* Bs = As + 2 * 256 * 64;
  const int nN = N >> 8, nM = M_TOT >> 8, nT = nM * nN, nk = K >> 6;
  const int lrow = tid >> 3, lch = tid & 7;
  const int sto = lrow * 64 + ((lch ^ ((lrow >> 1) & 7)) * 8);
  const int fsw = (l15 >> 1) & 7;
  const int fo0 = ((0 * 4 + quad) ^ fsw) * 8, fo1 = ((1 * 4 + quad) ^ fsw) * 8;
  const bool swz = (nb == 256);
  const int GN = (nN & 1) == 0 ? 2 : 1, GM = 32 / GN, nSN = nN / GN, nST = (nM / GM) * nSN;
  const int xcd = bid & 7, jb = bid >> 3;
  const int nIter = swz ? (nST - xcd + 7) / 8 : (nT - bid + nb - 1) / nb;
  for (int it = 0; it < nIter; ++it) {
    int tm, tn;
    if (swz) { const int st = xcd + 8 * it, sm = st / nSN, sn = st - sm * nSN; tm = sm * GM + jb / GN; tn = sn * GN + (jb % GN); }
    else { const int t = bid + it * nb; tm = t / nN; tn = t - tm * nN; }
    const u16* Ag = A + (size_t)(tm * 256 + lrow) * lda + lch * 8;
    const u16* Bg = Bt + (size_t)(tn * 256 + lrow) * K + lch * 8;
    f32x4 acc[8][4];
#pragma unroll
    for (int i = 0; i < 8; ++i)
#pragma unroll
      for (int j = 0; j < 4; ++j) acc[i][j] = (f32x4){0.f, 0.f, 0.f, 0.f};
    u32x4 ra[4], rb[4];
#define G_LOAD(KT) do { _Pragma("unroll") for (int i = 0; i < 4; ++i) { ra[i] = *(const u32x4*)(Ag + (size_t)i * 64 * lda + (KT) * 64); rb[i] = *(const u32x4*)(Bg + (size_t)i * 64 * K + (KT) * 64); } } while (0)
#define G_STORE(BUF) do { u16* ad = As + (BUF) * 256 * 64 + sto; u16* bd = Bs + (BUF) * 256 * 64 + sto; _Pragma("unroll") for (int i = 0; i < 4; ++i) { *(u32x4*)(ad + i * 64 * 64) = ra[i]; *(u32x4*)(bd + i * 64 * 64) = rb[i]; } } while (0)
#define G_MMA(BUF, FO) do { const u16* as = As + (BUF) * 256 * 64 + (wr * 128 + l15) * 64 + (FO); const u16* bs = Bs + (BUF) * 256 * 64 + (wc * 64 + l15) * 64 + (FO); \
        bf16x8 b_[4], a_[8]; \
        _Pragma("unroll") for (int j = 0; j < 4; ++j) b_[j] = *(const bf16x8*)(bs + j * 16 * 64); \
        _Pragma("unroll") for (int i = 0; i < 8; ++i) a_[i] = *(const bf16x8*)(as + i * 16 * 64); \
        __builtin_amdgcn_s_setprio(1); \
        _Pragma("unroll") for (int i = 0; i < 8; ++i) { _Pragma("unroll") for (int j = 0; j < 4; ++j) acc[i][j] = MFMA16(a_[i], b_[j], acc[i][j]); } \
        __builtin_amdgcn_s_setprio(0); } while (0)
    G_LOAD(0);
    G_STORE(0);
    __syncthreads();
    for (int kt = 0; kt < nk; ++kt) {
      const int cur = kt & 1;
      if (kt + 1 < nk) G_LOAD(kt + 1);
      G_MMA(cur, fo0);
      G_MMA(cur, fo1);
      if (kt + 1 < nk) G_STORE(cur ^ 1);
      __syncthreads();
    }
#undef G_LOAD
#undef G_STORE
#undef G_MMA
    const int mrow = tm * 256 + wr * 128 + quad * 4;
    if constexpr (EPI == EPI_BF16) {
      const int col = tn * 256 + wc * 64 + l15;
#pragma unroll
      for (int i = 0; i < 8; ++i)
#pragma unroll
        for (int r = 0; r < 4; ++r) {
          u16* o0 = outb + (size_t)(mrow + i * 16 + r) * ldo + col;
          o0[0] = f2bf(acc[i][0][r]); o0[16] = f2bf(acc[i][1][r]); o0[32] = f2bf(acc[i][2][r]); o0[48] = f2bf(acc[i][3][r]);
        }
    } else if constexpr (EPI == EPI_RESID) {
      const int col = tn * 256 + wc * 64 + l15;
      const float* rb_ = (tm * 256 < M_P) ? r0 : (r1 - (size_t)M_P * DM);
#pragma unroll
      for (int i = 0; i < 8; ++i)
#pragma unroll
        for (int r = 0; r < 4; ++r) {
          const size_t i0 = (size_t)(mrow + i * 16 + r) * DM + col;
          const float x0 = rb_[i0], x1 = rb_[i0 + 16], x2 = rb_[i0 + 32], x3 = rb_[i0 + 48];
          outf[i0] = x0 + acc[i][0][r]; outf[i0 + 16] = x1 + acc[i][1][r]; outf[i0 + 32] = x2 + acc[i][2][r]; outf[i0 + 48] = x3 + acc[i][3][r];
        }
    } else {
      const int col = (tn * 4 + wc) * 32 + l15;
#pragma unroll
      for (int i = 0; i < 8; ++i)
#pragma unroll
        for (int r = 0; r < 4; ++r) {
          const float g0 = acc[i][0][r], u0 = acc[i][2][r], g1 = acc[i][1][r], u1 = acc[i][3][r];
          u16* o0 = outb + (size_t)(mrow + i * 16 + r) * ldo + col;
          o0[0] = f2bf(g0 * sigmoidf_(g0) * u0); o0[16] = f2bf(g1 * sigmoidf_(g1) * u1);
        }
    }
  }
}

template <bool FINAL>
DI void rg_phase(const Params& p, char* lds, int bid, int nb) {
  const int tid = VT, lane = tid & 63, wid = tid >> 6, r32 = lane & 31, hi = lane >> 5;
  u16* xcb = (u16*)lds;
  float* A0 = (float*)(lds + 9216);
  float* U0 = (float*)(lds + 9216 + 16384);
  float* A1 = (float*)(lds + 9216 + 32768);
  float* U1 = (float*)(lds + 9216 + 49152);
  u16* raw = (u16*)A1;
  const u16* PROJ = (const u16*)(p.ws + OFF_PROJ);
  const u16* WG = (const u16*)(p.ws + WT_GATES);
  float* SUM = (float*)(p.ws + OFF_SUM);
  const float* CARRY = (const float*)(p.ws + OFF_CARRY);
  u16* Y = (u16*)(p.ws + OFF_Y);
  const int NIT = 768 * 8, nit = (NIT + nb - 1) / nb;
  const int mt = wid >> 1, nt = wid & 1;
  int cb_loaded = -1;
  float w0 = 0.f, w1 = 0.f, w2 = 0.f, w3 = 0.f, cbias = 0.f, bav[2] = {0.f, 0.f}, biv[2] = {0.f, 0.f}, spv[2] = {0.f, 0.f};
  u32x4 rr[3], rg[2], rrn[3], rgn[2];
  auto load_item = [&](int it, u32x4 (&xr)[3], u32x4 (&xg)[2]) {
    const int gc = it >> 3, cb = it & 7, m0 = gc * 64;
    int seq_lo, S; row_info(m0, seq_lo, S); const int seq_hi = seq_lo + S;
#pragma unroll
    for (int i = 0; i < 3; ++i) {
      const int c = tid + 256 * i, row = c >> 3, ch8 = c & 7, m = m0 - 2 + row;
      xr[i] = (c < 536 && m >= seq_lo && m < seq_hi) ? *(const u32x4*)(PROJ + (size_t)m * 2560 + cb * 64 + ch8 * 8) : (u32x4){0u, 0u, 0u, 0u};
    }
    if (FINAL) {
#pragma unroll
      for (int i = 0; i < 2; ++i) { const int c = tid + 256 * i, row = c >> 3, ch8 = c & 7; xg[i] = *(const u32x4*)(PROJ + (size_t)(m0 + row) * 2560 + 512 + cb * 64 + ch8 * 8); }
    }
  };
  { const int it = bid < NIT ? bid : NIT - 1; load_item(it, rr, rg); }
  for (int k = 0; k < nit; ++k) {
    const int it0 = bid + k * nb, it = it0 < NIT ? it0 : NIT - 1;
    const int gc = it >> 3, cb = it & 7, m0 = gc * 64;
    if (cb != cb_loaded) {
      cb_loaded = cb;
      const int cc = cb * 64 + (tid & 63);
      w0 = p.conv_w[cc]; w1 = p.conv_w[512 + cc]; w2 = p.conv_w[1024 + cc]; w3 = p.conv_w[1536 + cc]; cbias = p.conv_b[cc];
      const int cg_ = cb * 64 + nt * 32 + r32;
#pragma unroll
      for (int dir = 0; dir < 2; ++dir) { bav[dir] = p.b_a[dir * 512 + cg_]; biv[dir] = p.b_i[dir * 512 + cg_]; spv[dir] = log1pf(__expf(-p.lam[dir * 512 + cg_])); }
    }
    __syncthreads();
#pragma unroll
    for (int i = 0; i < 3; ++i) { const int c = tid + 256 * i; if (c < 536) *(u32x4*)(raw + c * 8) = rr[i]; }
    { const int itn0 = bid + (k + 1) * nb, itn = itn0 < NIT ? itn0 : NIT - 1; load_item(itn, rrn, rgn); }
    __syncthreads();
    {
      const int ch = tid & 63, t0 = (tid >> 6) * 16;
      float xm2 = bf2f(raw[(t0) * 64 + ch]), xm1 = bf2f(raw[(t0 + 1) * 64 + ch]), x0 = bf2f(raw[(t0 + 2) * 64 + ch]);
#pragma unroll
      for (int t = t0; t < t0 + 16; ++t) {
        const float xp1 = bf2f(raw[(t + 3) * 64 + ch]);
        xcb[t * 72 + ch] = f2bf(w0 * xm2 + w1 * xm1 + w2 * x0 + w3 * xp1 + cbias);
        xm2 = xm1; xm1 = x0; x0 = xp1;
      }
    }
    __syncthreads();
    {
      bf16x8 af[4];
#pragma unroll
      for (int ks = 0; ks < 4; ++ks) af[ks] = *(const bf16x8*)(xcb + (mt * 32 + r32) * 72 + ks * 16 + 8 * hi);
      const int ch = nt * 32 + r32;
      float xc[16];
#pragma unroll
      for (int reg = 0; reg < 16; ++reg) xc[reg] = bf2f(xcb[(mt * 32 + crow(reg, hi)) * 72 + ch]);
#pragma unroll
      for (int dir = 0; dir < 2; ++dir) {
        f32x16 aa = {}, ai = {};
        const u16* wga = WG + (size_t)((dir * 2 + 0) * 8 + cb) * 4096 + (nt * 32 + r32) * 64 + 8 * hi;
        const u16* wgi = WG + (size_t)((dir * 2 + 1) * 8 + cb) * 4096 + (nt * 32 + r32) * 64 + 8 * hi;
#pragma unroll
        for (int ks = 0; ks < 4; ++ks) { const bf16x8 ba = *(const bf16x8*)(wga + ks * 16), bi = *(const bf16x8*)(wgi + ks * 16); aa = MFMA32(af[ks], ba, aa); ai = MFMA32(af[ks], bi, ai); }
        float* Ab = dir == 0 ? A0 : A1; float* Ub = dir == 0 ? U0 : U1;
#pragma unroll
        for (int reg = 0; reg < 16; ++reg) {
          const int tok = mt * 32 + crow(reg, hi);
          const float r = sigmoidf_(aa[reg] + bav[dir]), gi = sigmoidf_(ai[reg] + biv[dir]);
          const float la2 = -8.f * 1.4426950408889634f * r * spv[dir], a = __builtin_amdgcn_exp2f(la2);
          const float mult = __builtin_amdgcn_sqrtf(fmaxf(0.f, 1.f - a * a));
          Ab[tok * 64 + ch] = a; Ub[tok * 64 + ch] = mult * gi * xc[reg];
        }
      }
    }
    __syncthreads();
    if (wid < 2) {
      const int dir = wid, ch = lane, c = cb * 64 + ch;
      float* Ab = dir == 0 ? A0 : A1; float* Ub = dir == 0 ? U0 : U1;
      if (!FINAL) {
        float h = 0.f, P = 1.f;
#pragma unroll 16
        for (int kk = 0; kk < 64; ++kk) { const int t = dir == 0 ? kk : 63 - kk; const float a = Ab[t * 64 + ch], u = Ub[t * 64 + ch]; h = a * h + u; P *= a; }
        SUM[(size_t)((gc * 2 + dir) * 2 + 0) * 512 + c] = P; SUM[(size_t)((gc * 2 + dir) * 2 + 1) * 512 + c] = h;
      } else {
        float h = CARRY[(size_t)(gc * 2 + dir) * 512 + c];
#pragma unroll 16
        for (int kk = 0; kk < 64; ++kk) { const int t = dir == 0 ? kk : 63 - kk; const float a = Ab[t * 64 + ch], u = Ub[t * 64 + ch]; h = a * h + u; Ub[t * 64 + ch] = h; }
      }
    }
    if (FINAL) {
      __syncthreads();
#pragma unroll
      for (int i = 0; i < 2; ++i) {
        const int c = tid + 256 * i, t = c >> 3, ch8 = c & 7;
        const f32x4 ha = *(const f32x4*)(U0 + t * 64 + ch8 * 8), hb = *(const f32x4*)(U0 + t * 64 + ch8 * 8 + 4);
        const f32x4 hc = *(const f32x4*)(U1 + t * 64 + ch8 * 8), hd = *(const f32x4*)(U1 + t * 64 + ch8 * 8 + 4);
        float hs[8] = {ha[0] + hc[0], ha[1] + hc[1], ha[2] + hc[2], ha[3] + hc[3], hb[0] + hd[0], hb[1] + hd[1], hb[2] + hd[2], hb[3] + hd[3]};
        float yv[8];
#pragma unroll
        for (int j = 0; j < 8; ++j) {
          const unsigned wv = rg[i][j >> 1];
          const float gt = __uint_as_float((j & 1) ? (wv & 0xffff0000u) : (wv << 16));
          const float ge = gt * sigmoidf_(1.5957691216057308f * (gt + 0.044715f * gt * gt * gt));
          yv[j] = ge * hs[j];
        }
        u32x4 o = {pk2(yv[0], yv[1]), pk2(yv[2], yv[3]), pk2(yv[4], yv[5]), pk2(yv[6], yv[7])};
        *(u32x4*)(Y + (size_t)(m0 + t) * 1024 + cb * 64 + ch8 * 8) = o;
      }
    }
#pragma unroll
    for (int i = 0; i < 3; ++i) rr[i] = rrn[i];
#pragma unroll
    for (int i = 0; i < 2; ++i) rg[i] = rgn[i];
  }
}

DI void rg_carry_phase(const Params& p, int bid, int nb) {
  const float* __restrict__ SUM = (const float*)(p.ws + OFF_SUM);
  float* __restrict__ CARRY = (float*)(p.ws + OFF_CARRY);
  for (int idx = bid * 256 + VT; idx < 8192; idx += nb * 256) {
    const int c = idx & 511, dir = (idx >> 9) & 1, seq = idx >> 10;
    const int gc0 = seq < 4 ? seq * 128 : 512 + (seq - 4) * 64, nch = seq < 4 ? 128 : 64;
    float carry = 0.f;
    for (int k0 = 0; k0 < nch; k0 += 8) {
      float P[8], Hh[8];
#pragma unroll
      for (int j = 0; j < 8; ++j) { const int k = k0 + j, gc = dir == 0 ? gc0 + k : gc0 + nch - 1 - k; P[j] = SUM[(size_t)((gc * 2 + dir) * 2 + 0) * 512 + c]; Hh[j] = SUM[(size_t)((gc * 2 + dir) * 2 + 1) * 512 + c]; }
#pragma unroll
      for (int j = 0; j < 8; ++j) { const int k = k0 + j, gc = dir == 0 ? gc0 + k : gc0 + nch - 1 - k; CARRY[(size_t)(gc * 2 + dir) * 512 + c] = carry; carry = P[j] * carry + Hh[j]; }
    }
  }
}

DI void dil_tile_info(int ti, int m0, int& d, int& u0) {
  if (ti < 5) { d = 16; u0 = m0 - 1024 + ti * 512; } else if (ti < 13) { d = 4; u0 = m0 - 256 + (ti - 5) * 128; } else { d = 1; u0 = m0 - 64 + (ti - 13) * 32; }
}
DI void dilated_phase(const Params& p, char* lds, int gw, int nw) {
  const int lane = VT & 63, wid = VT >> 6, r32 = lane & 31, hi = lane >> 5;
  u16* Vl = (u16*)(lds + wid * 6144);
  const unsigned vbase = (unsigned)(uintptr_t)Vl;
  const int li = lane & 15, tq = li >> 2, tp = li & 3, g1 = (lane >> 4) & 1;
  const unsigned trb = vbase + (4 * hi + tq) * 192 + (16 * g1 + 4 * tp) * 2;
  const u16* PROJ = (const u16*)(p.ws + OFF_PROJ);
  u16* Y = (u16*)(p.ws + OFF_Y);
  const int vrow = lane >> 3, vch = lane & 7;
  for (int id = gw; id < 12288; id += nw) {
    const int res = id & 15, h = (id >> 4) & 7, sp = id >> 7;
    const int m0 = sp * 512 + res;
    int seq_lo, S; row_info(sp * 512, seq_lo, S); const int seq_hi = seq_lo + S;
    const int mq = m0 + 16 * r32;
    bf16x8 qf[4];
#pragma unroll
    for (int ks = 0; ks < 4; ++ks) qf[ks] = *(const bf16x8*)(PROJ + (size_t)mq * 2560 + 1024 + h * 64 + ks * 16 + 8 * hi);
    const float slope2 = exp2f(-(float)(h + 1)) * LOG2E;
    const float c1 = 0.125f * LOG2E;
    float m_run = -1e30f, l_run = 0.f; f32x16 o0 = {}, o1 = {};
    const u16* kbase = PROJ + 1536 + h * 64 + 8 * hi;
    const u16* vbaseg = PROJ + 2048 + h * 64 + vch * 8;
    bf16x8 kfA[4], kfB[4]; u32x4 vrA[4], vrB[4];
#define DIL_LOAD(KF, VR, TIV) do { int d_, u_; dil_tile_info((TIV), m0, d_, u_); \
      const int ur_ = min(max(u_ + d_ * r32, seq_lo), seq_hi - 1); \
      _Pragma("unroll") for (int ks = 0; ks < 4; ++ks) KF[ks] = *(const bf16x8*)(kbase + (size_t)ur_ * 2560 + ks * 16); \
      _Pragma("unroll") for (int i = 0; i < 4; ++i) { const int uv_ = min(max(u_ + d_ * (vrow + 8 * i), seq_lo), seq_hi - 1); VR[i] = *(const u32x4*)(vbaseg + (size_t)uv_ * 2560); } } while (0)
#define DIL_TILE(KF, VR, TIV) do { const int ti = (TIV); \
      int d, u0; dil_tile_info(ti, m0, d, u0); \
      _Pragma("unroll") \
      for (int i = 0; i < 4; ++i) *(u32x4*)(Vl + (vrow + 8 * i) * 96 + vch * 8) = VR[i]; \
      f32x16 pt = {}; \
      _Pragma("unroll") \
      for (int ks = 0; ks < 4; ++ks) pt = MFMA32(KF[ks], qf[ks], pt); \
      if (ti + 2 < 33) DIL_LOAD(KF, VR, ti + 2);     \
      const s16x4 l00 = tr_read_o<0>(trb), h00 = tr_read_o<8 * 192>(trb), l01 = tr_read_o<64>(trb), h01 = tr_read_o<8 * 192 + 64>(trb); \
      const s16x4 l10 = tr_read_o<16 * 192>(trb), h10 = tr_read_o<24 * 192>(trb), l11 = tr_read_o<16 * 192 + 64>(trb), h11 = tr_read_o<24 * 192 + 64>(trb); \
      const float fd = (float)d, lim = 64.f * fd; \
      const float fdu0 = (float)(u0 - mq + d * 4 * hi); \
      const float lo_ = fmaxf((float)(seq_lo - mq), -lim), hi_ = fminf((float)(seq_hi - 1 - mq), lim); \
      const float mid = 0.5f * (lo_ + hi_), hw = 0.5f * (hi_ - lo_); \
      const float gdu0 = fdu0 - mid; \
      float pmax = -INFINITY; \
      _Pragma("unroll") \
      for (int reg = 0; reg < 16; ++reg) { \
        const float cf = (float)((reg & 3) + 8 * (reg >> 2)); \
        const float du = fmaf(fd, cf, fdu0), g = fmaf(fd, cf, gdu0); \
        const float tv = (__builtin_fabsf(g) <= hw) ? fmaf(__builtin_fabsf(du), -slope2, pt[reg] * c1) : -INFINITY; \
        pt[reg] = tv; pmax = max_nn(pmax, tv); \
      } \
      pmax = pl32_max(pmax); \
      if (__any(pmax > m_run)) { \
        const float mn = fmaxf(m_run, pmax), alpha = __builtin_amdgcn_exp2f(m_run - mn); \
        m_run = mn; l_run *= alpha; \
      _Pragma("unroll") \
        for (int reg = 0; reg < 16; ++reg) { o0[reg] *= alpha; o1[reg] *= alpha; } \
      } \
      float ps = 0.f; \
      _Pragma("unroll") \
      for (int reg = 0; reg < 16; ++reg) { pt[reg] = __builtin_amdgcn_exp2f(pt[reg] - m_run); ps += pt[reg]; } \
      ps = pl32_sum(ps); \
      l_run += ps; \
      const bf16x8 pb0 = pack8(pt, 0), pb1 = pack8(pt, 1); \
      LGKM0(); \
      o0 = MFMA32(cat4(l00, h00), pb0, o0); o0 = MFMA32(cat4(l10, h10), pb1, o0); \
      o1 = MFMA32(cat4(l01, h01), pb0, o1); o1 = MFMA32(cat4(l11, h11), pb1, o1); \
    } while (0)
    DIL_LOAD(kfA, vrA, 0);
    DIL_LOAD(kfB, vrB, 1);
#pragma unroll 1
    for (int tp2 = 0; tp2 < 32; tp2 += 2) { DIL_TILE(kfA, vrA, tp2); DIL_TILE(kfB, vrB, tp2 + 1); }
    DIL_TILE(kfA, vrA, 32);
#undef DIL_LOAD
#undef DIL_TILE
    const float inv = 1.f / l_run;
    u16* yo = Y + (size_t)mq * 1024 + 512 + h * 64 + 4 * hi;
#pragma unroll
    for (int g = 0; g < 4; ++g) {
      u32x2 w0 = {pk2(o0[4 * g] * inv, o0[4 * g + 1] * inv), pk2(o0[4 * g + 2] * inv, o0[4 * g + 3] * inv)};
      u32x2 w1 = {pk2(o1[4 * g] * inv, o1[4 * g + 1] * inv), pk2(o1[4 * g + 2] * inv, o1[4 * g + 3] * inv)};
      *(u32x2*)(yo + 8 * g) = w0; *(u32x2*)(yo + 32 + 8 * g) = w1;
    }
  }
}

DI void mla_norm_phase(const Params& p, int gw, int nw) {
  const int lane = threadIdx.x & 63;
  const u16* P2 = (const u16*)(p.ws + OFF_P2);
  u16* CQN = (u16*)(p.ws + OFF_CQN); u16* CKVN = (u16*)(p.ws + OFF_CKVN); u16* KR = (u16*)(p.ws + OFF_KR);
  const float* ct = (const float*)(p.ws + OFF_COS); const float* st = (const float*)(p.ws + OFF_SIN);
  float gq[6], gkv[4];
#pragma unroll
  for (int i = 0; i < 6; ++i) gq[i] = p.q_norm[6 * lane + i];
#pragma unroll
  for (int i = 0; i < 4; ++i) gkv[i] = p.kv_norm[4 * lane + i];
  for (int m = gw; m < M_TOT; m += nw) {
    const u16* src = P2 + (size_t)m * 768;
    const unsigned* s32 = (const unsigned*)src;
    const unsigned w0 = s32[3 * lane], w1 = s32[3 * lane + 1], w2 = s32[3 * lane + 2];
    const u32x2 wk = *(const u32x2*)(src + 384 + 4 * lane);
    float q[6] = {__uint_as_float(w0 << 16), __uint_as_float(w0 & 0xffff0000u), __uint_as_float(w1 << 16), __uint_as_float(w1 & 0xffff0000u), __uint_as_float(w2 << 16), __uint_as_float(w2 & 0xffff0000u)};
    float kv[4] = {__uint_as_float(wk[0] << 16), __uint_as_float(wk[0] & 0xffff0000u), __uint_as_float(wk[1] << 16), __uint_as_float(wk[1] & 0xffff0000u)};
    float sq = 0.f, skv = 0.f;
#pragma unroll
    for (int i = 0; i < 6; ++i) sq += q[i] * q[i];
#pragma unroll
    for (int i = 0; i < 4; ++i) skv += kv[i] * kv[i];
#pragma unroll
    for (int o = 32; o > 0; o >>= 1) { sq += __shfl_xor(sq, o); skv += __shfl_xor(skv, o); }
    const float rq = rsqrtf(sq * (1.f / 384.f) + 1e-6f), rkv = rsqrtf(skv * (1.f / 256.f) + 1e-6f);
    unsigned* dq = (unsigned*)(CQN + (size_t)m * 384) + 3 * lane;
    dq[0] = pk2(q[0] * rq * gq[0], q[1] * rq * gq[1]); dq[1] = pk2(q[2] * rq * gq[2], q[3] * rq * gq[3]); dq[2] = pk2(q[4] * rq * gq[4], q[5] * rq * gq[5]);
    u32x2 ok = {pk2(kv[0] * rkv * gkv[0], kv[1] * rkv * gkv[1]), pk2(kv[2] * rkv * gkv[2], kv[3] * rkv * gkv[3])};
    *(u32x2*)(CKVN + (size_t)m * 256 + 4 * lane) = ok;
    if (lane < 16) {
      const int pos = m < M_P ? (m & 8191) : ((m - M_P) & 4095);
      const float t1 = bf2f(src[640 + lane]), t2 = bf2f(src[656 + lane]);
      const float c = ct[pos * 16 + lane], s = st[pos * 16 + lane];
      KR[(size_t)m * 32 + lane] = f2bf(t1 * c - t2 * s); KR[(size_t)m * 32 + 16 + lane] = f2bf(t1 * s + t2 * c);
    }
  }
}

constexpr int KP = 104, VP = 96;
DI void mla_unit(const Params& p, char* lds, int seqbase, int S, int h, int qb) {
  const int tid = threadIdx.x, lane = tid & 63, wid = tid >> 6, r32 = lane & 31, hi = lane >> 5;
  u16* Kl = (u16*)lds;
  u16* Vl = (u16*)(lds + 3 * 64 * KP * 2);
  const unsigned vbase = (unsigned)(uintptr_t)Vl;
  const int li = lane & 15, tq = li >> 2, tp = li & 3, g1 = (lane >> 4) & 1;
  const unsigned trb = vbase + (4 * hi + tq) * (VP * 2) + (16 * g1 + 4 * tp) * 2;
  const u16* Q = (const u16*)(p.ws + OFF_Q); const u16* KV = (const u16*)(p.ws + OFF_KV); const u16* KR = (const u16*)(p.ws + OFF_KR);
  u16* O = (u16*)(p.ws + OFF_O);
  const float* ct = (const float*)(p.ws + OFF_COS); const float* st = (const float*)(p.ws + OFF_SIN);
  const int pos = qb * 256 + wid * 32 + r32, qrow = seqbase + pos;
  bf16x8 qf[6];
#pragma unroll
  for (int d0 = 0; d0 < 6; ++d0) qf[d0] = *(const bf16x8*)(Q + (size_t)qrow * 1536 + h * 96 + d0 * 16 + 8 * hi);
  const float C = 0.10206207261596577f * LOG2E;
#pragma unroll
  for (int j = 0; j < 8; ++j) {
    const float c = ct[pos * 16 + 8 * hi + j], s = st[pos * 16 + 8 * hi + j];
    const float t1 = bfs2f(qf[4][j]), t2 = bfs2f(qf[5][j]);
    qf[4][j] = (short)f2bf((t1 * c - t2 * s) * C); qf[5][j] = (short)f2bf((t1 * s + t2 * c) * C);
  }
#pragma unroll
  for (int d0 = 0; d0 < 4; ++d0)
#pragma unroll
    for (int j = 0; j < 8; ++j) qf[d0][j] = (short)f2bf(bfs2f(qf[d0][j]) * C);
  const int srow = tid >> 3, sc = tid & 7, rrow = (tid >> 2) & 63, rc = tid & 3;
  const bool kr_on = tid < 256;
  const u16* kvsrc = KV + (size_t)(seqbase + srow) * KVP + h * 128 + sc * 8;
  const u16* krsrc = KR + (size_t)(seqbase + rrow) * 32 + rc * 8;
  const int kdst0 = srow * KP + sc * 8, kdst2 = rrow * KP + 64 + rc * 8, vdst = srow * VP + sc * 8;
  float l_run = 0.f; f32x16 o0 = {}, o1 = {}, negm = {};
  const int nkt = S >> 6;
  u32x4 rkn, rkr, rvv;
#define MLA_GLOAD(T) do { rkn = *(const u32x4*)(kvsrc + (size_t)(T) * 64 * KVP); rvv = *(const u32x4*)(kvsrc + (size_t)(T) * 64 * KVP + 64); \
    if (kr_on) rkr = *(const u32x4*)(krsrc + (size_t)(T) * 64 * 32); } while (0)
#define MLA_LSTORE(B) do { u16* kd = Kl + (B) * 64 * KP; u16* vd = Vl + (B) * 64 * VP; *(u32x4*)(kd + kdst0) = rkn; *(u32x4*)(vd + vdst) = rvv; \
    if (kr_on) *(u32x4*)(kd + kdst2) = rkr; } while (0)
  MLA_GLOAD(0); MLA_LSTORE(0);
  MLA_GLOAD(1); MLA_LSTORE(1);
  __syncthreads();
  int cur = 0, nx2 = 2;
#pragma unroll 1
  for (int kt = 0; kt < nkt; ++kt) {
    if (kt + 2 < nkt) MLA_GLOAD(kt + 2);
    const u16* kl = Kl + cur * 64 * KP + r32 * KP + 8 * hi;
    f32x16 p0, p1;
    { const bf16x8 k0 = *(const bf16x8*)(kl), k1 = *(const bf16x8*)(kl + 32 * KP);
      p0 = MFMA32(k0, qf[0], negm); p1 = MFMA32(k1, qf[0], negm); }
#pragma unroll
    for (int d0 = 1; d0 < 6; ++d0) {
      const bf16x8 k0 = *(const bf16x8*)(kl + d0 * 16), k1 = *(const bf16x8*)(kl + 32 * KP + d0 * 16);
      p0 = MFMA32(k0, qf[d0], p0); p1 = MFMA32(k1, qf[d0], p1);
    }
    const unsigned tb = trb + cur * (64 * VP * 2);
    constexpr int R8 = 8 * VP * 2;
    const s16x4 a0 = tr_read_o<0>(tb), b0 = tr_read_o<R8>(tb), a1 = tr_read_o<2 * R8>(tb), b1 = tr_read_o<3 * R8>(tb);
    const s16x4 a2 = tr_read_o<4 * R8>(tb), b2 = tr_read_o<5 * R8>(tb), a3 = tr_read_o<6 * R8>(tb), b3 = tr_read_o<7 * R8>(tb);
    const s16x4 c0 = tr_read_o<64>(tb), d0_ = tr_read_o<R8 + 64>(tb), c1 = tr_read_o<2 * R8 + 64>(tb), d1 = tr_read_o<3 * R8 + 64>(tb);
    const s16x4 c2 = tr_read_o<4 * R8 + 64>(tb), d2 = tr_read_o<5 * R8 + 64>(tb), c3 = tr_read_o<6 * R8 + 64>(tb), d3 = tr_read_o<7 * R8 + 64>(tb);
    float pmax = max_nn(p0[0], p1[0]);
#pragma unroll
    for (int r = 1; r < 16; ++r) pmax = max_nn(pmax, max_nn(p0[r], p1[r]));
    pmax = pl32_max(pmax);
    if (kt == 0 || __any(pmax > 8.f)) {
      const float delta = kt == 0 ? pmax : fmaxf(pmax, 0.f);
      const float alpha = kt == 0 ? 1.f : __builtin_amdgcn_exp2f(-delta);
#pragma unroll
      for (int r = 0; r < 16; ++r) { negm[r] -= delta; p0[r] -= delta; p1[r] -= delta; o0[r] *= alpha; o1[r] *= alpha; }
      l_run *= alpha;
    }
    float ps = 0.f;
#pragma unroll
    for (int r = 0; r < 16; ++r) { p0[r] = __builtin_amdgcn_exp2f(p0[r]); p1[r] = __builtin_amdgcn_exp2f(p1[r]); ps += p0[r] + p1[r]; }
    ps = pl32_sum(ps);
    l_run += ps;
    const bf16x8 pb0 = pack8(p0, 0), pb1 = pack8(p0, 1), pb2 = pack8(p1, 0), pb3 = pack8(p1, 1);
    LGKM0();
    o0 = MFMA32(cat4(a0, b0), pb0, o0); o1 = MFMA32(cat4(c0, d0_), pb0, o1);
    o0 = MFMA32(cat4(a1, b1), pb1, o0); o1 = MFMA32(cat4(c1, d1), pb1, o1);
    o0 = MFMA32(cat4(a2, b2), pb2, o0); o1 = MFMA32(cat4(c2, d2), pb2, o1);
    o0 = MFMA32(cat4(a3, b3), pb3, o0); o1 = MFMA32(cat4(c3, d3), pb3, o1);
    __syncthreads();
    if (kt + 2 < nkt) MLA_LSTORE(nx2);
    cur = cur == 2 ? 0 : cur + 1; nx2 = nx2 == 2 ? 0 : nx2 + 1;
  }
  __syncthreads();
#undef MLA_GLOAD
#undef MLA_LSTORE
  const float inv = 1.f / l_run;
  u16* oo = O + (size_t)qrow * 1024 + h * 64 + 4 * hi;
#pragma unroll
  for (int g = 0; g < 4; ++g) {
    u32x2 w0 = {pk2(o0[4 * g] * inv, o0[4 * g + 1] * inv), pk2(o0[4 * g + 2] * inv, o0[4 * g + 3] * inv)};
    u32x2 w1 = {pk2(o1[4 * g] * inv, o1[4 * g + 1] * inv), pk2(o1[4 * g + 2] * inv, o1[4 * g + 3] * inv)};
    *(u32x2*)(oo + 8 * g) = w0; *(u32x2*)(oo + 32 + 8 * g) = w1;
  }
}

DI void mla_attn_phase(const Params& p, char* lds, int xcd, int j, int nper) {
  for (int lu0 = j; lu0 - j < 8 * 32; lu0 += nper) { const int lu = lu0 < 8 * 32 ? lu0 : 8 * 32 - 1; const int bh = (lu >> 5) * 8 + xcd, qb = lu & 31; mla_unit(p, lds, (bh >> 4) * 8192, 8192, bh & 15, qb); }
  for (int lu0 = j; lu0 - j < 8 * 16; lu0 += nper) { const int lu = lu0 < 8 * 16 ? lu0 : 8 * 16 - 1; const int bh = (lu >> 4) * 8 + xcd, qb = lu & 15; mla_unit(p, lds, M_P + (bh >> 4) * 4096, 4096, bh & 15, qb); }
}

#define XB_TMO      128
#define XB_XCNT(j)  (256  + 64 * (j))
#define XB_XSUB(j)  (1280 + 64 * (j))
#define XB_XGEN(j)  (2304 + 64 * (j))
#define XB_TOP      3328
#define XB_TOPGEN   3392
#define XCD_BAR_WORDS 3456
#define XB_SPIN_CAP (1u << 20)
#define LAS __attribute__((address_space(3)))
DI unsigned xb_ld(unsigned* p) { return __hip_atomic_load(p, __ATOMIC_RELAXED, __HIP_MEMORY_SCOPE_AGENT); }
DI unsigned xb_add(unsigned* p, unsigned v) { return __hip_atomic_fetch_add(p, v, __ATOMIC_RELAXED, __HIP_MEMORY_SCOPE_AGENT); }
DI unsigned xb_xcc_id() { return (unsigned)__builtin_amdgcn_s_getreg((3 << 11) | 20) & 0xFu; }
#define XB_SPIN(cond, bar) do { unsigned _sp = 0; while (cond) { __builtin_amdgcn_s_sleep(1); \
    if ((++_sp & 255u) == 0u) { if (xb_ld(&(bar)[XB_TMO])) break; if (_sp > XB_SPIN_CAP) { atomicAdd(&(bar)[XB_TMO], 1u); break; } } } } while (0)
struct XcdBarrier { unsigned* bar; unsigned x; volatile LAS unsigned* st; };
DI XcdBarrier xcd_barrier_post(unsigned* bar, volatile LAS unsigned* st) {
  XcdBarrier b; b.bar = bar; b.x = xb_xcc_id(); b.st = st;
  if (threadIdx.x == 0) (void)xb_add(&bar[XB_XCNT(b.x)], 1u);
  return b;
}
DI void xcd_barrier_complete(unsigned* bar, unsigned x, unsigned& nloc, unsigned& nx) {
  const unsigned G = gridDim.x * gridDim.y * gridDim.z;
  unsigned sum, cnt, mine, sp = 0u;
  for (;;) {
    sum = 0u; cnt = 0u; mine = 0u;
#pragma unroll
    for (unsigned j = 0; j < 16; ++j) { const unsigned c = xb_ld(&bar[XB_XCNT(j)]); sum += c; cnt += (c > 0u) ? 1u : 0u; mine = (j == x) ? c : mine; }
    if (sum == G) break;
    __builtin_amdgcn_s_sleep(1);
    if ((++sp & 255u) == 0u) { if (xb_ld(&bar[XB_TMO])) break; if (sp > XB_SPIN_CAP) { atomicAdd(&bar[XB_TMO], 1u); break; } }
  }
  nloc = mine > 0u ? mine : 1u; nx = cnt > 0u ? cnt : 1u;
}
DI void xcd_barrier(const XcdBarrier& b) {
  asm volatile("s_waitcnt vmcnt(0)" ::: "memory");
  __syncthreads();
  if (threadIdx.x == 0) {
    unsigned* bar = b.bar;
    __builtin_amdgcn_s_waitcnt(0);
    unsigned nloc = b.st[0], nx = b.st[1];
    if (nloc == 0u) { xcd_barrier_complete(bar, b.x, nloc, nx); b.st[0] = nloc; b.st[1] = nx; }
    const unsigned old = xb_add(&bar[XB_XSUB(b.x)], 1u);
    const unsigned gen = old / nloc;
    if (old + 1u == (gen + 1u) * nloc) {
      __builtin_amdgcn_fence(__ATOMIC_RELEASE, "agent");
      asm volatile("s_waitcnt vmcnt(0)" ::: "memory");
      const unsigned og = xb_add(&bar[XB_TOP], 1u);
      const unsigned tg = og / nx;
      if (og + 1u == (tg + 1u) * nx) xb_add(&bar[XB_TOPGEN], 1u);
      else XB_SPIN(xb_ld(&bar[XB_TOPGEN]) == tg, bar);
      __builtin_amdgcn_fence(__ATOMIC_ACQUIRE, "agent");
      xb_add(&bar[XB_XGEN(b.x)], 1u);
      asm volatile("s_waitcnt vmcnt(0)" ::: "memory");
    } else {
      XB_SPIN(xb_ld(&bar[XB_XGEN(b.x)]) == gen, bar);
      __builtin_amdgcn_fence(__ATOMIC_ACQUIRE, "agent");
      asm volatile("s_waitcnt vmcnt(0)" ::: "memory");
    }
  }
  __syncthreads();
}

constexpr int N_PHASES = 19;
constexpr int HALF_LDS = 76800;
constexpr int LDS_BYTES = 2 * HALF_LDS;
__global__ void __launch_bounds__(512, 2) mega(Params p, int ph_lo, int ph_hi) {
  __shared__ __attribute__((aligned(16))) char lds_all[LDS_BYTES];
  const int rbid = blockIdx.x, rnb = gridDim.x;
  const int half = __builtin_amdgcn_readfirstlane((int)(threadIdx.x >> 8));
  const int bid = rbid * 2 + half, nb = rnb * 2;
  char* lds = lds_all + half * HALF_LDS;
  const int gw = bid * 4 + __builtin_amdgcn_readfirstlane(VT >> 6), nw = nb * 4;
  char* ws = p.ws;
  float* out1 = p.out + (size_t)M_P * DM;
  __shared__ uint4 xb_words;
  if (threadIdx.x == 0) xb_words = make_uint4(0u, 0u, 0u, 0u);
  __syncthreads();
  XcdBarrier xb; xb.bar = (unsigned*)(ws + OFF_BAR); xb.x = 0; xb.st = (volatile LAS unsigned*)&xb_words;
  if (ph_hi - ph_lo > 1) xb = xcd_barrier_post((unsigned*)(ws + OFF_BAR), (volatile LAS unsigned*)&xb_words);
  if (ph_lo < 0) cg::this_grid().sync();
#ifndef DUP_MASK
#define DUP_MASK 0
#endif
#define PHASE(k, ...) do { if (ph_lo <= (k) && (k) < ph_hi) { __VA_ARGS__ if ((DUP_MASK >> (k)) & 1) { xcd_barrier(xb); __VA_ARGS__ } } if (ph_lo <= (k) && (k) + 1 < ph_hi) xcd_barrier(xb); } while (0)
  PHASE(0, prep_phase(p, lds, bid, nb););
  PHASE(1, gemm_phase<EPI_BF16>((const u16*)(ws + OFF_H), 1024, (const u16*)(ws + WT_ABIN), 1024, 2560, (u16*)(ws + OFF_PROJ), 2560, nullptr, nullptr, nullptr, lds_all, rbid, rnb););
  PHASE(2, rg_phase<false>(p, lds, bid, nb); __syncthreads(); dilated_phase(p, lds, gw, nw););
  PHASE(3, rg_carry_phase(p, bid, nb););
  PHASE(4, rg_phase<true>(p, lds, bid, nb););
  PHASE(5, gemm_phase<EPI_RESID>((const u16*)(ws + OFF_Y), 1024, (const u16*)(ws + WT_ABOUT), 1024, 1024, nullptr, 0, p.xin0, p.xin1, p.out, lds_all, rbid, rnb););
  PHASE(6, rmsnorm_phase(p.out, out1, p.norm_ffn, (u16*)(ws + OFF_H), nullptr, gw, nw););
  PHASE(7, gemm_phase<EPI_SWIGLU>((const u16*)(ws + OFF_H), 1024, (const u16*)(ws + WT_GU0), 1024, 5632, (u16*)(ws + OFF_ACT), FH, nullptr, nullptr, nullptr, lds_all, rbid, rnb););
  PHASE(8, gemm_phase<EPI_RESID>((const u16*)(ws + OFF_ACT), FH, (const u16*)(ws + WT_DOWN0), FH, 1024, nullptr, 0, p.out, out1, p.out, lds_all, rbid, rnb););
  PHASE(9, rmsnorm_phase(p.out, out1, p.norm_mix + 1024, (u16*)(ws + OFF_H), nullptr, gw, nw););
  PHASE(10, gemm_phase<EPI_BF16>((const u16*)(ws + OFF_H), 1024, (const u16*)(ws + WT_MLAIN), 1024, 768, (u16*)(ws + OFF_P2), 768, nullptr, nullptr, nullptr, lds_all, rbid, rnb););
  PHASE(11, mla_norm_phase(p, gw, nw););
  PHASE(12, gemm_phase<EPI_BF16>((const u16*)(ws + OFF_CQN), 384, (const u16*)(ws + WT_QB), 384, 1536, (u16*)(ws + OFF_Q), 1536, nullptr, nullptr, nullptr, lds_all, rbid, rnb); gemm_phase<EPI_BF16>((const u16*)(ws + OFF_CKVN), 256, (const u16*)(ws + WT_KVB), 256, 2048, (u16*)(ws + OFF_KV), KVP, nullptr, nullptr, nullptr, lds_all, rbid, rnb););
  PHASE(13, mla_attn_phase(p, lds_all, rbid & 7, rbid >> 3, rnb >> 3););
  PHASE(14, gemm_phase<EPI_RESID>((const u16*)(ws + OFF_O), 1024, (const u16*)(ws + WT_MLAOUT), 1024, 1024, nullptr, 0, p.out, out1, p.out, lds_all, rbid, rnb););
  PHASE(15, rmsnorm_phase(p.out, out1, p.norm_ffn + 1024, (u16*)(ws + OFF_H), nullptr, gw, nw););
  PHASE(16, gemm_phase<EPI_SWIGLU>((const u16*)(ws + OFF_H), 1024, (const u16*)(ws + WT_GU1), 1024, 5632, (u16*)(ws + OFF_ACT), FH, nullptr, nullptr, nullptr, lds_all, rbid, rnb););
  PHASE(17, gemm_phase<EPI_RESID>((const u16*)(ws + OFF_ACT), FH, (const u16*)(ws + WT_DOWN1), FH, 1024, nullptr, 0, p.out, out1, p.out, lds_all, rbid, rnb););
  PHASE(18, rmsnorm_phase(p.out, out1, p.norm_final, nullptr, p.out, gw, nw););
#undef PHASE
}

extern "C" void kernel_launch(void* const* d_in, const int* in_sizes, int n_in, void* d_out, int out_size, void* d_ws, size_t ws_size, hipStream_t stream) {
  static int grid_blocks = 0;
  if (!grid_blocks) {
    int dev = 0, cus = 0, per_cu = 0;
    hipGetDevice(&dev);
    hipDeviceGetAttribute(&cus, hipDeviceAttributeMultiprocessorCount, dev);
    hipOccupancyMaxActiveBlocksPerMultiprocessor(&per_cu, mega, 512, 0);
    if (per_cu > 1) per_cu = 1;
    if (per_cu < 1) per_cu = 1;
    grid_blocks = cus * per_cu;
  }
  if (n_in != 23 || ws_size < WS_NEED) { fprintf(stderr, "kernel_launch: bad inputs n_in=%d ws=%zu\n", n_in, ws_size); return; }
  Params p{};
  p.xin0 = (const float*)d_in[0]; p.xin1 = (const float*)d_in[1];
  p.norm_mix = (const float*)d_in[2]; p.norm_ffn = (const float*)d_in[3]; p.norm_final = (const float*)d_in[4];
  p.ab_w_in = (const float*)d_in[5]; p.conv_w = (const float*)d_in[6]; p.conv_b = (const float*)d_in[7];
  p.w_a = (const float*)d_in[8]; p.b_a = (const float*)d_in[9]; p.w_i = (const float*)d_in[10]; p.b_i = (const float*)d_in[11];
  p.lam = (const float*)d_in[12]; p.ab_w_out = (const float*)d_in[13];
  p.mla_w_in = (const float*)d_in[14]; p.q_norm = (const float*)d_in[15]; p.w_qb = (const float*)d_in[16]; p.kv_norm = (const float*)d_in[17];
  p.w_kvb = (const float*)d_in[18]; p.mla_w_out = (const float*)d_in[19];
  p.w_gate = (const float*)d_in[20]; p.w_up = (const float*)d_in[21]; p.w_down = (const float*)d_in[22];
  p.out = (float*)d_out; p.ws = (char*)d_ws;
#if SINGLE_LAUNCH
  hipMemsetAsync((char*)d_ws + OFF_BAR, 0, XCD_BAR_WORDS * 4, stream);
  int lo = 0, hi = N_PHASES;
  void* args[] = {&p, &lo, &hi};
  hipError_t e = hipLaunchCooperativeKernel((void*)mega, dim3(grid_blocks), dim3(512), args, 0, stream);
  if (e != hipSuccess) fprintf(stderr, "cooperative launch failed: %s (grid %d)\n", hipGetErrorString(e), grid_blocks);
#else
  for (int ph = 0; ph < N_PHASES; ++ph) hipLaunchKernelGGL(mega, dim3(grid_blocks), dim3(512), 0, stream, p, ph, ph + 1);
#endif
}
```

```cpp
#include <hip/hip_runtime.h>
#include <hip/hip_cooperative_groups.h>
#include <cstdint>
#include <cstdio>
namespace cg = cooperative_groups;

#ifndef SINGLE_LAUNCH
#define SINGLE_LAUNCH 1
#endif

typedef unsigned short u16;
typedef short bf16x8 __attribute__((ext_vector_type(8)));
typedef short s16x4 __attribute__((ext_vector_type(4)));
typedef float f32x16 __attribute__((ext_vector_type(16)));
typedef float f32x4 __attribute__((ext_vector_type(4)));
typedef float f32x2 __attribute__((ext_vector_type(2)));
typedef unsigned u32x4 __attribute__((ext_vector_type(4)));
typedef unsigned u32x2 __attribute__((ext_vector_type(2)));
typedef __bf16 bf2_t __attribute__((ext_vector_type(2)));
#define DI __device__ __forceinline__
#define VT ((int)(threadIdx.x & 255))
#define MFMA32(a, b, c) __builtin_amdgcn_mfma_f32_32x32x16_bf16((a), (b), (c), 0, 0, 0)

constexpr int M_TOT = 49152, M_P = 32768, DM = 1024, FH = 2816;
constexpr float LOG2E = 1.4426950408889634f;
constexpr size_t MiB = 1ull << 20;
constexpr size_t WT_ABIN = 0;
constexpr size_t WT_ABOUT = WT_ABIN + 2560ull * 1024 * 2;
constexpr size_t WT_GU0 = WT_ABOUT + 1024ull * 1024 * 2;
constexpr size_t WT_DOWN0 = WT_GU0 + 5632ull * 1024 * 2;
constexpr size_t WT_MLAIN = WT_DOWN0 + 1024ull * 2816 * 2;
constexpr size_t WT_QB = WT_MLAIN + 768ull * 1024 * 2;
constexpr size_t WT_KVB = WT_QB + 1536ull * 384 * 2;
constexpr size_t WT_MLAOUT = WT_KVB + 2048ull * 256 * 2;
constexpr size_t WT_GU1 = WT_MLAOUT + 1024ull * 1024 * 2;
constexpr size_t WT_DOWN1 = WT_GU1 + 5632ull * 1024 * 2;
constexpr size_t WT_GATES = WT_DOWN1 + 1024ull * 2816 * 2;
constexpr size_t WT_END = WT_GATES + 32ull * 4096 * 2;
static_assert(WT_END <= 46 * MiB, "weights region");
constexpr size_t OFF_SUM = 46 * MiB;
constexpr size_t OFF_KR = 46 * MiB;
constexpr size_t OFF_COS = 52 * MiB;
constexpr size_t OFF_SIN = 52 * MiB + 512 * 1024;
constexpr size_t OFF_H = 54 * MiB;
constexpr size_t OFF_CQN = 54 * MiB;
constexpr size_t OFF_CKVN = 90 * MiB;
constexpr size_t OFF_O = 54 * MiB;
constexpr size_t OFF_PROJ = 150 * MiB;
constexpr size_t OFF_ACT = 150 * MiB;
constexpr size_t OFF_P2 = 150 * MiB;
constexpr size_t OFF_Q = 150 * MiB;
constexpr size_t OFF_KV = 294 * MiB;
constexpr size_t OFF_Y = 390 * MiB;
constexpr size_t OFF_CARRY = 486 * MiB;
constexpr size_t OFF_BAR = 53 * MiB;
constexpr size_t WS_NEED = 496 * MiB;
constexpr int KVP = 2112;

struct Params {
  const float* xin0; const float* xin1;
  const float* norm_mix; const float* norm_ffn; const float* norm_final;
  const float* ab_w_in; const float* conv_w; const float* conv_b;
  const float* w_a; const float* b_a; const float* w_i; const float* b_i; const float* lam; const float* ab_w_out;
  const float* mla_w_in; const float* q_norm; const float* w_qb; const float* kv_norm; const float* w_kvb; const float* mla_w_out;
  const float* w_gate; const float* w_up; const float* w_down;
  float* out; char* ws;
};

DI float bf2f(u16 v) { return __uint_as_float(((unsigned)v) << 16); }
DI float bfs2f(short v) { return __uint_as_float(((unsigned)(u16)v) << 16); }
DI unsigned pk2(float lo, float hi) { f32x2 v = {lo, hi}; bf2_t r = __builtin_convertvector(v, bf2_t); return __builtin_bit_cast(unsigned, r); }
DI u16 f2bf(float a) { return (u16)(pk2(a, 0.f) & 0xffffu); }
DI int crow(int r, int hi) { return (r & 3) + 8 * (r >> 2) + 4 * hi; }
DI float sigmoidf_(float x) { return __builtin_amdgcn_rcpf(1.f + __builtin_amdgcn_exp2f(-1.4426950408889634f * x)); }
DI float pl32_max(float v) { auto rr = __builtin_amdgcn_permlane32_swap(__float_as_uint(v), __float_as_uint(v), false, false); return fmaxf(__uint_as_float(rr[0]), __uint_as_float(rr[1])); }
DI float pl32_sum(float v) { auto rr = __builtin_amdgcn_permlane32_swap(__float_as_uint(v), __float_as_uint(v), false, false); return __uint_as_float(rr[0]) + __uint_as_float(rr[1]); }
DI s16x4 tr_read(unsigned addr) { s16x4 r; asm volatile("ds_read_b64_tr_b16 %0, %1" : "=&v"(r) : "v"(addr) : "memory"); return r; }
template <int OFF> DI s16x4 tr_read_o(unsigned addr) { s16x4 r; asm volatile("ds_read_b64_tr_b16 %0, %1 offset:%2" : "=&v"(r) : "v"(addr), "i"(OFF) : "memory"); return r; }
DI float max_nn(float a, float b) { return __builtin_amdgcn_fmed3f(a, b, __builtin_inff()); }
#define LGKM0() do { asm volatile("s_waitcnt lgkmcnt(0)" ::: "memory"); __builtin_amdgcn_sched_barrier(0); } while (0)
DI bf16x8 cat4(s16x4 l, s16x4 h) { return (bf16x8){l[0], l[1], l[2], l[3], h[0], h[1], h[2], h[3]}; }
DI bf16x8 pack8(const f32x16& x, int s) {
  u32x4 w = {pk2(x[8 * s + 0], x[8 * s + 1]), pk2(x[8 * s + 2], x[8 * s + 3]), pk2(x[8 * s + 4], x[8 * s + 5]), pk2(x[8 * s + 6], x[8 * s + 7])};
  return __builtin_bit_cast(bf16x8, w);
}
DI void row_info(int m, int& seq_lo, int& S) { if (m < M_P) { seq_lo = m & ~8191; S = 8192; } else { seq_lo = M_P + ((m - M_P) & ~4095); S = 4096; } }

DI void tr_job(const float* __restrict__ src, int K, int N, u16* __restrict__ dst, int mode, float* tile, int bid, int nb, int& rot) {
  const int tk = K >> 6, tn = (N + 63) >> 6, nt = tk * tn;
  const int tx = VT & 63, ty = VT >> 6;
  const int t0 = (bid + nb - rot) % nb, nit = (nt + nb - 1) / nb;
  (void)tx; (void)ty;
  for (int i = 0; i < nit; ++i) {
    const int t = t0 + i * nb; const bool act = t < nt;
    const int k0 = (t / tn) << 6, n0 = (t % tn) << 6;
    __syncthreads();
    if (act) {
#pragma unroll
      for (int r = 0; r < 4; ++r) {
        const int idx = VT + 256 * r, kk = idx >> 4, c4 = idx & 15, n = n0 + c4 * 4;
        const f32x4 v = n < N ? *(const f32x4*)(src + (size_t)(k0 + kk) * N + n) : (f32x4){0.f, 0.f, 0.f, 0.f};
        float* tp = tile + kk * 65 + c4 * 4;
        tp[0] = v[0]; tp[1] = v[1]; tp[2] = v[2]; tp[3] = v[3];
      }
    }
    __syncthreads();
    if (act) {
#pragma unroll
      for (int r = 0; r < 2; ++r) {
        const int idx = VT + 256 * r, nn = idx >> 3, kc = idx & 7, n = n0 + nn;
        if (n < N) {
          const int row = mode == 0 ? n : ((n >> 5) * 64 + (n & 31) + (mode == 2 ? 32 : 0));
          const float* tp = tile + (kc * 8) * 65 + nn;
          u32x4 w = {pk2(tp[0], tp[65]), pk2(tp[2 * 65], tp[3 * 65]), pk2(tp[4 * 65], tp[5 * 65]), pk2(tp[6 * 65], tp[7 * 65])};
          *(u32x4*)(dst + (size_t)row * K + k0 + kc * 8) = w;
        }
      }
    }
  }
  rot = (rot + nt) % nb;
}

DI void rmsnorm_phase(const float* __restrict__ s0, const float* __restrict__ s1, const float* __restrict__ g, u16* outb, float* outf, int gw, int nw) {
  const int lane = threadIdx.x & 63;
  for (int m = gw; m < M_TOT; m += nw) {
    const float* src = m < M_P ? s0 + (size_t)m * DM : s1 + (size_t)(m - M_P) * DM;
    f32x4 v[4];
#pragma unroll
    for (int i = 0; i < 4; ++i) v[i] = *(const f32x4*)(src + i * 256 + lane * 4);
    float ss = 0.f;
#pragma unroll
    for (int i = 0; i < 4; ++i) ss += v[i][0] * v[i][0] + v[i][1] * v[i][1] + v[i][2] * v[i][2] + v[i][3] * v[i][3];
#pragma unroll
    for (int o = 32; o > 0; o >>= 1) ss += __shfl_xor(ss, o);
    const float rs = rsqrtf(ss * (1.f / 1024.f) + 1e-6f);
#pragma unroll
    for (int i = 0; i < 4; ++i) {
      const f32x4 gg = *(const f32x4*)(g + i * 256 + lane * 4);
      const f32x4 y = v[i] * rs * gg;
      if (outb) { u32x2 w = {pk2(y[0], y[1]), pk2(y[2], y[3])}; *(u32x2*)(outb + (size_t)m * DM + i * 256 + lane * 4) = w; }
      else *(f32x4*)(outf + (size_t)m * DM + i * 256 + lane * 4) = y;
    }
  }
}

DI void prep_phase(const Params& p, char* lds, int bid, int nb) {
  float* tile = (float*)lds;
  char* ws = p.ws;
  int rot = 0;
  tr_job(p.ab_w_in, 1024, 2560, (u16*)(ws + WT_ABIN), 0, tile, bid, nb, rot);
  tr_job(p.ab_w_out, 1024, 1024, (u16*)(ws + WT_ABOUT), 0, tile, bid, nb, rot);
  tr_job(p.w_gate, 1024, FH, (u16*)(ws + WT_GU0), 1, tile, bid, nb, rot);
  tr_job(p.w_up, 1024, FH, (u16*)(ws + WT_GU0), 2, tile, bid, nb, rot);
  tr_job(p.w_gate + (size_t)1024 * FH, 1024, FH, (u16*)(ws + WT_GU1), 1, tile, bid, nb, rot);
  tr_job(p.w_up + (size_t)1024 * FH, 1024, FH, (u16*)(ws + WT_GU1), 2, tile, bid, nb, rot);
  tr_job(p.w_down, FH, 1024, (u16*)(ws + WT_DOWN0), 0, tile, bid, nb, rot);
  tr_job(p.w_down + (size_t)FH * 1024, FH, 1024, (u16*)(ws + WT_DOWN1), 0, tile, bid, nb, rot);
  tr_job(p.mla_w_in, 1024, 672, (u16*)(ws + WT_MLAIN), 0, tile, bid, nb, rot);
  tr_job(p.w_qb, 384, 1536, (u16*)(ws + WT_QB), 0, tile, bid, nb, rot);
  tr_job(p.w_kvb, 256, 2048, (u16*)(ws + WT_KVB), 0, tile, bid, nb, rot);
  tr_job(p.mla_w_out, 1024, 1024, (u16*)(ws + WT_MLAOUT), 0, tile, bid, nb, rot);
  for (int dg = 0; dg < 32; ++dg) {
    const int cb = dg & 7, gate = (dg >> 3) & 1, dir = dg >> 4;
    const float* src = (gate == 0 ? p.w_a : p.w_i) + (size_t)(dir * 8 + cb) * 4096;
    tr_job(src, 64, 64, (u16*)(ws + WT_GATES) + (size_t)dg * 4096, 0, tile, bid, nb, rot);
  }
  const int gtid = bid * 256 + VT, gn = nb * 256;
  { u16* d = (u16*)(ws + WT_MLAIN) + (size_t)672 * 1024; for (int i = gtid; i < 96 * 1024; i += gn) d[i] = 0; }
  { float* ct = (float*)(ws + OFF_COS); float* st = (float*)(ws + OFF_SIN);
    for (int i = gtid; i < 8192 * 16; i += gn) {
      const int pos = i >> 4, k = i & 15;
      const float inv_freq = 1.0f / powf(10000.0f, (float)(2 * k) / 32.0f);
      const float ang = (float)pos * inv_freq;
      double f = (double)ang * 0.15915494309189535; f -= rint(f);
      ct[i] = __builtin_amdgcn_cosf((float)f); st[i] = __builtin_amdgcn_sinf((float)f);
    } }
  rmsnorm_phase(p.xin0, p.xin1, p.norm_mix, (u16*)(ws + OFF_H), nullptr, bid * 4 + (VT >> 6), nb * 4);
}

enum { EPI_BF16 = 0, EPI_RESID = 1, EPI_SWIGLU = 2 };
#define MFMA16(a, b, c) __builtin_amdgcn_mfma_f32_16x16x32_bf16((a), (b), (c), 0, 0, 0)
template <int EPI>
DI void gemm_phase(const u16* __restrict__ A, int lda, const u16* __restrict__ Bt, int K, int N, u16* outb, int ldo,
                   const float* r0, const float* r1, float* outf, char* lds, int bid, int nb) {
  const int tid = threadIdx.x, lane = tid & 63, wid = tid >> 6, wr = wid >> 2, wc = wid & 3, l15 = lane & 15, quad = lane >> 4;
  u16* As = (u16*)lds; u16* Bs = As + 2 * 256 * 64;
  const int nN = N >> 8, nM = M_TOT >> 8, nT = nM * nN, nk = K >> 6;
  const int lrow = tid >> 3, lch = tid & 7;
  const int sto = lrow * 64 + ((lch ^ ((lrow >> 1) & 7)) * 8);
  const int fsw = (l15 >> 1) & 7;
  const int fo0 = ((0 * 4 + quad) ^ fsw) * 8, fo1 = ((1 * 4 + quad) ^ fsw) * 8;
  const bool swz = (nb == 256);
  const int GN = (nN & 1) == 0 ? 2 : 1, GM = 32 / GN, nSN = nN / GN, nST = (nM / GM) * nSN;
  const int xcd = bid & 7, jb = bid >> 3;
  const int nIter = swz ? (nST - xcd + 7) / 8 : (nT - bid + nb - 1) / nb;
  for (int it = 0; it < nIter; ++it) {
    int tm, tn;
    if (swz) { const int st = xcd + 8 * it, sm = st / nSN, sn = st - sm * nSN; tm = sm * GM + jb / GN; tn = sn * GN + (jb % GN); }
    else { const int t = bid + it * nb; tm = t / nN; tn = t - tm * nN; }
    const u16* Ag = A + (size_t)(tm * 256 + lrow) * lda + lch * 8;
    const u16* Bg = Bt + (size_t)(tn * 256 + lrow) * K + lch * 8;
    f32x4 acc[8][4];
#pragma unroll
    for (int i = 0; i < 8; ++i)
#pragma unroll
      for (int j = 0; j < 4; ++j) acc[i][j] = (f32x4){0.f, 0.f, 0.f, 0.f};
    u32x4 ra[4], rb[4];
#define G_LOAD(KT) do { _Pragma("unroll") for (int i = 0; i < 4; ++i) { ra[i] = *(const u32x4*)(Ag + (size_t)i * 64 * lda + (KT) * 64); rb[i] = *(const u32x4*)(Bg + (size_t)i * 64 * K + (KT) * 64); } } while (0)
#define G_STORE(BUF) do { u16* ad = As + (BUF) * 256 * 64 + sto; u16* bd = Bs + (BUF) * 256 * 64 + sto; _Pragma("unroll") for (int i = 0; i < 4; ++i) { *(u32x4*)(ad + i * 64 * 64) = ra[i]; *(u32x4*)(bd + i * 64 * 64) = rb[i]; } } while (0)
#define G_MMA(BUF, FO) do { const u16* as = As + (BUF) * 256 * 64 + (wr * 128 + l15) * 64 + (FO); const u16* bs = Bs + (BUF) * 256 * 64 + (wc * 64 + l15) * 64 + (FO); \
        bf16x8 b_[4], a_[8]; \
        _Pragma("unroll") for (int j = 0; j < 4; ++j) b_[j] = *(const bf16x8*)(bs + j * 16 * 64); \
        _Pragma("unroll") for (int i = 0; i < 8; ++i) a_[i] = *(const bf16x8*)(as + i * 16 * 64); \
        __builtin_amdgcn_s_setprio(1); \
        _Pragma("unroll") for (int i = 0; i < 8; ++i) { _Pragma("unroll") for (int j = 0; j < 4; ++j) acc[i][j] = MFMA16(a_[i], b_[j], acc[i][j]); } \
        __builtin_amdgcn_s_setprio(0); } while (0)
    G_LOAD(0);
    G_STORE(0);
    __syncthreads();
    for (int kt = 0; kt < nk; ++kt) {
      const int cur = kt & 1;
      if (kt + 1 < nk) G_LOAD(kt + 1);
      G_MMA(cur, fo0);
      G_MMA(cur, fo1);
      if (kt + 1 < nk) G_STORE(cur ^ 1);
      __syncthreads();
    }
#undef G_LOAD
#undef G_STORE
#undef G_MMA
    const int mrow = tm * 256 + wr * 128 + quad * 4;
    if constexpr (EPI == EPI_BF16) {
      const int col = tn * 256 + wc * 64 + l15;
#pragma unroll
      for (int i = 0; i < 8; ++i)
#pragma unroll
        for (int r = 0; r < 4; ++r) {
          u16* o0 = outb + (size_t)(mrow + i * 16 + r) * ldo + col;
          o0[0] = f2bf(acc[i][0][r]); o0[16] = f2bf(acc[i][1][r]); o0[32] = f2bf(acc[i][2][r]); o0[48] = f2bf(acc[i][3][r]);
        }
    } else if constexpr (EPI == EPI_RESID) {
      const int col = tn * 256 + wc * 64 + l15;
      const float* rb_ = (tm * 256 < M_P) ? r0 : (r1 - (size_t)M_P * DM);
#pragma unroll
      for (int i = 0; i < 8; ++i)
#pragma unroll
        for (int r = 0; r < 4; ++r) {
          const size_t i0 = (size_t)(mrow + i * 16 + r) * DM + col;
          const float x0 = rb_[i0], x1 = rb_[i0 + 16], x2 = rb_[i0 + 32], x3 = rb_[i0 + 48];
          outf[i0] = x0 + acc[i][0][r]; outf[i0 + 16] = x1 + acc[i][1][r]; outf[i0 + 32] = x2 + acc[i][2][r]; outf[i0 + 48] = x3 + acc[i][3][r];
        }
    } else {
      const int col = (tn * 4 + wc) * 32 + l15;
#pragma unroll
      for (int i = 0; i < 8; ++i)
#pragma unroll
        for (int r = 0; r < 4; ++r) {
          const float g0 = acc[i][0][r], u0 = acc[i][2][r], g1 = acc[i][1][r], u1 = acc[i][3][r];
          u16* o0 = outb + (size_t)(mrow + i * 16 + r) * ldo + col;
          o0[0] = f2bf(g0 * sigmoidf_(g0) * u0); o0[16] = f2bf(g1 * sigmoidf_(g1) * u1);
        }
    }
  }
}

template <bool FINAL>
DI void rg_phase(const Params& p, char* lds, int bid, int nb) {
  const int tid = VT, lane = tid & 63, wid = tid >> 6, r32 = lane & 31, hi = lane >> 5;
  u16* xcb = (u16*)lds;
  float* A0 = (float*)(lds + 9216);
  float* U0 = (float*)(lds + 9216 + 16384);
  float* A1 = (float*)(lds + 9216 + 32768);
  float* U1 = (float*)(lds + 9216 + 49152);
  u16* raw = (u16*)A1;
  const u16* PROJ = (const u16*)(p.ws + OFF_PROJ);
  const u16* WG = (const u16*)(p.ws + WT_GATES);
  float* SUM = (float*)(p.ws + OFF_SUM);
  const float* CARRY = (const float*)(p.ws + OFF_CARRY);
  u16* Y = (u16*)(p.ws + OFF_Y);
  const int NIT = 768 * 8, nit = (NIT + nb - 1) / nb;
  const int mt = wid >> 1, nt = wid & 1;
  int cb_loaded = -1;
  float w0 = 0.f, w1 = 0.f, w2 = 0.f, w3 = 0.f, cbias = 0.f, bav[2] = {0.f, 0.f}, biv[2] = {0.f, 0.f}, spv[2] = {0.f, 0.f};
  u32x4 rr[3], rg[2], rrn[3], rgn[2];
  auto load_item = [&](int it, u32x4 (&xr)[3], u32x4 (&xg)[2]) {
    const int gc = it >> 3, cb = it & 7, m0 = gc * 64;
    int seq_lo, S; row_info(m0, seq_lo, S); const int seq_hi = seq_lo + S;
#pragma unroll
    for (int i = 0; i < 3; ++i) {
      const int c = tid + 256 * i, row = c >> 3, ch8 = c & 7, m = m0 - 2 + row;
      xr[i] = (c < 536 && m >= seq_lo && m < seq_hi) ? *(const u32x4*)(PROJ + (size_t)m * 2560 + cb * 64 + ch8 * 8) : (u32x4){0u, 0u, 0u, 0u};
    }
    if (FINAL) {
#pragma unroll
      for (int i = 0; i < 2; ++i) { const int c = tid + 256 * i, row = c >> 3, ch8 = c & 7; xg[i] = *(const u32x4*)(PROJ + (size_t)(m0 + row) * 2560 + 512 + cb * 64 + ch8 * 8); }
    }
  };
  { const int it = bid < NIT ? bid : NIT - 1; load_item(it, rr, rg); }
  for (int k = 0; k < nit; ++k) {
    const int it0 = bid + k * nb, it = it0 < NIT ? it0 : NIT - 1;
    const int gc = it >> 3, cb = it & 7, m0 = gc * 64;
    if (cb != cb_loaded) {
      cb_loaded = cb;
      const int cc = cb * 64 + (tid & 63);
      w0 = p.conv_w[cc]; w1 = p.conv_w[512 + cc]; w2 = p.conv_w[1024 + cc]; w3 = p.conv_w[1536 + cc]; cbias = p.conv_b[cc];
      const int cg_ = cb * 64 + nt * 32 + r32;
#pragma unroll
      for (int dir = 0; dir < 2; ++dir) { bav[dir] = p.b_a[dir * 512 + cg_]; biv[dir] = p.b_i[dir * 512 + cg_]; spv[dir] = log1pf(__expf(-p.lam[dir * 512 + cg_])); }
    }
    __syncthreads();
#pragma unroll
    for (int i = 0; i < 3; ++i) { const int c = tid + 256 * i; if (c < 536) *(u32x4*)(raw + c * 8) = rr[i]; }
    { const int itn0 = bid + (k + 1) * nb, itn = itn0 < NIT ? itn0 : NIT - 1; load_item(itn, rrn, rgn); }
    __syncthreads();
    {
      const int ch = tid & 63, t0 = (tid >> 6) * 16;
      float xm2 = bf2f(raw[(t0) * 64 + ch]), xm1 = bf2f(raw[(t0 + 1) * 64 + ch]), x0 = bf2f(raw[(t0 + 2) * 64 + ch]);
#pragma unroll
      for (int t = t0; t < t0 + 16; ++t) {
        const float xp1 = bf2f(raw[(t + 3) * 64 + ch]);
        xcb[t * 72 + ch] = f2bf(w0 * xm2 + w1 * xm1 + w2 * x0 + w3 * xp1 + cbias);
        xm2 = xm1; xm1 = x0; x0 = xp1;
      }
    }
    __syncthreads();
    {
      bf16x8 af[4];
#pragma unroll
      for (int ks = 0; ks < 4; ++ks) af[ks] = *(const bf16x8*)(xcb + (mt * 32 + r32) * 72 + ks * 16 + 8 * hi);
      const int ch = nt * 32 + r32;
      float xc[16];
#pragma unroll
      for (int reg = 0; reg < 16; ++reg) xc[reg] = bf2f(xcb[(mt * 32 + crow(reg, hi)) * 72 + ch]);
#pragma unroll
      for (int dir = 0; dir < 2; ++dir) {
        f32x16 aa = {}, ai = {};
        const u16* wga = WG + (size_t)((dir * 2 + 0) * 8 + cb) * 4096 + (nt * 32 + r32) * 64 + 8 * hi;
        const u16* wgi = WG + (size_t)((dir * 2 + 1) * 8 + cb) * 4096 + (nt * 32 + r32) * 64 + 8 * hi;
#pragma unroll
        for (int ks = 0; ks < 4; ++ks) { const bf16x8 ba = *(const bf16x8*)(wga + ks * 16), bi = *(const bf16x8*)(wgi + ks * 16); aa = MFMA32(af[ks], ba, aa); ai = MFMA32(af[ks], bi, ai); }
        float* Ab = dir == 0 ? A0 : A1; float* Ub = dir == 0 ? U0 : U1;
#pragma unroll
        for (int reg = 0; reg < 16; ++reg) {
          const int tok = mt * 32 + crow(reg, hi);
          const float r = sigmoidf_(aa[reg] + bav[dir]), gi = sigmoidf_(ai[reg] + biv[dir]);
          const float la2 = -8.f * 1.4426950408889634f * r * spv[dir], a = __builtin_amdgcn_exp2f(la2);
          const float mult = __builtin_amdgcn_sqrtf(fmaxf(0.f, 1.f - a * a));
          Ab[tok * 64 + ch] = a; Ub[tok * 64 + ch] = mult * gi * xc[reg];
        }
      }
    }
    __syncthreads();
    if (wid < 2) {
      const int dir = wid, ch = lane, c = cb * 64 + ch;
      float* Ab = dir == 0 ? A0 : A1; float* Ub = dir == 0 ? U0 : U1;
      if (!FINAL) {
        float h = 0.f, P = 1.f;
#pragma unroll 16
        for (int kk = 0; kk < 64; ++kk) { const int t = dir == 0 ? kk : 63 - kk; const float a = Ab[t * 64 + ch], u = Ub[t * 64 + ch]; h = a * h + u; P *= a; }
        SUM[(size_t)((gc * 2 + dir) * 2 + 0) * 512 + c] = P; SUM[(size_t)((gc * 2 + dir) * 2 + 1) * 512 + c] = h;
      } else {
        float h = CARRY[(size_t)(gc * 2 + dir) * 512 + c];
#pragma unroll 16
        for (int kk = 0; kk < 64; ++kk) { const int t = dir == 0 ? kk : 63 - kk; const float a = Ab[t * 64 + ch], u = Ub[t * 64 + ch]; h = a * h + u; Ub[t * 64 + ch] = h; }
      }
    }
    if (FINAL) {
      __syncthreads();
#pragma unroll
      for (int i = 0; i < 2; ++i) {
        const int c = tid + 256 * i, t = c >> 3, ch8 = c & 7;
        const f32x4 ha = *(const f32x4*)(U0 + t * 64 + ch8 * 8), hb = *(const f32x4*)(U0 + t * 64 + ch8 * 8 + 4);
        const f32x4 hc = *(const f32x4*)(U1 + t * 64 + ch8 * 8), hd = *(const f32x4*)(U1 + t * 64 + ch8 * 8 + 4);
        float hs[8] = {ha[0] + hc[0], ha[1] + hc[1], ha[2] + hc[2], ha[3] + hc[3], hb[0] + hd[0], hb[1] + hd[1], hb[2] + hd[2], hb[3] + hd[3]};
        float yv[8];
#pragma unroll
        for (int j = 0; j < 8; ++j) {
          const unsigned wv = rg[i][j >> 1];
          const float gt = __uint_as_float((j & 1) ? (wv & 0xffff0000u) : (wv << 16));
          const float ge = gt * sigmoidf_(1.5957691216057308f * (gt + 0.044715f * gt * gt * gt));
          yv[j] = ge * hs[j];
        }
        u32x4 o = {pk2(yv[0], yv[1]), pk2(yv[2], yv[3]), pk2(yv[4], yv[5]), pk2(yv[6], yv[7])};
        *(u32x4*)(Y + (size_t)(m0 + t) * 1024 + cb * 64 + ch8 * 8) = o;
      }
    }
#pragma unroll
    for (int i = 0; i < 3; ++i) rr[i] = rrn[i];
#pragma unroll
    for (int i = 0; i < 2; ++i) rg[i] = rgn[i];
  }
}

DI void rg_carry_phase(const Params& p, int bid, int nb) {
  const float* __restrict__ SUM = (const float*)(p.ws + OFF_SUM);
  float* __restrict__ CARRY = (float*)(p.ws + OFF_CARRY);
  for (int idx = bid * 256 + VT; idx < 8192; idx += nb * 256) {
    const int c = idx & 511, dir = (idx >> 9) & 1, seq = idx >> 10;
    const int gc0 = seq < 4 ? seq * 128 : 512 + (seq - 4) * 64, nch = seq < 4 ? 128 : 64;
    float carry = 0.f;
    for (int k0 = 0; k0 < nch; k0 += 8) {
      float P[8], Hh[8];
#pragma unroll
      for (int j = 0; j < 8; ++j) { const int k = k0 + j, gc = dir == 0 ? gc0 + k : gc0 + nch - 1 - k; P[j] = SUM[(size_t)((gc * 2 + dir) * 2 + 0) * 512 + c]; Hh[j] = SUM[(size_t)((gc * 2 + dir) * 2 + 1) * 512 + c]; }
#pragma unroll
      for (int j = 0; j < 8; ++j) { const int k = k0 + j, gc = dir == 0 ? gc0 + k : gc0 + nch - 1 - k; CARRY[(size_t)(gc * 2 + dir) * 512 + c] = carry; carry = P[j] * carry + Hh[j]; }
    }
  }
}

DI void dil_tile_info(int ti, int m0, int& d, int& u0) {
  if (ti < 5) { d = 16; u0 = m0 - 1024 + ti * 512; } else if (ti < 13) { d = 4; u0 = m0 - 256 + (ti - 5) * 128; } else { d = 1; u0 = m0 - 64 + (ti - 13) * 32; }
}
DI void dilated_phase(const Params& p, char* lds, int gw, int nw) {
  const int lane = VT & 63, wid = VT >> 6, r32 = lane & 31, hi = lane >> 5;
  u16* Vl = (u16*)(lds + wid * 6144);
  const unsigned vbase = (unsigned)(uintptr_t)Vl;
  const int li = lane & 15, tq = li >> 2, tp = li & 3, g1 = (lane >> 4) & 1;
  const unsigned trb = vbase + (4 * hi + tq) * 192 + (16 * g1 + 4 * tp) * 2;
  const u16* PROJ = (const u16*)(p.ws + OFF_PROJ);
  u16* Y = (u16*)(p.ws + OFF_Y);
  const int vrow = lane >> 3, vch = lane & 7;
  const int rb_ = gw >> 3, hf_ = (gw >> 2) & 1, w_ = gw & 3, rnb_ = nw >> 3;
  const bool remap = (rnb_ == 256);
  for (int itd = 0, id0 = gw; id0 < 12288; ++itd, id0 += nw) {
    int res, h, sp;
    if (remap) {
      const int xc = rb_ & 7, k = rb_ >> 3, G = itd * 256 + xc * 32 + 2 * (k >> 1) + (k & 1);
      const int hgrp = (G & 1) * 2 + hf_;
      res = hgrp + 4 * w_; h = (G >> 1) & 7; sp = G >> 4;
    } else { res = id0 & 15; h = (id0 >> 4) & 7; sp = id0 >> 7; }
    const int m0 = sp * 512 + res;
    int seq_lo, S; row_info(sp * 512, seq_lo, S); const int seq_hi = seq_lo + S;
    const int mq = m0 + 16 * r32;
    bf16x8 qf[4];
#pragma unroll
    for (int ks = 0; ks < 4; ++ks) qf[ks] = *(const bf16x8*)(PROJ + (size_t)mq * 2560 + 1024 + h * 64 + ks * 16 + 8 * hi);
    const float slope2 = exp2f(-(float)(h + 1)) * LOG2E;
    const float c1 = 0.125f * LOG2E;
    float m_run = -1e30f, l_run = 0.f; f32x16 o0 = {}, o1 = {};
    const u16* kbase = PROJ + 1536 + h * 64 + 8 * hi;
    const u16* vbaseg = PROJ + 2048 + h * 64 + vch * 8;
    bf16x8 kfA[4], kfB[4]; u32x4 vrA[4], vrB[4];
#define DIL_LOAD(KF, VR, TIV) do { int d_, u_; dil_tile_info((TIV), m0, d_, u_); \
      const int ur_ = min(max(u_ + d_ * r32, seq_lo), seq_hi - 1); \
      _Pragma("unroll") for (int ks = 0; ks < 4; ++ks) KF[ks] = *(const bf16x8*)(kbase + (size_t)ur_ * 2560 + ks * 16); \
      _Pragma("unroll") for (int i = 0; i < 4; ++i) { const int uv_ = min(max(u_ + d_ * (vrow + 8 * i), seq_lo), seq_hi - 1); VR[i] = *(const u32x4*)(vbaseg + (size_t)uv_ * 2560); } } while (0)
#define DIL_TILE(KF, VR, TIV) do { const int ti = (TIV); \
      int d, u0; dil_tile_info(ti, m0, d, u0); \
      _Pragma("unroll") \
      for (int i = 0; i < 4; ++i) *(u32x4*)(Vl + (vrow + 8 * i) * 96 + vch * 8) = VR[i]; \
      f32x16 pt = {}; \
      _Pragma("unroll") \
      for (int ks = 0; ks < 4; ++ks) pt = MFMA32(KF[ks], qf[ks], pt); \
      if (ti + 2 < 33) DIL_LOAD(KF, VR, ti + 2);     \
      const s16x4 l00 = tr_read_o<0>(trb), h00 = tr_read_o<8 * 192>(trb), l01 = tr_read_o<64>(trb), h01 = tr_read_o<8 * 192 + 64>(trb); \
      const s16x4 l10 = tr_read_o<16 * 192>(trb), h10 = tr_read_o<24 * 192>(trb), l11 = tr_read_o<16 * 192 + 64>(trb), h11 = tr_read_o<24 * 192 + 64>(trb); \
      const float fd = (float)d, lim = 64.f * fd; \
      const float fdu0 = (float)(u0 - mq + d * 4 * hi); \
      const float lo_ = fmaxf((float)(seq_lo - mq), -lim), hi_ = fminf((float)(seq_hi - 1 - mq), lim); \
      const float mid = 0.5f * (lo_ + hi_), hw = 0.5f * (hi_ - lo_); \
      const float gdu0 = fdu0 - mid; \
      float pmax = -INFINITY; \
      _Pragma("unroll") \
      for (int reg = 0; reg < 16; ++reg) { \
        const float cf = (float)((reg & 3) + 8 * (reg >> 2)); \
        const float du = fmaf(fd, cf, fdu0), g = fmaf(fd, cf, gdu0); \
        const float tv = (__builtin_fabsf(g) <= hw) ? fmaf(__builtin_fabsf(du), -slope2, pt[reg] * c1) : -INFINITY; \
        pt[reg] = tv; pmax = max_nn(pmax, tv); \
      } \
      pmax = pl32_max(pmax); \
      if (__any(pmax > m_run)) { \
        const float mn = fmaxf(m_run, pmax), alpha = __builtin_amdgcn_exp2f(m_run - mn); \
        m_run = mn; l_run *= alpha; \
      _Pragma("unroll") \
        for (int reg = 0; reg < 16; ++reg) { o0[reg] *= alpha; o1[reg] *= alpha; } \
      } \
      float ps = 0.f; \
      _Pragma("unroll") \
      for (int reg = 0; reg < 16; ++reg) { pt[reg] = __builtin_amdgcn_exp2f(pt[reg] - m_run); ps += pt[reg]; } \
      ps = pl32_sum(ps); \
      l_run += ps; \
      const bf16x8 pb0 = pack8(pt, 0), pb1 = pack8(pt, 1); \
      LGKM0(); \
      o0 = MFMA32(cat4(l00, h00), pb0, o0); o0 = MFMA32(cat4(l10, h10), pb1, o0); \
      o1 = MFMA32(cat4(l01, h01), pb0, o1); o1 = MFMA32(cat4(l11, h11), pb1, o1); \
    } while (0)
    DIL_LOAD(kfA, vrA, 0);
    DIL_LOAD(kfB, vrB, 1);
#pragma unroll 1
    for (int tp2 = 0; tp2 < 32; tp2 += 2) { DIL_TILE(kfA, vrA, tp2); DIL_TILE(kfB, vrB, tp2 + 1); }
    DIL_TILE(kfA, vrA, 32);
#undef DIL_LOAD
#undef DIL_TILE
    const float inv = 1.f / l_run;
    u16* yo = Y + (size_t)mq * 1024 + 512 + h * 64 + 4 * hi;
#pragma unroll
    for (int g = 0; g < 4; ++g) {
      u32x2 w0 = {pk2(o0[4 * g] * inv, o0[4 * g + 1] * inv), pk2(o0[4 * g + 2] * inv, o0[4 * g + 3] * inv)};
      u32x2 w1 = {pk2(o1[4 * g] * inv, o1[4 * g + 1] * inv), pk2(o1[4 * g + 2] * inv, o1[4 * g + 3] * inv)};
      *(u32x2*)(yo + 8 * g) = w0; *(u32x2*)(yo + 32 + 8 * g) = w1;
    }
  }
}

DI void mla_norm_phase(const Params& p, int gw, int nw) {
  const int lane = threadIdx.x & 63;
  const u16* P2 = (const u16*)(p.ws + OFF_P2);
  u16* CQN = (u16*)(p.ws + OFF_CQN); u16* CKVN = (u16*)(p.ws + OFF_CKVN); u16* KR = (u16*)(p.ws + OFF_KR);
  const float* ct = (const float*)(p.ws + OFF_COS); const float* st = (const float*)(p.ws + OFF_SIN);
  float gq[6], gkv[4];
#pragma unroll
  for (int i = 0; i < 6; ++i) gq[i] = p.q_norm[6 * lane + i];
#pragma unroll
  for (int i = 0; i < 4; ++i) gkv[i] = p.kv_norm[4 * lane + i];
  for (int m = gw; m < M_TOT; m += nw) {
    const u16* src = P2 + (size_t)m * 768;
    const unsigned* s32 = (const unsigned*)src;
    const unsigned w0 = s32[3 * lane], w1 = s32[3 * lane + 1], w2 = s32[3 * lane + 2];
    const u32x2 wk = *(const u32x2*)(src + 384 + 4 * lane);
    float q[6] = {__uint_as_float(w0 << 16), __uint_as_float(w0 & 0xffff0000u), __uint_as_float(w1 << 16), __uint_as_float(w1 & 0xffff0000u), __uint_as_float(w2 << 16), __uint_as_float(w2 & 0xffff0000u)};
    float kv[4] = {__uint_as_float(wk[0] << 16), __uint_as_float(wk[0] & 0xffff0000u), __uint_as_float(wk[1] << 16), __uint_as_float(wk[1] & 0xffff0000u)};
    float sq = 0.f, skv = 0.f;
#pragma unroll
    for (int i = 0; i < 6; ++i) sq += q[i] * q[i];
#pragma unroll
    for (int i = 0; i < 4; ++i) skv += kv[i] * kv[i];
#pragma unroll
    for (int o = 32; o > 0; o >>= 1) { sq += __shfl_xor(sq, o); skv += __shfl_xor(skv, o); }
    const float rq = rsqrtf(sq * (1.f / 384.f) + 1e-6f), rkv = rsqrtf(skv * (1.f / 256.f) + 1e-6f);
    unsigned* dq = (unsigned*)(CQN + (size_t)m * 384) + 3 * lane;
    dq[0] = pk2(q[0] * rq * gq[0], q[1] * rq * gq[1]); dq[1] = pk2(q[2] * rq * gq[2], q[3] * rq * gq[3]); dq[2] = pk2(q[4] * rq * gq[4], q[5] * rq * gq[5]);
    u32x2 ok = {pk2(kv[0] * rkv * gkv[0], kv[1] * rkv * gkv[1]), pk2(kv[2] * rkv * gkv[2], kv[3] * rkv * gkv[3])};
    *(u32x2*)(CKVN + (size_t)m * 256 + 4 * lane) = ok;
    if (lane < 16) {
      const int pos = m < M_P ? (m & 8191) : ((m - M_P) & 4095);
      const float t1 = bf2f(src[640 + lane]), t2 = bf2f(src[656 + lane]);
      const float c = ct[pos * 16 + lane], s = st[pos * 16 + lane];
      KR[(size_t)m * 32 + lane] = f2bf(t1 * c - t2 * s); KR[(size_t)m * 32 + 16 + lane] = f2bf(t1 * s + t2 * c);
    }
  }
}

constexpr int KP = 104, VP = 96;
DI void mla_unit(const Params& p, char* lds, int seqbase, int S, int h, int qb) {
  const int tid = threadIdx.x, lane = tid & 63, wid = tid >> 6, r32 = lane & 31, hi = lane >> 5;
  u16* Kl = (u16*)lds;
  u16* Vl = (u16*)(lds + 3 * 64 * KP * 2);
  const unsigned vbase = (unsigned)(uintptr_t)Vl;
  const int li = lane & 15, tq = li >> 2, tp = li & 3, g1 = (lane >> 4) & 1;
  const unsigned trb = vbase + (4 * hi + tq) * (VP * 2) + (16 * g1 + 4 * tp) * 2;
  const u16* Q = (const u16*)(p.ws + OFF_Q); const u16* KV = (const u16*)(p.ws + OFF_KV); const u16* KR = (const u16*)(p.ws + OFF_KR);
  u16* O = (u16*)(p.ws + OFF_O);
  const float* ct = (const float*)(p.ws + OFF_COS); const float* st = (const float*)(p.ws + OFF_SIN);
  const int pos = qb * 256 + wid * 32 + r32, qrow = seqbase + pos;
  bf16x8 qf[6];
#pragma unroll
  for (int d0 = 0; d0 < 6; ++d0) qf[d0] = *(const bf16x8*)(Q + (size_t)qrow * 1536 + h * 96 + d0 * 16 + 8 * hi);
  const float C = 0.10206207261596577f * LOG2E;
#pragma unroll
  for (int j = 0; j < 8; ++j) {
    const float c = ct[pos * 16 + 8 * hi + j], s = st[pos * 16 + 8 * hi + j];
    const float t1 = bfs2f(qf[4][j]), t2 = bfs2f(qf[5][j]);
    qf[4][j] = (short)f2bf((t1 * c - t2 * s) * C); qf[5][j] = (short)f2bf((t1 * s + t2 * c) * C);
  }
#pragma unroll
  for (int d0 = 0; d0 < 4; ++d0)
#pragma unroll
    for (int j = 0; j < 8; ++j) qf[d0][j] = (short)f2bf(bfs2f(qf[d0][j]) * C);
  const int srow = tid >> 3, sc = tid & 7, rrow = (tid >> 2) & 63, rc = tid & 3;
  const bool kr_on = tid < 256;
  const u16* kvsrc = KV + (size_t)(seqbase + srow) * KVP + h * 128 + sc * 8;
  const u16* krsrc = KR + (size_t)(seqbase + rrow) * 32 + rc * 8;
  const int kdst0 = srow * KP + sc * 8, kdst2 = rrow * KP + 64 + rc * 8, vdst = srow * VP + sc * 8;
  float l_run = 0.f; f32x16 o0 = {}, o1 = {}, negm = {};
  const int nkt = S >> 6;
  u32x4 rkn, rkr, rvv;
#define MLA_GLOAD(T) do { rkn = *(const u32x4*)(kvsrc + (size_t)(T) * 64 * KVP); rvv = *(const u32x4*)(kvsrc + (size_t)(T) * 64 * KVP + 64); \
    if (kr_on) rkr = *(const u32x4*)(krsrc + (size_t)(T) * 64 * 32); } while (0)
#define MLA_LSTORE(B) do { u16* kd = Kl + (B) * 64 * KP; u16* vd = Vl + (B) * 64 * VP; *(u32x4*)(kd + kdst0) = rkn; *(u32x4*)(vd + vdst) = rvv; \
    if (kr_on) *(u32x4*)(kd + kdst2) = rkr; } while (0)
  MLA_GLOAD(0); MLA_LSTORE(0);
  MLA_GLOAD(1); MLA_LSTORE(1);
  __syncthreads();
  int cur = 0, nx2 = 2;
#pragma unroll 1
  for (int kt = 0; kt < nkt; ++kt) {
    if (kt + 2 < nkt) MLA_GLOAD(kt + 2);
    const u16* kl = Kl + cur * 64 * KP + r32 * KP + 8 * hi;
    f32x16 p0, p1;
    { const bf16x8 k0 = *(const bf16x8*)(kl), k1 = *(const bf16x8*)(kl + 32 * KP);
      p0 = MFMA32(k0, qf[0], negm); p1 = MFMA32(k1, qf[0], negm); }
#pragma unroll
    for (int d0 = 1; d0 < 6; ++d0) {
      const bf16x8 k0 = *(const bf16x8*)(kl + d0 * 16), k1 = *(const bf16x8*)(kl + 32 * KP + d0 * 16);
      p0 = MFMA32(k0, qf[d0], p0); p1 = MFMA32(k1, qf[d0], p1);
    }
    const unsigned tb = trb + cur * (64 * VP * 2);
    constexpr int R8 = 8 * VP * 2;
    const s16x4 a0 = tr_read_o<0>(tb), b0 = tr_read_o<R8>(tb), a1 = tr_read_o<2 * R8>(tb), b1 = tr_read_o<3 * R8>(tb);
    const s16x4 a2 = tr_read_o<4 * R8>(tb), b2 = tr_read_o<5 * R8>(tb), a3 = tr_read_o<6 * R8>(tb), b3 = tr_read_o<7 * R8>(tb);
    const s16x4 c0 = tr_read_o<64>(tb), d0_ = tr_read_o<R8 + 64>(tb), c1 = tr_read_o<2 * R8 + 64>(tb), d1 = tr_read_o<3 * R8 + 64>(tb);
    const s16x4 c2 = tr_read_o<4 * R8 + 64>(tb), d2 = tr_read_o<5 * R8 + 64>(tb), c3 = tr_read_o<6 * R8 + 64>(tb), d3 = tr_read_o<7 * R8 + 64>(tb);
    float pmax = max_nn(p0[0], p1[0]);
#pragma unroll
    for (int r = 1; r < 16; ++r) pmax = max_nn(pmax, max_nn(p0[r], p1[r]));
    pmax = pl32_max(pmax);
    if (kt == 0 || __any(pmax > 8.f)) {
      const float delta = kt == 0 ? pmax : fmaxf(pmax, 0.f);
      const float alpha = kt == 0 ? 1.f : __builtin_amdgcn_exp2f(-delta);
#pragma unroll
      for (int r = 0; r < 16; ++r) { negm[r] -= delta; p0[r] -= delta; p1[r] -= delta; o0[r] *= alpha; o1[r] *= alpha; }
      l_run *= alpha;
    }
    float ps = 0.f;
#pragma unroll
    for (int r = 0; r < 16; ++r) { p0[r] = __builtin_amdgcn_exp2f(p0[r]); p1[r] = __builtin_amdgcn_exp2f(p1[r]); ps += p0[r] + p1[r]; }
    ps = pl32_sum(ps);
    l_run += ps;
    const bf16x8 pb0 = pack8(p0, 0), pb1 = pack8(p0, 1), pb2 = pack8(p1, 0), pb3 = pack8(p1, 1);
    LGKM0();
    o0 = MFMA32(cat4(a0, b0), pb0, o0); o1 = MFMA32(cat4(c0, d0_), pb0, o1);
    o0 = MFMA32(cat4(a1, b1), pb1, o0); o1 = MFMA32(cat4(c1, d1), pb1, o1);
    o0 = MFMA32(cat4(a2, b2), pb2, o0); o1 = MFMA32(cat4(c2, d2), pb2, o1);
    o0 = MFMA32(cat4(a3, b3), pb3, o0); o1 = MFMA32(cat4(c3, d3), pb3, o1);
    __syncthreads();
    if (kt + 2 < nkt) MLA_LSTORE(nx2);
    cur = cur == 2 ? 0 : cur + 1; nx2 = nx2 == 2 ? 0 : nx2 + 1;
  }
  __syncthreads();
#undef MLA_GLOAD
#undef MLA_LSTORE
  const float inv = 1.f / l_run;
  u16* oo = O + (size_t)qrow * 1024 + h * 64 + 4 * hi;
#pragma unroll
  for (int g = 0; g < 4; ++g) {
    u32x2 w0 = {pk2(o0[4 * g] * inv, o0[4 * g + 1] * inv), pk2(o0[4 * g + 2] * inv, o0[4 * g + 3] * inv)};
    u32x2 w1 = {pk2(o1[4 * g] * inv, o1[4 * g + 1] * inv), pk2(o1[4 * g + 2] * inv, o1[4 * g + 3] * inv)};
    *(u32x2*)(oo + 8 * g) = w0; *(u32x2*)(oo + 32 + 8 * g) = w1;
  }
}

DI void mla_attn_phase(const Params& p, char* lds, int xcd, int j, int nper) {
  for (int lu0 = j; lu0 - j < 8 * 32; lu0 += nper) { const int lu = lu0 < 8 * 32 ? lu0 : 8 * 32 - 1; const int bh = (lu >> 5) * 8 + xcd, qb = lu & 31; mla_unit(p, lds, (bh >> 4) * 8192, 8192, bh & 15, qb); }
  for (int lu0 = j; lu0 - j < 8 * 16; lu0 += nper) { const int lu = lu0 < 8 * 16 ? lu0 : 8 * 16 - 1; const int bh = (lu >> 4) * 8 + xcd, qb = lu & 15; mla_unit(p, lds, M_P + (bh >> 4) * 4096, 4096, bh & 15, qb); }
}

#define XB_TMO      128
#define XB_XCNT(j)  (256  + 64 * (j))
#define XB_XSUB(j)  (1280 + 64 * (j))
#define XB_XGEN(j)  (2304 + 64 * (j))
#define XB_TOP      3328
#define XB_TOPGEN   3392
#define XCD_BAR_WORDS 3456
#define XB_SPIN_CAP (1u << 20)
#define LAS __attribute__((address_space(3)))
DI unsigned xb_ld(unsigned* p) { return __hip_atomic_load(p, __ATOMIC_RELAXED, __HIP_MEMORY_SCOPE_AGENT); }
DI unsigned xb_add(unsigned* p, unsigned v) { return __hip_atomic_fetch_add(p, v, __ATOMIC_RELAXED, __HIP_MEMORY_SCOPE_AGENT); }
DI unsigned xb_xcc_id() { return (unsigned)__builtin_amdgcn_s_getreg((3 << 11) | 20) & 0xFu; }
#define XB_SPIN(cond, bar) do { unsigned _sp = 0; while (cond) { __builtin_amdgcn_s_sleep(1); \
    if ((++_sp & 255u) == 0u) { if (xb_ld(&(bar)[XB_TMO])) break; if (_sp > XB_SPIN_CAP) { atomicAdd(&(bar)[XB_TMO], 1u); break; } } } } while (0)
struct XcdBarrier { unsigned* bar; unsigned x; volatile LAS unsigned* st; };
DI XcdBarrier xcd_barrier_post(unsigned* bar, volatile LAS unsigned* st) {
  XcdBarrier b; b.bar = bar; b.x = xb_xcc_id(); b.st = st;
  if (threadIdx.x == 0) (void)xb_add(&bar[XB_XCNT(b.x)], 1u);
  return b;
}
DI void xcd_barrier_complete(unsigned* bar, unsigned x, unsigned& nloc, unsigned& nx) {
  const unsigned G = gridDim.x * gridDim.y * gridDim.z;
  unsigned sum, cnt, mine, sp = 0u;
  for (;;) {
    sum = 0u; cnt = 0u; mine = 0u;
#pragma unroll
    for (unsigned j = 0; j < 16; ++j) { const unsigned c = xb_ld(&bar[XB_XCNT(j)]); sum += c; cnt += (c > 0u) ? 1u : 0u; mine = (j == x) ? c : mine; }
    if (sum == G) break;
    __builtin_amdgcn_s_sleep(1);
    if ((++sp & 255u) == 0u) { if (xb_ld(&bar[XB_TMO])) break; if (sp > XB_SPIN_CAP) { atomicAdd(&bar[XB_TMO], 1u); break; } }
  }
  nloc = mine > 0u ? mine : 1u; nx = cnt > 0u ? cnt : 1u;
}
DI void xcd_barrier(const XcdBarrier& b) {
  asm volatile("s_waitcnt vmcnt(0)" ::: "memory");
  __syncthreads();
  if (threadIdx.x == 0) {
    unsigned* bar = b.bar;
    __builtin_amdgcn_s_waitcnt(0);
    unsigned nloc = b.st[0], nx = b.st[1];
    if (nloc == 0u) { xcd_barrier_complete(bar, b.x, nloc, nx); b.st[0] = nloc; b.st[1] = nx; }
    const unsigned old = xb_add(&bar[XB_XSUB(b.x)], 1u);
    const unsigned gen = old / nloc;
    if (old + 1u == (gen + 1u) * nloc) {
      __builtin_amdgcn_fence(__ATOMIC_RELEASE, "agent");
      asm volatile("s_waitcnt vmcnt(0)" ::: "memory");
      const unsigned og = xb_add(&bar[XB_TOP], 1u);
      const unsigned tg = og / nx;
      if (og + 1u == (tg + 1u) * nx) xb_add(&bar[XB_TOPGEN], 1u);
      else XB_SPIN(xb_ld(&bar[XB_TOPGEN]) == tg, bar);
      __builtin_amdgcn_fence(__ATOMIC_ACQUIRE, "agent");
      xb_add(&bar[XB_XGEN(b.x)], 1u);
      asm volatile("s_waitcnt vmcnt(0)" ::: "memory");
    } else {
      XB_SPIN(xb_ld(&bar[XB_XGEN(b.x)]) == gen, bar);
      __builtin_amdgcn_fence(__ATOMIC_ACQUIRE, "agent");
      asm volatile("s_waitcnt vmcnt(0)" ::: "memory");
    }
  }
  __syncthreads();
}

constexpr int N_PHASES = 19;
constexpr int HALF_LDS = 76800;
constexpr int LDS_BYTES = 2 * HALF_LDS;
__global__ void __launch_bounds__(512, 2) mega(Params p, int ph_lo, int ph_hi) {
  __shared__ __attribute__((aligned(16))) char lds_all[LDS_BYTES];
  const int rbid = blockIdx.x, rnb = gridDim.x;
  const int half = __builtin_amdgcn_readfirstlane((int)(threadIdx.x >> 8));
  const int bid = rbid * 2 + half, nb = rnb * 2;
  char* lds = lds_all + half * HALF_LDS;
  const int gw = bid * 4 + __builtin_amdgcn_readfirstlane(VT >> 6), nw = nb * 4;
  char* ws = p.ws;
  float* out1 = p.out + (size_t)M_P * DM;
  __shared__ uint4 xb_words;
  if (threadIdx.x == 0) xb_words = make_uint4(0u, 0u, 0u, 0u);
  __syncthreads();
  XcdBarrier xb; xb.bar = (unsigned*)(ws + OFF_BAR); xb.x = 0; xb.st = (volatile LAS unsigned*)&xb_words;
  if (ph_hi - ph_lo > 1) xb = xcd_barrier_post((unsigned*)(ws + OFF_BAR), (volatile LAS unsigned*)&xb_words);
  if (ph_lo < 0) cg::this_grid().sync();
#ifndef DUP_MASK
#define DUP_MASK 0
#endif
#define PHASE(k, ...) do { if (ph_lo <= (k) && (k) < ph_hi) { __VA_ARGS__ if ((DUP_MASK >> (k)) & 1) { xcd_barrier(xb); __VA_ARGS__ } } if (ph_lo <= (k) && (k) + 1 < ph_hi) xcd_barrier(xb); } while (0)
  PHASE(0, prep_phase(p, lds, bid, nb););
  PHASE(1, gemm_phase<EPI_BF16>((const u16*)(ws + OFF_H), 1024, (const u16*)(ws + WT_ABIN), 1024, 2560, (u16*)(ws + OFF_PROJ), 2560, nullptr, nullptr, nullptr, lds_all, rbid, rnb););
  PHASE(2, rg_phase<false>(p, lds, bid, nb); __syncthreads(); dilated_phase(p, lds, gw, nw););
  PHASE(3, rg_carry_phase(p, bid, nb););
  PHASE(4, rg_phase<true>(p, lds, bid, nb););
  PHASE(5, gemm_phase<EPI_RESID>((const u16*)(ws + OFF_Y), 1024, (const u16*)(ws + WT_ABOUT), 1024, 1024, nullptr, 0, p.xin0, p.xin1, p.out, lds_all, rbid, rnb););
  PHASE(6, rmsnorm_phase(p.out, out1, p.norm_ffn, (u16*)(ws + OFF_H), nullptr, gw, nw););
  PHASE(7, gemm_phase<EPI_SWIGLU>((const u16*)(ws + OFF_H), 1024, (const u16*)(ws + WT_GU0), 1024, 5632, (u16*)(ws + OFF_ACT), FH, nullptr, nullptr, nullptr, lds_all, rbid, rnb););
  PHASE(8, gemm_phase<EPI_RESID>((const u16*)(ws + OFF_ACT), FH, (const u16*)(ws + WT_DOWN0), FH, 1024, nullptr, 0, p.out, out1, p.out, lds_all, rbid, rnb););
  PHASE(9, rmsnorm_phase(p.out, out1, p.norm_mix + 1024, (u16*)(ws + OFF_H), nullptr, gw, nw););
  PHASE(10, gemm_phase<EPI_BF16>((const u16*)(ws + OFF_H), 1024, (const u16*)(ws + WT_MLAIN), 1024, 768, (u16*)(ws + OFF_P2), 768, nullptr, nullptr, nullptr, lds_all, rbid, rnb););
  PHASE(11, mla_norm_phase(p, gw, nw););
  PHASE(12, gemm_phase<EPI_BF16>((const u16*)(ws + OFF_CQN), 384, (const u16*)(ws + WT_QB), 384, 1536, (u16*)(ws + OFF_Q), 1536, nullptr, nullptr, nullptr, lds_all, rbid, rnb); gemm_phase<EPI_BF16>((const u16*)(ws + OFF_CKVN), 256, (const u16*)(ws + WT_KVB), 256, 2048, (u16*)(ws + OFF_KV), KVP, nullptr, nullptr, nullptr, lds_all, rbid, rnb););
  PHASE(13, mla_attn_phase(p, lds_all, rbid & 7, rbid >> 3, rnb >> 3););
  PHASE(14, gemm_phase<EPI_RESID>((const u16*)(ws + OFF_O), 1024, (const u16*)(ws + WT_MLAOUT), 1024, 1024, nullptr, 0, p.out, out1, p.out, lds_all, rbid, rnb););
  PHASE(15, rmsnorm_phase(p.out, out1, p.norm_ffn + 1024, (u16*)(ws + OFF_H), nullptr, gw, nw););
  PHASE(16, gemm_phase<EPI_SWIGLU>((const u16*)(ws + OFF_H), 1024, (const u16*)(ws + WT_GU1), 1024, 5632, (u16*)(ws + OFF_ACT), FH, nullptr, nullptr, nullptr, lds_all, rbid, rnb););
  PHASE(17, gemm_phase<EPI_RESID>((const u16*)(ws + OFF_ACT), FH, (const u16*)(ws + WT_DOWN1), FH, 1024, nullptr, 0, p.out, out1, p.out, lds_all, rbid, rnb););
  PHASE(18, rmsnorm_phase(p.out, out1, p.norm_final, nullptr, p.out, gw, nw););
#undef PHASE
}

extern "C" void kernel_launch(void* const* d_in, const int* in_sizes, int n_in, void* d_out, int out_size, void* d_ws, size_t ws_size, hipStream_t stream) {
  static int grid_blocks = 0;
  if (!grid_blocks) {
    int dev = 0, cus = 0, per_cu = 0;
    hipGetDevice(&dev);
    hipDeviceGetAttribute(&cus, hipDeviceAttributeMultiprocessorCount, dev);
    hipOccupancyMaxActiveBlocksPerMultiprocessor(&per_cu, mega, 512, 0);
    if (per_cu > 1) per_cu = 1;
    if (per_cu < 1) per_cu = 1;
    grid_blocks = cus * per_cu;
  }
  if (n_in != 23 || ws_size < WS_NEED) { fprintf(stderr, "kernel_launch: bad inputs n_in=%d ws=%zu\n", n_in, ws_size); return; }
  Params p{};
  p.xin0 = (const float*)d_in[0]; p.xin1 = (const float*)d_in[1];
  p.norm_mix = (const float*)d_in[2]; p.norm_ffn = (const float*)d_in[3]; p.norm_final = (const float*)d_in[4];
  p.ab_w_in = (const float*)d_in[5]; p.conv_w = (const float*)d_in[6]; p.conv_b = (const float*)d_in[7];
  p.w_a = (const float*)d_in[8]; p.b_a = (const float*)d_in[9]; p.w_i = (const float*)d_in[10]; p.b_i = (const float*)d_in[11];
  p.lam = (const float*)d_in[12]; p.ab_w_out = (const float*)d_in[13];
  p.mla_w_in = (const float*)d_in[14]; p.q_norm = (const float*)d_in[15]; p.w_qb = (const float*)d_in[16]; p.kv_norm = (const float*)d_in[17];
  p.w_kvb = (const float*)d_in[18]; p.mla_w_out = (const float*)d_in[19];
  p.w_gate = (const float*)d_in[20]; p.w_up = (const float*)d_in[21]; p.w_down = (const float*)d_in[22];
  p.out = (float*)d_out; p.ws = (char*)d_ws;
#if SINGLE_LAUNCH
  hipMemsetAsync((char*)d_ws + OFF_BAR, 0, XCD_BAR_WORDS * 4, stream);
  int lo = 0, hi = N_PHASES;
  void* args[] = {&p, &lo, &hi};
  hipError_t e = hipLaunchCooperativeKernel((void*)mega, dim3(grid_blocks), dim3(512), args, 0, stream);
  if (e != hipSuccess) fprintf(stderr, "cooperative launch failed: %s (grid %d)\n", hipGetErrorString(e), grid_blocks);
#else
  for (int ph = 0; ph < N_PHASES; ++ph) hipLaunchKernelGGL(mega, dim3(grid_blocks), dim3(512), 0, stream, p, ph, ph + 1);
#endif
}
```

```cpp
#include <hip/hip_runtime.h>
#include <hip/hip_cooperative_groups.h>
#include <cstdint>
#include <cstdio>
namespace cg = cooperative_groups;

#ifndef SINGLE_LAUNCH
#define SINGLE_LAUNCH 1
#endif

typedef unsigned short u16;
typedef short bf16x8 __attribute__((ext_vector_type(8)));
typedef short s16x4 __attribute__((ext_vector_type(4)));
typedef float f32x16 __attribute__((ext_vector_type(16)));
typedef float f32x4 __attribute__((ext_vector_type(4)));
typedef float f32x2 __attribute__((ext_vector_type(2)));
typedef unsigned u32x4 __attribute__((ext_vector_type(4)));
typedef unsigned u32x2 __attribute__((ext_vector_type(2)));
typedef __bf16 bf2_t __attribute__((ext_vector_type(2)));
#define DI __device__ __forceinline__
#define VT ((int)(threadIdx.x & 255))
#define MFMA32(a, b, c) __builtin_amdgcn_mfma_f32_32x32x16_bf16((a), (b), (c), 0, 0, 0)

constexpr int M_TOT = 49152, M_P = 32768, DM = 1024, FH = 2816;
constexpr float LOG2E = 1.4426950408889634f;
constexpr size_t MiB = 1ull << 20;
constexpr size_t WT_ABIN = 0;
constexpr size_t WT_ABOUT = WT_ABIN + 2560ull * 1024 * 2;
constexpr size_t WT_GU0 = WT_ABOUT + 1024ull * 1024 * 2;
constexpr size_t WT_DOWN0 = WT_GU0 + 5632ull * 1024 * 2;
constexpr size_t WT_MLAIN = WT_DOWN0 + 1024ull * 2816 * 2;
constexpr size_t WT_QB = WT_MLAIN + 768ull * 1024 * 2;
constexpr size_t WT_KVB = WT_QB + 1536ull * 384 * 2;
constexpr size_t WT_MLAOUT = WT_KVB + 2048ull * 256 * 2;
constexpr size_t WT_GU1 = WT_MLAOUT + 1024ull * 1024 * 2;
constexpr size_t WT_DOWN1 = WT_GU1 + 5632ull * 1024 * 2;
constexpr size_t WT_GATES = WT_DOWN1 + 1024ull * 2816 * 2;
constexpr size_t WT_END = WT_GATES + 32ull * 4096 * 2;
static_assert(WT_END <= 46 * MiB, "weights region");
constexpr size_t OFF_SUM = 46 * MiB;
constexpr size_t OFF_KR = 46 * MiB;
constexpr size_t OFF_COS = 52 * MiB;
constexpr size_t OFF_SIN = 52 * MiB + 512 * 1024;
constexpr size_t OFF_H = 54 * MiB;
constexpr size_t OFF_CQN = 54 * MiB;
constexpr size_t OFF_CKVN = 90 * MiB;
constexpr size_t OFF_O = 54 * MiB;
constexpr size_t OFF_PROJ = 150 * MiB;
constexpr size_t OFF_ACT = 150 * MiB;
constexpr size_t OFF_P2 = 150 * MiB;
constexpr size_t OFF_Q = 150 * MiB;
constexpr size_t OFF_KV = 294 * MiB;
constexpr size_t OFF_Y = 390 * MiB;
constexpr size_t OFF_CARRY = 486 * MiB;
constexpr size_t OFF_BAR = 53 * MiB;
constexpr size_t WS_NEED = 496 * MiB;
constexpr int KVP = 2112;

struct Params {
  const float* xin0; const float* xin1;
  const float* norm_mix; const float* norm_ffn; const float* norm_final;
  const float* ab_w_in; const float* conv_w; const float* conv_b;
  const float* w_a; const float* b_a; const float* w_i; const float* b_i; const float* lam; const float* ab_w_out;
  const float* mla_w_in; const float* q_norm; const float* w_qb; const float* kv_norm; const float* w_kvb; const float* mla_w_out;
  const float* w_gate; const float* w_up; const float* w_down;
  float* out; char* ws;
};

DI float bf2f(u16 v) { return __uint_as_float(((unsigned)v) << 16); }
DI float bfs2f(short v) { return __uint_as_float(((unsigned)(u16)v) << 16); }
DI unsigned pk2(float lo, float hi) { f32x2 v = {lo, hi}; bf2_t r = __builtin_convertvector(v, bf2_t); return __builtin_bit_cast(unsigned, r); }
DI u16 f2bf(float a) { return (u16)(pk2(a, 0.f) & 0xffffu); }
DI int crow(int r, int hi) { return (r & 3) + 8 * (r >> 2) + 4 * hi; }
DI float sigmoidf_(float x) { return __builtin_amdgcn_rcpf(1.f + __builtin_amdgcn_exp2f(-1.4426950408889634f * x)); }
DI float pl32_max(float v) { auto rr = __builtin_amdgcn_permlane32_swap(__float_as_uint(v), __float_as_uint(v), false, false); return fmaxf(__uint_as_float(rr[0]), __uint_as_float(rr[1])); }
DI float pl32_sum(float v) { auto rr = __builtin_amdgcn_permlane32_swap(__float_as_uint(v), __float_as_uint(v), false, false); return __uint_as_float(rr[0]) + __uint_as_float(rr[1]); }
DI s16x4 tr_read(unsigned addr) { s16x4 r; asm volatile("ds_read_b64_tr_b16 %0, %1" : "=&v"(r) : "v"(addr) : "memory"); return r; }
template <int OFF> DI s16x4 tr_read_o(unsigned addr) { s16x4 r; asm volatile("ds_read_b64_tr_b16 %0, %1 offset:%2" : "=&v"(r) : "v"(addr), "i"(OFF) : "memory"); return r; }
DI float max_nn(float a, float b) { return __builtin_amdgcn_fmed3f(a, b, __builtin_inff()); }
#define LGKM0() do { asm volatile("s_waitcnt lgkmcnt(0)" ::: "memory"); __builtin_amdgcn_sched_barrier(0); } while (0)
DI bf16x8 cat4(s16x4 l, s16x4 h) { return (bf16x8){l[0], l[1], l[2], l[3], h[0], h[1], h[2], h[3]}; }
DI bf16x8 pack8(const f32x16& x, int s) {
  u32x4 w = {pk2(x[8 * s + 0], x[8 * s + 1]), pk2(x[8 * s + 2], x[8 * s + 3]), pk2(x[8 * s + 4], x[8 * s + 5]), pk2(x[8 * s + 6], x[8 * s + 7])};
  return __builtin_bit_cast(bf16x8, w);
}
DI void row_info(int m, int& seq_lo, int& S) { if (m < M_P) { seq_lo = m & ~8191; S = 8192; } else { seq_lo = M_P + ((m - M_P) & ~4095); S = 4096; } }

DI void tr_job(const float* __restrict__ src, int K, int N, u16* __restrict__ dst, int mode, float* tile, int bid, int nb, int& rot) {
  const int tk = K >> 6, tn = (N + 63) >> 6, nt = tk * tn;
  const int tx = VT & 63, ty = VT >> 6;
  const int t0 = (bid + nb - rot) % nb, nit = (nt + nb - 1) / nb;
  (void)tx; (void)ty;
  for (int i = 0; i < nit; ++i) {
    const int t = t0 + i * nb; const bool act = t < nt;
    const int k0 = (t / tn) << 6, n0 = (t % tn) << 6;
    __syncthreads();
    if (act) {
#pragma unroll
      for (int r = 0; r < 4; ++r) {
        const int idx = VT + 256 * r, kk = idx >> 4, c4 = idx & 15, n = n0 + c4 * 4;
        const f32x4 v = n < N ? *(const f32x4*)(src + (size_t)(k0 + kk) * N + n) : (f32x4){0.f, 0.f, 0.f, 0.f};
        float* tp = tile + kk * 65 + c4 * 4;
        tp[0] = v[0]; tp[1] = v[1]; tp[2] = v[2]; tp[3] = v[3];
      }
    }
    __syncthreads();
    if (act) {
#pragma unroll
      for (int r = 0; r < 2; ++r) {
        const int idx = VT + 256 * r, nn = idx >> 3, kc = idx & 7, n = n0 + nn;
        if (n < N) {
          const int row = mode == 0 ? n : ((n >> 5) * 64 + (n & 31) + (mode == 2 ? 32 : 0));
          const float* tp = tile + (kc * 8) * 65 + nn;
          u32x4 w = {pk2(tp[0], tp[65]), pk2(tp[2 * 65], tp[3 * 65]), pk2(tp[4 * 65], tp[5 * 65]), pk2(tp[6 * 65], tp[7 * 65])};
          *(u32x4*)(dst + (size_t)row * K + k0 + kc * 8) = w;
        }
      }
    }
  }
  rot = (rot + nt) % nb;
}

DI void rmsnorm_phase(const float* __restrict__ s0, const float* __restrict__ s1, const float* __restrict__ g, u16* outb, float* outf, int gw, int nw) {
  const int lane = threadIdx.x & 63;
  for (int m = gw; m < M_TOT; m += nw) {
    const float* src = m < M_P ? s0 + (size_t)m * DM : s1 + (size_t)(m - M_P) * DM;
    f32x4 v[4];
#pragma unroll
    for (int i = 0; i < 4; ++i) v[i] = *(const f32x4*)(src + i * 256 + lane * 4);
    float ss = 0.f;
#pragma unroll
    for (int i = 0; i < 4; ++i) ss += v[i][0] * v[i][0] + v[i][1] * v[i][1] + v[i][2] * v[i][2] + v[i][3] * v[i][3];
#pragma unroll
    for (int o = 32; o > 0; o >>= 1) ss += __shfl_xor(ss, o);
    const float rs = rsqrtf(ss * (1.f / 1024.f) + 1e-6f);
#pragma unroll
    for (int i = 0; i < 4; ++i) {
      const f32x4 gg = *(const f32x4*)(g + i * 256 + lane * 4);
      const f32x4 y = v[i] * rs * gg;
      if (outb) { u32x2 w = {pk2(y[0], y[1]), pk2(y[2], y[3])}; *(u32x2*)(outb + (size_t)m * DM + i * 256 + lane * 4) = w; }
      else *(f32x4*)(outf + (size_t)m * DM + i * 256 + lane * 4) = y;
    }
  }
}

DI void prep_phase(const Params& p, char* lds, int bid, int nb) {
  float* tile = (float*)lds;
  char* ws = p.ws;
  int rot = 0;
  tr_job(p.ab_w_in, 1024, 2560, (u16*)(ws + WT_ABIN), 0, tile, bid, nb, rot);
  tr_job(p.ab_w_out, 1024, 1024, (u16*)(ws + WT_ABOUT), 0, tile, bid, nb, rot);
  tr_job(p.w_gate, 1024, FH, (u16*)(ws + WT_GU0), 1, tile, bid, nb, rot);
  tr_job(p.w_up, 1024, FH, (u16*)(ws + WT_GU0), 2, tile, bid, nb, rot);
  tr_job(p.w_gate + (size_t)1024 * FH, 1024, FH, (u16*)(ws + WT_GU1), 1, tile, bid, nb, rot);
  tr_job(p.w_up + (size_t)1024 * FH, 1024, FH, (u16*)(ws + WT_GU1), 2, tile, bid, nb, rot);
  tr_job(p.w_down, FH, 1024, (u16*)(ws + WT_DOWN0), 0, tile, bid, nb, rot);
  tr_job(p.w_down + (size_t)FH * 1024, FH, 1024, (u16*)(ws + WT_DOWN1), 0, tile, bid, nb, rot);
  tr_job(p.mla_w_in, 1024, 672, (u16*)(ws + WT_MLAIN), 0, tile, bid, nb, rot);
  tr_job(p.w_qb, 384, 1536, (u16*)(ws + WT_QB), 0, tile, bid, nb, rot);
  tr_job(p.w_kvb, 256, 2048, (u16*)(ws + WT_KVB), 0, tile, bid, nb, rot);
  tr_job(p.mla_w_out, 1024, 1024, (u16*)(ws + WT_MLAOUT), 0, tile, bid, nb, rot);
  for (int dg = 0; dg < 32; ++dg) {
    const int cb = dg & 7, gate = (dg >> 3) & 1, dir = dg >> 4;
    const float* src = (gate == 0 ? p.w_a : p.w_i) + (size_t)(dir * 8 + cb) * 4096;
    tr_job(src, 64, 64, (u16*)(ws + WT_GATES) + (size_t)dg * 4096, 0, tile, bid, nb, rot);
  }
  const int gtid = bid * 256 + VT, gn = nb * 256;
  { u16* d = (u16*)(ws + WT_MLAIN) + (size_t)672 * 1024; for (int i = gtid; i < 96 * 1024; i += gn) d[i] = 0; }
  { float* ct = (float*)(ws + OFF_COS); float* st = (float*)(ws + OFF_SIN);
    for (int i = gtid; i < 8192 * 16; i += gn) {
      const int pos = i >> 4, k = i & 15;
      const float inv_freq = 1.0f / powf(10000.0f, (float)(2 * k) / 32.0f);
      const float ang = (float)pos * inv_freq;
      double f = (double)ang * 0.15915494309189535; f -= rint(f);
      ct[i] = __builtin_amdgcn_cosf((float)f); st[i] = __builtin_amdgcn_sinf((float)f);
    } }
  rmsnorm_phase(p.xin0, p.xin1, p.norm_mix, (u16*)(ws + OFF_H), nullptr, bid * 4 + (VT >> 6), nb * 4);
}

enum { EPI_BF16 = 0, EPI_RESID = 1, EPI_SWIGLU = 2 };
#define MFMA16(a, b, c) __builtin_amdgcn_mfma_f32_16x16x32_bf16((a), (b), (c), 0, 0, 0)
template <int EPI>
DI void gemm_phase(const u16* __restrict__ A, int lda, const u16* __restrict__ Bt, int K, int N, u16* outb, int ldo,
                   const float* r0, const float* r1, float* outf, char* lds, int bid, int nb) {
  const int tid = threadIdx.x, lane = tid & 63, wid = tid >> 6, wr = wid >> 2, wc = wid & 3, l15 = lane & 15, quad = lane >> 4;
  u16* As = (u16*)lds; u16* Bs = As + 2 * 256 * 64;
  const int nN = N >> 8, nM = M_TOT >> 8, nT = nM * nN, nk = K >> 6;
  const int lrow = tid >> 3, lch = tid & 7;
  const int sto = lrow * 64 + ((lch ^ ((lrow >> 1) & 7)) * 8);
  const int fsw = (l15 >> 1) & 7;
  const int fo0 = ((0 * 4 + quad) ^ fsw) * 8, fo1 = ((1 * 4 + quad) ^ fsw) * 8;
  const bool swz = (nb == 256);
  const int GN = (nN & 1) == 0 ? 2 : 1, GM = 32 / GN, nSN = nN / GN, nST = (nM / GM) * nSN;
  const int xcd = bid & 7, jb = bid >> 3;
  const int nIter = swz ? (nST - xcd + 7) / 8 : (nT - bid + nb - 1) / nb;
  for (int it = 0; it < nIter; ++it) {
    int tm, tn;
    if (swz) { const int st = xcd + 8 * it, sm = st / nSN, sn = st - sm * nSN; tm = sm * GM + jb / GN; tn = sn * GN + (jb % GN); }
    else { const int t = bid + it * nb; tm = t / nN; tn = t - tm * nN; }
    const u16* Ag = A + (size_t)(tm * 256 + lrow) * lda + lch * 8;
    const u16* Bg = Bt + (size_t)(tn * 256 + lrow) * K + lch * 8;
    f32x4 acc[8][4];
#pragma unroll
    for (int i = 0; i < 8; ++i)
#pragma unroll
      for (int j = 0; j < 4; ++j) acc[i][j] = (f32x4){0.f, 0.f, 0.f, 0.f};
    u32x4 ra[4], rb[4];
#define G_LOAD(KT) do { _Pragma("unroll") for (int i = 0; i < 4; ++i) { ra[i] = *(const u32x4*)(Ag + (size_t)i * 64 * lda + (KT) * 64); rb[i] = *(const u32x4*)(Bg + (size_t)i * 64 * K + (KT) * 64); } } while (0)
#define G_STORE(BUF) do { u16* ad = As + (BUF) * 256 * 64 + sto; u16* bd = Bs + (BUF) * 256 * 64 + sto; _Pragma("unroll") for (int i = 0; i < 4; ++i) { *(u32x4*)(ad + i * 64 * 64) = ra[i]; *(u32x4*)(bd + i * 64 * 64) = rb[i]; } } while (0)
#define G_MMA(BUF, FO) do { const u16* as = As + (BUF) * 256 * 64 + (wr * 128 + l15) * 64 + (FO); const u16* bs = Bs + (BUF) * 256 * 64 + (wc * 64 + l15) * 64 + (FO); \
        bf16x8 b_[4], a_[8]; \
        _Pragma("unroll") for (int j = 0; j < 4; ++j) b_[j] = *(const bf16x8*)(bs + j * 16 * 64); \
        _Pragma("unroll") for (int i = 0; i < 8; ++i) a_[i] = *(const bf16x8*)(as + i * 16 * 64); \
        __builtin_amdgcn_s_setprio(1); \
        _Pragma("unroll") for (int i = 0; i < 8; ++i) { _Pragma("unroll") for (int j = 0; j < 4; ++j) acc[i][j] = MFMA16(a_[i], b_[j], acc[i][j]); } \
        __builtin_amdgcn_s_setprio(0); } while (0)
    G_LOAD(0);
    G_STORE(0);
    __syncthreads();
    for (int kt = 0; kt < nk; ++kt) {
      const int cur = kt & 1;
      if (kt + 1 < nk) G_LOAD(kt + 1);
      G_MMA(cur, fo0);
      G_MMA(cur, fo1);
      if (kt + 1 < nk) G_STORE(cur ^ 1);
      __syncthreads();
    }
#undef G_LOAD
#undef G_STORE
#undef G_MMA
    const int mrow = tm * 256 + wr * 128 + quad * 4;
    if constexpr (EPI == EPI_BF16) {
      const int col = tn * 256 + wc * 64 + l15;
#pragma unroll
      for (int i = 0; i < 8; ++i)
#pragma unroll
        for (int r = 0; r < 4; ++r) {
          u16* o0 = outb + (size_t)(mrow + i * 16 + r) * ldo + col;
          o0[0] = f2bf(acc[i][0][r]); o0[16] = f2bf(acc[i][1][r]); o0[32] = f2bf(acc[i][2][r]); o0[48] = f2bf(acc[i][3][r]);
        }
    } else if constexpr (EPI == EPI_RESID) {
      const int col = tn * 256 + wc * 64 + l15;
      const float* rb_ = (tm * 256 < M_P) ? r0 : (r1 - (size_t)M_P * DM);
#pragma unroll
      for (int i = 0; i < 8; ++i)
#pragma unroll
        for (int r = 0; r < 4; ++r) {
          const size_t i0 = (size_t)(mrow + i * 16 + r) * DM + col;
          const float x0 = rb_[i0], x1 = rb_[i0 + 16], x2 = rb_[i0 + 32], x3 = rb_[i0 + 48];
          outf[i0] = x0 + acc[i][0][r]; outf[i0 + 16] = x1 + acc[i][1][r]; outf[i0 + 32] = x2 + acc[i][2][r]; outf[i0 + 48] = x3 + acc[i][3][r];
        }
    } else {
      const int col = (tn * 4 + wc) * 32 + l15;
#pragma unroll
      for (int i = 0; i < 8; ++i)
#pragma unroll
        for (int r = 0; r < 4; ++r) {
          const float g0 = acc[i][0][r], u0 = acc[i][2][r], g1 = acc[i][1][r], u1 = acc[i][3][r];
          u16* o0 = outb + (size_t)(mrow + i * 16 + r) * ldo + col;
          o0[0] = f2bf(g0 * sigmoidf_(g0) * u0); o0[16] = f2bf(g1 * sigmoidf_(g1) * u1);
        }
    }
  }
}

template <bool FINAL>
DI void rg_phase(const Params& p, char* lds, int bid, int nb) {
  const int tid = VT, lane = tid & 63, wid = tid >> 6, r32 = lane & 31, hi = lane >> 5;
  u16* xcb = (u16*)lds;
  float* A0 = (float*)(lds + 9216);
  float* U0 = (float*)(lds + 9216 + 16384);
  float* A1 = (float*)(lds + 9216 + 32768);
  float* U1 = (float*)(lds + 9216 + 49152);
  u16* raw = (u16*)A1;
  const u16* PROJ = (const u16*)(p.ws + OFF_PROJ);
  const u16* WG = (const u16*)(p.ws + WT_GATES);
  float* SUM = (float*)(p.ws + OFF_SUM);
  const float* CARRY = (const float*)(p.ws + OFF_CARRY);
  u16* Y = (u16*)(p.ws + OFF_Y);
  const int NIT = 768 * 8, nit = (NIT + nb - 1) / nb;
  const int mt = wid >> 1, nt = wid & 1;
  int cb_loaded = -1;
  float w0 = 0.f, w1 = 0.f, w2 = 0.f, w3 = 0.f, cbias = 0.f, bav[2] = {0.f, 0.f}, biv[2] = {0.f, 0.f}, spv[2] = {0.f, 0.f};
  u32x4 rr[3], rg[2], rrn[3], rgn[2];
  auto load_item = [&](int it, u32x4 (&xr)[3], u32x4 (&xg)[2]) {
    const int gc = it >> 3, cb = it & 7, m0 = gc * 64;
    int seq_lo, S; row_info(m0, seq_lo, S); const int seq_hi = seq_lo + S;
#pragma unroll
    for (int i = 0; i < 3; ++i) {
      const int c = tid + 256 * i, row = c >> 3, ch8 = c & 7, m = m0 - 2 + row;
      xr[i] = (c < 536 && m >= seq_lo && m < seq_hi) ? *(const u32x4*)(PROJ + (size_t)m * 2560 + cb * 64 + ch8 * 8) : (u32x4){0u, 0u, 0u, 0u};
    }
    if (FINAL) {
#pragma unroll
      for (int i = 0; i < 2; ++i) { const int c = tid + 256 * i, row = c >> 3, ch8 = c & 7; xg[i] = *(const u32x4*)(PROJ + (size_t)(m0 + row) * 2560 + 512 + cb * 64 + ch8 * 8); }
    }
  };
  { const int it = bid < NIT ? bid : NIT - 1; load_item(it, rr, rg); }
  for (int k = 0; k < nit; ++k) {
    const int it0 = bid + k * nb, it = it0 < NIT ? it0 : NIT - 1;
    const int gc = it >> 3, cb = it & 7, m0 = gc * 64;
    if (cb != cb_loaded) {
      cb_loaded = cb;
      const int cc = cb * 64 + (tid & 63);
      w0 = p.conv_w[cc]; w1 = p.conv_w[512 + cc]; w2 = p.conv_w[1024 + cc]; w3 = p.conv_w[1536 + cc]; cbias = p.conv_b[cc];
      const int cg_ = cb * 64 + nt * 32 + r32;
#pragma unroll
      for (int dir = 0; dir < 2; ++dir) { bav[dir] = p.b_a[dir * 512 + cg_]; biv[dir] = p.b_i[dir * 512 + cg_]; spv[dir] = log1pf(__expf(-p.lam[dir * 512 + cg_])); }
    }
    __syncthreads();
#pragma unroll
    for (int i = 0; i < 3; ++i) { const int c = tid + 256 * i; if (c < 536) *(u32x4*)(raw + c * 8) = rr[i]; }
    { const int itn0 = bid + (k + 1) * nb, itn = itn0 < NIT ? itn0 : NIT - 1; load_item(itn, rrn, rgn); }
    __syncthreads();
    {
      const int ch = tid & 63, t0 = (tid >> 6) * 16;
      float xm2 = bf2f(raw[(t0) * 64 + ch]), xm1 = bf2f(raw[(t0 + 1) * 64 + ch]), x0 = bf2f(raw[(t0 + 2) * 64 + ch]);
#pragma unroll
      for (int t = t0; t < t0 + 16; ++t) {
        const float xp1 = bf2f(raw[(t + 3) * 64 + ch]);
        xcb[t * 72 + ch] = f2bf(w0 * xm2 + w1 * xm1 + w2 * x0 + w3 * xp1 + cbias);
        xm2 = xm1; xm1 = x0; x0 = xp1;
      }
    }
    __syncthreads();
    {
      bf16x8 af[4];
#pragma unroll
      for (int ks = 0; ks < 4; ++ks) af[ks] = *(const bf16x8*)(xcb + (mt * 32 + r32) * 72 + ks * 16 + 8 * hi);
      const int ch = nt * 32 + r32;
      float xc[16];
#pragma unroll
      for (int reg = 0; reg < 16; ++reg) xc[reg] = bf2f(xcb[(mt * 32 + crow(reg, hi)) * 72 + ch]);
#pragma unroll
      for (int dir = 0; dir < 2; ++dir) {
        f32x16 aa = {}, ai = {};
        const u16* wga = WG + (size_t)((dir * 2 + 0) * 8 + cb) * 4096 + (nt * 32 + r32) * 64 + 8 * hi;
        const u16* wgi = WG + (size_t)((dir * 2 + 1) * 8 + cb) * 4096 + (nt * 32 + r32) * 64 + 8 * hi;
#pragma unroll
        for (int ks = 0; ks < 4; ++ks) { const bf16x8 ba = *(const bf16x8*)(wga + ks * 16), bi = *(const bf16x8*)(wgi + ks * 16); aa = MFMA32(af[ks], ba, aa); ai = MFMA32(af[ks], bi, ai); }
        float* Ab = dir == 0 ? A0 : A1; float* Ub = dir == 0 ? U0 : U1;
#pragma unroll
        for (int reg = 0; reg < 16; ++reg) {
          const int tok = mt * 32 + crow(reg, hi);
          const float r = sigmoidf_(aa[reg] + bav[dir]), gi = sigmoidf_(ai[reg] + biv[dir]);
          const float la2 = -8.f * 1.4426950408889634f * r * spv[dir], a = __builtin_amdgcn_exp2f(la2);
          const float mult = __builtin_amdgcn_sqrtf(fmaxf(0.f, 1.f - a * a));
          Ab[tok * 64 + ch] = a; Ub[tok * 64 + ch] = mult * gi * xc[reg];
        }
      }
    }
    __syncthreads();
    if (wid < 2) {
      const int dir = wid, ch = lane, c = cb * 64 + ch;
      float* Ab = dir == 0 ? A0 : A1; float* Ub = dir == 0 ? U0 : U1;
      if (!FINAL) {
        float h = 0.f, P = 1.f;
#pragma unroll 16
        for (int kk = 0; kk < 64; ++kk) { const int t = dir == 0 ? kk : 63 - kk; const float a = Ab[t * 64 + ch], u = Ub[t * 64 + ch]; h = a * h + u; P *= a; }
        SUM[(size_t)((gc * 2 + dir) * 2 + 0) * 512 + c] = P; SUM[(size_t)((gc * 2 + dir) * 2 + 1) * 512 + c] = h;
      } else {
        float h = CARRY[(size_t)(gc * 2 + dir) * 512 + c];
#pragma unroll 16
        for (int kk = 0; kk < 64; ++kk) { const int t = dir == 0 ? kk : 63 - kk; const float a = Ab[t * 64 + ch], u = Ub[t * 64 + ch]; h = a * h + u; Ub[t * 64 + ch] = h; }
      }
    }
    if (FINAL) {
      __syncthreads();
#pragma unroll
      for (int i = 0; i < 2; ++i) {
        const int c = tid + 256 * i, t = c >> 3, ch8 = c & 7;
        const f32x4 ha = *(const f32x4*)(U0 + t * 64 + ch8 * 8), hb = *(const f32x4*)(U0 + t * 64 + ch8 * 8 + 4);
        const f32x4 hc = *(const f32x4*)(U1 + t * 64 + ch8 * 8), hd = *(const f32x4*)(U1 + t * 64 + ch8 * 8 + 4);
        float hs[8] = {ha[0] + hc[0], ha[1] + hc[1], ha[2] + hc[2], ha[3] + hc[3], hb[0] + hd[0], hb[1] + hd[1], hb[2] + hd[2], hb[3] + hd[3]};
        float yv[8];
#pragma unroll
        for (int j = 0; j < 8; ++j) {
          const unsigned wv = rg[i][j >> 1];
          const float gt = __uint_as_float((j & 1) ? (wv & 0xffff0000u) : (wv << 16));
          const float ge = gt * sigmoidf_(1.5957691216057308f * (gt + 0.044715f * gt * gt * gt));
          yv[j] = ge * hs[j];
        }
        u32x4 o = {pk2(yv[0], yv[1]), pk2(yv[2], yv[3]), pk2(yv[4], yv[5]), pk2(yv[6], yv[7])};
        *(u32x4*)(Y + (size_t)(m0 + t) * 1024 + cb * 64 + ch8 * 8) = o;
      }
    }
#pragma unroll
    for (int i = 0; i < 3; ++i) rr[i] = rrn[i];
#pragma unroll
    for (int i = 0; i < 2; ++i) rg[i] = rgn[i];
  }
}

DI void rg_carry_phase(const Params& p, int bid, int nb) {
  const float* __restrict__ SUM = (const float*)(p.ws + OFF_SUM);
  float* __restrict__ CARRY = (float*)(p.ws + OFF_CARRY);
  for (int idx = bid * 256 + VT; idx < 8192; idx += nb * 256) {
    const int c = idx & 511, dir = (idx >> 9) & 1, seq = idx >> 10;
    const int gc0 = seq < 4 ? seq * 128 : 512 + (seq - 4) * 64, nch = seq < 4 ? 128 : 64;
    float carry = 0.f;
    for (int k0 = 0; k0 < nch; k0 += 8) {
      float P[8], Hh[8];
#pragma unroll
      for (int j = 0; j < 8; ++j) { const int k = k0 + j, gc = dir == 0 ? gc0 + k : gc0 + nch - 1 - k; P[j] = SUM[(size_t)((gc * 2 + dir) * 2 + 0) * 512 + c]; Hh[j] = SUM[(size_t)((gc * 2 + dir) * 2 + 1) * 512 + c]; }
#pragma unroll
      for (int j = 0; j < 8; ++j) { const int k = k0 + j, gc = dir == 0 ? gc0 + k : gc0 + nch - 1 - k; CARRY[(size_t)(gc * 2 + dir) * 512 + c] = carry; carry = P[j] * carry + Hh[j]; }
    }
  }
}

DI void dil_tile_info(int ti, int m0, int& d, int& u0) {
  if (ti < 5) { d = 16; u0 = m0 - 1024 + ti * 512; } else if (ti < 13) { d = 4; u0 = m0 - 256 + (ti - 5) * 128; } else { d = 1; u0 = m0 - 64 + (ti - 13) * 32; }
}
DI void dilated_phase(const Params& p, char* lds, int gw, int nw) {
  const int lane = VT & 63, wid = VT >> 6, r32 = lane & 31, hi = lane >> 5;
  u16* Vl = (u16*)(lds + wid * 10752);
  u16* Kl = Vl + 32 * 96;
  const unsigned vbase = (unsigned)(uintptr_t)Vl;
  const int li = lane & 15, tq = li >> 2, tp = li & 3, g1 = (lane >> 4) & 1;
  const unsigned trb = vbase + (4 * hi + tq) * 192 + (16 * g1 + 4 * tp) * 2;
  const u16* PROJ = (const u16*)(p.ws + OFF_PROJ);
  u16* Y = (u16*)(p.ws + OFF_Y);
  const int vrow = lane >> 3, vch = lane & 7;
  const int rb_ = gw >> 3, hf_ = (gw >> 2) & 1, w_ = gw & 3, rnb_ = nw >> 3;
  const bool remap = (rnb_ == 256);
  for (int itd = 0, id0 = gw; id0 < 12288; ++itd, id0 += nw) {
    int res, h, sp;
    if (remap) {
      const int xc = rb_ & 7, k = rb_ >> 3, G = itd * 256 + xc * 32 + 2 * (k >> 1) + (k & 1);
      const int hgrp = (G & 1) * 2 + hf_;
      res = hgrp + 4 * w_; h = (G >> 1) & 7; sp = G >> 4;
    } else { res = id0 & 15; h = (id0 >> 4) & 7; sp = id0 >> 7; }
    const int m0 = sp * 512 + res;
    int seq_lo, S; row_info(sp * 512, seq_lo, S); const int seq_hi = seq_lo + S;
    const int mq = m0 + 16 * r32;
    bf16x8 qf[4];
#pragma unroll
    for (int ks = 0; ks < 4; ++ks) qf[ks] = *(const bf16x8*)(PROJ + (size_t)mq * 2560 + 1024 + h * 64 + ks * 16 + 8 * hi);
    const float slope2 = exp2f(-(float)(h + 1)) * LOG2E;
    const float c1 = 0.125f * LOG2E;
    float m_run = -1e30f, l_run = 0.f; f32x16 o0 = {}, o1 = {};
    const u16* kbase = PROJ + 1536 + h * 64 + vch * 8;
    const u16* vbaseg = PROJ + 2048 + h * 64 + vch * 8;
    u32x4 kfA[4], kfB[4]; u32x4 vrA[4], vrB[4];
#define DIL_LOAD(KF, VR, TIV) do { int d_, u_; dil_tile_info((TIV), m0, d_, u_); \
      const int ur_ = min(max(u_ + d_ * r32, seq_lo), seq_hi - 1); \
      _Pragma("unroll") for (int i = 0; i < 4; ++i) { const int uv_ = min(max(u_ + d_ * (vrow + 8 * i), seq_lo), seq_hi - 1); VR[i] = *(const u32x4*)(vbaseg + (size_t)uv_ * 2560); KF[i] = *(const u32x4*)(kbase + (size_t)uv_ * 2560); } } while (0)
#define DIL_TILE(KF, VR, TIV) do { const int ti = (TIV); \
      int d, u0; dil_tile_info(ti, m0, d, u0); \
      _Pragma("unroll") \
      for (int i = 0; i < 4; ++i) { *(u32x4*)(Vl + (vrow + 8 * i) * 96 + vch * 8) = VR[i]; *(u32x4*)(Kl + (vrow + 8 * i) * 72 + vch * 8) = KF[i]; } \
      f32x16 pt = {}; \
      _Pragma("unroll") \
      for (int ks = 0; ks < 4; ++ks) pt = MFMA32(*(const bf16x8*)(Kl + r32 * 72 + ks * 16 + 8 * hi), qf[ks], pt); \
      if (ti + 2 < 33) DIL_LOAD(KF, VR, ti + 2);     \
      const s16x4 l00 = tr_read_o<0>(trb), h00 = tr_read_o<8 * 192>(trb), l01 = tr_read_o<64>(trb), h01 = tr_read_o<8 * 192 + 64>(trb); \
      const s16x4 l10 = tr_read_o<16 * 192>(trb), h10 = tr_read_o<24 * 192>(trb), l11 = tr_read_o<16 * 192 + 64>(trb), h11 = tr_read_o<24 * 192 + 64>(trb); \
      const float fd = (float)d, lim = 64.f * fd; \
      const float fdu0 = (float)(u0 - mq + d * 4 * hi); \
      const float lo_ = fmaxf((float)(seq_lo - mq), -lim), hi_ = fminf((float)(seq_hi - 1 - mq), lim); \
      const float mid = 0.5f * (lo_ + hi_), hw = 0.5f * (hi_ - lo_); \
      const float gdu0 = fdu0 - mid; \
      float pmax = -INFINITY; \
      _Pragma("unroll") \
      for (int reg = 0; reg < 16; ++reg) { \
        const float cf = (float)((reg & 3) + 8 * (reg >> 2)); \
        const float du = fmaf(fd, cf, fdu0), g = fmaf(fd, cf, gdu0); \
        const float tv = (__builtin_fabsf(g) <= hw) ? fmaf(__builtin_fabsf(du), -slope2, pt[reg] * c1) : -INFINITY; \
        pt[reg] = tv; pmax = max_nn(pmax, tv); \
      } \
      pmax = pl32_max(pmax); \
      if (__any(pmax > m_run)) { \
        const float mn = fmaxf(m_run, pmax), alpha = __builtin_amdgcn_exp2f(m_run - mn); \
        m_run = mn; l_run *= alpha; \
      _Pragma("unroll") \
        for (int reg = 0; reg < 16; ++reg) { o0[reg] *= alpha; o1[reg] *= alpha; } \
      } \
      float ps = 0.f; \
      _Pragma("unroll") \
      for (int reg = 0; reg < 16; ++reg) { pt[reg] = __builtin_amdgcn_exp2f(pt[reg] - m_run); ps += pt[reg]; } \
      ps = pl32_sum(ps); \
      l_run += ps; \
      const bf16x8 pb0 = pack8(pt, 0), pb1 = pack8(pt, 1); \
      LGKM0(); \
      o0 = MFMA32(cat4(l00, h00), pb0, o0); o0 = MFMA32(cat4(l10, h10), pb1, o0); \
      o1 = MFMA32(cat4(l01, h01), pb0, o1); o1 = MFMA32(cat4(l11, h11), pb1, o1); \
    } while (0)
    DIL_LOAD(kfA, vrA, 0);
    DIL_LOAD(kfB, vrB, 1);
#pragma unroll 1
    for (int tp2 = 0; tp2 < 32; tp2 += 2) { DIL_TILE(kfA, vrA, tp2); DIL_TILE(kfB, vrB, tp2 + 1); }
    DIL_TILE(kfA, vrA, 32);
#undef DIL_LOAD
#undef DIL_TILE
    const float inv = 1.f / l_run;
    u16* yo = Y + (size_t)mq * 1024 + 512 + h * 64 + 4 * hi;
#pragma unroll
    for (int g = 0; g < 4; ++g) {
      u32x2 w0 = {pk2(o0[4 * g] * inv, o0[4 * g + 1] * inv), pk2(o0[4 * g + 2] * inv, o0[4 * g + 3] * inv)};
      u32x2 w1 = {pk2(o1[4 * g] * inv, o1[4 * g + 1] * inv), pk2(o1[4 * g + 2] * inv, o1[4 * g + 3] * inv)};
      *(u32x2*)(yo + 8 * g) = w0; *(u32x2*)(yo + 32 + 8 * g) = w1;
    }
  }
}

DI void mla_norm_phase(const Params& p, int gw, int nw) {
  const int lane = threadIdx.x & 63;
  const u16* P2 = (const u16*)(p.ws + OFF_P2);
  u16* CQN = (u16*)(p.ws + OFF_CQN); u16* CKVN = (u16*)(p.ws + OFF_CKVN); u16* KR = (u16*)(p.ws + OFF_KR);
  const float* ct = (const float*)(p.ws + OFF_COS); const float* st = (const float*)(p.ws + OFF_SIN);
  float gq[6], gkv[4];
#pragma unroll
  for (int i = 0; i < 6; ++i) gq[i] = p.q_norm[6 * lane + i];
#pragma unroll
  for (int i = 0; i < 4; ++i) gkv[i] = p.kv_norm[4 * lane + i];
  for (int m = gw; m < M_TOT; m += nw) {
    const u16* src = P2 + (size_t)m * 768;
    const unsigned* s32 = (const unsigned*)src;
    const unsigned w0 = s32[3 * lane], w1 = s32[3 * lane + 1], w2 = s32[3 * lane + 2];
    const u32x2 wk = *(const u32x2*)(src + 384 + 4 * lane);
    float q[6] = {__uint_as_float(w0 << 16), __uint_as_float(w0 & 0xffff0000u), __uint_as_float(w1 << 16), __uint_as_float(w1 & 0xffff0000u), __uint_as_float(w2 << 16), __uint_as_float(w2 & 0xffff0000u)};
    float kv[4] = {__uint_as_float(wk[0] << 16), __uint_as_float(wk[0] & 0xffff0000u), __uint_as_float(wk[1] << 16), __uint_as_float(wk[1] & 0xffff0000u)};
    float sq = 0.f, skv = 0.f;
#pragma unroll
    for (int i = 0; i < 6; ++i) sq += q[i] * q[i];
#pragma unroll
    for (int i = 0; i < 4; ++i) skv += kv[i] * kv[i];
#pragma unroll
    for (int o = 32; o > 0; o >>= 1) { sq += __shfl_xor(sq, o); skv += __shfl_xor(skv, o); }
    const float rq = rsqrtf(sq * (1.f / 384.f) + 1e-6f), rkv = rsqrtf(skv * (1.f / 256.f) + 1e-6f);
    unsigned* dq = (unsigned*)(CQN + (size_t)m * 384) + 3 * lane;
    dq[0] = pk2(q[0] * rq * gq[0], q[1] * rq * gq[1]); dq[1] = pk2(q[2] * rq * gq[2], q[3] * rq * gq[3]); dq[2] = pk2(q[4] * rq * gq[4], q[5] * rq * gq[5]);
    u32x2 ok = {pk2(kv[0] * rkv * gkv[0], kv[1] * rkv * gkv[1]), pk2(kv[2] * rkv * gkv[2], kv[3] * rkv * gkv[3])};
    *(u32x2*)(CKVN + (size_t)m * 256 + 4 * lane) = ok;
    if (lane < 16) {
      const int pos = m < M_P ? (m & 8191) : ((m - M_P) & 4095);
      const float t1 = bf2f(src[640 + lane]), t2 = bf2f(src[656 + lane]);
      const float c = ct[pos * 16 + lane], s = st[pos * 16 + lane];
      KR[(size_t)m * 32 + lane] = f2bf(t1 * c - t2 * s); KR[(size_t)m * 32 + 16 + lane] = f2bf(t1 * s + t2 * c);
    }
  }
}

constexpr int KP = 104, VP = 96;
DI void mla_unit(const Params& p, char* lds, int seqbase, int S, int h, int qb) {
  const int tid = threadIdx.x, lane = tid & 63, wid = tid >> 6, r32 = lane & 31, hi = lane >> 5;
  u16* Kl = (u16*)lds;
  u16* Vl = (u16*)(lds + 3 * 64 * KP * 2);
  const unsigned vbase = (unsigned)(uintptr_t)Vl;
  const int li = lane & 15, tq = li >> 2, tp = li & 3, g1 = (lane >> 4) & 1;
  const unsigned trb = vbase + (4 * hi + tq) * (VP * 2) + (16 * g1 + 4 * tp) * 2;
  const u16* Q = (const u16*)(p.ws + OFF_Q); const u16* KV = (const u16*)(p.ws + OFF_KV); const u16* KR = (const u16*)(p.ws + OFF_KR);
  u16* O = (u16*)(p.ws + OFF_O);
  const float* ct = (const float*)(p.ws + OFF_COS); const float* st = (const float*)(p.ws + OFF_SIN);
  const int pos = qb * 256 + wid * 32 + r32, qrow = seqbase + pos;
  bf16x8 qf[6];
#pragma unroll
  for (int d0 = 0; d0 < 6; ++d0) qf[d0] = *(const bf16x8*)(Q + (size_t)qrow * 1536 + h * 96 + d0 * 16 + 8 * hi);
  const float C = 0.10206207261596577f * LOG2E;
#pragma unroll
  for (int j = 0; j < 8; ++j) {
    const float c = ct[pos * 16 + 8 * hi + j], s = st[pos * 16 + 8 * hi + j];
    const float t1 = bfs2f(qf[4][j]), t2 = bfs2f(qf[5][j]);
    qf[4][j] = (short)f2bf((t1 * c - t2 * s) * C); qf[5][j] = (short)f2bf((t1 * s + t2 * c) * C);
  }
#pragma unroll
  for (int d0 = 0; d0 < 4; ++d0)
#pragma unroll
    for (int j = 0; j < 8; ++j) qf[d0][j] = (short)f2bf(bfs2f(qf[d0][j]) * C);
  const int srow = tid >> 3, sc = tid & 7, rrow = (tid >> 2) & 63, rc = tid & 3;
  const bool kr_on = tid < 256;
  const u16* kvsrc = KV + (size_t)(seqbase + srow) * KVP + h * 128 + sc * 8;
  const u16* krsrc = KR + (size_t)(seqbase + rrow) * 32 + rc * 8;
  const int kdst0 = srow * KP + sc * 8, kdst2 = rrow * KP + 64 + rc * 8, vdst = srow * VP + sc * 8;
  float l_run = 0.f; f32x16 o0 = {}, o1 = {}, negm = {};
  const int nkt = S >> 6;
  u32x4 rkn, rkr, rvv;
#define MLA_GLOAD(T) do { rkn = *(const u32x4*)(kvsrc + (size_t)(T) * 64 * KVP); rvv = *(const u32x4*)(kvsrc + (size_t)(T) * 64 * KVP + 64); \
    if (kr_on) rkr = *(const u32x4*)(krsrc + (size_t)(T) * 64 * 32); } while (0)
#define MLA_LSTORE(B) do { u16* kd = Kl + (B) * 64 * KP; u16* vd = Vl + (B) * 64 * VP; *(u32x4*)(kd + kdst0) = rkn; *(u32x4*)(vd + vdst) = rvv; \
    if (kr_on) *(u32x4*)(kd + kdst2) = rkr; } while (0)
  MLA_GLOAD(0); MLA_LSTORE(0);
  MLA_GLOAD(1); MLA_LSTORE(1);
  __syncthreads();
  int cur = 0, nx2 = 2;
#pragma unroll 1
  for (int kt = 0; kt < nkt; ++kt) {
    if (kt + 2 < nkt) MLA_GLOAD(kt + 2);
    const u16* kl = Kl + cur * 64 * KP + r32 * KP + 8 * hi;
    f32x16 p0, p1;
    { const bf16x8 k0 = *(const bf16x8*)(kl), k1 = *(const bf16x8*)(kl + 32 * KP);
      p0 = MFMA32(k0, qf[0], negm); p1 = MFMA32(k1, qf[0], negm); }
#pragma unroll
    for (int d0 = 1; d0 < 6; ++d0) {
      const bf16x8 k0 = *(const bf16x8*)(kl + d0 * 16), k1 = *(const bf16x8*)(kl + 32 * KP + d0 * 16);
      p0 = MFMA32(k0, qf[d0], p0); p1 = MFMA32(k1, qf[d0], p1);
    }
    const unsigned tb = trb + cur * (64 * VP * 2);
    constexpr int R8 = 8 * VP * 2;
    const s16x4 a0 = tr_read_o<0>(tb), b0 = tr_read_o<R8>(tb), a1 = tr_read_o<2 * R8>(tb), b1 = tr_read_o<3 * R8>(tb);
    const s16x4 a2 = tr_read_o<4 * R8>(tb), b2 = tr_read_o<5 * R8>(tb), a3 = tr_read_o<6 * R8>(tb), b3 = tr_read_o<7 * R8>(tb);
    const s16x4 c0 = tr_read_o<64>(tb), d0_ = tr_read_o<R8 + 64>(tb), c1 = tr_read_o<2 * R8 + 64>(tb), d1 = tr_read_o<3 * R8 + 64>(tb);
    const s16x4 c2 = tr_read_o<4 * R8 + 64>(tb), d2 = tr_read_o<5 * R8 + 64>(tb), c3 = tr_read_o<6 * R8 + 64>(tb), d3 = tr_read_o<7 * R8 + 64>(tb);
    float pmax = max_nn(p0[0], p1[0]);
#pragma unroll
    for (int r = 1; r < 16; ++r) pmax = max_nn(pmax, max_nn(p0[r], p1[r]));
    pmax = pl32_max(pmax);
    if (kt == 0 || __any(pmax > 8.f)) {
      const float delta = kt == 0 ? pmax : fmaxf(pmax, 0.f);
      const float alpha = kt == 0 ? 1.f : __builtin_amdgcn_exp2f(-delta);
#pragma unroll
      for (int r = 0; r < 16; ++r) { negm[r] -= delta; p0[r] -= delta; p1[r] -= delta; o0[r] *= alpha; o1[r] *= alpha; }
      l_run *= alpha;
    }
    float ps = 0.f;
#pragma unroll
    for (int r = 0; r < 16; ++r) { p0[r] = __builtin_amdgcn_exp2f(p0[r]); p1[r] = __builtin_amdgcn_exp2f(p1[r]); ps += p0[r] + p1[r]; }
    ps = pl32_sum(ps);
    l_run += ps;
    const bf16x8 pb0 = pack8(p0, 0), pb1 = pack8(p0, 1), pb2 = pack8(p1, 0), pb3 = pack8(p1, 1);
    LGKM0();
    o0 = MFMA32(cat4(a0, b0), pb0, o0); o1 = MFMA32(cat4(c0, d0_), pb0, o1);
    o0 = MFMA32(cat4(a1, b1), pb1, o0); o1 = MFMA32(cat4(c1, d1), pb1, o1);
    o0 = MFMA32(cat4(a2, b2), pb2, o0); o1 = MFMA32(cat4(c2, d2), pb2, o1);
    o0 = MFMA32(cat4(a3, b3), pb3, o0); o1 = MFMA32(cat4(c3, d3), pb3, o1);
    __syncthreads();
    if (kt + 2 < nkt) MLA_LSTORE(nx2);
    cur = cur == 2 ? 0 : cur + 1; nx2 = nx2 == 2 ? 0 : nx2 + 1;
  }
  __syncthreads();
#undef MLA_GLOAD
#undef MLA_LSTORE
  const float inv = 1.f / l_run;
  u16* oo = O + (size_t)qrow * 1024 + h * 64 + 4 * hi;
#pragma unroll
  for (int g = 0; g < 4; ++g) {
    u32x2 w0 = {pk2(o0[4 * g] * inv, o0[4 * g + 1] * inv), pk2(o0[4 * g + 2] * inv, o0[4 * g + 3] * inv)};
    u32x2 w1 = {pk2(o1[4 * g] * inv, o1[4 * g + 1] * inv), pk2(o1[4 * g + 2] * inv, o1[4 * g + 3] * inv)};
    *(u32x2*)(oo + 8 * g) = w0; *(u32x2*)(oo + 32 + 8 * g) = w1;
  }
}

DI void mla_attn_phase(const Params& p, char* lds, int xcd, int j, int nper) {
  for (int lu0 = j; lu0 - j < 8 * 32; lu0 += nper) { const int lu = lu0 < 8 * 32 ? lu0 : 8 * 32 - 1; const int bh = (lu >> 5) * 8 + xcd, qb = lu & 31; mla_unit(p, lds, (bh >> 4) * 8192, 8192, bh & 15, qb); }
  for (int lu0 = j; lu0 - j < 8 * 16; lu0 += nper) { const int lu = lu0 < 8 * 16 ? lu0 : 8 * 16 - 1; const int bh = (lu >> 4) * 8 + xcd, qb = lu & 15; mla_unit(p, lds, M_P + (bh >> 4) * 4096, 4096, bh & 15, qb); }
}

#define XB_TMO      128
#define XB_XCNT(j)  (256  + 64 * (j))
#define XB_XSUB(j)  (1280 + 64 * (j))
#define XB_XGEN(j)  (2304 + 64 * (j))
#define XB_TOP      3328
#define XB_TOPGEN   3392
#define XCD_BAR_WORDS 3456
#define XB_SPIN_CAP (1u << 20)
#define LAS __attribute__((address_space(3)))
DI unsigned xb_ld(unsigned* p) { return __hip_atomic_load(p, __ATOMIC_RELAXED, __HIP_MEMORY_SCOPE_AGENT); }
DI unsigned xb_add(unsigned* p, unsigned v) { return __hip_atomic_fetch_add(p, v, __ATOMIC_RELAXED, __HIP_MEMORY_SCOPE_AGENT); }
DI unsigned xb_xcc_id() { return (unsigned)__builtin_amdgcn_s_getreg((3 << 11) | 20) & 0xFu; }
#define XB_SPIN(cond, bar) do { unsigned _sp = 0; while (cond) { __builtin_amdgcn_s_sleep(1); \
    if ((++_sp & 255u) == 0u) { if (xb_ld(&(bar)[XB_TMO])) break; if (_sp > XB_SPIN_CAP) { atomicAdd(&(bar)[XB_TMO], 1u); break; } } } } while (0)
struct XcdBarrier { unsigned* bar; unsigned x; volatile LAS unsigned* st; };
DI XcdBarrier xcd_barrier_post(unsigned* bar, volatile LAS unsigned* st) {
  XcdBarrier b; b.bar = bar; b.x = xb_xcc_id(); b.st = st;
  if (threadIdx.x == 0) (void)xb_add(&bar[XB_XCNT(b.x)], 1u);
  return b;
}
DI void xcd_barrier_complete(unsigned* bar, unsigned x, unsigned& nloc, unsigned& nx) {
  const unsigned G = gridDim.x * gridDim.y * gridDim.z;
  unsigned sum, cnt, mine, sp = 0u;
  for (;;) {
    sum = 0u; cnt = 0u; mine = 0u;
#pragma unroll
    for (unsigned j = 0; j < 16; ++j) { const unsigned c = xb_ld(&bar[XB_XCNT(j)]); sum += c; cnt += (c > 0u) ? 1u : 0u; mine = (j == x) ? c : mine; }
    if (sum == G) break;
    __builtin_amdgcn_s_sleep(1);
    if ((++sp & 255u) == 0u) { if (xb_ld(&bar[XB_TMO])) break; if (sp > XB_SPIN_CAP) { atomicAdd(&bar[XB_TMO], 1u); break; } }
  }
  nloc = mine > 0u ? mine : 1u; nx = cnt > 0u ? cnt : 1u;
}
DI void xcd_barrier(const XcdBarrier& b) {
  asm volatile("s_waitcnt vmcnt(0)" ::: "memory");
  __syncthreads();
  if (threadIdx.x == 0) {
    unsigned* bar = b.bar;
    __builtin_amdgcn_s_waitcnt(0);
    unsigned nloc = b.st[0], nx = b.st[1];
    if (nloc == 0u) { xcd_barrier_complete(bar, b.x, nloc, nx); b.st[0] = nloc; b.st[1] = nx; }
    const unsigned old = xb_add(&bar[XB_XSUB(b.x)], 1u);
    const unsigned gen = old / nloc;
    if (old + 1u == (gen + 1u) * nloc) {
      __builtin_amdgcn_fence(__ATOMIC_RELEASE, "agent");
      asm volatile("s_waitcnt vmcnt(0)" ::: "memory");
      const unsigned og = xb_add(&bar[XB_TOP], 1u);
      const unsigned tg = og / nx;
      if (og + 1u == (tg + 1u) * nx) xb_add(&bar[XB_TOPGEN], 1u);
      else XB_SPIN(xb_ld(&bar[XB_TOPGEN]) == tg, bar);
      __builtin_amdgcn_fence(__ATOMIC_ACQUIRE, "agent");
      xb_add(&bar[XB_XGEN(b.x)], 1u);
      asm volatile("s_waitcnt vmcnt(0)" ::: "memory");
    } else {
      XB_SPIN(xb_ld(&bar[XB_XGEN(b.x)]) == gen, bar);
      __builtin_amdgcn_fence(__ATOMIC_ACQUIRE, "agent");
      asm volatile("s_waitcnt vmcnt(0)" ::: "memory");
    }
  }
  __syncthreads();
}

constexpr int N_PHASES = 19;
constexpr int HALF_LDS = 76800;
constexpr int LDS_BYTES = 2 * HALF_LDS;
__global__ void __launch_bounds__(512, 2) mega(Params p, int ph_lo, int ph_hi) {
  __shared__ __attribute__((aligned(16))) char lds_all[LDS_BYTES];
  const int rbid = blockIdx.x, rnb = gridDim.x;
  const int half = __builtin_amdgcn_readfirstlane((int)(threadIdx.x >> 8));
  const int bid = rbid * 2 + half, nb = rnb * 2;
  char* lds = lds_all + half * HALF_LDS;
  const int gw = bid * 4 + __builtin_amdgcn_readfirstlane(VT >> 6), nw = nb * 4;
  char* ws = p.ws;
  float* out1 = p.out + (size_t)M_P * DM;
  __shared__ uint4 xb_words;
  if (threadIdx.x == 0) xb_words = make_uint4(0u, 0u, 0u, 0u);
  __syncthreads();
  XcdBarrier xb; xb.bar = (unsigned*)(ws + OFF_BAR); xb.x = 0; xb.st = (volatile LAS unsigned*)&xb_words;
  if (ph_hi - ph_lo > 1) xb = xcd_barrier_post((unsigned*)(ws + OFF_BAR), (volatile LAS unsigned*)&xb_words);
  if (ph_lo < 0) cg::this_grid().sync();
#ifndef DUP_MASK
#define DUP_MASK 0
#endif
#define PHASE(k, ...) do { if (ph_lo <= (k) && (k) < ph_hi) { __VA_ARGS__ if ((DUP_MASK >> (k)) & 1) { xcd_barrier(xb); __VA_ARGS__ } } if (ph_lo <= (k) && (k) + 1 < ph_hi) xcd_barrier(xb); } while (0)
  PHASE(0, prep_phase(p, lds, bid, nb););
  PHASE(1, gemm_phase<EPI_BF16>((const u16*)(ws + OFF_H), 1024, (const u16*)(ws + WT_ABIN), 1024, 2560, (u16*)(ws + OFF_PROJ), 2560, nullptr, nullptr, nullptr, lds_all, rbid, rnb););
  PHASE(2, rg_phase<false>(p, lds, bid, nb); __syncthreads(); dilated_phase(p, lds, gw, nw););
  PHASE(3, rg_carry_phase(p, bid, nb););
  PHASE(4, rg_phase<true>(p, lds, bid, nb););
  PHASE(5, gemm_phase<EPI_RESID>((const u16*)(ws + OFF_Y), 1024, (const u16*)(ws + WT_ABOUT), 1024, 1024, nullptr, 0, p.xin0, p.xin1, p.out, lds_all, rbid, rnb););
  PHASE(6, rmsnorm_phase(p.out, out1, p.norm_ffn, (u16*)(ws + OFF_H), nullptr, gw, nw););
  PHASE(7, gemm_phase<EPI_SWIGLU>((const u16*)(ws + OFF_H), 1024, (const u16*)(ws + WT_GU0), 1024, 5632, (u16*)(ws + OFF_ACT), FH, nullptr, nullptr, nullptr, lds_all, rbid, rnb););
  PHASE(8, gemm_phase<EPI_RESID>((const u16*)(ws + OFF_ACT), FH, (const u16*)(ws + WT_DOWN0), FH, 1024, nullptr, 0, p.out, out1, p.out, lds_all, rbid, rnb););
  PHASE(9, rmsnorm_phase(p.out, out1, p.norm_mix + 1024, (u16*)(ws + OFF_H), nullptr, gw, nw););
  PHASE(10, gemm_phase<EPI_BF16>((const u16*)(ws + OFF_H), 1024, (const u16*)(ws + WT_MLAIN), 1024, 768, (u16*)(ws + OFF_P2), 768, nullptr, nullptr, nullptr, lds_all, rbid, rnb););
  PHASE(11, mla_norm_phase(p, gw, nw););
  PHASE(12, gemm_phase<EPI_BF16>((const u16*)(ws + OFF_CQN), 384, (const u16*)(ws + WT_QB), 384, 1536, (u16*)(ws + OFF_Q), 1536, nullptr, nullptr, nullptr, lds_all, rbid, rnb); gemm_phase<EPI_BF16>((const u16*)(ws + OFF_CKVN), 256, (const u16*)(ws + WT_KVB), 256, 2048, (u16*)(ws + OFF_KV), KVP, nullptr, nullptr, nullptr, lds_all, rbid, rnb););
  PHASE(13, mla_attn_phase(p, lds_all, rbid & 7, rbid >> 3, rnb >> 3););
  PHASE(14, gemm_phase<EPI_RESID>((const u16*)(ws + OFF_O), 1024, (const u16*)(ws + WT_MLAOUT), 1024, 1024, nullptr, 0, p.out, out1, p.out, lds_all, rbid, rnb););
  PHASE(15, rmsnorm_phase(p.out, out1, p.norm_ffn + 1024, (u16*)(ws + OFF_H), nullptr, gw, nw););
  PHASE(16, gemm_phase<EPI_SWIGLU>((const u16*)(ws + OFF_H), 1024, (const u16*)(ws + WT_GU1), 1024, 5632, (u16*)(ws + OFF_ACT), FH, nullptr, nullptr, nullptr, lds_all, rbid, rnb););
  PHASE(17, gemm_phase<EPI_RESID>((const u16*)(ws + OFF_ACT), FH, (const u16*)(ws + WT_DOWN1), FH, 1024, nullptr, 0, p.out, out1, p.out, lds_all, rbid, rnb););
  PHASE(18, rmsnorm_phase(p.out, out1, p.norm_final, nullptr, p.out, gw, nw););
#undef PHASE
}

extern "C" void kernel_launch(void* const* d_in, const int* in_sizes, int n_in, void* d_out, int out_size, void* d_ws, size_t ws_size, hipStream_t stream) {
  static int grid_blocks = 0;
  if (!grid_blocks) {
    int dev = 0, cus = 0, per_cu = 0;
    hipGetDevice(&dev);
    hipDeviceGetAttribute(&cus, hipDeviceAttributeMultiprocessorCount, dev);
    hipOccupancyMaxActiveBlocksPerMultiprocessor(&per_cu, mega, 512, 0);
    if (per_cu > 1) per_cu = 1;
    if (per_cu < 1) per_cu = 1;
    grid_blocks = cus * per_cu;
  }
  if (n_in != 23 || ws_size < WS_NEED) { fprintf(stderr, "kernel_launch: bad inputs n_in=%d ws=%zu\n", n_in, ws_size); return; }
  Params p{};
  p.xin0 = (const float*)d_in[0]; p.xin1 = (const float*)d_in[1];
  p.norm_mix = (const float*)d_in[2]; p.norm_ffn = (const float*)d_in[3]; p.norm_final = (const float*)d_in[4];
  p.ab_w_in = (const float*)d_in[5]; p.conv_w = (const float*)d_in[6]; p.conv_b = (const float*)d_in[7];
  p.w_a = (const float*)d_in[8]; p.b_a = (const float*)d_in[9]; p.w_i = (const float*)d_in[10]; p.b_i = (const float*)d_in[11];
  p.lam = (const float*)d_in[12]; p.ab_w_out = (const float*)d_in[13];
  p.mla_w_in = (const float*)d_in[14]; p.q_norm = (const float*)d_in[15]; p.w_qb = (const float*)d_in[16]; p.kv_norm = (const float*)d_in[17];
  p.w_kvb = (const float*)d_in[18]; p.mla_w_out = (const float*)d_in[19];
  p.w_gate = (const float*)d_in[20]; p.w_up = (const float*)d_in[21]; p.w_down = (const float*)d_in[22];
  p.out = (float*)d_out; p.ws = (char*)d_ws;
#if SINGLE_LAUNCH
  hipMemsetAsync((char*)d_ws + OFF_BAR, 0, XCD_BAR_WORDS * 4, stream);
  int lo = 0, hi = N_PHASES;
  void* args[] = {&p, &lo, &hi};
  hipError_t e = hipLaunchCooperativeKernel((void*)mega, dim3(grid_blocks), dim3(512), args, 0, stream);
  if (e != hipSuccess) fprintf(stderr, "cooperative launch failed: %s (grid %d)\n", hipGetErrorString(e), grid_blocks);
#else
  for (int ph = 0; ph < N_PHASES; ++ph) hipLaunchKernelGGL(mega, dim3(grid_blocks), dim3(512), 0, stream, p, ph, ph + 1);
#endif
}
```

```cpp
#include <hip/hip_runtime.h>
#include <hip/hip_cooperative_groups.h>
#include <cstdint>
#include <cstdio>
namespace cg = cooperative_groups;

#ifndef SINGLE_LAUNCH
#define SINGLE_LAUNCH 1
#endif

typedef unsigned short u16;
typedef short bf16x8 __attribute__((ext_vector_type(8)));
typedef short s16x4 __attribute__((ext_vector_type(4)));
typedef float f32x16 __attribute__((ext_vector_type(16)));
typedef float f32x4 __attribute__((ext_vector_type(4)));
typedef float f32x2 __attribute__((ext_vector_type(2)));
typedef unsigned u32x4 __attribute__((ext_vector_type(4)));
typedef unsigned u32x2 __attribute__((ext_vector_type(2)));
typedef __bf16 bf2_t __attribute__((ext_vector_type(2)));
#define DI __device__ __forceinline__
#define VT ((int)(threadIdx.x & 255))
#define MFMA32(a, b, c) __builtin_amdgcn_mfma_f32_32x32x16_bf16((a), (b), (c), 0, 0, 0)

constexpr int M_TOT = 49152, M_P = 32768, DM = 1024, FH = 2816;
constexpr float LOG2E = 1.4426950408889634f;
constexpr size_t MiB = 1ull << 20;
constexpr size_t WT_ABIN = 0;
constexpr size_t WT_ABOUT = WT_ABIN + 2560ull * 1024 * 2;
constexpr size_t WT_GU0 = WT_ABOUT + 1024ull * 1024 * 2;
constexpr size_t WT_DOWN0 = WT_GU0 + 5632ull * 1024 * 2;
constexpr size_t WT_MLAIN = WT_DOWN0 + 1024ull * 2816 * 2;
constexpr size_t WT_QB = WT_MLAIN + 768ull * 1024 * 2;
constexpr size_t WT_KVB = WT_QB + 1536ull * 384 * 2;
constexpr size_t WT_MLAOUT = WT_KVB + 2048ull * 256 * 2;
constexpr size_t WT_GU1 = WT_MLAOUT + 1024ull * 1024 * 2;
constexpr size_t WT_DOWN1 = WT_GU1 + 5632ull * 1024 * 2;
constexpr size_t WT_GATES = WT_DOWN1 + 1024ull * 2816 * 2;
constexpr size_t WT_END = WT_GATES + 32ull * 4096 * 2;
static_assert(WT_END <= 46 * MiB, "weights region");
constexpr size_t OFF_SUM = 46 * MiB;
constexpr size_t OFF_KR = 46 * MiB;
constexpr size_t OFF_COS = 52 * MiB;
constexpr size_t OFF_SIN = 52 * MiB + 512 * 1024;
constexpr size_t OFF_H = 54 * MiB;
constexpr size_t OFF_CQN = 54 * MiB;
constexpr size_t OFF_CKVN = 90 * MiB;
constexpr size_t OFF_O = 54 * MiB;
constexpr size_t OFF_PROJ = 150 * MiB;
constexpr size_t OFF_ACT = 150 * MiB;
constexpr size_t OFF_P2 = 150 * MiB;
constexpr size_t OFF_Q = 150 * MiB;
constexpr size_t OFF_KV = 294 * MiB;
constexpr size_t OFF_Y = 390 * MiB;
constexpr size_t OFF_CARRY = 486 * MiB;
constexpr size_t OFF_BAR = 53 * MiB;
constexpr size_t WS_NEED = 496 * MiB;
constexpr int KVP = 2112;

struct Params {
  const float* xin0; const float* xin1;
  const float* norm_mix; const float* norm_ffn; const float* norm_final;
  const float* ab_w_in; const float* conv_w; const float* conv_b;
  const float* w_a; const float* b_a; const float* w_i; const float* b_i; const float* lam; const float* ab_w_out;
  const float* mla_w_in; const float* q_norm; const float* w_qb; const float* kv_norm; const float* w_kvb; const float* mla_w_out;
  const float* w_gate; const float* w_up; const float* w_down;
  float* out; char* ws;
};

DI float bf2f(u16 v) { return __uint_as_float(((unsigned)v) << 16); }
DI float bfs2f(short v) { return __uint_as_float(((unsigned)(u16)v) << 16); }
DI unsigned pk2(float lo, float hi) { f32x2 v = {lo, hi}; bf2_t r = __builtin_convertvector(v, bf2_t); return __builtin_bit_cast(unsigned, r); }
DI u16 f2bf(float a) { return (u16)(pk2(a, 0.f) & 0xffffu); }
DI int crow(int r, int hi) { return (r & 3) + 8 * (r >> 2) + 4 * hi; }
DI float sigmoidf_(float x) { return __builtin_amdgcn_rcpf(1.f + __builtin_amdgcn_exp2f(-1.4426950408889634f * x)); }
DI float pl32_max(float v) { auto rr = __builtin_amdgcn_permlane32_swap(__float_as_uint(v), __float_as_uint(v), false, false); return fmaxf(__uint_as_float(rr[0]), __uint_as_float(rr[1])); }
DI float pl32_sum(float v) { auto rr = __builtin_amdgcn_permlane32_swap(__float_as_uint(v), __float_as_uint(v), false, false); return __uint_as_float(rr[0]) + __uint_as_float(rr[1]); }
DI s16x4 tr_read(unsigned addr) { s16x4 r; asm volatile("ds_read_b64_tr_b16 %0, %1" : "=&v"(r) : "v"(addr) : "memory"); return r; }
template <int OFF> DI s16x4 tr_read_o(unsigned addr) { s16x4 r; asm volatile("ds_read_b64_tr_b16 %0, %1 offset:%2" : "=&v"(r) : "v"(addr), "i"(OFF) : "memory"); return r; }
DI float max_nn(float a, float b) { return __builtin_amdgcn_fmed3f(a, b, __builtin_inff()); }
#define LGKM0() do { asm volatile("s_waitcnt lgkmcnt(0)" ::: "memory"); __builtin_amdgcn_sched_barrier(0); } while (0)
DI bf16x8 cat4(s16x4 l, s16x4 h) { return (bf16x8){l[0], l[1], l[2], l[3], h[0], h[1], h[2], h[3]}; }
DI bf16x8 pack8(const f32x16& x, int s) {
  u32x4 w = {pk2(x[8 * s + 0], x[8 * s + 1]), pk2(x[8 * s + 2], x[8 * s + 3]), pk2(x[8 * s + 4], x[8 * s + 5]), pk2(x[8 * s + 6], x[8 * s + 7])};
  return __builtin_bit_cast(bf16x8, w);
}
DI void row_info(int m, int& seq_lo, int& S) { if (m < M_P) { seq_lo = m & ~8191; S = 8192; } else { seq_lo = M_P + ((m - M_P) & ~4095); S = 4096; } }

DI void tr_job(const float* __restrict__ src, int K, int N, u16* __restrict__ dst, int mode, float* tile, int bid, int nb, int& rot) {
  const int tk = K >> 6, tn = (N + 63) >> 6, nt = tk * tn;
  const int tx = VT & 63, ty = VT >> 6;
  const int t0 = (bid + nb - rot) % nb, nit = (nt + nb - 1) / nb;
  (void)tx; (void)ty;
  for (int i = 0; i < nit; ++i) {
    const int t = t0 + i * nb; const bool act = t < nt;
    const int k0 = (t / tn) << 6, n0 = (t % tn) << 6;
    __syncthreads();
    if (act) {
#pragma unroll
      for (int r = 0; r < 4; ++r) {
        const int idx = VT + 256 * r, kk = idx >> 4, c4 = idx & 15, n = n0 + c4 * 4;
        const f32x4 v = n < N ? *(const f32x4*)(src + (size_t)(k0 + kk) * N + n) : (f32x4){0.f, 0.f, 0.f, 0.f};
        float* tp = tile + kk * 65 + c4 * 4;
        tp[0] = v[0]; tp[1] = v[1]; tp[2] = v[2]; tp[3] = v[3];
      }
    }
    __syncthreads();
    if (act) {
#pragma unroll
      for (int r = 0; r < 2; ++r) {
        const int idx = VT + 256 * r, nn = idx >> 3, kc = idx & 7, n = n0 + nn;
        if (n < N) {
          const int row = mode == 0 ? n : ((n >> 5) * 64 + (n & 31) + (mode == 2 ? 32 : 0));
          const float* tp = tile + (kc * 8) * 65 + nn;
          u32x4 w = {pk2(tp[0], tp[65]), pk2(tp[2 * 65], tp[3 * 65]), pk2(tp[4 * 65], tp[5 * 65]), pk2(tp[6 * 65], tp[7 * 65])};
          *(u32x4*)(dst + (size_t)row * K + k0 + kc * 8) = w;
        }
      }
    }
  }
  rot = (rot + nt) % nb;
}

DI void rmsnorm_phase(const float* __restrict__ s0, const float* __restrict__ s1, const float* __restrict__ g, u16* outb, float* outf, int gw, int nw) {
  const int lane = threadIdx.x & 63;
  for (int m = gw; m < M_TOT; m += nw) {
    const float* src = m < M_P ? s0 + (size_t)m * DM : s1 + (size_t)(m - M_P) * DM;
    f32x4 v[4];
#pragma unroll
    for (int i = 0; i < 4; ++i) v[i] = *(const f32x4*)(src + i * 256 + lane * 4);
    float ss = 0.f;
#pragma unroll
    for (int i = 0; i < 4; ++i) ss += v[i][0] * v[i][0] + v[i][1] * v[i][1] + v[i][2] * v[i][2] + v[i][3] * v[i][3];
#pragma unroll
    for (int o = 32; o > 0; o >>= 1) ss += __shfl_xor(ss, o);
    const float rs = rsqrtf(ss * (1.f / 1024.f) + 1e-6f);
#pragma unroll
    for (int i = 0; i < 4; ++i) {
      const f32x4 gg = *(const f32x4*)(g + i * 256 + lane * 4);
      const f32x4 y = v[i] * rs * gg;
      if (outb) { u32x2 w = {pk2(y[0], y[1]), pk2(y[2], y[3])}; *(u32x2*)(outb + (size_t)m * DM + i * 256 + lane * 4) = w; }
      else *(f32x4*)(outf + (size_t)m * DM + i * 256 + lane * 4) = y;
    }
  }
}

DI void prep_phase(const Params& p, char* lds, int bid, int nb) {
  float* tile = (float*)lds;
  char* ws = p.ws;
  int rot = 0;
  tr_job(p.ab_w_in, 1024, 2560, (u16*)(ws + WT_ABIN), 0, tile, bid, nb, rot);
  tr_job(p.ab_w_out, 1024, 1024, (u16*)(ws + WT_ABOUT), 0, tile, bid, nb, rot);
  tr_job(p.w_gate, 1024, FH, (u16*)(ws + WT_GU0), 1, tile, bid, nb, rot);
  tr_job(p.w_up, 1024, FH, (u16*)(ws + WT_GU0), 2, tile, bid, nb, rot);
  tr_job(p.w_gate + (size_t)1024 * FH, 1024, FH, (u16*)(ws + WT_GU1), 1, tile, bid, nb, rot);
  tr_job(p.w_up + (size_t)1024 * FH, 1024, FH, (u16*)(ws + WT_GU1), 2, tile, bid, nb, rot);
  tr_job(p.w_down, FH, 1024, (u16*)(ws + WT_DOWN0), 0, tile, bid, nb, rot);
  tr_job(p.w_down + (size_t)FH * 1024, FH, 1024, (u16*)(ws + WT_DOWN1), 0, tile, bid, nb, rot);
  tr_job(p.mla_w_in, 1024, 672, (u16*)(ws + WT_MLAIN), 0, tile, bid, nb, rot);
  tr_job(p.w_qb, 384, 1536, (u16*)(ws + WT_QB), 0, tile, bid, nb, rot);
  tr_job(p.w_kvb, 256, 2048, (u16*)(ws + WT_KVB), 0, tile, bid, nb, rot);
  tr_job(p.mla_w_out, 1024, 1024, (u16*)(ws + WT_MLAOUT), 0, tile, bid, nb, rot);
  for (int dg = 0; dg < 32; ++dg) {
    const int cb = dg & 7, gate = (dg >> 3) & 1, dir = dg >> 4;
    const float* src = (gate == 0 ? p.w_a : p.w_i) + (size_t)(dir * 8 + cb) * 4096;
    tr_job(src, 64, 64, (u16*)(ws + WT_GATES) + (size_t)dg * 4096, 0, tile, bid, nb, rot);
  }
  const int gtid = bid * 256 + VT, gn = nb * 256;
  { u16* d = (u16*)(ws + WT_MLAIN) + (size_t)672 * 1024; for (int i = gtid; i < 96 * 1024; i += gn) d[i] = 0; }
  { float* ct = (float*)(ws + OFF_COS); float* st = (float*)(ws + OFF_SIN);
    for (int i = gtid; i < 8192 * 16; i += gn) {
      const int pos = i >> 4, k = i & 15;
      const float inv_freq = 1.0f / powf(10000.0f, (float)(2 * k) / 32.0f);
      const float ang = (float)pos * inv_freq;
      double f = (double)ang * 0.15915494309189535; f -= rint(f);
      ct[i] = __builtin_amdgcn_cosf((float)f); st[i] = __builtin_amdgcn_sinf((float)f);
    } }
  rmsnorm_phase(p.xin0, p.xin1, p.norm_mix, (u16*)(ws + OFF_H), nullptr, bid * 4 + (VT >> 6), nb * 4);
}

enum { EPI_BF16 = 0, EPI_RESID = 1, EPI_SWIGLU = 2 };
#define MFMA16(a, b, c) __builtin_amdgcn_mfma_f32_16x16x32_bf16((a), (b), (c), 0, 0, 0)
template <int EPI>
DI void gemm_phase(const u16* __restrict__ A, int lda, const u16* __restrict__ Bt, int K, int N, u16* outb, int ldo,
                   const float* r0, const float* r1, float* outf, char* lds, int bid, int nb) {
  const int tid = threadIdx.x, lane = tid & 63, wid = tid >> 6, wr = wid >> 2, wc = wid & 3, l15 = lane & 15, quad = lane >> 4;
  u16* As = (u16*)lds; u16* Bs = As + 2 * 256 * 64;
  const int nN = N >> 8, nM = M_TOT >> 8, nT = nM * nN, nk = K >> 6;
  const int lrow = tid >> 3, lch = tid & 7;
  const int sto = lrow * 64 + ((lch ^ ((lrow >> 1) & 7)) * 8);
  const int fsw = (l15 >> 1) & 7;
  const int fo0 = ((0 * 4 + quad) ^ fsw) * 8, fo1 = ((1 * 4 + quad) ^ fsw) * 8;
  const bool swz = (nb == 256);
  const int GN = (nN & 1) == 0 ? 2 : 1, GM = 32 / GN, nSN = nN / GN, nST = (nM / GM) * nSN;
  const int xcd = bid & 7, jb = bid >> 3;
  const int nIter = swz ? (nST - xcd + 7) / 8 : (nT - bid + nb - 1) / nb;
  for (int it = 0; it < nIter; ++it) {
    int tm, tn;
    if (swz) { const int st = xcd + 8 * it, sm = st / nSN, sn = st - sm * nSN; tm = sm * GM + jb / GN; tn = sn * GN + (jb % GN); }
    else { const int t = bid + it * nb; tm = t / nN; tn = t - tm * nN; }
    const u16* Ag = A + (size_t)(tm * 256 + lrow) * lda + lch * 8;
    const u16* Bg = Bt + (size_t)(tn * 256 + lrow) * K + lch * 8;
    f32x4 acc[8][4];
#pragma unroll
    for (int i = 0; i < 8; ++i)
#pragma unroll
      for (int j = 0; j < 4; ++j) acc[i][j] = (f32x4){0.f, 0.f, 0.f, 0.f};
    u32x4 ra[4], rb[4];
#define G_LOAD(KT) do { _Pragma("unroll") for (int i = 0; i < 4; ++i) { ra[i] = *(const u32x4*)(Ag + (size_t)i * 64 * lda + (KT) * 64); rb[i] = *(const u32x4*)(Bg + (size_t)i * 64 * K + (KT) * 64); } } while (0)
#define G_STORE(BUF) do { u16* ad = As + (BUF) * 256 * 64 + sto; u16* bd = Bs + (BUF) * 256 * 64 + sto; _Pragma("unroll") for (int i = 0; i < 4; ++i) { *(u32x4*)(ad + i * 64 * 64) = ra[i]; *(u32x4*)(bd + i * 64 * 64) = rb[i]; } } while (0)
#define G_MMA(BUF, FO) do { const u16* as = As + (BUF) * 256 * 64 + (wr * 128 + l15) * 64 + (FO); const u16* bs = Bs + (BUF) * 256 * 64 + (wc * 64 + l15) * 64 + (FO); \
        bf16x8 b_[4], a_[8]; \
        _Pragma("unroll") for (int j = 0; j < 4; ++j) b_[j] = *(const bf16x8*)(bs + j * 16 * 64); \
        _Pragma("unroll") for (int i = 0; i < 8; ++i) a_[i] = *(const bf16x8*)(as + i * 16 * 64); \
        __builtin_amdgcn_s_setprio(1); \
        _Pragma("unroll") for (int i = 0; i < 8; ++i) { _Pragma("unroll") for (int j = 0; j < 4; ++j) acc[i][j] = MFMA16(a_[i], b_[j], acc[i][j]); } \
        __builtin_amdgcn_s_setprio(0); } while (0)
    G_LOAD(0);
    G_STORE(0);
    __syncthreads();
    for (int kt = 0; kt < nk; ++kt) {
      const int cur = kt & 1;
      if (kt + 1 < nk) G_LOAD(kt + 1);
      G_MMA(cur, fo0);
      G_MMA(cur, fo1);
      if (kt + 1 < nk) G_STORE(cur ^ 1);
      __syncthreads();
    }
#undef G_LOAD
#undef G_STORE
#undef G_MMA
    const int mrow = tm * 256 + wr * 128 + quad * 4;
    if constexpr (EPI == EPI_BF16) {
      const int col = tn * 256 + wc * 64 + l15;
#pragma unroll
      for (int i = 0; i < 8; ++i)
#pragma unroll
        for (int r = 0; r < 4; ++r) {
          u16* o0 = outb + (size_t)(mrow + i * 16 + r) * ldo + col;
          o0[0] = f2bf(acc[i][0][r]); o0[16] = f2bf(acc[i][1][r]); o0[32] = f2bf(acc[i][2][r]); o0[48] = f2bf(acc[i][3][r]);
        }
    } else if constexpr (EPI == EPI_RESID) {
      const int col = tn * 256 + wc * 64 + l15;
      const float* rb_ = (tm * 256 < M_P) ? r0 : (r1 - (size_t)M_P * DM);
#pragma unroll
      for (int i = 0; i < 8; ++i)
#pragma unroll
        for (int r = 0; r < 4; ++r) {
          const size_t i0 = (size_t)(mrow + i * 16 + r) * DM + col;
          const float x0 = rb_[i0], x1 = rb_[i0 + 16], x2 = rb_[i0 + 32], x3 = rb_[i0 + 48];
          outf[i0] = x0 + acc[i][0][r]; outf[i0 + 16] = x1 + acc[i][1][r]; outf[i0 + 32] = x2 + acc[i][2][r]; outf[i0 + 48] = x3 + acc[i][3][r];
        }
    } else {
      const int col = (tn * 4 + wc) * 32 + l15;
#pragma unroll
      for (int i = 0; i < 8; ++i)
#pragma unroll
        for (int r = 0; r < 4; ++r) {
          const float g0 = acc[i][0][r], u0 = acc[i][2][r], g1 = acc[i][1][r], u1 = acc[i][3][r];
          u16* o0 = outb + (size_t)(mrow + i * 16 + r) * ldo + col;
          o0[0] = f2bf(g0 * sigmoidf_(g0) * u0); o0[16] = f2bf(g1 * sigmoidf_(g1) * u1);
        }
    }
  }
}

template <bool FINAL>
DI void rg_phase(const Params& p, char* lds, int bid, int nb) {
  const int tid = VT, lane = tid & 63, wid = tid >> 6, r32 = lane & 31, hi = lane >> 5;
  u16* xcb = (u16*)lds;
  float* A0 = (float*)(lds + 9216);
  float* U0 = (float*)(lds + 9216 + 16384);
  float* A1 = (float*)(lds + 9216 + 32768);
  float* U1 = (float*)(lds + 9216 + 49152);
  u16* raw = (u16*)A1;
  const u16* PROJ = (const u16*)(p.ws + OFF_PROJ);
  const u16* WG = (const u16*)(p.ws + WT_GATES);
  float* SUM = (float*)(p.ws + OFF_SUM);
  const float* CARRY = (const float*)(p.ws + OFF_CARRY);
  u16* Y = (u16*)(p.ws + OFF_Y);
  const int NIT = 768 * 8, nit = (NIT + nb - 1) / nb;
  const int mt = wid >> 1, nt = wid & 1;
  int cb_loaded = -1;
  float w0 = 0.f, w1 = 0.f, w2 = 0.f, w3 = 0.f, cbias = 0.f, bav[2] = {0.f, 0.f}, biv[2] = {0.f, 0.f}, spv[2] = {0.f, 0.f};
  u32x4 rr[3], rg[2], rrn[3], rgn[2];
  auto load_item = [&](int it, u32x4 (&xr)[3], u32x4 (&xg)[2]) {
    const int gc = it >> 3, cb = it & 7, m0 = gc * 64;
    int seq_lo, S; row_info(m0, seq_lo, S); const int seq_hi = seq_lo + S;
#pragma unroll
    for (int i = 0; i < 3; ++i) {
      const int c = tid + 256 * i, row = c >> 3, ch8 = c & 7, m = m0 - 2 + row;
      xr[i] = (c < 536 && m >= seq_lo && m < seq_hi) ? *(const u32x4*)(PROJ + (size_t)m * 2560 + cb * 64 + ch8 * 8) : (u32x4){0u, 0u, 0u, 0u};
    }
    if (FINAL) {
#pragma unroll
      for (int i = 0; i < 2; ++i) { const int c = tid + 256 * i, row = c >> 3, ch8 = c & 7; xg[i] = *(const u32x4*)(PROJ + (size_t)(m0 + row) * 2560 + 512 + cb * 64 + ch8 * 8); }
    }
  };
  { const int it = bid < NIT ? bid : NIT - 1; load_item(it, rr, rg); }
  for (int k = 0; k < nit; ++k) {
    const int it0 = bid + k * nb, it = it0 < NIT ? it0 : NIT - 1;
    const int gc = it >> 3, cb = it & 7, m0 = gc * 64;
    if (cb != cb_loaded) {
      cb_loaded = cb;
      const int cc = cb * 64 + (tid & 63);
      w0 = p.conv_w[cc]; w1 = p.conv_w[512 + cc]; w2 = p.conv_w[1024 + cc]; w3 = p.conv_w[1536 + cc]; cbias = p.conv_b[cc];
      const int cg_ = cb * 64 + nt * 32 + r32;
#pragma unroll
      for (int dir = 0; dir < 2; ++dir) { bav[dir] = p.b_a[dir * 512 + cg_]; biv[dir] = p.b_i[dir * 512 + cg_]; spv[dir] = log1pf(__expf(-p.lam[dir * 512 + cg_])); }
    }
    __syncthreads();
#pragma unroll
    for (int i = 0; i < 3; ++i) { const int c = tid + 256 * i; if (c < 536) *(u32x4*)(raw + c * 8) = rr[i]; }
    { const int itn0 = bid + (k + 1) * nb, itn = itn0 < NIT ? itn0 : NIT - 1; load_item(itn, rrn, rgn); }
    __syncthreads();
    {
      const int ch = tid & 63, t0 = (tid >> 6) * 16;
      float xm2 = bf2f(raw[(t0) * 64 + ch]), xm1 = bf2f(raw[(t0 + 1) * 64 + ch]), x0 = bf2f(raw[(t0 + 2) * 64 + ch]);
#pragma unroll
      for (int t = t0; t < t0 + 16; ++t) {
        const float xp1 = bf2f(raw[(t + 3) * 64 + ch]);
        xcb[t * 72 + ch] = f2bf(w0 * xm2 + w1 * xm1 + w2 * x0 + w3 * xp1 + cbias);
        xm2 = xm1; xm1 = x0; x0 = xp1;
      }
    }
    __syncthreads();
    {
      bf16x8 af[4];
#pragma unroll
      for (int ks = 0; ks < 4; ++ks) af[ks] = *(const bf16x8*)(xcb + (mt * 32 + r32) * 72 + ks * 16 + 8 * hi);
      const int ch = nt * 32 + r32;
      float xc[16];
#pragma unroll
      for (int reg = 0; reg < 16; ++reg) xc[reg] = bf2f(xcb[(mt * 32 + crow(reg, hi)) * 72 + ch]);
#pragma unroll
      for (int dir = 0; dir < 2; ++dir) {
        f32x16 aa = {}, ai = {};
        const u16* wga = WG + (size_t)((dir * 2 + 0) * 8 + cb) * 4096 + (nt * 32 + r32) * 64 + 8 * hi;
        const u16* wgi = WG + (size_t)((dir * 2 + 1) * 8 + cb) * 4096 + (nt * 32 + r32) * 64 + 8 * hi;
#pragma unroll
        for (int ks = 0; ks < 4; ++ks) { const bf16x8 ba = *(const bf16x8*)(wga + ks * 16), bi = *(const bf16x8*)(wgi + ks * 16); aa = MFMA32(af[ks], ba, aa); ai = MFMA32(af[ks], bi, ai); }
        float* Ab = dir == 0 ? A0 : A1; float* Ub = dir == 0 ? U0 : U1;
#pragma unroll
        for (int reg = 0; reg < 16; ++reg) {
          const int tok = mt * 32 + crow(reg, hi);
          const float r = sigmoidf_(aa[reg] + bav[dir]), gi = sigmoidf_(ai[reg] + biv[dir]);
          const float la2 = -8.f * 1.4426950408889634f * r * spv[dir], a = __builtin_amdgcn_exp2f(la2);
          const float mult = __builtin_amdgcn_sqrtf(fmaxf(0.f, 1.f - a * a));
          Ab[tok * 64 + ch] = a; Ub[tok * 64 + ch] = mult * gi * xc[reg];
        }
      }
    }
    __syncthreads();
    if (wid < 2) {
      const int dir = wid, ch = lane, c = cb * 64 + ch;
      float* Ab = dir == 0 ? A0 : A1; float* Ub = dir == 0 ? U0 : U1;
      if (!FINAL) {
        float h = 0.f, P = 1.f;
#pragma unroll 16
        for (int kk = 0; kk < 64; ++kk) { const int t = dir == 0 ? kk : 63 - kk; const float a = Ab[t * 64 + ch], u = Ub[t * 64 + ch]; h = a * h + u; P *= a; }
        SUM[(size_t)((gc * 2 + dir) * 2 + 0) * 512 + c] = P; SUM[(size_t)((gc * 2 + dir) * 2 + 1) * 512 + c] = h;
      } else {
        float h = CARRY[(size_t)(gc * 2 + dir) * 512 + c];
#pragma unroll 16
        for (int kk = 0; kk < 64; ++kk) { const int t = dir == 0 ? kk : 63 - kk; const float a = Ab[t * 64 + ch], u = Ub[t * 64 + ch]; h = a * h + u; Ub[t * 64 + ch] = h; }
      }
    }
    if (FINAL) {
      __syncthreads();
#pragma unroll
      for (int i = 0; i < 2; ++i) {
        const int c = tid + 256 * i, t = c >> 3, ch8 = c & 7;
        const f32x4 ha = *(const f32x4*)(U0 + t * 64 + ch8 * 8), hb = *(const f32x4*)(U0 + t * 64 + ch8 * 8 + 4);
        const f32x4 hc = *(const f32x4*)(U1 + t * 64 + ch8 * 8), hd = *(const f32x4*)(U1 + t * 64 + ch8 * 8 + 4);
        float hs[8] = {ha[0] + hc[0], ha[1] + hc[1], ha[2] + hc[2], ha[3] + hc[3], hb[0] + hd[0], hb[1] + hd[1], hb[2] + hd[2], hb[3] + hd[3]};
        float yv[8];
#pragma unroll
        for (int j = 0; j < 8; ++j) {
          const unsigned wv = rg[i][j >> 1];
          const float gt = __uint_as_float((j & 1) ? (wv & 0xffff0000u) : (wv << 16));
          const float ge = gt * sigmoidf_(1.5957691216057308f * (gt + 0.044715f * gt * gt * gt));
          yv[j] = ge * hs[j];
        }
        u32x4 o = {pk2(yv[0], yv[1]), pk2(yv[2], yv[3]), pk2(yv[4], yv[5]), pk2(yv[6], yv[7])};
        *(u32x4*)(Y + (size_t)(m0 + t) * 1024 + cb * 64 + ch8 * 8) = o;
      }
    }
#pragma unroll
    for (int i = 0; i < 3; ++i) rr[i] = rrn[i];
#pragma unroll
    for (int i = 0; i < 2; ++i) rg[i] = rgn[i];
  }
}

DI void rg_carry_phase(const Params& p, int bid, int nb) {
  const float* __restrict__ SUM = (const float*)(p.ws + OFF_SUM);
  float* __restrict__ CARRY = (float*)(p.ws + OFF_CARRY);
  for (int idx = bid * 256 + VT; idx < 8192; idx += nb * 256) {
    const int c = idx & 511, dir = (idx >> 9) & 1, seq = idx >> 10;
    const int gc0 = seq < 4 ? seq * 128 : 512 + (seq - 4) * 64, nch = seq < 4 ? 128 : 64;
    float carry = 0.f;
    for (int k0 = 0; k0 < nch; k0 += 8) {
      float P[8], Hh[8];
#pragma unroll
      for (int j = 0; j < 8; ++j) { const int k = k0 + j, gc = dir == 0 ? gc0 + k : gc0 + nch - 1 - k; P[j] = SUM[(size_t)((gc * 2 + dir) * 2 + 0) * 512 + c]; Hh[j] = SUM[(size_t)((gc * 2 + dir) * 2 + 1) * 512 + c]; }
#pragma unroll
      for (int j = 0; j < 8; ++j) { const int k = k0 + j, gc = dir == 0 ? gc0 + k : gc0 + nch - 1 - k; CARRY[(size_t)(gc * 2 + dir) * 512 + c] = carry; carry = P[j] * carry + Hh[j]; }
    }
  }
}

DI void dil_tile_info(int ti, int m0, int& d, int& u0) {
  if (ti < 5) { d = 16; u0 = m0 - 1024 + ti * 512; } else if (ti < 13) { d = 4; u0 = m0 - 256 + (ti - 5) * 128; } else { d = 1; u0 = m0 - 64 + (ti - 13) * 32; }
}
DI void dilated_phase(const Params& p, char* lds, int gw, int nw) {
  const int lane = VT & 63, wid = VT >> 6, r32 = lane & 31, hi = lane >> 5;
  u16* Vl = (u16*)(lds + wid * 10752);
  u16* Kl = Vl + 32 * 96;
  const unsigned vbase = (unsigned)(uintptr_t)Vl;
  const int li = lane & 15, tq = li >> 2, tp = li & 3, g1 = (lane >> 4) & 1;
  const unsigned trb = vbase + (4 * hi + tq) * 192 + (16 * g1 + 4 * tp) * 2;
  const u16* PROJ = (const u16*)(p.ws + OFF_PROJ);
  u16* Y = (u16*)(p.ws + OFF_Y);
  const int vrow = lane >> 3, vch = lane & 7;
  const int rb_ = gw >> 3, hf_ = (gw >> 2) & 1, w_ = gw & 3, rnb_ = nw >> 3;
  const bool remap = (rnb_ == 256);
  for (int itd = 0, id0 = gw; id0 < 12288; ++itd, id0 += nw) {
    int res, h, sp;
    if (remap) {
      const int xc = rb_ & 7, k = rb_ >> 3, G = itd * 256 + xc * 32 + 2 * (k >> 1) + (k & 1);
      const int hgrp = (G & 1) * 2 + hf_;
      res = hgrp + 4 * w_; h = (G >> 1) & 7; sp = G >> 4;
    } else { res = id0 & 15; h = (id0 >> 4) & 7; sp = id0 >> 7; }
    const int m0 = sp * 512 + res;
    int seq_lo, S; row_info(sp * 512, seq_lo, S); const int seq_hi = seq_lo + S;
    const int mq = m0 + 16 * r32;
    bf16x8 qf[4];
#pragma unroll
    for (int ks = 0; ks < 4; ++ks) qf[ks] = *(const bf16x8*)(PROJ + (size_t)mq * 2560 + 1024 + h * 64 + ks * 16 + 8 * hi);
    const float slope2 = exp2f(-(float)(h + 1)) * LOG2E;
    const float c1 = 0.125f * LOG2E;
    float m_run = -1e30f, l_run = 0.f; f32x16 o0 = {}, o1 = {};
    const u16* kbase = PROJ + 1536 + h * 64 + vch * 8;
    const u16* vbaseg = PROJ + 2048 + h * 64 + vch * 8;
    u32x4 kfA[4], kfB[4]; u32x4 vrA[4], vrB[4];
#define DIL_LOAD(KF, VR, TIV) do { int d_, u_; dil_tile_info((TIV), m0, d_, u_); \
      const int ur_ = min(max(u_ + d_ * r32, seq_lo), seq_hi - 1); \
      _Pragma("unroll") for (int i = 0; i < 4; ++i) { const int uv_ = min(max(u_ + d_ * (vrow + 8 * i), seq_lo), seq_hi - 1); VR[i] = *(const u32x4*)(vbaseg + (size_t)uv_ * 2560); KF[i] = *(const u32x4*)(kbase + (size_t)uv_ * 2560); } } while (0)
#define DIL_TILE(KF, VR, TIV) do { const int ti = (TIV); \
      int d, u0; dil_tile_info(ti, m0, d, u0); \
      _Pragma("unroll") \
      for (int i = 0; i < 4; ++i) { *(u32x4*)(Vl + (vrow + 8 * i) * 96 + vch * 8) = VR[i]; *(u32x4*)(Kl + (vrow + 8 * i) * 72 + vch * 8) = KF[i]; } \
      f32x16 pt = {}; \
      _Pragma("unroll") \
      for (int ks = 0; ks < 4; ++ks) pt = MFMA32(*(const bf16x8*)(Kl + r32 * 72 + ks * 16 + 8 * hi), qf[ks], pt); \
      if (ti + 2 < 33) DIL_LOAD(KF, VR, ti + 2);     \
      const s16x4 l00 = tr_read_o<0>(trb), h00 = tr_read_o<8 * 192>(trb), l01 = tr_read_o<64>(trb), h01 = tr_read_o<8 * 192 + 64>(trb); \
      const s16x4 l10 = tr_read_o<16 * 192>(trb), h10 = tr_read_o<24 * 192>(trb), l11 = tr_read_o<16 * 192 + 64>(trb), h11 = tr_read_o<24 * 192 + 64>(trb); \
      const float fd = (float)d, lim = 64.f * fd; \
      const float fdu0 = (float)(u0 - mq + d * 4 * hi); \
      const float lo_ = fmaxf((float)(seq_lo - mq), -lim), hi_ = fminf((float)(seq_hi - 1 - mq), lim); \
      const float mid = 0.5f * (lo_ + hi_), hw = 0.5f * (hi_ - lo_); \
      const float gdu0 = fdu0 - mid; \
      float pmax = -INFINITY; \
      _Pragma("unroll") \
      for (int reg = 0; reg < 16; ++reg) { \
        const float cf = (float)((reg & 3) + 8 * (reg >> 2)); \
        const float du = fmaf(fd, cf, fdu0), g = fmaf(fd, cf, gdu0); \
        const float tv = (__builtin_fabsf(g) <= hw) ? fmaf(__builtin_fabsf(du), -slope2, pt[reg] * c1) : -INFINITY; \
        pt[reg] = tv; pmax = max_nn(pmax, tv); \
      } \
      pmax = pl32_max(pmax); \
      if (__any(pmax > m_run)) { \
        const float mn = fmaxf(m_run, pmax), alpha = __builtin_amdgcn_exp2f(m_run - mn); \
        m_run = mn; l_run *= alpha; \
      _Pragma("unroll") \
        for (int reg = 0; reg < 16; ++reg) { o0[reg] *= alpha; o1[reg] *= alpha; } \
      } \
      float ps = 0.f; \
      _Pragma("unroll") \
      for (int reg = 0; reg < 16; ++reg) { pt[reg] = __builtin_amdgcn_exp2f(pt[reg] - m_run); ps += pt[reg]; } \
      ps = pl32_sum(ps); \
      l_run += ps; \
      const bf16x8 pb0 = pack8(pt, 0), pb1 = pack8(pt, 1); \
      LGKM0(); \
      o0 = MFMA32(cat4(l00, h00), pb0, o0); o0 = MFMA32(cat4(l10, h10), pb1, o0); \
      o1 = MFMA32(cat4(l01, h01), pb0, o1); o1 = MFMA32(cat4(l11, h11), pb1, o1); \
    } while (0)
    DIL_LOAD(kfA, vrA, 0);
    DIL_LOAD(kfB, vrB, 1);
#pragma unroll 1
    for (int tp2 = 0; tp2 < 32; tp2 += 2) { DIL_TILE(kfA, vrA, tp2); DIL_TILE(kfB, vrB, tp2 + 1); }
    DIL_TILE(kfA, vrA, 32);
#undef DIL_LOAD
#undef DIL_TILE
    const float inv = 1.f / l_run;
    u16* yo = Y + (size_t)mq * 1024 + 512 + h * 64 + 4 * hi;
#pragma unroll
    for (int g = 0; g < 4; ++g) {
      u32x2 w0 = {pk2(o0[4 * g] * inv, o0[4 * g + 1] * inv), pk2(o0[4 * g + 2] * inv, o0[4 * g + 3] * inv)};
      u32x2 w1 = {pk2(o1[4 * g] * inv, o1[4 * g + 1] * inv), pk2(o1[4 * g + 2] * inv, o1[4 * g + 3] * inv)};
      *(u32x2*)(yo + 8 * g) = w0; *(u32x2*)(yo + 32 + 8 * g) = w1;
    }
  }
}

DI void mla_norm_phase(const Params& p, int gw, int nw) {
  const int lane = threadIdx.x & 63;
  const u16* P2 = (const u16*)(p.ws + OFF_P2);
  u16* CQN = (u16*)(p.ws + OFF_CQN); u16* CKVN = (u16*)(p.ws + OFF_CKVN); u16* KR = (u16*)(p.ws + OFF_KR);
  const float* ct = (const float*)(p.ws + OFF_COS); const float* st = (const float*)(p.ws + OFF_SIN);
  float gq[6], gkv[4];
#pragma unroll
  for (int i = 0; i < 6; ++i) gq[i] = p.q_norm[6 * lane + i];
#pragma unroll
  for (int i = 0; i < 4; ++i) gkv[i] = p.kv_norm[4 * lane + i];
  for (int m = gw; m < M_TOT; m += nw) {
    const u16* src = P2 + (size_t)m * 768;
    const unsigned* s32 = (const unsigned*)src;
    const unsigned w0 = s32[3 * lane], w1 = s32[3 * lane + 1], w2 = s32[3 * lane + 2];
    const u32x2 wk = *(const u32x2*)(src + 384 + 4 * lane);
    float q[6] = {__uint_as_float(w0 << 16), __uint_as_float(w0 & 0xffff0000u), __uint_as_float(w1 << 16), __uint_as_float(w1 & 0xffff0000u), __uint_as_float(w2 << 16), __uint_as_float(w2 & 0xffff0000u)};
    float kv[4] = {__uint_as_float(wk[0] << 16), __uint_as_float(wk[0] & 0xffff0000u), __uint_as_float(wk[1] << 16), __uint_as_float(wk[1] & 0xffff0000u)};
    float sq = 0.f, skv = 0.f;
#pragma unroll
    for (int i = 0; i < 6; ++i) sq += q[i] * q[i];
#pragma unroll
    for (int i = 0; i < 4; ++i) skv += kv[i] * kv[i];
#pragma unroll
    for (int o = 32; o > 0; o >>= 1) { sq += __shfl_xor(sq, o); skv += __shfl_xor(skv, o); }
    const float rq = rsqrtf(sq * (1.f / 384.f) + 1e-6f), rkv = rsqrtf(skv * (1.f / 256.f) + 1e-6f);
    unsigned* dq = (unsigned*)(CQN + (size_t)m * 384) + 3 * lane;
    dq[0] = pk2(q[0] * rq * gq[0], q[1] * rq * gq[1]); dq[1] = pk2(q[2] * rq * gq[2], q[3] * rq * gq[3]); dq[2] = pk2(q[4] * rq * gq[4], q[5] * rq * gq[5]);
    u32x2 ok = {pk2(kv[0] * rkv * gkv[0], kv[1] * rkv * gkv[1]), pk2(kv[2] * rkv * gkv[2], kv[3] * rkv * gkv[3])};
    *(u32x2*)(CKVN + (size_t)m * 256 + 4 * lane) = ok;
    if (lane < 16) {
      const int pos = m < M_P ? (m & 8191) : ((m - M_P) & 4095);
      const float t1 = bf2f(src[640 + lane]), t2 = bf2f(src[656 + lane]);
      const float c = ct[pos * 16 + lane], s = st[pos * 16 + lane];
      KR[(size_t)m * 32 + lane] = f2bf(t1 * c - t2 * s); KR[(size_t)m * 32 + 16 + lane] = f2bf(t1 * s + t2 * c);
    }
  }
}

constexpr int KP = 104, VP = 96;
DI void mla_unit(const Params& p, char* lds, int seqbase, int S, int h, int qb) {
  const int tid = threadIdx.x, lane = tid & 63, wid = tid >> 6, r32 = lane & 31, hi = lane >> 5;
  u16* Kl = (u16*)lds;
  u16* Vl = (u16*)(lds + 3 * 64 * KP * 2);
  const unsigned vbase = (unsigned)(uintptr_t)Vl;
  const int li = lane & 15, tq = li >> 2, tp = li & 3, g1 = (lane >> 4) & 1;
  const unsigned trb = vbase + (4 * hi + tq) * (VP * 2) + (16 * g1 + 4 * tp) * 2;
  const u16* Q = (const u16*)(p.ws + OFF_Q); const u16* KV = (const u16*)(p.ws + OFF_KV); const u16* KR = (const u16*)(p.ws + OFF_KR);
  u16* O = (u16*)(p.ws + OFF_O);
  const float* ct = (const float*)(p.ws + OFF_COS); const float* st = (const float*)(p.ws + OFF_SIN);
  const int pos = qb * 256 + wid * 32 + r32, qrow = seqbase + pos;
  bf16x8 qf[6];
#pragma unroll
  for (int d0 = 0; d0 < 6; ++d0) qf[d0] = *(const bf16x8*)(Q + (size_t)qrow * 1536 + h * 96 + d0 * 16 + 8 * hi);
  const float C = 0.10206207261596577f * LOG2E;
#pragma unroll
  for (int j = 0; j < 8; ++j) {
    const float c = ct[pos * 16 + 8 * hi + j], s = st[pos * 16 + 8 * hi + j];
    const float t1 = bfs2f(qf[4][j]), t2 = bfs2f(qf[5][j]);
    qf[4][j] = (short)f2bf((t1 * c - t2 * s) * C); qf[5][j] = (short)f2bf((t1 * s + t2 * c) * C);
  }
#pragma unroll
  for (int d0 = 0; d0 < 4; ++d0)
#pragma unroll
    for (int j = 0; j < 8; ++j) qf[d0][j] = (short)f2bf(bfs2f(qf[d0][j]) * C);
  const int srow = tid >> 3, sc = tid & 7, rrow = (tid >> 2) & 63, rc = tid & 3;
  const bool kr_on = tid < 256;
  const u16* kvsrc = KV + (size_t)(seqbase + srow) * KVP + h * 128 + sc * 8;
  const u16* krsrc = KR + (size_t)(seqbase + rrow) * 32 + rc * 8;
  const int kdst0 = srow * KP + sc * 8, kdst2 = rrow * KP + 64 + rc * 8, vdst = srow * VP + sc * 8;
  float l_run = 0.f; f32x16 o0 = {}, o1 = {}, negm = {};
  const int nkt = S >> 6;
  u32x4 rkn, rkr, rvv;
#define MLA_GLOAD(T) do { rkn = *(const u32x4*)(kvsrc + (size_t)(T) * 64 * KVP); rvv = *(const u32x4*)(kvsrc + (size_t)(T) * 64 * KVP + 64); \
    if (kr_on) rkr = *(const u32x4*)(krsrc + (size_t)(T) * 64 * 32); } while (0)
#define MLA_LSTORE(B) do { u16* kd = Kl + (B) * 64 * KP; u16* vd = Vl + (B) * 64 * VP; *(u32x4*)(kd + kdst0) = rkn; *(u32x4*)(vd + vdst) = rvv; \
    if (kr_on) *(u32x4*)(kd + kdst2) = rkr; } while (0)
  MLA_GLOAD(0); MLA_LSTORE(0);
  MLA_GLOAD(1); MLA_LSTORE(1);
  __syncthreads();
  int cur = 0, nx2 = 2;
  if (wid >= 4) __builtin_amdgcn_s_setprio(1);
#pragma unroll 1
  for (int kt = 0; kt < nkt; ++kt) {
    if (kt + 2 < nkt) MLA_GLOAD(kt + 2);
    const u16* kl = Kl + cur * 64 * KP + r32 * KP + 8 * hi;
    f32x16 p0, p1;
    { const bf16x8 k0 = *(const bf16x8*)(kl), k1 = *(const bf16x8*)(kl + 32 * KP);
      p0 = MFMA32(k0, qf[0], negm); p1 = MFMA32(k1, qf[0], negm); }
#pragma unroll
    for (int d0 = 1; d0 < 6; ++d0) {
      const bf16x8 k0 = *(const bf16x8*)(kl + d0 * 16), k1 = *(const bf16x8*)(kl + 32 * KP + d0 * 16);
      p0 = MFMA32(k0, qf[d0], p0); p1 = MFMA32(k1, qf[d0], p1);
    }
    const unsigned tb = trb + cur * (64 * VP * 2);
    constexpr int R8 = 8 * VP * 2;
    const s16x4 a0 = tr_read_o<0>(tb), b0 = tr_read_o<R8>(tb), a1 = tr_read_o<2 * R8>(tb), b1 = tr_read_o<3 * R8>(tb);
    const s16x4 a2 = tr_read_o<4 * R8>(tb), b2 = tr_read_o<5 * R8>(tb), a3 = tr_read_o<6 * R8>(tb), b3 = tr_read_o<7 * R8>(tb);
    const s16x4 c0 = tr_read_o<64>(tb), d0_ = tr_read_o<R8 + 64>(tb), c1 = tr_read_o<2 * R8 + 64>(tb), d1 = tr_read_o<3 * R8 + 64>(tb);
    const s16x4 c2 = tr_read_o<4 * R8 + 64>(tb), d2 = tr_read_o<5 * R8 + 64>(tb), c3 = tr_read_o<6 * R8 + 64>(tb), d3 = tr_read_o<7 * R8 + 64>(tb);
    float pmax = max_nn(p0[0], p1[0]);
#pragma unroll
    for (int r = 1; r < 16; ++r) pmax = max_nn(pmax, max_nn(p0[r], p1[r]));
    pmax = pl32_max(pmax);
    if (kt == 0 || __any(pmax > 8.f)) {
      const float delta = kt == 0 ? pmax : fmaxf(pmax, 0.f);
      const float alpha = kt == 0 ? 1.f : __builtin_amdgcn_exp2f(-delta);
#pragma unroll
      for (int r = 0; r < 16; ++r) { negm[r] -= delta; p0[r] -= delta; p1[r] -= delta; o0[r] *= alpha; o1[r] *= alpha; }
      l_run *= alpha;
    }
    float ps = 0.f;
#pragma unroll
    for (int r = 0; r < 16; ++r) { p0[r] = __builtin_amdgcn_exp2f(p0[r]); p1[r] = __builtin_amdgcn_exp2f(p1[r]); ps += p0[r] + p1[r]; }
    ps = pl32_sum(ps);
    l_run += ps;
    const bf16x8 pb0 = pack8(p0, 0), pb1 = pack8(p0, 1), pb2 = pack8(p1, 0), pb3 = pack8(p1, 1);
    LGKM0();
    o0 = MFMA32(cat4(a0, b0), pb0, o0); o1 = MFMA32(cat4(c0, d0_), pb0, o1);
    o0 = MFMA32(cat4(a1, b1), pb1, o0); o1 = MFMA32(cat4(c1, d1), pb1, o1);
    o0 = MFMA32(cat4(a2, b2), pb2, o0); o1 = MFMA32(cat4(c2, d2), pb2, o1);
    o0 = MFMA32(cat4(a3, b3), pb3, o0); o1 = MFMA32(cat4(c3, d3), pb3, o1);
    __syncthreads();
    if (kt + 2 < nkt) MLA_LSTORE(nx2);
    cur = cur == 2 ? 0 : cur + 1; nx2 = nx2 == 2 ? 0 : nx2 + 1;
  }
  __builtin_amdgcn_s_setprio(0);
  __syncthreads();
#undef MLA_GLOAD
#undef MLA_LSTORE
  const float inv = 1.f / l_run;
  u16* oo = O + (size_t)qrow * 1024 + h * 64 + 4 * hi;
#pragma unroll
  for (int g = 0; g < 4; ++g) {
    u32x2 w0 = {pk2(o0[4 * g] * inv, o0[4 * g + 1] * inv), pk2(o0[4 * g + 2] * inv, o0[4 * g + 3] * inv)};
    u32x2 w1 = {pk2(o1[4 * g] * inv, o1[4 * g + 1] * inv), pk2(o1[4 * g + 2] * inv, o1[4 * g + 3] * inv)};
    *(u32x2*)(oo + 8 * g) = w0; *(u32x2*)(oo + 32 + 8 * g) = w1;
  }
}

DI void mla_attn_phase(const Params& p, char* lds, int xcd, int j, int nper) {
  for (int lu0 = j; lu0 - j < 8 * 32; lu0 += nper) { const int lu = lu0 < 8 * 32 ? lu0 : 8 * 32 - 1; const int bh = (lu >> 5) * 8 + xcd, qb = lu & 31; mla_unit(p, lds, (bh >> 4) * 8192, 8192, bh & 15, qb); }
  for (int lu0 = j; lu0 - j < 8 * 16; lu0 += nper) { const int lu = lu0 < 8 * 16 ? lu0 : 8 * 16 - 1; const int bh = (lu >> 4) * 8 + xcd, qb = lu & 15; mla_unit(p, lds, M_P + (bh >> 4) * 4096, 4096, bh & 15, qb); }
}

#define XB_TMO      128
#define XB_XCNT(j)  (256  + 64 * (j))
#define XB_XSUB(j)  (1280 + 64 * (j))
#define XB_XGEN(j)  (2304 + 64 * (j))
#define XB_TOP      3328
#define XB_TOPGEN   3392
#define XCD_BAR_WORDS 3456
#define XB_SPIN_CAP (1u << 20)
#define LAS __attribute__((address_space(3)))
DI unsigned xb_ld(unsigned* p) { return __hip_atomic_load(p, __ATOMIC_RELAXED, __HIP_MEMORY_SCOPE_AGENT); }
DI unsigned xb_add(unsigned* p, unsigned v) { return __hip_atomic_fetch_add(p, v, __ATOMIC_RELAXED, __HIP_MEMORY_SCOPE_AGENT); }
DI unsigned xb_xcc_id() { return (unsigned)__builtin_amdgcn_s_getreg((3 << 11) | 20) & 0xFu; }
#define XB_SPIN(cond, bar) do { unsigned _sp = 0; while (cond) { __builtin_amdgcn_s_sleep(1); \
    if ((++_sp & 255u) == 0u) { if (xb_ld(&(bar)[XB_TMO])) break; if (_sp > XB_SPIN_CAP) { atomicAdd(&(bar)[XB_TMO], 1u); break; } } } } while (0)
struct XcdBarrier { unsigned* bar; unsigned x; volatile LAS unsigned* st; };
DI XcdBarrier xcd_barrier_post(unsigned* bar, volatile LAS unsigned* st) {
  XcdBarrier b; b.bar = bar; b.x = xb_xcc_id(); b.st = st;
  if (threadIdx.x == 0) (void)xb_add(&bar[XB_XCNT(b.x)], 1u);
  return b;
}
DI void xcd_barrier_complete(unsigned* bar, unsigned x, unsigned& nloc, unsigned& nx) {
  const unsigned G = gridDim.x * gridDim.y * gridDim.z;
  unsigned sum, cnt, mine, sp = 0u;
  for (;;) {
    sum = 0u; cnt = 0u; mine = 0u;
#pragma unroll
    for (unsigned j = 0; j < 16; ++j) { const unsigned c = xb_ld(&bar[XB_XCNT(j)]); sum += c; cnt += (c > 0u) ? 1u : 0u; mine = (j == x) ? c : mine; }
    if (sum == G) break;
    __builtin_amdgcn_s_sleep(1);
    if ((++sp & 255u) == 0u) { if (xb_ld(&bar[XB_TMO])) break; if (sp > XB_SPIN_CAP) { atomicAdd(&bar[XB_TMO], 1u); break; } }
  }
  nloc = mine > 0u ? mine : 1u; nx = cnt > 0u ? cnt : 1u;
}
DI void xcd_barrier(const XcdBarrier& b) {
  asm volatile("s_waitcnt vmcnt(0)" ::: "memory");
  __syncthreads();
  if (threadIdx.x == 0) {
    unsigned* bar = b.bar;
    __builtin_amdgcn_s_waitcnt(0);
    unsigned nloc = b.st[0], nx = b.st[1];
    if (nloc == 0u) { xcd_barrier_complete(bar, b.x, nloc, nx); b.st[0] = nloc; b.st[1] = nx; }
    const unsigned old = xb_add(&bar[XB_XSUB(b.x)], 1u);
    const unsigned gen = old / nloc;
    if (old + 1u == (gen + 1u) * nloc) {
      __builtin_amdgcn_fence(__ATOMIC_RELEASE, "agent");
      asm volatile("s_waitcnt vmcnt(0)" ::: "memory");
      const unsigned og = xb_add(&bar[XB_TOP], 1u);
      const unsigned tg = og / nx;
      if (og + 1u == (tg + 1u) * nx) xb_add(&bar[XB_TOPGEN], 1u);
      else XB_SPIN(xb_ld(&bar[XB_TOPGEN]) == tg, bar);
      __builtin_amdgcn_fence(__ATOMIC_ACQUIRE, "agent");
      xb_add(&bar[XB_XGEN(b.x)], 1u);
      asm volatile("s_waitcnt vmcnt(0)" ::: "memory");
    } else {
      XB_SPIN(xb_ld(&bar[XB_XGEN(b.x)]) == gen, bar);
      __builtin_amdgcn_fence(__ATOMIC_ACQUIRE, "agent");
      asm volatile("s_waitcnt vmcnt(0)" ::: "memory");
    }
  }
  __syncthreads();
}

constexpr int N_PHASES = 19;
constexpr int HALF_LDS = 76800;
constexpr int LDS_BYTES = 2 * HALF_LDS;
__global__ void __launch_bounds__(512, 2) mega(Params p, int ph_lo, int ph_hi) {
  __shared__ __attribute__((aligned(16))) char lds_all[LDS_BYTES];
  const int rbid = blockIdx.x, rnb = gridDim.x;
  const int half = __builtin_amdgcn_readfirstlane((int)(threadIdx.x >> 8));
  const int bid = rbid * 2 + half, nb = rnb * 2;
  char* lds = lds_all + half * HALF_LDS;
  const int gw = bid * 4 + __builtin_amdgcn_readfirstlane(VT >> 6), nw = nb * 4;
  char* ws = p.ws;
  float* out1 = p.out + (size_t)M_P * DM;
  __shared__ uint4 xb_words;
  if (threadIdx.x == 0) xb_words = make_uint4(0u, 0u, 0u, 0u);
  __syncthreads();
  XcdBarrier xb; xb.bar = (unsigned*)(ws + OFF_BAR); xb.x = 0; xb.st = (volatile LAS unsigned*)&xb_words;
  if (ph_hi - ph_lo > 1) xb = xcd_barrier_post((unsigned*)(ws + OFF_BAR), (volatile LAS unsigned*)&xb_words);
  if (ph_lo < 0) cg::this_grid().sync();
#ifndef DUP_MASK
#define DUP_MASK 0
#endif
#define PHASE(k, ...) do { if (ph_lo <= (k) && (k) < ph_hi) { __VA_ARGS__ if ((DUP_MASK >> (k)) & 1) { xcd_barrier(xb); __VA_ARGS__ } } if (ph_lo <= (k) && (k) + 1 < ph_hi) xcd_barrier(xb); } while (0)
  PHASE(0, prep_phase(p, lds, bid, nb););
  PHASE(1, gemm_phase<EPI_BF16>((const u16*)(ws + OFF_H), 1024, (const u16*)(ws + WT_ABIN), 1024, 2560, (u16*)(ws + OFF_PROJ), 2560, nullptr, nullptr, nullptr, lds_all, rbid, rnb););
  PHASE(2, rg_phase<false>(p, lds, bid, nb); __syncthreads(); dilated_phase(p, lds, gw, nw););
  PHASE(3, rg_carry_phase(p, bid, nb););
  PHASE(4, rg_phase<true>(p, lds, bid, nb););
  PHASE(5, gemm_phase<EPI_RESID>((const u16*)(ws + OFF_Y), 1024, (const u16*)(ws + WT_ABOUT), 1024, 1024, nullptr, 0, p.xin0, p.xin1, p.out, lds_all, rbid, rnb););
  PHASE(6, rmsnorm_phase(p.out, out1, p.norm_ffn, (u16*)(ws + OFF_H), nullptr, gw, nw););
  PHASE(7, gemm_phase<EPI_SWIGLU>((const u16*)(ws + OFF_H), 1024, (const u16*)(ws + WT_GU0), 1024, 5632, (u16*)(ws + OFF_ACT), FH, nullptr, nullptr, nullptr, lds_all, rbid, rnb););
  PHASE(8, gemm_phase<EPI_RESID>((const u16*)(ws + OFF_ACT), FH, (const u16*)(ws + WT_DOWN0), FH, 1024, nullptr, 0, p.out, out1, p.out, lds_all, rbid, rnb););
  PHASE(9, rmsnorm_phase(p.out, out1, p.norm_mix + 1024, (u16*)(ws + OFF_H), nullptr, gw, nw););
  PHASE(10, gemm_phase<EPI_BF16>((const u16*)(ws + OFF_H), 1024, (const u16*)(ws + WT_MLAIN), 1024, 768, (u16*)(ws + OFF_P2), 768, nullptr, nullptr, nullptr, lds_all, rbid, rnb););
  PHASE(11, mla_norm_phase(p, gw, nw););
  PHASE(12, gemm_phase<EPI_BF16>((const u16*)(ws + OFF_CQN), 384, (const u16*)(ws + WT_QB), 384, 1536, (u16*)(ws + OFF_Q), 1536, nullptr, nullptr, nullptr, lds_all, rbid, rnb); gemm_phase<EPI_BF16>((const u16*)(ws + OFF_CKVN), 256, (const u16*)(ws + WT_KVB), 256, 2048, (u16*)(ws + OFF_KV), KVP, nullptr, nullptr, nullptr, lds_all, rbid, rnb););
  PHASE(13, mla_attn_phase(p, lds_all, rbid & 7, rbid >> 3, rnb >> 3););
  PHASE(14, gemm_phase<EPI_RESID>((const u16*)(ws + OFF_O), 1024, (const u16*)(ws + WT_MLAOUT), 1024, 1024, nullptr, 0, p.out, out1, p.out, lds_all, rbid, rnb););
  PHASE(15, rmsnorm_phase(p.out, out1, p.norm_ffn + 1024, (u16*)(ws + OFF_H), nullptr, gw, nw););
  PHASE(16, gemm_phase<EPI_SWIGLU>((const u16*)(ws + OFF_H), 1024, (const u16*)(ws + WT_GU1), 1024, 5632, (u16*)(ws + OFF_ACT), FH, nullptr, nullptr, nullptr, lds_all, rbid, rnb););
  PHASE(17, gemm_phase<EPI_RESID>((const u16*)(ws + OFF_ACT), FH, (const u16*)(ws + WT_DOWN1), FH, 1024, nullptr, 0, p.out, out1, p.out, lds_all, rbid, rnb););
  PHASE(18, rmsnorm_phase(p.out, out1, p.norm_final, nullptr, p.out, gw, nw););
#undef PHASE
}

extern "C" void kernel_launch(void* const* d_in, const int* in_sizes, int n_in, void* d_out, int out_size, void* d_ws, size_t ws_size, hipStream_t stream) {
  static int grid_blocks = 0;
  if (!grid_blocks) {
    int dev = 0, cus = 0, per_cu = 0;
    hipGetDevice(&dev);
    hipDeviceGetAttribute(&cus, hipDeviceAttributeMultiprocessorCount, dev);
    hipOccupancyMaxActiveBlocksPerMultiprocessor(&per_cu, mega, 512, 0);
    if (per_cu > 1) per_cu = 1;
    if (per_cu < 1) per_cu = 1;
    grid_blocks = cus * per_cu;
  }
  if (n_in != 23 || ws_size < WS_NEED) { fprintf(stderr, "kernel_launch: bad inputs n_in=%d ws=%zu\n", n_in, ws_size); return; }
  Params p{};
  p.xin0 = (const float*)d_in[0]; p.xin1 = (const float*)d_in[1];
  p.norm_mix = (const float*)d_in[2]; p.norm_ffn = (const float*)d_in[3]; p.norm_final = (const float*)d_in[4];
  p.ab_w_in = (const float*)d_in[5]; p.conv_w = (const float*)d_in[6]; p.conv_b = (const float*)d_in[7];
  p.w_a = (const float*)d_in[8]; p.b_a = (const float*)d_in[9]; p.w_i = (const float*)d_in[10]; p.b_i = (const float*)d_in[11];
  p.lam = (const float*)d_in[12]; p.ab_w_out = (const float*)d_in[13];
  p.mla_w_in = (const float*)d_in[14]; p.q_norm = (const float*)d_in[15]; p.w_qb = (const float*)d_in[16]; p.kv_norm = (const float*)d_in[17];
  p.w_kvb = (const float*)d_in[18]; p.mla_w_out = (const float*)d_in[19];
  p.w_gate = (const float*)d_in[20]; p.w_up = (const float*)d_in[21]; p.w_down = (const float*)d_in[22];
  p.out = (float*)d_out; p.ws = (char*)d_ws;
#if SINGLE_LAUNCH
  hipMemsetAsync((char*)d_ws + OFF_BAR, 0, XCD_BAR_WORDS * 4, stream);
  int lo = 0, hi = N_PHASES;
  void* args[] = {&p, &lo, &hi};
  hipError_t e = hipLaunchCooperativeKernel((void*)mega, dim3(grid_blocks), dim3(512), args, 0, stream);
  if (e != hipSuccess) fprintf(stderr, "cooperative launch failed: %s (grid %d)\n", hipGetErrorString(e), grid_blocks);
#else
  for (int ph = 0; ph < N_PHASES; ++ph) hipLaunchKernelGGL(mega, dim3(grid_blocks), dim3(512), 0, stream, p, ph, ph + 1);
#endif
}
```
